# Optimizing an MI355X kernel written in HIP

```python
import jax, jax.numpy as jnp
from jax import lax
import numpy as np

D_MODEL = 1024
BATCH = 4
SEQ = 8192
DEPTH = 4

CTX_LEN = 256
GRID_W = 64
EPS = 1e-6

FOURIER_GROUPS = 4
FOURIER_GD = 64
FOURIER_W = FOURIER_GROUPS * FOURIER_GD
ATT_HEADS = 8
ATT_KV_HEADS = 2
ATT_GROUP = ATT_HEADS // ATT_KV_HEADS
HEAD_DIM = 64
ATT_W = ATT_HEADS * HEAD_DIM
ATT_KV_W = ATT_KV_HEADS * HEAD_DIM
HG_HEADS = 4
HG_DK = 64
HG_DV = 64
HG_W = HG_HEADS * HG_DK
MIX_W = FOURIER_W + ATT_W + HG_W

OFF_FOURIER = 0
OFF_Q = OFF_FOURIER + FOURIER_W
OFF_K = OFF_Q + ATT_W
OFF_V = OFF_K + ATT_KV_W
OFF_FF = OFF_V + ATT_KV_W
OFF_FB = OFF_FF + HG_W
OFF_I = OFF_FB + HG_W
OFF_HQ = OFF_I + HG_W
OFF_G = OFF_HQ + HG_W
PROJ_W = OFF_G + HG_W

D_FF = -(-8 * D_MODEL // (3 * 256)) * 256
ROPE_THETA = 10000.0
Q_BLOCK = 128
HG_CHUNK = 64

kernel_name = "hybrid_fourier_gqa_hgrn2_dit_prefix"


def rmsnorm(x, gain=None):
    xf = x.astype(jnp.float32)
    y = xf * lax.rsqrt(jnp.mean(xf * xf, axis=-1, keepdims=True) + EPS)
    if gain is not None:
        y = y * gain.astype(jnp.float32)
    return y.astype(x.dtype)


def col(u, off, width, base=0):
    return u[..., off - base: off - base + width]


def axial_rope_tables(n):
    rows = n // GRID_W
    row = jnp.repeat(jnp.arange(rows), GRID_W).astype(jnp.float32)
    colp = jnp.tile(jnp.arange(GRID_W), rows).astype(jnp.float32)
    half = HEAD_DIM // 2
    freqs = ROPE_THETA ** (-jnp.arange(0, half, 2, dtype=jnp.float32) / half)
    ang_r = row[:, None] * freqs
    ang_c = colp[:, None] * freqs
    return (jnp.cos(ang_r), jnp.sin(ang_r), jnp.cos(ang_c), jnp.sin(ang_c))


def rope_axis(x, cos, sin):
    x1, x2 = jnp.split(x, 2, axis=-1)
    return jnp.concatenate([x1 * cos - x2 * sin, x1 * sin + x2 * cos], axis=-1)


def apply_axial_rope(x, tabs):
    cr, sr, cc, sc = tabs
    xf = x.astype(jnp.float32)
    xr, xc = jnp.split(xf, 2, axis=-1)
    return jnp.concatenate([rope_axis(xr, cr, sr), rope_axis(xc, cc, sc)], axis=-1).astype(x.dtype)


def fourier_mix(u, w):
    b, n, _ = u.shape
    z = u.astype(jnp.float32).reshape(b, n, FOURIER_GROUPS, FOURIER_GD)
    z = jnp.fft.fftn(z, axes=(1, 3), norm="ortho").real
    return z.reshape(b, n, FOURIER_W).astype(u.dtype) @ w


def attend(q, k, v):
    s = jnp.einsum('bkgqd,bksd->bkgqs', q, k).astype(jnp.float32) * (HEAD_DIM ** -0.5)
    p = jax.nn.softmax(s, axis=-1).astype(v.dtype)
    return jnp.einsum('bkgqs,bksd->bkgqd', p, v)


def attend_blocked(q, k, v):
    b, kh, g, n, d = q.shape
    nb = n // Q_BLOCK
    qb = jnp.moveaxis(q.reshape(b, kh, g, nb, Q_BLOCK, d), 3, 0)
    ob = lax.map(lambda qi: attend(qi, k, v), qb)
    return jnp.moveaxis(ob, 0, 3).reshape(b, kh, g, n, d)


def q_heads(u, gain):
    b, n, _ = u.shape
    return rmsnorm(u.reshape(b, n, ATT_HEADS, HEAD_DIM), gain).transpose(0, 2, 1, 3)


def kv_heads(u, gain=None):
    b, n, _ = u.shape
    return rmsnorm(u.reshape(b, n, ATT_KV_HEADS, HEAD_DIM), gain).transpose(0, 2, 1, 3) if gain is not None \
        else u.reshape(b, n, ATT_KV_HEADS, HEAD_DIM).transpose(0, 2, 1, 3)


def group_q(qh):
    b, h, n, d = qh.shape
    return qh.reshape(b, ATT_KV_HEADS, ATT_GROUP, n, d)


def ungroup(o):
    b, kh, g, n, d = o.shape
    return o.transpose(0, 3, 1, 2, 4).reshape(b, n, kh * g * d)


def attention_group(ux, uc, base_c, q_gain, k_gain, tabs, ctx_out):
    qx = group_q(apply_axial_rope(q_heads(col(ux, OFF_Q, ATT_W), q_gain), tabs))
    kx = apply_axial_rope(kv_heads(col(ux, OFF_K, ATT_KV_W), k_gain), tabs)
    vx = kv_heads(col(ux, OFF_V, ATT_KV_W))
    kc = kv_heads(col(uc, OFF_K, ATT_KV_W, base_c), k_gain)
    vc = kv_heads(col(uc, OFF_V, ATT_KV_W, base_c))
    k_all = jnp.concatenate([kc, kx], axis=2)
    v_all = jnp.concatenate([vc, vx], axis=2)
    out_x = ungroup(attend_blocked(qx, k_all, v_all))
    out_c = None
    if ctx_out:
        qc = group_q(q_heads(col(uc, OFF_Q, ATT_W, base_c), q_gain))
        out_c = ungroup(attend(qc, kc, vc))
    return out_x, out_c


def hgrn_scan(k, v, log_f, s0, q=None):
    b, h, n, dk = k.shape
    nc = n // HG_CHUNK
    with_out = q is not None

    def chunks(a):
        return jnp.moveaxis(a.reshape(b, h, nc, HG_CHUNK, a.shape[-1]), 2, 0)

    mask = jnp.tril(jnp.ones((HG_CHUNK, HG_CHUNK), dtype=bool))[:, :, None]

    def step(s, inp):
        kc, vc, lf = inp[0], inp[1], inp[2]
        cum = jnp.cumsum(lf, axis=2)
        last = cum[:, :, -1:, :]
        s_new = jnp.exp(last[:, :, 0, :])[..., None] * s + \
            jnp.einsum('bhsd,bhse->bhde', kc * jnp.exp(last - cum), vc)
        if not with_out:
            return s_new, None
        qc = inp[3]
        o_inter = jnp.einsum('bhtd,bhde->bhte', qc * jnp.exp(cum), s)
        diff = cum[:, :, :, None, :] - cum[:, :, None, :, :]
        decay = jnp.exp(jnp.where(mask, diff, -jnp.inf))
        att = jnp.einsum('bhtd,bhsd,bhtsd->bhts', qc, kc, decay)
        return s_new, o_inter + jnp.einsum('bhts,bhse->bhte', att, vc)

    xs = (chunks(k), chunks(v), chunks(log_f)) + ((chunks(q),) if with_out else ())
    s_fin, o = lax.scan(step, s0, xs)
    if with_out:
        o = jnp.moveaxis(o, 0, 2).reshape(b, h, n, v.shape[-1])
    return o, s_fin


def hg_heads(u):
    b, n, _ = u.shape
    return u.reshape(b, n, HG_HEADS, -1).transpose(0, 2, 1, 3).astype(jnp.float32)


def hg_gate(z, lb):
    lb = lb.reshape(HG_HEADS, 1, HG_DK)
    k = (1.0 - lb) * jax.nn.sigmoid(-z)
    log_f = jnp.log(lb + (1.0 - lb) * jax.nn.sigmoid(z))
    return k, log_f


def hg_readout(o, g, gain, dtype):
    b, h, n, dv = o.shape
    y = rmsnorm(o, gain).transpose(0, 2, 1, 3).reshape(b, n, h * dv)
    return (y * jax.nn.silu(g.astype(jnp.float32))).astype(dtype)


def hgrn_group(ux, uc, base_c, lb_dirs, gain, ctx_out):
    b = ux.shape[0]
    vx = hg_heads(col(ux, OFF_I, HG_W))
    qx = hg_heads(col(ux, OFF_HQ, HG_W))
    vc = hg_heads(col(uc, OFF_I, HG_W, base_c))
    qc = hg_heads(col(uc, OFF_HQ, HG_W, base_c)) if ctx_out else None
    s0 = jnp.zeros((b, HG_HEADS, HG_DK, HG_DV), jnp.float32)
    o_x = jnp.zeros_like(vx)
    o_c = jnp.zeros_like(vc) if ctx_out else None
    for d, (off, rev) in enumerate(((OFF_FF, False), (OFF_FB, True))):
        fl = (lambda a: jnp.flip(a, axis=2)) if rev else (lambda a: a)
        kx, lfx = hg_gate(hg_heads(col(ux, off, HG_W)), lb_dirs[d])
        kc, lfc = hg_gate(hg_heads(col(uc, off, HG_W, base_c)), lb_dirs[d])
        oc, s_ctx = hgrn_scan(fl(kc), fl(vc), fl(lfc), s0, fl(qc) if ctx_out else None)
        ox, _ = hgrn_scan(fl(kx), fl(vx), fl(lfx), s_ctx, fl(qx))
        o_x = o_x + fl(ox)
        if ctx_out:
            o_c = o_c + fl(oc)
    out_x = hg_readout(o_x, col(ux, OFF_G, HG_W), gain, ux.dtype)
    out_c = hg_readout(o_c, col(uc, OFF_G, HG_W, base_c), gain, uc.dtype) if ctx_out else None
    return out_x, out_c


def swiglu(h, wg, wu, wd):
    return (jax.nn.silu(h @ wg) * (h @ wu)) @ wd


def setup_inputs(seed: int = 0) -> dict:
    key = jax.random.key(seed)
    ks = jax.random.split(key, 18)
    nrm = jax.random.normal
    f32 = jnp.float32
    return {
        "x": nrm(ks[0], (BATCH, SEQ, D_MODEL), f32),
        "c": nrm(ks[1], (BATCH, D_MODEL), f32),
        "ctx": nrm(ks[2], (BATCH, CTX_LEN, D_MODEL), f32),
        "c_ctx": nrm(ks[3], (D_MODEL,), f32),
        "w_ada": nrm(ks[4], (DEPTH, D_MODEL, 6 * D_MODEL), f32) * D_MODEL ** -0.5,
        "b_ada": nrm(ks[5], (DEPTH, 6 * D_MODEL), f32) * 0.02,
        "w_in": nrm(ks[6], (DEPTH, D_MODEL, PROJ_W), f32) * D_MODEL ** -0.5,
        "w_four": nrm(ks[7], (DEPTH, FOURIER_W, FOURIER_W), f32) * FOURIER_W ** -0.5,
        "q_norm": 1.0 + 0.02 * nrm(ks[8], (DEPTH, HEAD_DIM), f32),
        "k_norm": 1.0 + 0.02 * nrm(ks[9], (DEPTH, HEAD_DIM), f32),
        "hg_lb_logits": 0.5 * nrm(ks[10], (2, DEPTH, HG_W), f32),
        "hg_norm": 1.0 + 0.02 * nrm(ks[11], (DEPTH, HG_DV), f32),
        "w_out": nrm(ks[12], (DEPTH, MIX_W, D_MODEL), f32) * MIX_W ** -0.5,
        "w_gate": nrm(ks[13], (DEPTH, D_MODEL, D_FF), f32) * D_MODEL ** -0.5,
        "w_up": nrm(ks[14], (DEPTH, D_MODEL, D_FF), f32) * D_MODEL ** -0.5,
        "w_down": nrm(ks[15], (DEPTH, D_FF, D_MODEL), f32) * D_FF ** -0.5,
        "final_norm": 1.0 + 0.02 * nrm(ks[16], (D_MODEL,), f32),
    }


def reference(x, c, ctx, c_ctx, w_ada, b_ada, w_in, w_four, q_norm, k_norm,
              hg_lb_logits, hg_norm, w_out, w_gate, w_up, w_down, final_norm):
    d = D_MODEL
    tabs = axial_rope_tables(x.shape[1])
    silu_c = jax.nn.silu(c)
    silu_cc = jax.nn.silu(c_ctx)
    lb_sm = jax.nn.softmax(hg_lb_logits.astype(jnp.float32), axis=1)
    lb_all = jnp.cumsum(lb_sm, axis=1) - lb_sm[:, :1]
    for l in range(DEPTH):
        ctx_out = l < DEPTH - 1
        mod = silu_c @ w_ada[l] + b_ada[l]
        sh_a, sc_a, g_a, sh_f, sc_f, g_f = jnp.split(mod[:, None, :], 6, axis=-1)
        n_c = 6 * d if ctx_out else 2 * d
        mc = jnp.split(silu_cc @ w_ada[l][:, :n_c] + b_ada[l][:n_c], n_c // d)
        hx = rmsnorm(x) * (1 + sc_a) + sh_a
        hc = rmsnorm(ctx) * (1 + mc[1]) + mc[0]
        ux = hx @ w_in[l]
        base_c = 0 if ctx_out else OFF_K
        uc = hc @ (w_in[l] if ctx_out else w_in[l][:, OFF_K:OFF_HQ])
        fx = fourier_mix(col(ux, OFF_FOURIER, FOURIER_W), w_four[l])
        ax, ac = attention_group(ux, uc, base_c, q_norm[l], k_norm[l], tabs, ctx_out)
        rx, rc = hgrn_group(ux, uc, base_c, lb_all[:, l], hg_norm[l], ctx_out)
        x = x + g_a * (jnp.concatenate([fx, ax, rx], axis=-1) @ w_out[l])
        x = x + g_f * swiglu(rmsnorm(x) * (1 + sc_f) + sh_f, w_gate[l], w_up[l], w_down[l])
        if ctx_out:
            fc = fourier_mix(col(uc, OFF_FOURIER, FOURIER_W), w_four[l])
            ctx = ctx + mc[2] * (jnp.concatenate([fc, ac, rc], axis=-1) @ w_out[l])
            ctx = ctx + mc[5] * swiglu(rmsnorm(ctx) * (1 + mc[4]) + mc[3], w_gate[l], w_up[l], w_down[l])
    return rmsnorm(x, final_norm)
```

```cpp
#include <hip/hip_runtime.h>
#include <hip/hip_bf16.h>
#include <cstdio>
#include <cstdint>
#include <cmath>
namespace pg8 {
#define PG8_LAS __attribute__((address_space(3)))
typedef unsigned short bf16_t;
typedef short bf16x8 __attribute__((ext_vector_type(8)));
typedef float f32x4 __attribute__((ext_vector_type(4)));
typedef unsigned u32x4 __attribute__((ext_vector_type(4)));
constexpr int BM = 256, BK = 64, HALF = 128, HTB = HALF * BK * 2  , STAGE_BYTES = 8 * HTB, NXCD = 8, WGM = 8;

__host__ __device__ __forceinline__ int lds_byte(int r, int c) { const int st = (r >> 4) * 2 + (c >> 5), rr = r & 15, cc = c & 31, ob = rr * 64 + cc * 2; return st * 1024 + (ob ^ (((ob >> 9) & 1) << 5)); }
__host__ __device__ __forceinline__ void stage_rc(int b, int& R, int& C) { const int st = b / 1024, sb = b % 1024, swz = sb ^ (((sb >> 9) & 1) << 5); R = (st >> 1) * 16 + swz / 64; C = (st & 1) * 32 + (swz % 64) / 2; }
__host__ __device__ __forceinline__ int perm32(int rho) { const int n = rho >> 4, i = rho & 15; return 8 * (i >> 2) + 4 * n + (i & 3); }

struct Unit { int pm, pn; };
struct Gemm { const bf16_t* A; const bf16_t* Bt; int M, N, K; };

struct StaticOrder {
    int nM, nN, nwg, G, c;
    __host__ __device__ void init(int M, int N, int G_, int c_) { nM = M / BM; nN = N / BM; nwg = nM * nN; G = G_; c = c_; }
    __host__ __device__ bool next(int i, Unit& u) const {
        const long L = (long)i * G + c; if (L >= nwg) return false;
        int wgid = (int)L; { const int q = nwg / NXCD, r = nwg % NXCD, xcd = wgid % NXCD, off = wgid / NXCD; wgid = (xcd < r ? xcd * (q + 1) : r * (q + 1) + (xcd - r) * q) + off; }
        const int nig = WGM * nN, gid = wgid / nig, fm = gid * WGM, gsz = (nM - fm) < WGM ? (nM - fm) : WGM;
        u.pm = fm + ((wgid % nig) % gsz); u.pn = (wgid % nig) / gsz; return true;
    }
    __device__ __forceinline__ void a_ready(const Unit&) const {}
    __device__ __forceinline__ void done(const Unit&) const {}
};

__device__ __forceinline__ unsigned cvt_pk_bf16(float lo, float hi) { unsigned r; asm volatile("v_cvt_pk_bf16_f32 %0, %1, %2" : "=v"(r) : "v"(lo), "v"(hi)); return r; }
typedef float f32x2 __attribute__((ext_vector_type(2)));
__device__ __forceinline__ f32x2 gelu_pk(f32x2 v) {
    const f32x2 av = __builtin_elementwise_abs(v), d = av * 0.2316418882f + 1.0f;
    f32x2 t; t.x = __builtin_amdgcn_rcpf(d.x); t.y = __builtin_amdgcn_rcpf(d.y);
    f32x2 q = t * 0.5307027145f + (-0.7265760135f); q = q * t + 0.7107068705f; q = q * t + (-0.142248368f); q = q * t + 0.127414796f; q = q * t;
    const f32x2 s = (v * v) * (-0.72134752044f);
    f32x2 e; e.x = __builtin_amdgcn_exp2f(s.x); e.y = __builtin_amdgcn_exp2f(s.y);
    const f32x2 m = v * (q * e), r = v - m;
    f32x2 o; o.x = v.x < 0.f ? m.x : r.x; o.y = v.y < 0.f ? m.y : r.y; return o;
}

template <int ACT  > struct EpiBf16 {
    static constexpr bool PERM = true, AFTER_DRAIN = false; static_assert(ACT == 0 || ACT == 1, "EpiBf16: ACT is 0 (none) or 1 (gelu_pk)");
    bf16_t* O; int ldc; const float* bias; int split_cols; size_t split_stride; float scale0;
    __device__ __forceinline__ void operator()(const f32x4 (&acc)[2][2][4][2], const Unit& u, int wr, int wc, int fr, int fq) const {
        const int row0 = u.pm * BM + wr * 64 + fr; int colt = u.pn * BM; bf16_t* base = O;
        float sc = 1.f; if (split_cols) { const int t = colt / split_cols; base += (size_t)t * split_stride; colt -= t * split_cols; if (t == 0) sc = scale0; }
        const int col0 = colt + wc * 32 + 8 * fq, bcol0 = u.pn * BM + wc * 32 + 8 * fq;
        f32x4 bv[2][2];
#pragma unroll
        for (int bj = 0; bj < 2; ++bj)
#pragma unroll
            for (int n = 0; n < 2; ++n) bv[bj][n] = bias ? *(const f32x4*)(bias + bcol0 + bj * HALF + 4 * n) : (f32x4){0.f, 0.f, 0.f, 0.f};
#pragma unroll
        for (int ai = 0; ai < 2; ++ai)
#pragma unroll
            for (int m = 0; m < 4; ++m) { bf16_t* rowp = base + (size_t)(row0 + ai * HALF + m * 16) * ldc + col0;
#pragma unroll
                for (int bj = 0; bj < 2; ++bj) { f32x4 v0 = acc[ai][bj][m][0] + bv[bj][0], v1 = acc[ai][bj][m][1] + bv[bj][1];
                    if (ACT == 1) { f32x2 a = gelu_pk((f32x2){v0[0], v0[1]}), b = gelu_pk((f32x2){v0[2], v0[3]}), c = gelu_pk((f32x2){v1[0], v1[1]}), d = gelu_pk((f32x2){v1[2], v1[3]});
                        v0 = (f32x4){a.x, a.y, b.x, b.y}; v1 = (f32x4){c.x, c.y, d.x, d.y}; }
                    v0 = v0 * sc; v1 = v1 * sc; u32x4 w; w.x = cvt_pk_bf16(v0[0], v0[1]); w.y = cvt_pk_bf16(v0[2], v0[3]); w.z = cvt_pk_bf16(v1[0], v1[1]); w.w = cvt_pk_bf16(v1[2], v1[3]);
                    *(u32x4*)(rowp + bj * HALF) = w; } }
    }
};
template <class Epi, class Sched, bool ALIGN_EPI = false, bool SP2 = false>
__device__ __forceinline__ void gemm_phase(PG8_LAS unsigned char* lds, const Gemm g, const Sched& S, const Epi& E) {
    int tid_ = threadIdx.x; asm volatile("" : "+v"(tid_));
    const int tid = tid_, wid = __builtin_amdgcn_readfirstlane(tid >> 6), lane = tid & 63, wr = wid >> 2, wc = wid & 3, fr = lane & 15, fq = lane >> 4;
    const int K = g.K, nt = K / BK;
    unsigned voffA[2], voffB[2];
#pragma unroll
    for (int i = 0; i < 2; ++i) { int R, C; stage_rc(tid * 16 + i * 8192, R, C); const int Rb = Epi::PERM ? ((R & ~31) + perm32(R & 31)) : R;
        voffA[i] = (unsigned)(R * K + C) * 2u; voffB[i] = (unsigned)(Rb * K + C) * 2u; }
    const size_t kstep = (size_t)(BK * 2);
    const size_t hstep = (size_t)HALF * K * 2;
    const size_t tstep = 2 * hstep;
    const unsigned ldsw = (unsigned)wid * 1024u;
    const int aoff = lds_byte(wr * 64 + fr, fq * 8), boff = lds_byte(wc * 32 + fr, fq * 8);
#define PG8_SA(b, h) (((b) * 2 + (h)) * HTB)
#define PG8_SB(b, h) ((4 + (b) * 2 + (h)) * HTB)
#define PG8_STAGE(bufoff, gbase, voff) do { _Pragma("unroll") for (int _i = 0; _i < 2; ++_i) \
        __builtin_amdgcn_global_load_lds((const unsigned*)((const char*)(gbase) + (voff)[_i]), (PG8_LAS unsigned*)(lds + (bufoff) + ldsw + _i * 8192), 16, 0, 0); } while (0)
#define PG8_LDA(dst, b, h) do { _Pragma("unroll") for (int m = 0; m < 4; ++m) _Pragma("unroll") for (int k = 0; k < 2; ++k) dst[m][k] = *(const PG8_LAS bf16x8*)(lds + PG8_SA(b, h) + aoff + m * 2048 + k * 1024); } while (0)
#define PG8_LDB(dst, b, h) do { _Pragma("unroll") for (int n = 0; n < 2; ++n) _Pragma("unroll") for (int k = 0; k < 2; ++k) dst[n][k] = *(const PG8_LAS bf16x8*)(lds + PG8_SB(b, h) + boff + n * 2048 + k * 1024); } while (0)
#define PG8_MMA(ai, bj, At, Bt) do { __builtin_amdgcn_s_setprio(1); _Pragma("unroll") for (int m = 0; m < 4; ++m) _Pragma("unroll") for (int n = 0; n < 2; ++n) _Pragma("unroll") for (int k = 0; k < 2; ++k) \
        acc[ai][bj][m][n] = __builtin_amdgcn_mfma_f32_16x16x32_bf16(Bt[n][k], At[m][k], acc[ai][bj][m][n], 0, 0, 0); __builtin_amdgcn_s_setprio(0); } while (0)
#define PG8_WAIT_V(n) asm volatile("s_waitcnt vmcnt(" #n ")" ::: "memory")
#define PG8_WAIT_L(n) asm volatile("s_waitcnt lgkmcnt(" #n ")" ::: "memory")
#define PG8_BAR __builtin_amdgcn_s_barrier()
#define PG8_SCHED __builtin_amdgcn_sched_barrier(0)
    Unit cur, nxt; int ui = 0;
    if (!S.next(0, cur)) return;
    f32x4 acc[2][2][4][2];
#pragma unroll
    for (int a = 0; a < 2; ++a)
#pragma unroll
        for (int b = 0; b < 2; ++b)
#pragma unroll
            for (int m = 0; m < 4; ++m)
#pragma unroll
                for (int n = 0; n < 2; ++n) acc[a][b][m][n] = (f32x4){0.f, 0.f, 0.f, 0.f};
    bf16x8 At[4][2], B0[2][2], B1[2][2];
    const char* cA = (const char*)g.A + (size_t)cur.pm * tstep; const char* cB = (const char*)g.Bt + (size_t)cur.pn * tstep;
    S.a_ready(cur);
    if constexpr (SP2) {
        PG8_STAGE(PG8_SB(0, 0), cB, voffB); PG8_STAGE(PG8_SB(0, 1), cB + hstep, voffB); PG8_STAGE(PG8_SA(0, 0), cA, voffA); PG8_STAGE(PG8_SA(0, 1), cA + hstep, voffA);
        if (wr == 1) PG8_BAR;
        PG8_WAIT_V(2); PG8_BAR;
        PG8_STAGE(PG8_SB(1, 0), cB + kstep, voffB); PG8_STAGE(PG8_SA(1, 0), cA + kstep, voffA); PG8_STAGE(PG8_SB(1, 1), cB + hstep + kstep, voffB);
        PG8_WAIT_V(6); PG8_BAR;
    } else {
        PG8_STAGE(PG8_SB(0, 0), cB, voffB); PG8_STAGE(PG8_SA(0, 0), cA, voffA); PG8_STAGE(PG8_SB(0, 1), cB + hstep, voffB); PG8_STAGE(PG8_SA(0, 1), cA + hstep, voffA);
        if (wr == 1) PG8_BAR;
        PG8_WAIT_V(4); PG8_BAR;
        PG8_STAGE(PG8_SB(1, 0), cB + kstep, voffB); PG8_STAGE(PG8_SA(1, 0), cA + kstep, voffA); PG8_STAGE(PG8_SB(1, 1), cB + hstep + kstep, voffB);
        PG8_WAIT_V(6); PG8_BAR;
    }
    for (;;) {
        const bool has_next = S.next(ui + 1, nxt);
        const char* nA = has_next ? (const char*)g.A + (size_t)nxt.pm * tstep : cA; const char* nB = has_next ? (const char*)g.Bt + (size_t)nxt.pn * tstep : cB;
        for (int t = 0; t < nt; t += 2) {
            const bool last = (t == nt - 2);
            const char* a1 = cA + (size_t)(t + 1) * kstep;
            const char* a2 = last ? nA : cA + (size_t)(t + 2) * kstep; const char* b2 = last ? nB : cB + (size_t)(t + 2) * kstep;
            const char* a3 = a2 + kstep; const char* b3 = b2 + kstep;
            if (last && has_next) S.a_ready(nxt);
            if constexpr (SP2) {
            PG8_LDB(B0, 0, 0); PG8_LDB(B1, 0, 1); PG8_SCHED; PG8_LDA(At, 0, 0); PG8_STAGE(PG8_SA(1, 1), a1 + hstep, voffA);
            PG8_WAIT_V(8); PG8_WAIT_L(0); PG8_BAR; PG8_MMA(0, 0, At, B0); PG8_MMA(0, 1, At, B1); PG8_BAR; PG8_SCHED;
            PG8_LDA(At, 0, 1); PG8_STAGE(PG8_SB(0, 0), b2, voffB); PG8_STAGE(PG8_SB(0, 1), b2 + hstep, voffB); PG8_STAGE(PG8_SA(0, 0), a2, voffA);
            PG8_WAIT_V(8); PG8_WAIT_L(0); PG8_BAR; PG8_MMA(1, 0, At, B0); PG8_MMA(1, 1, At, B1); PG8_BAR; PG8_SCHED;
            PG8_LDB(B0, 1, 0); PG8_LDB(B1, 1, 1); PG8_SCHED; PG8_LDA(At, 1, 0); PG8_STAGE(PG8_SA(0, 1), a2 + hstep, voffA);
            PG8_WAIT_V(8); PG8_WAIT_L(0); PG8_BAR; PG8_MMA(0, 0, At, B0); PG8_MMA(0, 1, At, B1); PG8_BAR; PG8_SCHED;
            PG8_LDA(At, 1, 1); PG8_STAGE(PG8_SB(1, 0), b3, voffB); PG8_STAGE(PG8_SB(1, 1), b3 + hstep, voffB); PG8_STAGE(PG8_SA(1, 0), a3, voffA);
            PG8_WAIT_V(8); PG8_WAIT_L(0); PG8_BAR; PG8_MMA(1, 0, At, B0); PG8_MMA(1, 1, At, B1); PG8_BAR; PG8_SCHED;
            } else {
            PG8_LDB(B0, 0, 0); PG8_SCHED; PG8_LDA(At, 0, 0); PG8_STAGE(PG8_SA(1, 1), a1 + hstep, voffA);
            PG8_WAIT_L(8); PG8_BAR; PG8_WAIT_L(0); PG8_MMA(0, 0, At, B0); PG8_BAR; PG8_SCHED;
            PG8_LDB(B1, 0, 1); PG8_STAGE(PG8_SB(0, 0), b2, voffB);
            PG8_BAR; PG8_WAIT_L(0); PG8_MMA(0, 1, At, B1); PG8_BAR;
            PG8_LDA(At, 0, 1); PG8_STAGE(PG8_SA(0, 0), a2, voffA);
            PG8_BAR; PG8_WAIT_L(0); PG8_MMA(1, 0, At, B0); PG8_BAR; PG8_SCHED;
            PG8_STAGE(PG8_SB(0, 1), b2 + hstep, voffB);
            PG8_WAIT_V(6); PG8_BAR; PG8_MMA(1, 1, At, B1); PG8_BAR;
            PG8_LDB(B0, 1, 0); PG8_SCHED; PG8_LDA(At, 1, 0); PG8_STAGE(PG8_SA(0, 1), a2 + hstep, voffA);
            PG8_WAIT_L(8); PG8_BAR; PG8_WAIT_L(0); PG8_MMA(0, 0, At, B0); PG8_BAR; PG8_SCHED;
            PG8_LDB(B1, 1, 1); PG8_STAGE(PG8_SB(1, 0), b3, voffB);
            PG8_BAR; PG8_WAIT_L(0); PG8_MMA(0, 1, At, B1); PG8_BAR;
            PG8_LDA(At, 1, 1); PG8_STAGE(PG8_SA(1, 0), a3, voffA);
            PG8_BAR; PG8_WAIT_L(0); PG8_MMA(1, 0, At, B0); PG8_BAR; PG8_SCHED;
            PG8_STAGE(PG8_SB(1, 1), b3 + hstep, voffB);
            PG8_WAIT_V(6); PG8_BAR; PG8_MMA(1, 1, At, B1); PG8_BAR;
            }
        }
        if constexpr (ALIGN_EPI) { if (wr == 0) PG8_BAR; }
        if constexpr (!Epi::AFTER_DRAIN) { E(acc, cur, wr, wc, fr, fq); S.done(cur); }
        if (!has_next) break;
#pragma unroll
        for (int a = 0; a < 2; ++a)
#pragma unroll
            for (int b = 0; b < 2; ++b)
#pragma unroll
                for (int m = 0; m < 4; ++m)
#pragma unroll
                    for (int n = 0; n < 2; ++n) acc[a][b][m][n] = (f32x4){0.f, 0.f, 0.f, 0.f};
        cur = nxt; cA = nA; cB = nB; ++ui;
        if constexpr (ALIGN_EPI) { if (wr == 1) PG8_BAR; }
    }
    PG8_WAIT_V(0);
    if constexpr (!ALIGN_EPI) { if (wr == 0) PG8_BAR; }
    PG8_BAR;
    if constexpr (Epi::AFTER_DRAIN) { E.fused(acc, cur, wr, wc, fr, fq, lds, wid, lane); S.done(cur); }
#undef PG8_SA
#undef PG8_SB
#undef PG8_STAGE
#undef PG8_LDA
#undef PG8_LDB
#undef PG8_MMA
#undef PG8_WAIT_V
#undef PG8_WAIT_L
#undef PG8_BAR
#undef PG8_SCHED
}
}
namespace pg8 {
struct EpiResGate {
    static constexpr bool PERM = false, AFTER_DRAIN = false;
    const float* in_lat; const float* in_ctx; float* out_lat; float* out_ctx; const float* gate;
    __device__ __forceinline__ void operator()(const f32x4 (&acc)[2][2][4][2], const Unit& u, int wr, int wc, int fr, int fq) const {
        const int b = u.pm / 33, p = u.pm % 33, bb = (p == 0) ? 4 : b;
        const size_t pbase = (p == 0) ? (size_t)b * 256 * 1024 : ((size_t)b * 8192 + (size_t)(p - 1) * 256) * 1024;
        const float* ib = ((p == 0) ? in_ctx : in_lat) + pbase; float* ob = ((p == 0) ? out_ctx : out_lat) + pbase;
        const int col0 = u.pn * BM + wc * 32 + 4 * fq;
        const float* gp = gate + bb * 6144 + col0;
        f32x4 gv[2][2];
#pragma unroll
        for (int bj = 0; bj < 2; ++bj)
#pragma unroll
            for (int n = 0; n < 2; ++n) gv[bj][n] = *(const f32x4*)(gp + bj * HALF + n * 16);
#pragma unroll
        for (int ai = 0; ai < 2; ++ai)
#pragma unroll
            for (int m = 0; m < 4; ++m) { const size_t off = (size_t)(ai * HALF + wr * 64 + m * 16 + fr) * 1024 + col0;
#pragma unroll
                for (int bj = 0; bj < 2; ++bj)
#pragma unroll
                    for (int n = 0; n < 2; ++n) { const f32x4 xv = *(const f32x4*)(ib + off + bj * HALF + n * 16);
                        *(f32x4*)(ob + off + bj * HALF + n * 16) = xv + gv[bj][n] * acc[ai][bj][m][n]; }
                asm volatile("" ::: "memory"); }
    }
};
struct EpiSwiGLU {
    static constexpr bool PERM = true, AFTER_DRAIN = false;
    bf16_t* O; int ldc;
    __device__ __forceinline__ void operator()(const f32x4 (&acc)[2][2][4][2], const Unit& u, int wr, int wc, int fr, int fq) const {
        const int row0 = u.pm * BM + wr * 64 + fr, col0 = u.pn * HALF + wc * 32 + 8 * fq;
#pragma unroll
        for (int ai = 0; ai < 2; ++ai)
#pragma unroll
            for (int m = 0; m < 4; ++m) { bf16_t* rowp = O + (size_t)(row0 + ai * HALF + m * 16) * ldc + col0;
                float hv[8];
#pragma unroll
                for (int n = 0; n < 2; ++n)
#pragma unroll
                    for (int e = 0; e < 4; ++e) { const float g = acc[ai][0][m][n][e], up = acc[ai][1][m][n][e];
                        hv[n * 4 + e] = g * up * __builtin_amdgcn_rcpf(1.0f + __builtin_amdgcn_exp2f(-1.44269504089f * g)); }
                u32x4 w; w.x = cvt_pk_bf16(hv[0], hv[1]); w.y = cvt_pk_bf16(hv[2], hv[3]); w.z = cvt_pk_bf16(hv[4], hv[5]); w.w = cvt_pk_bf16(hv[6], hv[7]);
                *(u32x4*)rowp = w; }
    }
};
}
#ifndef PG8_SP2
#define PG8_SP2 true
#endif
#ifndef PG8_ALIGN
#define PG8_ALIGN true
#endif

constexpr int NWAVES = 8, NTHREADS = NWAVES * 64;
constexpr int DM = 1024, NB = 4, SEQ = 8192, CTXL = 256, DEPTH = 4;
constexpr int TPB = SEQ + CTXL;
constexpr int MROWS = NB * TPB;
constexpr int PROJ = 2304, DFF = 2816, KMIX = 1280;
constexpr int OFF_Q = 256, OFF_K = 768, OFF_V = 896, OFF_FF = 1024, OFF_FB = 1280, OFF_I = 1536, OFF_HQ = 1792, OFF_G = 2048;
constexpr int MIX_P = 0, MIX_Q = 256, MIX_A = 512, MIX_R = 1024;
constexpr float EPS = 1e-6f;
constexpr float QSCALE = 0.125f * 1.4426950408889634f;
constexpr int MOD_SH_A = 0, MOD_SC_A = 1024, MOD_G_A = 2048, MOD_SH_F = 3072, MOD_SC_F = 4096, MOD_G_F = 5120;

constexpr size_t MiB = 1u << 20;
constexpr size_t WS_CTL = 0, CTL_ZERO_BYTES = 1 * MiB;
constexpr size_t WS_MODS = 1 * MiB;
constexpr size_t WS_LB = WS_MODS + 512 * 1024;
constexpr size_t WS_ROPE = 2 * MiB;
constexpr size_t WS_TF = 4 * MiB;
constexpr size_t WS_XC = 6 * MiB;
constexpr size_t WS_WIN = 10 * MiB;
constexpr size_t WS_WOUT = 28 * MiB;
constexpr size_t WS_WGU = 38 * MiB;
constexpr size_t WS_WDN = 82 * MiB;
constexpr size_t WS_HN = 104 * MiB;
constexpr size_t WS_HGS = 170 * MiB;
constexpr size_t WS_UX = 236 * MiB;
constexpr size_t WS_MIX = 385 * MiB;
constexpr size_t WS_H = WS_UX;
constexpr size_t WS_END = 468 * MiB;
static_assert(WS_UX + (size_t)MROWS * PROJ * 2 <= WS_MIX && WS_MIX + (size_t)MROWS * KMIX * 2 <= WS_END && WS_H + (size_t)MROWS * DFF * 2 <= WS_END, "d_ws map");
static_assert(WS_HN + (size_t)MROWS * DM * 2 <= WS_HGS && WS_HGS + (size_t)2 * MROWS * 256 * 4 <= WS_UX, "d_ws map 2");
constexpr int CW_TMO = 0, CW_CODE = 1, CW_BAR = 4096;

constexpr int RING_OFF = 0, RING_BYTES = 131072;
constexpr int LDSCTL_OFF = RING_BYTES, MISC_OFF = LDSCTL_OFF + 320;
constexpr int LDS_BYTES = 147456;

#define GAS __attribute__((address_space(1)))
#define LAS __attribute__((address_space(3)))
typedef unsigned short bf16;
typedef unsigned v4u __attribute__((ext_vector_type(4)));
typedef float f32x4 __attribute__((ext_vector_type(4)));
typedef short bf16x8 __attribute__((ext_vector_type(8)));
typedef GAS unsigned gu32;
typedef GAS unsigned long long gu64;
#define RLX_AGENT __ATOMIC_RELAXED, __HIP_MEMORY_SCOPE_AGENT
#define LDS_WAIT() asm volatile("s_waitcnt lgkmcnt(0)" ::: "memory")
#define VM_WAIT() asm volatile("s_waitcnt vmcnt(0)" ::: "memory")
__device__ __forceinline__ unsigned long long rt() { return __builtin_amdgcn_s_memrealtime(); }
__device__ __forceinline__ unsigned f2bf(float f) { unsigned u = __builtin_bit_cast(unsigned, f); return (u + 0x7fffu + ((u >> 16) & 1u)) >> 16; }
__device__ __forceinline__ unsigned pk2(float lo, float hi) { return f2bf(lo) | (f2bf(hi) << 16); }

#define XB_TMO      128
#define XB_XCNT(j)  (256  + 64 * (j))
#define XB_XSUB(j)  (1280 + 64 * (j))
#define XB_XGEN(j)  (2304 + 64 * (j))
#define XB_TOP      3328
#define XB_TOPGEN   3392
#define XCD_BAR_WORDS 3456
#define XB_SPIN_CAP (1u << 18)

__device__ __forceinline__ unsigned xb_ld(unsigned* p)              { return __hip_atomic_load(p, __ATOMIC_RELAXED, __HIP_MEMORY_SCOPE_AGENT); }
__device__ __forceinline__ unsigned xb_add(unsigned* p, unsigned v) { return __hip_atomic_fetch_add(p, v, __ATOMIC_RELAXED, __HIP_MEMORY_SCOPE_AGENT); }
__device__ __forceinline__ unsigned xb_xcc_id() { return (unsigned)__builtin_amdgcn_s_getreg((3 << 11) | 20) & 0xFu; }
#define XB_SPIN(cond, bar) do { unsigned _sp = 0; while (cond) { __builtin_amdgcn_s_sleep(1); \
    if ((++_sp & 255u) == 0u) { if (xb_ld(&(bar)[XB_TMO])) break; if (_sp > XB_SPIN_CAP) { atomicAdd(&(bar)[XB_TMO], 1u); break; } } } } while (0)

struct XcdBarrier {
    unsigned* bar; unsigned x;
    volatile LAS unsigned* st;
};

__device__ __forceinline__ XcdBarrier xcd_barrier_post(unsigned* bar, volatile LAS unsigned* st) {
    XcdBarrier b; b.bar = bar; b.x = xb_xcc_id(); b.st = st;
    if (threadIdx.x == 0) (void)xb_add(&bar[XB_XCNT(b.x)], 1u);
    return b;
}
__device__ __forceinline__ void xcd_barrier_complete(unsigned* bar, unsigned x, unsigned& nloc, unsigned& nx) {
    const unsigned G = gridDim.x * gridDim.y * gridDim.z;
    unsigned sum, cnt, mine, sp = 0u;
    for (;;) {
        sum = 0u; cnt = 0u; mine = 0u;
#pragma unroll
        for (unsigned j = 0; j < 16; ++j) { const unsigned c = xb_ld(&bar[XB_XCNT(j)]); sum += c; cnt += (c > 0u) ? 1u : 0u; mine = (j == x) ? c : mine; }
        if (sum == G) break;
        __builtin_amdgcn_s_sleep(1);
        if ((++sp & 255u) == 0u) { if (xb_ld(&bar[XB_TMO])) break; if (sp > XB_SPIN_CAP) { atomicAdd(&bar[XB_TMO], 1u); break; } }
    }
    nloc = mine > 0u ? mine : 1u; nx = cnt > 0u ? cnt : 1u;
}

__device__ __forceinline__ void xcd_barrier(const XcdBarrier& b) {
    asm volatile("s_waitcnt vmcnt(0)" ::: "memory");
    __syncthreads();
    if (threadIdx.x == 0) {
        unsigned* bar = b.bar;
        __builtin_amdgcn_s_waitcnt(0);
        unsigned nloc = b.st[0], nx = b.st[1];
        if (nloc == 0u) { xcd_barrier_complete(bar, b.x, nloc, nx); b.st[0] = nloc; b.st[1] = nx; }
        const unsigned old = xb_add(&bar[XB_XSUB(b.x)], 1u);
        const unsigned gen = old / nloc;
        if (old + 1u == (gen + 1u) * nloc) {
            __builtin_amdgcn_fence(__ATOMIC_RELEASE, "agent");
            asm volatile("s_waitcnt vmcnt(0)" ::: "memory");
            const unsigned og = xb_add(&bar[XB_TOP], 1u);
            const unsigned tg = og / nx;
            if (og + 1u == (tg + 1u) * nx) xb_add(&bar[XB_TOPGEN], 1u);
            else XB_SPIN(xb_ld(&bar[XB_TOPGEN]) == tg, bar);
            __builtin_amdgcn_fence(__ATOMIC_ACQUIRE, "agent");
            xb_add(&bar[XB_XGEN(b.x)], 1u);
            asm volatile("s_waitcnt vmcnt(0)" ::: "memory");
        } else {
            XB_SPIN(xb_ld(&bar[XB_XGEN(b.x)]) == gen, bar);
            __builtin_amdgcn_fence(__ATOMIC_ACQUIRE, "agent");
            asm volatile("s_waitcnt vmcnt(0)" ::: "memory");
        }
    }
    __syncthreads();
}

typedef float f32x2 __attribute__((ext_vector_type(2)));
typedef unsigned u32x2 __attribute__((ext_vector_type(2)));
typedef const float* const __attribute__((address_space(4)))* kargs_t;
struct Frame {
    LAS unsigned char* lds;
    volatile LAS unsigned* MISC;
    int tid, lane, wave, vcu, G;
    unsigned char* ws; float* out;
    __device__ __forceinline__ const float* in(int i) const { return ((kargs_t)__builtin_amdgcn_kernarg_segment_ptr())[i]; }
#define FIN(name, idx) __device__ __forceinline__ const float* name() const { return in(idx); }
    FIN(x, 0) FIN(c, 1) FIN(ctx, 2) FIN(c_ctx, 3) FIN(w_ada, 4) FIN(b_ada, 5) FIN(w_in, 6) FIN(w_four, 7) FIN(q_norm, 8) FIN(k_norm, 9) FIN(hg_lb, 10) FIN(hg_norm, 11) FIN(w_out, 12) FIN(w_gate, 13) FIN(w_up, 14) FIN(w_down, 15) FIN(final_norm, 16)
#undef FIN
#define FWS(type, name, off) __device__ __forceinline__ type* name() const { return (type*)(ws + (off)); }
    FWS(unsigned, ctlw, WS_CTL) FWS(float, MODS, WS_MODS) FWS(float, LB, WS_LB) FWS(f32x2, ROPE, WS_ROPE) FWS(float, TF, WS_TF) FWS(float, XC, WS_XC) FWS(float, HGS, WS_HGS)
    FWS(bf16, WIN, WS_WIN) FWS(bf16, WOUT, WS_WOUT) FWS(bf16, WGU, WS_WGU) FWS(bf16, WDN, WS_WDN) FWS(bf16, HN, WS_HN) FWS(bf16, UX, WS_UX) FWS(bf16, MIX, WS_MIX) FWS(bf16, HB, WS_H)
#undef FWS
};
__device__ __forceinline__ float bf2f(unsigned short h) { return __builtin_bit_cast(float, (unsigned)h << 16); }
__device__ __forceinline__ float bflo(unsigned w) { return __builtin_bit_cast(float, w << 16); }
__device__ __forceinline__ float bfhi(unsigned w) { return __builtin_bit_cast(float, w & 0xffff0000u); }
__device__ __forceinline__ float wave_sum(float v) {
#pragma unroll
    for (int o = 1; o < 64; o <<= 1) v += __shfl_xor(v, o);
    return v;
}
__device__ __forceinline__ float sigmoidf_(float z) { return __builtin_amdgcn_rcpf(1.0f + __builtin_amdgcn_exp2f(-1.44269504089f * z)); }
__device__ __forceinline__ float siluf_(float z) { return z * sigmoidf_(z); }
__device__ __forceinline__ const float* xrow_ptr(const float* lat, const float* ctx, int R) {
    const int b = R / TPB, t = R - b * TPB;
    return (t < CTXL) ? ctx + ((size_t)b * CTXL + t) * DM : lat + ((size_t)b * SEQ + (t - CTXL)) * DM;
}

__device__ __forceinline__ void tr_item(const float* src, int ldsrc, bf16* dst, int ldt, LAS float* scr, int lane) {
#pragma unroll 8
    for (int i = 0; i < 32; ++i) { const int kk = 2 * i + (lane >> 5); scr[kk * 33 + (lane & 31)] = src[(size_t)kk * ldsrc + (lane & 31)]; }
    LDS_WAIT(); asm volatile("" ::: "memory");
    const int c = lane & 7;
#pragma unroll
    for (int j = 0; j < 4; ++j) { const int n = (lane >> 3) + 8 * j; const LAS float* s = scr + (8 * c) * 33 + n;
        v4u o; o.x = pk2(s[0 * 33], s[1 * 33]); o.y = pk2(s[2 * 33], s[3 * 33]); o.z = pk2(s[4 * 33], s[5 * 33]); o.w = pk2(s[6 * 33], s[7 * 33]);
        *(GAS v4u*)(dst + (size_t)n * ldt + 8 * c) = o; }
    LDS_WAIT(); asm volatile("" ::: "memory");
}
__device__ __forceinline__ void p0a_prologue(Frame& F) {
    const int gw = F.vcu * NWAVES + F.wave, NGW = F.G * NWAVES;
    const int gt = F.vcu * NTHREADS + F.tid, NGT = F.G * NTHREADS;
    LAS float* scr = (LAS float*)(F.lds + RING_OFF + F.wave * 12288);
    LAS float* sil = (LAS float*)(F.lds + RING_OFF + 98304);
    for (int i = F.tid; i < 5 * DM; i += NTHREADS) { const int bb = i >> 10, k = i & 1023; const float v = (bb < 4) ? F.c()[bb * DM + k] : F.c_ctx()[k]; sil[i] = v / (1.0f + expf(-v)); }
    __syncthreads();
    for (int it = gw; it < DEPTH * 96; it += NGW) {
        const int l = it / 96, j = (it % 96) * 64 + F.lane;
        const float* wp = F.w_ada() + (size_t)l * DM * 6144 + j;
        float a0 = 0.f, a1 = 0.f, a2 = 0.f, a3 = 0.f, a4 = 0.f;
        for (int k0 = 0; k0 < DM; k0 += 8) {
            float w[8];
#pragma unroll
            for (int i = 0; i < 8; ++i) w[i] = wp[(size_t)(k0 + i) * 6144];
#pragma unroll
            for (int i = 0; i < 8; ++i) { const int k = k0 + i; a0 += sil[k] * w[i]; a1 += sil[1024 + k] * w[i]; a2 += sil[2048 + k] * w[i]; a3 += sil[3072 + k] * w[i]; a4 += sil[4096 + k] * w[i]; }
        }
        const float bv = F.b_ada()[l * 6144 + j]; float* mo = F.MODS() + (size_t)l * 5 * 6144 + j;
        mo[0] = a0 + bv; mo[6144] = a1 + bv; mo[2 * 6144] = a2 + bv; mo[3 * 6144] = a3 + bv; mo[4 * 6144] = a4 + bv;
    }
    constexpr int I_IN = 16 * 72, I_OUT = 12 * 32, I_G = 16 * 88, I_D = 44 * 32, I_L = I_IN + I_OUT + 2 * I_G + I_D;
    for (int it = gw; it < DEPTH * I_L; it += NGW) {
        const int l = it / I_L; int r = it % I_L;
        if (r < I_IN) { const int kb = r / 72, nb = r % 72;
            tr_item(F.w_in() + (size_t)l * DM * PROJ + (size_t)(64 * kb) * PROJ + 32 * nb, PROJ, F.WIN() + (size_t)l * PROJ * DM + (size_t)(32 * nb) * DM + 64 * kb, DM, scr, F.lane); continue; }
        r -= I_IN;
        if (r < I_OUT) { const int kb = r / 32, nb = r % 32;
            tr_item(F.w_out() + (size_t)l * DM * DM + (size_t)(256 + 64 * kb) * DM + 32 * nb, DM, F.WOUT() + (size_t)l * DM * KMIX + (size_t)(32 * nb) * KMIX + 512 + 64 * kb, KMIX, scr, F.lane); continue; }
        r -= I_OUT;
        if (r < 2 * I_G) { const int up = r / I_G, rr = r % I_G, kb = rr / 88, nb = rr % 88, n0 = 32 * nb;
            const float* W = (up ? F.w_up() : F.w_gate()) + (size_t)l * DM * DFF;
            const int drow = (n0 >> 7) * 256 + up * 128 + (n0 & 127);
            tr_item(W + (size_t)(64 * kb) * DFF + n0, DFF, F.WGU() + (size_t)l * 5632 * DM + (size_t)drow * DM + 64 * kb, DM, scr, F.lane); continue; }
        r -= 2 * I_G;
        { const int kb = r / 32, nb = r % 32;
            tr_item(F.w_down() + (size_t)l * DFF * DM + (size_t)(64 * kb) * DM + 32 * nb, DM, F.WDN() + (size_t)l * DM * DFF + (size_t)(32 * nb) * DFF + 64 * kb, DFF, scr, F.lane); }
    }
    for (int it = gt; it < DEPTH * 2 * 256 * 256; it += NGT) {
        const int jp = it & 255, gc = (it >> 8) & 255, s = (it >> 16) & 1, l = it >> 17, g = gc >> 6, cc = gc & 63;
        const float* wf = F.w_four() + (size_t)l * 65536 + (size_t)(g * 64) * 256 + jp;
        float a = 0.f;
        for (int m = 0; m < 64; ++m) { const float ang = (float)((cc * m) & 63) * (1.0f / 32.0f); const float tw = s ? -sinpif(ang) : cospif(ang); a += tw * wf[m * 256]; }
        F.TF()[it] = a * 0.125f;
    }
    for (int it = gt; it < 2 * 256; it += NGT) {
        const int d = it >> 8, cc = it & 255; float v[DEPTH], mx = -INFINITY, sm = 0.f;
#pragma unroll
        for (int l = 0; l < DEPTH; ++l) { v[l] = F.hg_lb()[(d * DEPTH + l) * 256 + cc]; mx = fmaxf(mx, v[l]); }
#pragma unroll
        for (int l = 0; l < DEPTH; ++l) { v[l] = expf(v[l] - mx); sm += v[l]; }
        float cum = 0.f;
#pragma unroll
        for (int l = 0; l < DEPTH; ++l) { if (l > 0) cum += v[l] / sm; F.LB()[(d * DEPTH + l) * 256 + cc] = cum; }
    }
    for (int it = gt; it < SEQ * 32; it += NGT) {
        const int p = it >> 5, i = it & 31; const float pos = (float)((i < 16) ? (p >> 6) : (p & 63));
        const float fr = powf(10000.0f, -(float)(2 * (i & 15)) / 32.0f); const float ang = pos * fr;
        F.ROPE()[it] = (f32x2){cosf(ang), sinf(ang)};
    }
}
__device__ __forceinline__ void p0b_fold(Frame& F) {
    const int gt = F.vcu * NTHREADS + F.tid, NGT = F.G * NTHREADS;
    for (int it = gt; it < DEPTH * 64 * 1024; it += NGT) {
        const int j = it & 1023, kg = (it >> 10) & 63, l = it >> 16;
        const float* tf = F.TF() + (size_t)l * 131072 + (size_t)(kg * 8) * 256; const float* wo = F.w_out() + (size_t)l * DM * DM + j;
        float a[8] = {0.f, 0.f, 0.f, 0.f, 0.f, 0.f, 0.f, 0.f};
        for (int jp = 0; jp < 256; ++jp) { const float w = wo[(size_t)jp * DM];
#pragma unroll
            for (int e = 0; e < 8; ++e) a[e] += tf[e * 256 + jp] * w; }
        v4u o; o.x = pk2(a[0], a[1]); o.y = pk2(a[2], a[3]); o.z = pk2(a[4], a[5]); o.w = pk2(a[6], a[7]);
        *(GAS v4u*)(F.WOUT() + (size_t)l * DM * KMIX + (size_t)j * KMIX + kg * 8) = o;
    }
}

__device__ __forceinline__ void norm_mod_phase(Frame& F, const float* lat, const float* ctx, const float* mods, int off_sh, int off_sc) {
    const int gw = F.vcu * NWAVES + F.wave, NGW = F.G * NWAVES;
    for (int R = gw; R < MROWS; R += NGW) {
        const int b = R / TPB, t = R - b * TPB, bb = (t < CTXL) ? 4 : b;
        const GAS f32x4* xr = (const GAS f32x4*)xrow_ptr(lat, ctx, R) + F.lane;
        const GAS f32x4* shp = (const GAS f32x4*)(mods + bb * 6144 + off_sh) + F.lane; const GAS f32x4* scp = (const GAS f32x4*)(mods + bb * 6144 + off_sc) + F.lane;
        f32x4 v[4]; float s = 0.f;
#pragma unroll
        for (int j = 0; j < 4; ++j) { v[j] = xr[64 * j]; s += (v[j].x * v[j].x + v[j].y * v[j].y) + (v[j].z * v[j].z + v[j].w * v[j].w); }
        const float rinv = 1.0f / sqrtf(wave_sum(s) * (1.0f / DM) + EPS);
        GAS u32x2* o8 = (GAS u32x2*)(F.HN() + (size_t)R * DM) + F.lane;
#pragma unroll
        for (int j = 0; j < 4; ++j) { const f32x4 sh = shp[64 * j], sc = scp[64 * j]; const f32x4 y = v[j] * rinv * (sc + 1.0f) + sh;
            u32x2 w; w.x = pk2(y.x, y.y); w.y = pk2(y.z, y.w); o8[64 * j] = w; }
    }
}
__device__ __forceinline__ void final_norm_phase(Frame& F) {
    const int gw = F.vcu * NWAVES + F.wave, NGW = F.G * NWAVES;
    for (int r = gw; r < NB * SEQ; r += NGW) {
        GAS f32x4* xr = (GAS f32x4*)(F.out + (size_t)r * DM) + F.lane; const GAS f32x4* gp = (const GAS f32x4*)F.final_norm() + F.lane;
        f32x4 v[4]; float s = 0.f;
#pragma unroll
        for (int j = 0; j < 4; ++j) { v[j] = xr[64 * j]; s += (v[j].x * v[j].x + v[j].y * v[j].y) + (v[j].z * v[j].z + v[j].w * v[j].w); }
        const float rinv = 1.0f / sqrtf(wave_sum(s) * (1.0f / DM) + EPS);
#pragma unroll
        for (int j = 0; j < 4; ++j) xr[64 * j] = v[j] * rinv * gp[64 * j];
    }
}
__device__ __forceinline__ void qk_prep_phase(Frame& F, int l) {
    const int gw = F.vcu * NWAVES + F.wave, NGW = F.G * NWAVES;
    const int j = F.lane & 7;
    float gq[8], gk[8];
#pragma unroll
    for (int e = 0; e < 8; ++e) { gq[e] = F.q_norm()[l * 64 + 8 * j + e]; gk[e] = F.k_norm()[l * 64 + 8 * j + e]; }
    const int ti0 = ((j >> 2) * 16) + ((j & 1) * 8); const bool is_x2 = (j >> 1) & 1;
    for (int R = gw; R < MROWS; R += NGW) {
        const int b = R / TPB, t = R - b * TPB; const bool lat = t >= CTXL;
        bf16* row = F.UX() + (size_t)R * PROJ;
        f32x2 cs[8];
#pragma unroll
        for (int e = 0; e < 8; ++e) cs[e] = lat ? F.ROPE()[(size_t)(t - CTXL) * 32 + ti0 + e] : (f32x2){1.0f, 0.0f};
#pragma unroll
        for (int which = 0; which < 2; ++which) {
            const int colbase = which == 0 ? OFF_Q + F.lane * 8 : OFF_K + (F.lane & 15) * 8;
            const v4u raw = *(const GAS v4u*)(row + colbase);
            float v[8] = {bflo(raw.x), bfhi(raw.x), bflo(raw.y), bfhi(raw.y), bflo(raw.z), bfhi(raw.z), bflo(raw.w), bfhi(raw.w)};
            float ss = 0.f;
#pragma unroll
            for (int e = 0; e < 8; ++e) ss += v[e] * v[e];
            ss += __shfl_xor(ss, 1); ss += __shfl_xor(ss, 2); ss += __shfl_xor(ss, 4);
            const float rinv = 1.0f / sqrtf(ss * (1.0f / 64.0f) + EPS);
            float o[8];
#pragma unroll
            for (int e = 0; e < 8; ++e) { v[e] = v[e] * rinv * (which == 0 ? gq[e] : gk[e]); }
#pragma unroll
            for (int e = 0; e < 8; ++e) { const float pv = __shfl_xor(v[e], 2);
                o[e] = is_x2 ? (pv * cs[e].y + v[e] * cs[e].x) : (v[e] * cs[e].x - pv * cs[e].y);
                if (which == 0) o[e] *= QSCALE; }
            v4u w; w.x = pk2(o[0], o[1]); w.y = pk2(o[2], o[3]); w.z = pk2(o[4], o[5]); w.w = pk2(o[6], o[7]);
            if (which == 0 || F.lane < 16) *(GAS v4u*)(row + colbase) = w;
        }
    }
}

__device__ __forceinline__ void attn_simple_phase(Frame& F) {
    const int gw = F.vcu * NWAVES + F.wave, NGW = F.G * NWAVES;
    for (int wi = gw; wi < NB * 8 * (TPB / 64); wi += NGW) {
        const int bh = __builtin_amdgcn_readfirstlane(wi / (TPB / 64)), tb = __builtin_amdgcn_readfirstlane(wi % (TPB / 64));
        const int b = bh >> 3, h = bh & 7, kvh = h >> 2, t = tb * 64 + F.lane;
        const int nkeys = (tb < CTXL / 64) ? CTXL : TPB;
        const size_t R = (size_t)b * TPB + t;
        float q[64], o[64];
        { const GAS v4u* qp = (const GAS v4u*)(F.UX() + R * PROJ + OFF_Q + h * 64);
#pragma unroll
          for (int i = 0; i < 8; ++i) { const v4u w = qp[i]; q[8 * i] = bflo(w.x); q[8 * i + 1] = bfhi(w.x); q[8 * i + 2] = bflo(w.y); q[8 * i + 3] = bfhi(w.y); q[8 * i + 4] = bflo(w.z); q[8 * i + 5] = bfhi(w.z); q[8 * i + 6] = bflo(w.w); q[8 * i + 7] = bfhi(w.w); } }
#pragma unroll
        for (int d = 0; d < 64; ++d) o[d] = 0.f;
        float m = -1e30f, ls = 0.f;
        const bf16* kbase = F.UX() + (size_t)b * TPB * PROJ + OFF_K + kvh * 64;
        for (int s = 0; s < nkeys; ++s) {
            const unsigned* kp = (const unsigned*)(kbase + (size_t)s * PROJ); const unsigned* vp = kp + (OFF_V - OFF_K) / 2;
            float dot = 0.f;
#pragma unroll
            for (int i = 0; i < 32; ++i) { const unsigned w = kp[i]; dot += q[2 * i] * bflo(w) + q[2 * i + 1] * bfhi(w); }
            const float mn = fmaxf(m, dot), corr = __builtin_amdgcn_exp2f(m - mn), p = __builtin_amdgcn_exp2f(dot - mn);
            ls = ls * corr + p; m = mn;
#pragma unroll
            for (int i = 0; i < 32; ++i) { const unsigned w = vp[i]; o[2 * i] = o[2 * i] * corr + p * bflo(w); o[2 * i + 1] = o[2 * i + 1] * corr + p * bfhi(w); }
        }
        const float inv = 1.0f / ls;
        GAS v4u* op = (GAS v4u*)(F.MIX() + R * KMIX + MIX_A + h * 64);
#pragma unroll
        for (int i = 0; i < 8; ++i) { v4u w; w.x = pk2(o[8 * i] * inv, o[8 * i + 1] * inv); w.y = pk2(o[8 * i + 2] * inv, o[8 * i + 3] * inv); w.z = pk2(o[8 * i + 4] * inv, o[8 * i + 5] * inv); w.w = pk2(o[8 * i + 6] * inv, o[8 * i + 7] * inv); op[i] = w; }
    }
}
__device__ __forceinline__ void fourier_simple_phase(Frame& F) {
    const int gw = F.vcu * NWAVES + F.wave, NGW = F.G * NWAVES;
    LAS f32x2* tw = (LAS f32x2*)(F.lds + RING_OFF);
    for (int i = F.tid; i < SEQ; i += NTHREADS) { const float a = (float)i * (1.0f / 4096.0f); tw[i] = (f32x2){cospif(a), sinpif(a)}; }
    __syncthreads();
    for (int wi = gw; wi < NB * (SEQ + CTXL) * 4; wi += NGW) {
        const int cg = wi & 3, bk = wi >> 2, b = bk / TPB, kt = bk - b * TPB;
        const bool isctx = kt < CTXL; const int k = isctx ? kt : kt - CTXL, n_len = isctx ? CTXL : SEQ, shift = isctx ? 5 : 0;
        const bf16* zp = F.UX() + ((size_t)b * TPB + (isctx ? 0 : CTXL)) * PROJ + cg * 64 + F.lane;
        float P = 0.f, Q = 0.f;
        for (int n = 0; n < n_len; n += 4) {
            float z[4];
#pragma unroll
            for (int e = 0; e < 4; ++e) z[e] = bf2f(zp[(size_t)(n + e) * PROJ]);
#pragma unroll
            for (int e = 0; e < 4; ++e) { const f32x2 cs = tw[((k * (n + e)) << shift) & (SEQ - 1)]; P += z[e] * cs.x; Q += z[e] * cs.y; }
        }
        const float sc = isctx ? (1.0f / 16.0f) : 0.011048543456039806f;
        bf16* mp = F.MIX() + ((size_t)b * TPB + kt) * KMIX + cg * 64 + F.lane;
        mp[MIX_P] = (bf16)f2bf(P * sc); mp[MIX_Q] = (bf16)f2bf(Q * sc);
    }
    __syncthreads();
}
__device__ __forceinline__ int hg_tok(int dir, int i) { return dir == 0 ? i : (i < CTXL ? CTXL - 1 - i : TPB + CTXL - 1 - i); }
__device__ __forceinline__ void hgrn_simple_phase(Frame& F, int l) {
    const int gw = F.vcu * NWAVES + F.wave;
    if (gw >= NB * 4 * 2) return;
    const int dir = gw & 1, h = (gw >> 1) & 3, b = gw >> 3;
    LAS float* sh = (LAS float*)(F.lds + RING_OFF + F.wave * 1024);
    const float lbv = F.LB()[(dir * DEPTH + l) * 256 + h * 64 + F.lane];
    float S[64];
#pragma unroll
    for (int d = 0; d < 64; ++d) S[d] = 0.f;
    const bf16* base = F.UX() + (size_t)b * TPB * PROJ + h * 64 + F.lane;
    float* ob = F.HGS() + ((size_t)dir * MROWS + (size_t)b * TPB) * 256 + h * 64 + F.lane;
    const int zoff = dir ? OFF_FB : OFF_FF;
    float zf0, qv0, vv0, zf1, qv1, vv1;
    { const bf16* p = base + (size_t)hg_tok(dir, 0) * PROJ; zf0 = bf2f(p[zoff]); qv0 = bf2f(p[OFF_HQ]); vv0 = bf2f(p[OFF_I]); }
    { const bf16* p = base + (size_t)hg_tok(dir, 1) * PROJ; zf1 = bf2f(p[zoff]); qv1 = bf2f(p[OFF_HQ]); vv1 = bf2f(p[OFF_I]); }
    for (int i = 0; i < TPB; ++i) {
        const int t = hg_tok(dir, i);
        float zf2 = 0.f, qv2 = 0.f, vv2 = 0.f;
        if (i + 2 < TPB) { const bf16* p = base + (size_t)hg_tok(dir, i + 2) * PROJ; zf2 = bf2f(p[zoff]); qv2 = bf2f(p[OFF_HQ]); vv2 = bf2f(p[OFF_I]); }
        const float sg = sigmoidf_(zf0), fv = lbv + (1.0f - lbv) * sg, kv = (1.0f - lbv) * (1.0f - sg);
        sh[F.lane] = fv; sh[64 + F.lane] = kv; sh[128 + F.lane] = qv0;
        asm volatile("s_waitcnt lgkmcnt(0)" ::: "memory");
        float o = 0.f;
#pragma unroll
        for (int d4 = 0; d4 < 16; ++d4) {
            const f32x4 f4 = *(const LAS f32x4*)(sh + 4 * d4), k4 = *(const LAS f32x4*)(sh + 64 + 4 * d4), q4 = *(const LAS f32x4*)(sh + 128 + 4 * d4);
#pragma unroll
            for (int e = 0; e < 4; ++e) { const int d = 4 * d4 + e; S[d] = f4[e] * S[d] + k4[e] * vv0; o += S[d] * q4[e]; }
        }
        asm volatile("s_waitcnt lgkmcnt(0)" ::: "memory");
        ob[(size_t)t * 256] = o;
        zf0 = zf1; qv0 = qv1; vv0 = vv1; zf1 = zf2; qv1 = qv2; vv1 = vv2;
    }
}
__device__ __forceinline__ void hgrn_readout_phase(Frame& F, int l) {
    const int gw = F.vcu * NWAVES + F.wave, NGW = F.G * NWAVES;
    const f32x4 gn = *(const GAS f32x4*)(F.hg_norm() + l * 64 + 4 * (F.lane & 15));
    for (int R = gw; R < MROWS; R += NGW) {
        const f32x4 a = *(const GAS f32x4*)(F.HGS() + (size_t)R * 256 + 4 * F.lane), bq = *(const GAS f32x4*)(F.HGS() + ((size_t)MROWS + R) * 256 + 4 * F.lane);
        const f32x4 o = a + bq;
        float ss = (o.x * o.x + o.y * o.y) + (o.z * o.z + o.w * o.w);
        ss += __shfl_xor(ss, 1); ss += __shfl_xor(ss, 2); ss += __shfl_xor(ss, 4); ss += __shfl_xor(ss, 8);
        const float rinv = 1.0f / sqrtf(ss * (1.0f / 64.0f) + EPS);
        const u32x2 graw = *(const GAS u32x2*)(F.UX() + (size_t)R * PROJ + OFF_G + 4 * F.lane);
        const float g0 = bflo(graw.x), g1 = bfhi(graw.x), g2 = bflo(graw.y), g3 = bfhi(graw.y);
        u32x2 w; w.x = pk2(o.x * rinv * gn.x * siluf_(g0), o.y * rinv * gn.y * siluf_(g1)); w.y = pk2(o.z * rinv * gn.z * siluf_(g2), o.w * rinv * gn.w * siluf_(g3));
        *(GAS u32x2*)(F.MIX() + (size_t)R * KMIX + MIX_R + 4 * F.lane) = w;
    }
}

#ifndef MK_MULTI
#define MK_MULTI 0
#endif
constexpr int PH_L0 = 2, NPL = 11, PH_FINAL = PH_L0 + NPL, NPH = PH_FINAL + 1;
struct Args { const float* in[17]; float* out; unsigned char* ws; int l_lo, l_hi; };
template <int PH_LO, int PH_HI>
__global__ void __launch_bounds__(NTHREADS, 2) fwd_kernel(Args args) {
    extern __shared__ __attribute__((aligned(16))) unsigned char lds[];
    Frame F;
    F.lds = (LAS unsigned char*)lds;
    F.MISC = (volatile LAS unsigned*)(F.lds + MISC_OFF);
    F.tid = threadIdx.x; F.lane = F.tid & 63; F.wave = __builtin_amdgcn_readfirstlane(F.tid >> 6);
    F.G = gridDim.x; { const int bx = blockIdx.x; F.vcu = (F.G % 8 == 0) ? (bx % 8) * (F.G / 8) + bx / 8 : bx; }
    F.ws = args.ws; F.out = args.out;
    for (int u = F.tid; u < (LDS_BYTES - LDSCTL_OFF) / 4; u += NTHREADS) ((LAS unsigned*)(F.lds + LDSCTL_OFF))[u] = 0u;
    __syncthreads();
    XcdBarrier bar; bar.bar = (F.ctlw() + CW_BAR); bar.x = 0; bar.st = nullptr;
    if (!MK_MULTI) bar = xcd_barrier_post((F.ctlw() + CW_BAR), F.MISC + 8);
#define IN(k) (PH_LO <= (k) && (k) < PH_HI)
#define RELANE() do { int t_ = threadIdx.x; asm volatile("" : "+v"(t_)); F.tid = t_; F.lane = t_ & 63; } while (0)
#define SEAM() do { if (!MK_MULTI) xcd_barrier(bar); } while (0)

    if (IN(0)) { p0a_prologue(F); SEAM(); }
    if (IN(1)) { p0b_fold(F); SEAM(); }

    for (int l = args.l_lo; l < args.l_hi; ++l) {
        constexpr int s0 = PH_L0;
        const float* lat_in = (l == 0) ? F.x() : F.out; const float* ctx_in = (l == 0) ? F.ctx() : F.XC();
        const float* mods = F.MODS() + (size_t)l * 5 * 6144;
        if (IN(s0 + 0)) { RELANE(); norm_mod_phase(F, lat_in, ctx_in, mods, MOD_SH_A, MOD_SC_A); SEAM(); }
        if (IN(s0 + 1)) { RELANE();
            pg8::Gemm g{F.HN(), F.WIN() + (size_t)l * PROJ * DM, MROWS, PROJ, DM}; pg8::StaticOrder S; S.init(MROWS, PROJ, F.G, (int)blockIdx.x);
            pg8::EpiBf16<0> E{F.UX(), PROJ, nullptr, 0, 0, 1.f};
            pg8::gemm_phase<pg8::EpiBf16<0>, pg8::StaticOrder, PG8_ALIGN, PG8_SP2>(F.lds + RING_OFF, g, S, E);
            SEAM();
        }
        if (IN(s0 + 2)) { RELANE(); qk_prep_phase(F, l); SEAM(); }
        if (IN(s0 + 3)) { RELANE(); attn_simple_phase(F); SEAM(); }
        if (IN(s0 + 4)) { RELANE(); fourier_simple_phase(F); SEAM(); }
        if (IN(s0 + 5)) { RELANE(); hgrn_simple_phase(F, l); SEAM(); }
        if (IN(s0 + 6)) { RELANE(); hgrn_readout_phase(F, l); SEAM(); }
        if (IN(s0 + 7)) { RELANE();
            pg8::Gemm g{F.MIX(), F.WOUT() + (size_t)l * DM * KMIX, MROWS, DM, KMIX}; pg8::StaticOrder S; S.init(MROWS, DM, F.G, (int)blockIdx.x);
            pg8::EpiResGate E{lat_in, ctx_in, F.out, F.XC(), mods + MOD_G_A};
            pg8::gemm_phase<pg8::EpiResGate, pg8::StaticOrder, PG8_ALIGN, PG8_SP2>(F.lds + RING_OFF, g, S, E);
            SEAM();
        }
        if (IN(s0 + 8)) { RELANE(); norm_mod_phase(F, F.out, F.XC(), mods, MOD_SH_F, MOD_SC_F); SEAM(); }
        if (IN(s0 + 9)) { RELANE();
            pg8::Gemm g{F.HN(), F.WGU() + (size_t)l * 5632 * DM, MROWS, 5632, DM}; pg8::StaticOrder S; S.init(MROWS, 5632, F.G, (int)blockIdx.x);
            pg8::EpiSwiGLU E{F.HB(), DFF};
            pg8::gemm_phase<pg8::EpiSwiGLU, pg8::StaticOrder, PG8_ALIGN, PG8_SP2>(F.lds + RING_OFF, g, S, E);
            SEAM();
        }
        if (IN(s0 + 10)) { RELANE();
            pg8::Gemm g{F.HB(), F.WDN() + (size_t)l * DM * DFF, MROWS, DM, DFF}; pg8::StaticOrder S; S.init(MROWS, DM, F.G, (int)blockIdx.x);
            pg8::EpiResGate E{F.out, F.XC(), F.out, F.XC(), mods + MOD_G_F};
            pg8::gemm_phase<pg8::EpiResGate, pg8::StaticOrder, PG8_ALIGN, PG8_SP2>(F.lds + RING_OFF, g, S, E);
            SEAM();
        }
    }
    if (IN(PH_FINAL)) { RELANE(); final_norm_phase(F); }
#undef IN
#undef SEAM
}

#if MK_MULTI
#define MAIN_KERNEL (fwd_kernel<3, 4>)
#define LAUNCH(p) hipLaunchKernelGGL((fwd_kernel<p, p + 1>), dim3(grid), dim3(NTHREADS), LDS_BYTES, stream, a)
template <int P> static bool set_lds_one() { return hipFuncSetAttribute((const void*)fwd_kernel<P, P + 1>, hipFuncAttributeMaxDynamicSharedMemorySize, LDS_BYTES) == hipSuccess; }
static bool set_lds_all() { return set_lds_one<0>() && set_lds_one<1>() && set_lds_one<2>() && set_lds_one<3>() && set_lds_one<4>() && set_lds_one<5>() && set_lds_one<6>() && set_lds_one<7>() && set_lds_one<8>() && set_lds_one<9>() && set_lds_one<10>() && set_lds_one<11>() && set_lds_one<12>() && set_lds_one<13>(); }
#else
#define MAIN_KERNEL (fwd_kernel<0, NPH>)
static bool set_lds_all() { return hipFuncSetAttribute((const void*)fwd_kernel<0, NPH>, hipFuncAttributeMaxDynamicSharedMemorySize, LDS_BYTES) == hipSuccess; }
#endif
extern "C" void kernel_launch(void* const* d_in, const int* in_sizes, int n_in, void* d_out, int out_size, void* d_ws, size_t ws_size, hipStream_t stream) {
    static int grid = 0;
    if (grid == 0) {
        if (n_in != 17 || in_sizes[0] != NB * SEQ * DM || out_size != NB * SEQ * DM || ws_size < WS_END) { fprintf(stderr, "kernel_launch: unexpected shapes (n_in %d, in0 %d, out %d, ws %zu < %zu); nothing launched\n", n_in, n_in > 0 ? in_sizes[0] : -1, out_size, ws_size, (size_t)WS_END); grid = -1; return; }
        int dev = 0, cus = 0, per_cu = 0;
        if (hipGetDevice(&dev) != hipSuccess || hipDeviceGetAttribute(&cus, hipDeviceAttributeMultiprocessorCount, dev) != hipSuccess) { grid = -1; return; }
        if (!set_lds_all()) { fprintf(stderr, "kernel_launch: hipFuncSetAttribute failed\n"); grid = -1; return; }
        if (hipOccupancyMaxActiveBlocksPerMultiprocessor(&per_cu, (const void*)MAIN_KERNEL, NTHREADS, LDS_BYTES) != hipSuccess || per_cu < 1) { fprintf(stderr, "kernel_launch: occupancy query says %d blocks per CU; nothing launched\n", per_cu); (void)hipGetLastError(); grid = -1; return; }
        grid = cus;
    }
    if (grid < 0) return;
    if (hipMemsetAsync((char*)d_ws + WS_CTL, 0, CTL_ZERO_BYTES, stream) != hipSuccess) return;
    Args a{};
    for (int i = 0; i < 17; ++i) a.in[i] = (const float*)d_in[i];
    a.out = (float*)d_out; a.ws = (unsigned char*)d_ws;
#if MK_MULTI
    a.l_lo = 0; a.l_hi = 0;
    LAUNCH(0); LAUNCH(1);
    for (int l = 0; l < DEPTH; ++l) { a.l_lo = l; a.l_hi = l + 1; LAUNCH(2); LAUNCH(3); LAUNCH(4); LAUNCH(5); LAUNCH(6); LAUNCH(7); LAUNCH(8); LAUNCH(9); LAUNCH(10); LAUNCH(11); LAUNCH(12); }
    a.l_lo = 0; a.l_hi = 0; LAUNCH(13);
#else
    a.l_lo = 0; a.l_hi = DEPTH;
    hipLaunchKernelGGL((fwd_kernel<0, NPH>), dim3(grid), dim3(NTHREADS), LDS_BYTES, stream, a);
#endif
}
```

```cpp
#include <hip/hip_runtime.h>
#include <hip/hip_bf16.h>
#include <cstdio>
#include <cstdint>
#include <cmath>
#ifndef DIAG_J
#define DIAG_J -1
#endif
#ifndef DIAG_A
#define DIAG_A 4
#endif
#define STAMP(tag) do { if (DIAG_J >= 0) { const unsigned long long t_ = __builtin_amdgcn_s_memrealtime(); if ((tag) == DIAG_J) F.da += t_ - F.dt; F.dt = t_; } } while (0)
#ifndef XL_DPP
#define XL_DPP 1
#endif
#ifndef XL_P32
#define XL_P32 0
#endif
__device__ __forceinline__ float xl_bperm_xor(float v, int mask) {
    int ln_; asm volatile("v_mbcnt_lo_u32_b32 %0, -1, 0\n\tv_mbcnt_hi_u32_b32 %0, -1, %0" : "=v"(ln_));
    return __builtin_bit_cast(float, __builtin_amdgcn_ds_bpermute((ln_ ^ mask) << 2, __builtin_bit_cast(int, v)));
}
#if !XL_DPP
__device__ __forceinline__ float xl_dpp_qp2301(float v) { return xl_bperm_xor(v, 2); }
__device__ __forceinline__ float xl_sum4(float v) { v += xl_bperm_xor(v, 1); v += xl_bperm_xor(v, 2); return v; }
__device__ __forceinline__ float xl_sum8(float v) { v = xl_sum4(v); v += xl_bperm_xor(v, 4); return v; }
__device__ __forceinline__ float xl_sum16(float v) { v = xl_sum8(v); v += xl_bperm_xor(v, 8); return v; }
#else
__device__ __forceinline__ float xl_dpp_qp1032(float v) { return __builtin_bit_cast(float, __builtin_amdgcn_update_dpp(0, __builtin_bit_cast(int, v), 0xB1, 0xF, 0xF, false)); }
__device__ __forceinline__ float xl_dpp_qp2301(float v) { return __builtin_bit_cast(float, __builtin_amdgcn_update_dpp(0, __builtin_bit_cast(int, v), 0x4E, 0xF, 0xF, false)); }
__device__ __forceinline__ float xl_dpp_hmirror(float v) { return __builtin_bit_cast(float, __builtin_amdgcn_update_dpp(0, __builtin_bit_cast(int, v), 0x141, 0xF, 0xF, false)); }
__device__ __forceinline__ float xl_dpp_mirror(float v) { return __builtin_bit_cast(float, __builtin_amdgcn_update_dpp(0, __builtin_bit_cast(int, v), 0x140, 0xF, 0xF, false)); }
__device__ __forceinline__ float xl_sum4(float v) { v += xl_dpp_qp1032(v); v += xl_dpp_qp2301(v); return v; }
__device__ __forceinline__ float xl_sum8(float v) { v = xl_sum4(v); v += xl_dpp_hmirror(v); return v; }
__device__ __forceinline__ float xl_sum16(float v) { v = xl_sum8(v); v += xl_dpp_mirror(v); return v; }
#endif
__device__ __forceinline__ float xl_sumx16(float v) { return v + xl_bperm_xor(v, 16); }
#if XL_P32
__device__ __forceinline__ float xl_sumx32(float v) { const auto r = __builtin_amdgcn_permlane32_swap(__builtin_bit_cast(unsigned, v), __builtin_bit_cast(unsigned, v), false, false); return __builtin_bit_cast(float, r[0]) + __builtin_bit_cast(float, r[1]); }
#else
__device__ __forceinline__ float xl_sumx32(float v) { return v + xl_bperm_xor(v, 32); }
#endif
__device__ __forceinline__ float xl_sum64(float v) { return xl_sumx32(xl_sumx16(xl_sum16(v))); }
namespace pg8 {
#define PG8_LAS __attribute__((address_space(3)))
typedef unsigned short bf16_t;
typedef short bf16x8 __attribute__((ext_vector_type(8)));
typedef float f32x4 __attribute__((ext_vector_type(4)));
typedef unsigned u32x4 __attribute__((ext_vector_type(4)));
constexpr int BM = 256, BK = 64, HALF = 128, HTB = HALF * BK * 2  , STAGE_BYTES = 8 * HTB, NXCD = 8, WGM = 8;

__host__ __device__ __forceinline__ int lds_byte(int r, int c) { const int st = (r >> 4) * 2 + (c >> 5), rr = r & 15, cc = c & 31, ob = rr * 64 + cc * 2; return st * 1024 + (ob ^ (((ob >> 9) & 1) << 5)); }
__host__ __device__ __forceinline__ void stage_rc(int b, int& R, int& C) { const int st = b / 1024, sb = b % 1024, swz = sb ^ (((sb >> 9) & 1) << 5); R = (st >> 1) * 16 + swz / 64; C = (st & 1) * 32 + (swz % 64) / 2; }
__host__ __device__ __forceinline__ int perm32(int rho) { const int n = rho >> 4, i = rho & 15; return 8 * (i >> 2) + 4 * n + (i & 3); }

struct Unit { int pm, pn, ko; };
struct Gemm { const bf16_t* A; const bf16_t* Bt; int M, N, K, ld; };

struct StaticOrder {
    int nM, nN, nwg, G, c, skipc;
    __host__ __device__ void init(int M, int N, int G_, int c_, int skipc_ = 0) { nM = M / BM; nN = N / BM; nwg = nM * nN; G = G_; c = c_; skipc = skipc_; }
    __host__ __device__ bool next(int i, Unit& u) const {
        const long L = (long)i * G + c; if (L >= nwg) return false;
        int wgid = (int)L; { const int q = nwg / NXCD, r = nwg % NXCD, xcd = wgid % NXCD, off = wgid / NXCD; wgid = (xcd < r ? xcd * (q + 1) : r * (q + 1) + (xcd - r) * q) + off; }
        const int nig = WGM * nN, gid = wgid / nig, fm = gid * WGM, gsz = (nM - fm) < WGM ? (nM - fm) : WGM;
        u.pm = fm + ((wgid % nig) % gsz); u.pn = (wgid % nig) / gsz; if (skipc) u.pm += u.pm / 32 + 1; u.ko = 0; return true;
    }
    __device__ __forceinline__ void a_ready(const Unit&) const {}
    __device__ __forceinline__ void done(const Unit&) const {}
};

struct CtxSplitOrder {
    int nsplit, kslice, G, c;
    __host__ __device__ void init(int N, int K, int kslice_, int G_, int c_) { kslice = kslice_; nsplit = K / kslice_; G = G_; c = c_; (void)N; }
    __host__ __device__ bool next(int i, Unit& u) const {
        const int L = i * G + c; if (L >= 16 * nsplit) return false;
        const int ks = L >> 4, r = L & 15; u.pm = 33 * (r >> 2); u.pn = r & 3; u.ko = ks * kslice; return true;
    }
    __device__ __forceinline__ void a_ready(const Unit&) const {}
    __device__ __forceinline__ void done(const Unit&) const {}
};
__device__ __forceinline__ unsigned cvt_pk_bf16(float lo, float hi) { unsigned r; asm volatile("v_cvt_pk_bf16_f32 %0, %1, %2" : "=v"(r) : "v"(lo), "v"(hi)); return r; }
typedef float f32x2 __attribute__((ext_vector_type(2)));
__device__ __forceinline__ f32x2 gelu_pk(f32x2 v) {
    const f32x2 av = __builtin_elementwise_abs(v), d = av * 0.2316418882f + 1.0f;
    f32x2 t; t.x = __builtin_amdgcn_rcpf(d.x); t.y = __builtin_amdgcn_rcpf(d.y);
    f32x2 q = t * 0.5307027145f + (-0.7265760135f); q = q * t + 0.7107068705f; q = q * t + (-0.142248368f); q = q * t + 0.127414796f; q = q * t;
    const f32x2 s = (v * v) * (-0.72134752044f);
    f32x2 e; e.x = __builtin_amdgcn_exp2f(s.x); e.y = __builtin_amdgcn_exp2f(s.y);
    const f32x2 m = v * (q * e), r = v - m;
    f32x2 o; o.x = v.x < 0.f ? m.x : r.x; o.y = v.y < 0.f ? m.y : r.y; return o;
}

template <int ACT  > struct EpiBf16 {
    static constexpr bool PERM = true, AFTER_DRAIN = false; static_assert(ACT == 0 || ACT == 1, "EpiBf16: ACT is 0 (none) or 1 (gelu_pk)");
    bf16_t* O; int ldc; const float* bias; int split_cols; size_t split_stride; float scale0;
    __device__ __forceinline__ void operator()(const f32x4 (&acc)[2][2][4][2], const Unit& u, int wr, int wc, int fr, int fq) const {
        const int row0 = u.pm * BM + wr * 64 + fr; int colt = u.pn * BM; bf16_t* base = O;
        float sc = 1.f; if (split_cols) { const int t = colt / split_cols; base += (size_t)t * split_stride; colt -= t * split_cols; if (t == 0) sc = scale0; }
        const int col0 = colt + wc * 32 + 8 * fq, bcol0 = u.pn * BM + wc * 32 + 8 * fq;
        f32x4 bv[2][2];
#pragma unroll
        for (int bj = 0; bj < 2; ++bj)
#pragma unroll
            for (int n = 0; n < 2; ++n) bv[bj][n] = bias ? *(const f32x4*)(bias + bcol0 + bj * HALF + 4 * n) : (f32x4){0.f, 0.f, 0.f, 0.f};
#pragma unroll
        for (int ai = 0; ai < 2; ++ai)
#pragma unroll
            for (int m = 0; m < 4; ++m) { bf16_t* rowp = base + (size_t)(row0 + ai * HALF + m * 16) * ldc + col0;
#pragma unroll
                for (int bj = 0; bj < 2; ++bj) { f32x4 v0 = acc[ai][bj][m][0] + bv[bj][0], v1 = acc[ai][bj][m][1] + bv[bj][1];
                    if (ACT == 1) { f32x2 a = gelu_pk((f32x2){v0[0], v0[1]}), b = gelu_pk((f32x2){v0[2], v0[3]}), c = gelu_pk((f32x2){v1[0], v1[1]}), d = gelu_pk((f32x2){v1[2], v1[3]});
                        v0 = (f32x4){a.x, a.y, b.x, b.y}; v1 = (f32x4){c.x, c.y, d.x, d.y}; }
                    v0 = v0 * sc; v1 = v1 * sc; u32x4 w; w.x = cvt_pk_bf16(v0[0], v0[1]); w.y = cvt_pk_bf16(v0[2], v0[3]); w.z = cvt_pk_bf16(v1[0], v1[1]); w.w = cvt_pk_bf16(v1[2], v1[3]);
                    *(u32x4*)(rowp + bj * HALF) = w; } }
    }
};
template <class Epi, class Sched, bool ALIGN_EPI = false, bool SP2 = false, int KC = 0, int LDC = 0, class Dg = int>
__device__ __forceinline__ void gemm_phase(PG8_LAS unsigned char* lds, const Gemm g, const Sched& S, const Epi& E, int tid_in, Dg& F) {
    int tid_ = tid_in; asm volatile("" : "+v"(tid_));
    const int tid = tid_, wid = __builtin_amdgcn_readfirstlane(tid >> 6), lane = tid & 63, wr = wid >> 2, wc = wid & 3, fr = lane & 15, fq = lane >> 4;
    const int K = KC ? KC : g.K, nt = K / BK, LD = LDC ? LDC : g.ld;
    unsigned voffA[2], voffB[2];
#pragma unroll
    for (int i = 0; i < 2; ++i) { int R, C; stage_rc(tid * 16 + i * 8192, R, C); const int Rb = Epi::PERM ? ((R & ~31) + perm32(R & 31)) : R;
        voffA[i] = (unsigned)(R * LD + C) * 2u; voffB[i] = (unsigned)(Rb * LD + C) * 2u; }
    const size_t kstep = (size_t)(BK * 2);
    const size_t hstep = (size_t)HALF * LD * 2;
    const size_t tstep = 2 * hstep;
    const int aoff = lds_byte(wr * 64 + fr, fq * 8), boff = lds_byte(wc * 32 + fr, fq * 8);
    const unsigned ldsw = (unsigned)wid * 1024u;
#define PG8_SA(b, h) (((b) * 2 + (h)) * HTB)
#define PG8_SB(b, h) ((4 + (b) * 2 + (h)) * HTB)
#define PG8_STAGE(bufoff, gbase, voff) do { _Pragma("unroll") for (int _i = 0; _i < 2; ++_i) \
        __builtin_amdgcn_global_load_lds((const unsigned*)((const char*)(gbase) + (voff)[_i]), (PG8_LAS unsigned*)(lds + (bufoff) + ldsw + _i * 8192), 16, 0, 0); } while (0)
#define PG8_LDA(dst, b, h) do { _Pragma("unroll") for (int m = 0; m < 4; ++m) _Pragma("unroll") for (int k = 0; k < 2; ++k) dst[m][k] = *(const PG8_LAS bf16x8*)(lds + PG8_SA(b, h) + aoff + m * 2048 + k * 1024); } while (0)
#define PG8_LDB(dst, b, h) do { _Pragma("unroll") for (int n = 0; n < 2; ++n) _Pragma("unroll") for (int k = 0; k < 2; ++k) dst[n][k] = *(const PG8_LAS bf16x8*)(lds + PG8_SB(b, h) + boff + n * 2048 + k * 1024); } while (0)
#define PG8_MMA(ai, bj, At, Bt) do { __builtin_amdgcn_s_setprio(1); _Pragma("unroll") for (int m = 0; m < 4; ++m) _Pragma("unroll") for (int n = 0; n < 2; ++n) _Pragma("unroll") for (int k = 0; k < 2; ++k) \
        acc[ai][bj][m][n] = __builtin_amdgcn_mfma_f32_16x16x32_bf16(Bt[n][k], At[m][k], acc[ai][bj][m][n], 0, 0, 0); __builtin_amdgcn_s_setprio(0); } while (0)
#define PG8_WAIT_V(n) asm volatile("s_waitcnt vmcnt(" #n ")" ::: "memory")
#define PG8_WAIT_L(n) asm volatile("s_waitcnt lgkmcnt(" #n ")" ::: "memory")
#define PG8_BAR __builtin_amdgcn_s_barrier()
#define PG8_SCHED __builtin_amdgcn_sched_barrier(0)
    Unit cur, nxt; int ui = 0;
    if (!S.next(0, cur)) return;
    f32x4 acc[2][2][4][2];
#pragma unroll
    for (int a = 0; a < 2; ++a)
#pragma unroll
        for (int b = 0; b < 2; ++b)
#pragma unroll
            for (int m = 0; m < 4; ++m)
#pragma unroll
                for (int n = 0; n < 2; ++n) acc[a][b][m][n] = (f32x4){0.f, 0.f, 0.f, 0.f};
    bf16x8 At[4][2], B0[2][2], B1[2][2];
    const char* cA = (const char*)g.A + (size_t)cur.pm * tstep + (size_t)cur.ko * 2; const char* cB = (const char*)g.Bt + (size_t)cur.pn * tstep + (size_t)cur.ko * 2;
    S.a_ready(cur);
    if constexpr (SP2) {
        PG8_STAGE(PG8_SB(0, 0), cB, voffB); PG8_STAGE(PG8_SB(0, 1), cB + hstep, voffB); PG8_STAGE(PG8_SA(0, 0), cA, voffA); PG8_STAGE(PG8_SA(0, 1), cA + hstep, voffA);
        if (wr == 1) PG8_BAR;
        PG8_WAIT_V(2); PG8_BAR;
        PG8_STAGE(PG8_SB(1, 0), cB + kstep, voffB); PG8_STAGE(PG8_SA(1, 0), cA + kstep, voffA); PG8_STAGE(PG8_SB(1, 1), cB + hstep + kstep, voffB);
        PG8_WAIT_V(6); PG8_BAR;
    } else {
        PG8_STAGE(PG8_SB(0, 0), cB, voffB); PG8_STAGE(PG8_SA(0, 0), cA, voffA); PG8_STAGE(PG8_SB(0, 1), cB + hstep, voffB); PG8_STAGE(PG8_SA(0, 1), cA + hstep, voffA);
        if (wr == 1) PG8_BAR;
        PG8_WAIT_V(4); PG8_BAR;
        PG8_STAGE(PG8_SB(1, 0), cB + kstep, voffB); PG8_STAGE(PG8_SA(1, 0), cA + kstep, voffA); PG8_STAGE(PG8_SB(1, 1), cB + hstep + kstep, voffB);
        PG8_WAIT_V(6); PG8_BAR;
    }
    for (;;) {
        const bool has_next = S.next(ui + 1, nxt);
        const char* nA = has_next ? (const char*)g.A + (size_t)nxt.pm * tstep + (size_t)nxt.ko * 2 : cA; const char* nB = has_next ? (const char*)g.Bt + (size_t)nxt.pn * tstep + (size_t)nxt.ko * 2 : cB;
        for (int t = 0; t < nt; t += 2) {
            const bool last = (t == nt - 2);
            const char* a1 = cA + (size_t)(t + 1) * kstep;
            const char* a2 = last ? nA : cA + (size_t)(t + 2) * kstep; const char* b2 = last ? nB : cB + (size_t)(t + 2) * kstep;
            const char* a3 = a2 + kstep; const char* b3 = b2 + kstep;
            if (last && has_next) S.a_ready(nxt);
            if constexpr (SP2) {
            PG8_LDB(B0, 0, 0); PG8_LDB(B1, 0, 1); PG8_SCHED; PG8_LDA(At, 0, 0); PG8_STAGE(PG8_SA(1, 1), a1 + hstep, voffA);
            PG8_WAIT_V(8); PG8_WAIT_L(0); PG8_BAR; PG8_MMA(0, 0, At, B0); PG8_MMA(0, 1, At, B1); PG8_BAR; PG8_SCHED;
            PG8_LDA(At, 0, 1); PG8_STAGE(PG8_SB(0, 0), b2, voffB); PG8_STAGE(PG8_SB(0, 1), b2 + hstep, voffB); PG8_STAGE(PG8_SA(0, 0), a2, voffA);
            PG8_WAIT_V(8); PG8_WAIT_L(0); PG8_BAR; PG8_MMA(1, 0, At, B0); PG8_MMA(1, 1, At, B1); PG8_BAR; PG8_SCHED;
            PG8_LDB(B0, 1, 0); PG8_LDB(B1, 1, 1); PG8_SCHED; PG8_LDA(At, 1, 0); PG8_STAGE(PG8_SA(0, 1), a2 + hstep, voffA);
            PG8_WAIT_V(8); PG8_WAIT_L(0); PG8_BAR; PG8_MMA(0, 0, At, B0); PG8_MMA(0, 1, At, B1); PG8_BAR; PG8_SCHED;
            PG8_LDA(At, 1, 1); PG8_STAGE(PG8_SB(1, 0), b3, voffB); PG8_STAGE(PG8_SB(1, 1), b3 + hstep, voffB); PG8_STAGE(PG8_SA(1, 0), a3, voffA);
            PG8_WAIT_V(8); PG8_WAIT_L(0); PG8_BAR; PG8_MMA(1, 0, At, B0); PG8_MMA(1, 1, At, B1); PG8_BAR; PG8_SCHED;
            } else {
            PG8_LDB(B0, 0, 0); PG8_SCHED; PG8_LDA(At, 0, 0); PG8_STAGE(PG8_SA(1, 1), a1 + hstep, voffA);
            PG8_WAIT_L(8); PG8_BAR; PG8_WAIT_L(0); PG8_MMA(0, 0, At, B0); PG8_BAR; PG8_SCHED;
            PG8_LDB(B1, 0, 1); PG8_STAGE(PG8_SB(0, 0), b2, voffB);
            PG8_BAR; PG8_WAIT_L(0); PG8_MMA(0, 1, At, B1); PG8_BAR;
            PG8_LDA(At, 0, 1); PG8_STAGE(PG8_SA(0, 0), a2, voffA);
            PG8_BAR; PG8_WAIT_L(0); PG8_MMA(1, 0, At, B0); PG8_BAR; PG8_SCHED;
            PG8_STAGE(PG8_SB(0, 1), b2 + hstep, voffB);
            PG8_WAIT_V(6); PG8_BAR; PG8_MMA(1, 1, At, B1); PG8_BAR;
            PG8_LDB(B0, 1, 0); PG8_SCHED; PG8_LDA(At, 1, 0); PG8_STAGE(PG8_SA(0, 1), a2 + hstep, voffA);
            PG8_WAIT_L(8); PG8_BAR; PG8_WAIT_L(0); PG8_MMA(0, 0, At, B0); PG8_BAR; PG8_SCHED;
            PG8_LDB(B1, 1, 1); PG8_STAGE(PG8_SB(1, 0), b3, voffB);
            PG8_BAR; PG8_WAIT_L(0); PG8_MMA(0, 1, At, B1); PG8_BAR;
            PG8_LDA(At, 1, 1); PG8_STAGE(PG8_SA(1, 0), a3, voffA);
            PG8_BAR; PG8_WAIT_L(0); PG8_MMA(1, 0, At, B0); PG8_BAR; PG8_SCHED;
            PG8_STAGE(PG8_SB(1, 1), b3 + hstep, voffB);
            PG8_WAIT_V(6); PG8_BAR; PG8_MMA(1, 1, At, B1); PG8_BAR;
            }
        }
        STAMP(30);
        if constexpr (ALIGN_EPI) { if (wr == 0) PG8_BAR; }
        STAMP(31);
        if constexpr (!Epi::AFTER_DRAIN) { E(acc, cur, wr, wc, fr, fq); S.done(cur); }
        STAMP(32);
        if (!has_next) break;
#pragma unroll
        for (int a = 0; a < 2; ++a)
#pragma unroll
            for (int b = 0; b < 2; ++b)
#pragma unroll
                for (int m = 0; m < 4; ++m)
#pragma unroll
                    for (int n = 0; n < 2; ++n) acc[a][b][m][n] = (f32x4){0.f, 0.f, 0.f, 0.f};
        cur = nxt; cA = nA; cB = nB; ++ui;
        if constexpr (ALIGN_EPI) { if (wr == 1) PG8_BAR; }
    }
    PG8_WAIT_V(0);
    if constexpr (!ALIGN_EPI) { if (wr == 0) PG8_BAR; }
    PG8_BAR;
    if constexpr (Epi::AFTER_DRAIN) { E.fused(acc, cur, wr, wc, fr, fq, lds, wid, lane); S.done(cur); }
#undef PG8_SA
#undef PG8_SB
#undef PG8_STAGE
#undef PG8_LDA
#undef PG8_LDB
#undef PG8_MMA
#undef PG8_WAIT_V
#undef PG8_WAIT_L
#undef PG8_BAR
#undef PG8_SCHED
}
}
namespace pg8 {
__device__ __forceinline__ float row_rinv(const float* rowss, size_t R, int fq) {
    const f32x4 v = *(const f32x4*)(rowss + R * 16 + 4 * fq); float s = (v[0] + v[1]) + (v[2] + v[3]);
    s = xl_sumx32(xl_sumx16(s));
    return 1.0f / sqrtf(s * (1.0f / 1024.0f) + 1e-6f);
}
struct EpiResGate {
    static constexpr bool PERM = true, AFTER_DRAIN = false;
    bf16_t* XB; const float* gate; const float* scn; bf16_t* XM; float* rowss;
    __device__ __forceinline__ void operator()(const f32x4 (&acc)[2][2][4][2], const Unit& u, int wr, int wc, int fr, int fq) const {
        asm volatile("" : "+v"(fr), "+v"(fq));
        const int b = u.pm / 33, p = u.pm % 33, bb = (p == 0) ? 4 : b;
        const int col0 = u.pn * BM + wc * 32 + 8 * fq;
        f32x4 (&accw)[2][2][4][2] = const_cast<f32x4 (&)[2][2][4][2]>(acc);
        unsigned sp[2][4];
#pragma unroll
        for (int bj = 0; bj < 2; ++bj)
#pragma unroll
            for (int n = 0; n < 2; ++n) { const f32x4 gq = *(const f32x4*)(gate + bb * 6144 + col0 + bj * HALF + 4 * n);
#pragma unroll
                for (int ai = 0; ai < 2; ++ai)
#pragma unroll
                    for (int m = 0; m < 4; ++m) accw[ai][bj][m][n] *= gq;
                if (scn) { const f32x4 sq = *(const f32x4*)(scn + bb * 6144 + col0 + bj * HALF + 4 * n) + 1.0f; sp[bj][2 * n] = cvt_pk_bf16(sq[0], sq[1]); sp[bj][2 * n + 1] = cvt_pk_bf16(sq[2], sq[3]); }
                else { sp[bj][2 * n] = 0x3f803f80u; sp[bj][2 * n + 1] = 0x3f803f80u; } }
#define PG8_LO(w) __builtin_bit_cast(float, (w) << 16)
#define PG8_HI(w) __builtin_bit_cast(float, (w) & 0xffff0000u)
#pragma unroll
        for (int ai = 0; ai < 2; ++ai) {
            u32x4 xin[4][2];
#pragma unroll
            for (int m = 0; m < 4; ++m) { const size_t R = (size_t)u.pm * BM + ai * HALF + wr * 64 + m * 16 + fr;
#pragma unroll
                for (int bj = 0; bj < 2; ++bj) xin[m][bj] = *(const u32x4*)(XB + R * 1024 + col0 + bj * HALF); }
            asm volatile("" ::: "memory");
#pragma unroll
            for (int m = 0; m < 4; ++m) { const size_t R = (size_t)u.pm * BM + ai * HALF + wr * 64 + m * 16 + fr;
                float ss = 0.f;
#pragma unroll
                for (int bj = 0; bj < 2; ++bj) { const u32x4 xw = xin[m][bj];
                    const f32x4 o0 = (f32x4){PG8_LO(xw.x), PG8_HI(xw.x), PG8_LO(xw.y), PG8_HI(xw.y)} + acc[ai][bj][m][0], o1 = (f32x4){PG8_LO(xw.z), PG8_HI(xw.z), PG8_LO(xw.w), PG8_HI(xw.w)} + acc[ai][bj][m][1];
                    u32x4 w; w.x = cvt_pk_bf16(o0[0], o0[1]); w.y = cvt_pk_bf16(o0[2], o0[3]); w.z = cvt_pk_bf16(o1[0], o1[1]); w.w = cvt_pk_bf16(o1[2], o1[3]);
                    *(u32x4*)(XB + R * 1024 + col0 + bj * HALF) = w;
                    ss += ((o0[0] * o0[0] + o0[1] * o0[1]) + (o0[2] * o0[2] + o0[3] * o0[3])) + ((o1[0] * o1[0] + o1[1] * o1[1]) + (o1[2] * o1[2] + o1[3] * o1[3]));
                    if (scn) { const f32x4 s0 = (f32x4){PG8_LO(sp[bj][0]), PG8_HI(sp[bj][0]), PG8_LO(sp[bj][1]), PG8_HI(sp[bj][1])}, s1 = (f32x4){PG8_LO(sp[bj][2]), PG8_HI(sp[bj][2]), PG8_LO(sp[bj][3]), PG8_HI(sp[bj][3])};
                        const f32x4 y0 = o0 * s0, y1 = o1 * s1; w.x = cvt_pk_bf16(y0[0], y0[1]); w.y = cvt_pk_bf16(y0[2], y0[3]); w.z = cvt_pk_bf16(y1[0], y1[1]); w.w = cvt_pk_bf16(y1[2], y1[3]);
                        *(u32x4*)(XM + R * 1024 + col0 + bj * HALF) = w; } }
                ss = xl_sumx32(xl_sumx16(ss));
                if (fq == 0) rowss[R * 16 + u.pn * 4 + wc] = ss; }
            asm volatile("" ::: "memory");
        }
#undef PG8_LO
#undef PG8_HI
    }
};
struct EpiPartial {
    static constexpr bool PERM = false, AFTER_DRAIN = false;
    float* P; int kslice;
    __device__ __forceinline__ void operator()(const f32x4 (&acc)[2][2][4][2], const Unit& u, int wr, int wc, int fr, int fq) const {
        asm volatile("" : "+v"(fr), "+v"(fq));
        const int b = u.pm / 33, ks = u.ko / kslice; const int col0 = u.pn * BM + wc * 32 + 4 * fq;
        float* rp = P + ((size_t)ks * 1024 + (size_t)b * 256 + wr * 64 + fr) * 1024 + col0;
#pragma unroll
        for (int ai = 0; ai < 2; ++ai)
#pragma unroll
            for (int m = 0; m < 4; ++m) {
#pragma unroll
                for (int bj = 0; bj < 2; ++bj)
#pragma unroll
                    for (int n = 0; n < 2; ++n) *(f32x4*)(rp + bj * HALF + n * 16) = acc[ai][bj][m][n];
                rp += (m == 3 ? 80 : 16) * 1024; asm volatile("" : "+v"(rp)); }
    }
};
struct EpiBf16N {
    static constexpr bool PERM = true, AFTER_DRAIN = false;
    bf16_t* O; int ldc; const float* bias; int nb; const float* rowss; const float* qn; const float* kn; const float* rope; float qscale;
    __device__ __forceinline__ void operator()(const f32x4 (&acc)[2][2][4][2], const Unit& u, int wr, int wc, int fr, int fq) const {
        asm volatile("" : "+v"(fr), "+v"(fq));
        const int b = u.pm / 33, p = u.pm % 33, bb = (p == 0) ? 4 : b;
        const int row0 = u.pm * BM + wr * 64 + fr, col0 = u.pn * BM + wc * 32 + 8 * fq;
        f32x4 bv[2][2];
#pragma unroll
        for (int bj = 0; bj < 2; ++bj)
#pragma unroll
            for (int n = 0; n < 2; ++n) bv[bj][n] = *(const f32x4*)(bias + (size_t)bb * nb + col0 + bj * HALF + 4 * n);
        if (u.pn >= 1 && u.pn <= 3) {
            const int hh = 4 * (u.pn - 1) + wc;
            const int dlo = (fq < 2) ? 8 * fq : 8 * fq + 16;
            bf16_t* obase = O + 256 + hh * 64 + dlo;
            const bool normed = hh < 10, isq = hh < 8;
            f32x4 g1[2], g2[2];
#pragma unroll
            for (int n = 0; n < 2; ++n) { const float* gp = (isq ? qn : kn) + dlo + 4 * n; const float sc = isq ? qscale : 1.0f;
                g1[n] = normed ? *(const f32x4*)gp * sc : (f32x4){1.f, 1.f, 1.f, 1.f}; g2[n] = normed ? *(const f32x4*)(gp + 16) * sc : (f32x4){1.f, 1.f, 1.f, 1.f}; }
#pragma unroll
            for (int ai = 0; ai < 2; ++ai)
#pragma unroll
                for (int m = 0; m < 4; ++m) { const int rl = ai * HALF + wr * 64 + m * 16 + fr; const size_t R = (size_t)u.pm * BM + rl; const float ri = row_rinv(rowss, R, fq);
                    f32x4 v1[2], v2[2];
#pragma unroll
                    for (int n = 0; n < 2; ++n) { v1[n] = acc[ai][0][m][n] * ri + bv[0][n]; v2[n] = acc[ai][1][m][n] * ri + bv[1][n]; }
                    if (normed) {
                        float ss = 0.f;
#pragma unroll
                        for (int n = 0; n < 2; ++n) ss += ((v1[n][0] * v1[n][0] + v1[n][1] * v1[n][1]) + (v1[n][2] * v1[n][2] + v1[n][3] * v1[n][3])) + ((v2[n][0] * v2[n][0] + v2[n][1] * v2[n][1]) + (v2[n][2] * v2[n][2] + v2[n][3] * v2[n][3]));
                        ss = xl_sumx32(xl_sumx16(ss));
                        const float hr = 1.0f / sqrtf(ss * (1.0f / 64.0f) + 1e-6f);
#pragma unroll
                        for (int n = 0; n < 2; ++n) { v1[n] = v1[n] * hr * g1[n]; v2[n] = v2[n] * hr * g2[n]; }
                        if (p != 0) {
                            const float* rp = rope + ((size_t)(256 * (p - 1) + rl) * 32 + 8 * fq) * 2;
#pragma unroll
                            for (int n = 0; n < 2; ++n) { const f32x4 c0 = *(const f32x4*)(rp + 8 * n), c1 = *(const f32x4*)(rp + 8 * n + 4);
                                const f32x4 cs = (f32x4){c0[0], c0[2], c1[0], c1[2]}, sn = (f32x4){c0[1], c0[3], c1[1], c1[3]};
                                const f32x4 o1 = v1[n] * cs - v2[n] * sn, o2 = v1[n] * sn + v2[n] * cs; v1[n] = o1; v2[n] = o2; }
                        }
                    }
                    u32x4 w; w.x = cvt_pk_bf16(v1[0][0], v1[0][1]); w.y = cvt_pk_bf16(v1[0][2], v1[0][3]); w.z = cvt_pk_bf16(v1[1][0], v1[1][1]); w.w = cvt_pk_bf16(v1[1][2], v1[1][3]);
                    *(u32x4*)(obase + R * ldc) = w;
                    w.x = cvt_pk_bf16(v2[0][0], v2[0][1]); w.y = cvt_pk_bf16(v2[0][2], v2[0][3]); w.z = cvt_pk_bf16(v2[1][0], v2[1][1]); w.w = cvt_pk_bf16(v2[1][2], v2[1][3]);
                    *(u32x4*)(obase + R * ldc + 16) = w; }
            return;
        }
#pragma unroll
        for (int ai = 0; ai < 2; ++ai)
#pragma unroll
            for (int m = 0; m < 4; ++m) { const size_t R = (size_t)(row0 + ai * HALF + m * 16); const float ri = row_rinv(rowss, R, fq); bf16_t* rowp = O + R * ldc + col0;
#pragma unroll
                for (int bj = 0; bj < 2; ++bj) { const f32x4 v0 = acc[ai][bj][m][0] * ri + bv[bj][0], v1 = acc[ai][bj][m][1] * ri + bv[bj][1];
                    u32x4 w; w.x = cvt_pk_bf16(v0[0], v0[1]); w.y = cvt_pk_bf16(v0[2], v0[3]); w.z = cvt_pk_bf16(v1[0], v1[1]); w.w = cvt_pk_bf16(v1[2], v1[3]);
                    *(u32x4*)(rowp + bj * HALF) = w; } }
    }
};
struct EpiSwiGLU {
    static constexpr bool PERM = true, AFTER_DRAIN = false;
    bf16_t* O; int ldc; const float* bias; int nb; const float* rowss;
    __device__ __forceinline__ void operator()(const f32x4 (&acc)[2][2][4][2], const Unit& u, int wr, int wc, int fr, int fq) const {
        asm volatile("" : "+v"(fr), "+v"(fq));
        const int b = u.pm / 33, p = u.pm % 33, bb = (p == 0) ? 4 : b;
        const int row0 = u.pm * BM + wr * 64 + fr, col0 = u.pn * HALF + wc * 32 + 8 * fq, bcol0 = u.pn * BM + wc * 32 + 8 * fq;
        f32x4 bv[2][2];
#pragma unroll
        for (int bj = 0; bj < 2; ++bj)
#pragma unroll
            for (int n = 0; n < 2; ++n) bv[bj][n] = *(const f32x4*)(bias + (size_t)bb * nb + bcol0 + bj * HALF + 4 * n);
#pragma unroll
        for (int ai = 0; ai < 2; ++ai)
#pragma unroll
            for (int m = 0; m < 4; ++m) { const size_t R = (size_t)(row0 + ai * HALF + m * 16); const float ri = row_rinv(rowss, R, fq); bf16_t* rowp = O + R * ldc + col0;
                float hv[8];
#pragma unroll
                for (int n = 0; n < 2; ++n)
#pragma unroll
                    for (int e = 0; e < 4; ++e) { const float g = acc[ai][0][m][n][e] * ri + bv[0][n][e], up = acc[ai][1][m][n][e] * ri + bv[1][n][e];
                        hv[n * 4 + e] = g * up * __builtin_amdgcn_rcpf(1.0f + __builtin_amdgcn_exp2f(-1.44269504089f * g)); }
                u32x4 w; w.x = cvt_pk_bf16(hv[0], hv[1]); w.y = cvt_pk_bf16(hv[2], hv[3]); w.z = cvt_pk_bf16(hv[4], hv[5]); w.w = cvt_pk_bf16(hv[6], hv[7]);
                *(u32x4*)rowp = w; }
    }
};
}
#ifndef PG8_SP2
#define PG8_SP2 true
#endif
#ifndef PG8_ALIGN
#define PG8_ALIGN true
#endif
#include <hip/hip_bf16.h>
#include <cmath>
namespace attn_body {
using bf16=__hip_bfloat16;
using bf16x8=__attribute__((ext_vector_type(8)))short;
using s16x4=__attribute__((ext_vector_type(4)))short;
using f32x16=__attribute__((ext_vector_type(16)))float;
using u32x4=__attribute__((ext_vector_type(4)))unsigned;
constexpr int D=64,PQ=2304,PO=1280;
constexpr int NW=8,QBLK=32,QB=QBLK*NW,KVBLK=64;
constexpr int ATTN_UNIT_ROWS=QB;
__device__ __forceinline__ int crow(int r,int hi){return (r&3)+8*(r>>2)+4*hi;}
#define SBAR() __builtin_amdgcn_sched_barrier(0)
constexpr int NSLOT=3, SLOTB=8192;
constexpr int LDS_K=0, LDS_V=NSLOT*SLOTB, LDS_WS=2*NSLOT*SLOTB, LDS_OST=LDS_WS+NW*64*4, LDS_BYTES=LDS_OST+NW*4096;
constexpr float C2=0.125f*1.4426950408889634f;
__device__ __forceinline__ void glds16(const void*gsrc,unsigned lds_dst){unsigned keep;
  asm volatile("s_mov_b32 %0, m0\n\ts_mov_b32 m0, %2\n\ts_nop 0\n\tglobal_load_lds_dwordx4 %1, off\n\ts_mov_b32 m0, %0":"=&s"(keep):"v"(gsrc),"s"(lds_dst):"memory");}
__device__ __forceinline__ float max3f(float a,float b,float c){float r;asm("v_max3_f32 %0, %1, %2, %3":"=v"(r):"v"(a),"v"(b),"v"(c));return r;}
__device__ __forceinline__ float max2f(float a,float b){float r;asm("v_max_f32_e32 %0, %1, %2":"=v"(r):"v"(a),"v"(b));return r;}
__device__ __forceinline__ float fadd_s(float a,float b){float r;asm("v_add_f32_e32 %0, %1, %2":"=v"(r):"v"(a),"v"(b));return r;}
__device__ __forceinline__ float fsub_s(float a,float b){float r;asm("v_sub_f32_e32 %0, %1, %2":"=v"(r):"v"(a),"v"(b));return r;}
typedef float f32x2_t __attribute__((ext_vector_type(2))); typedef __bf16 bf16x2_t __attribute__((ext_vector_type(2)));
__device__ __forceinline__ unsigned cvtpk_s(float lo,float hi){f32x2_t v={lo,hi};bf16x2_t b=__builtin_convertvector(v,bf16x2_t);return __builtin_bit_cast(unsigned,b);}
#define WAIT_BAR(N) asm volatile("s_waitcnt vmcnt(" #N ") lgkmcnt(0)\n\ts_barrier":::"memory")

__device__ __forceinline__ void qkt(f32x16&p0,f32x16&p1,const char*Kslot,const bf16x8*qr,const f32x16&negm,int r32,int hi){
  const char*kb=Kslot+hi*1024+r32*16;
  #pragma unroll
  for(int d0=0;d0<4;++d0){
    const bf16x8 b0=*reinterpret_cast<const bf16x8*>(kb+d0*2048);
    const bf16x8 b1=*reinterpret_cast<const bf16x8*>(kb+d0*2048+512);
    if(d0==0){p0=__builtin_amdgcn_mfma_f32_32x32x16_bf16(b0,qr[0],negm,0,0,0);p1=__builtin_amdgcn_mfma_f32_32x32x16_bf16(b1,qr[0],negm,0,0,0);}
    else{p0=__builtin_amdgcn_mfma_f32_32x32x16_bf16(b0,qr[d0],p0,0,0,0);p1=__builtin_amdgcn_mfma_f32_32x32x16_bf16(b1,qr[d0],p1,0,0,0);}}
}
typedef __attribute__((address_space(3))) const char* lds_cptr;
typedef short v4i16_t __attribute__((ext_vector_type(4)));
__device__ __forceinline__ void kload8(bf16x8*kf,lds_cptr kp){
  kf[0]=*(const __attribute__((address_space(3))) bf16x8*)(kp);      kf[1]=*(const __attribute__((address_space(3))) bf16x8*)(kp+512);
  kf[2]=*(const __attribute__((address_space(3))) bf16x8*)(kp+2048); kf[3]=*(const __attribute__((address_space(3))) bf16x8*)(kp+2560);
  kf[4]=*(const __attribute__((address_space(3))) bf16x8*)(kp+4096); kf[5]=*(const __attribute__((address_space(3))) bf16x8*)(kp+4608);
  kf[6]=*(const __attribute__((address_space(3))) bf16x8*)(kp+6144); kf[7]=*(const __attribute__((address_space(3))) bf16x8*)(kp+6656);
}
__device__ __forceinline__ void kload2(bf16x8*kf,lds_cptr kp,int j){ kf[2*j]=*(const __attribute__((address_space(3))) bf16x8*)(kp+j*2048); kf[2*j+1]=*(const __attribute__((address_space(3))) bf16x8*)(kp+j*2048+512); }
__device__ __forceinline__ s16x4 vtr(lds_cptr p){ return __builtin_bit_cast(s16x4,__builtin_amdgcn_ds_read_tr16_b64_v4i16((__attribute__((address_space(3))) v4i16_t*)p)); }
__device__ __forceinline__ float rowmax(const f32x16&p0,const f32x16&p1){
  float a=max3f(p0[0],p0[1],p1[0]),b=max3f(p0[2],p0[3],p1[1]);a=max3f(a,p1[2],p1[3]);
  #pragma unroll
  for(int r=4;r<16;r+=4){a=max3f(a,p0[r],p0[r+1]);b=max3f(b,p0[r+2],p0[r+3]);a=max3f(a,p1[r],p1[r+1]);b=max3f(b,p1[r+2],p1[r+3]);}
  const float m=max2f(a,b);
  auto rr=__builtin_amdgcn_permlane32_swap(__float_as_uint(m),__float_as_uint(m),false,false);
  return max2f(__uint_as_float(rr[0]),__uint_as_float(rr[1]));
}
__device__ __forceinline__ void pv(f32x16*o,int vb,bf16x8 pa0,bf16x8 pa1,bf16x8 pa2,bf16x8 pa3){
  #pragma unroll
  for(int d0=0;d0<2;++d0){s16x4 lo[4],hi[4];
    #pragma unroll
    for(int ks=0;ks<4;++ks){
      asm volatile("ds_read_b64_tr_b16 %0,%1 offset:%c2":"=&v"(lo[ks]):"v"(vb),"i"(d0*4096+ks*1024):"memory");
      asm volatile("ds_read_b64_tr_b16 %0,%1 offset:%c2":"=&v"(hi[ks]):"v"(vb),"i"(d0*4096+ks*1024+512):"memory");}
    asm volatile("s_waitcnt lgkmcnt(0)":::"memory");SBAR();
    #define PK(k) (bf16x8){lo[k][0],lo[k][1],lo[k][2],lo[k][3],hi[k][0],hi[k][1],hi[k][2],hi[k][3]}
    o[d0]=__builtin_amdgcn_mfma_f32_32x32x16_bf16(pa0,PK(0),o[d0],0,0,0);
    o[d0]=__builtin_amdgcn_mfma_f32_32x32x16_bf16(pa1,PK(1),o[d0],0,0,0);
    o[d0]=__builtin_amdgcn_mfma_f32_32x32x16_bf16(pa2,PK(2),o[d0],0,0,0);
    o[d0]=__builtin_amdgcn_mfma_f32_32x32x16_bf16(pa3,PK(3),o[d0],0,0,0);
    #undef PK
  }
}

#ifndef ATTN_STORE16
#define ATTN_STORE16(p,v) (*(u32x4*)(p)=(v))
#endif
template<int THRL> __device__ __forceinline__ void attn_unit(const bf16*Qu,const bf16*__restrict__ Kh,const bf16*__restrict__ Vh,bf16*Ou,const int NT,char*shm,int tid){
  const int lane=tid&63,r32=lane&31,hi=lane>>5; const int wid=__builtin_amdgcn_readfirstlane(tid>>6);
  const bf16*Qw=Qu+(long)(wid*QBLK)*PQ;
  const unsigned lds0=(unsigned)(uintptr_t)shm;
  float*wsf=(float*)(shm+LDS_WS)+wid*64;
  const bf16*ksrc=Kh+(long)lane*PQ+wid*8;
  const bf16*vsrc=Vh+(long)(16*(wid&3)+(lane>>2))*PQ+(wid>>2)*32+(lane&3)*8;
  const unsigned kdst=lds0+LDS_K+wid*1024, vdst=lds0+LDS_V+wid*1024;
  #define DMA_K(t,slot) glds16(ksrc+(long)(t)*KVBLK*PQ,(unsigned)__builtin_amdgcn_readfirstlane(kdst+(slot)))
  #define DMA_V(t,slot) glds16(vsrc+(long)(t)*KVBLK*PQ,(unsigned)__builtin_amdgcn_readfirstlane(vdst+(slot)))
  const int vb0=(int)(lds0+LDS_V)+((lane>>4)&1)*32+(lane&3)*8+(4*hi+((lane&15)>>2))*64;
  const char*Kbase=shm+LDS_K; bf16x8 kf[8];
  const lds_cptr shm3=(lds_cptr)shm; const lds_cptr kp0=shm3+LDS_K+hi*1024+r32*16; const lds_cptr vp0=shm3+LDS_V+((lane>>4)&1)*32+(lane&3)*8+(4*hi+((lane&15)>>2))*64;
  DMA_K(0,0);DMA_V(0,0);DMA_K(1,SLOTB);
  bf16x8 qr[4];
  #pragma unroll
  for(int d0=0;d0<4;++d0)qr[d0]=*reinterpret_cast<const bf16x8*>(&Qw[(long)r32*PQ+d0*16+hi*8]);
  float mhat=0.f,l_reg=0.f;f32x16 o[2];o[0]=f32x16{};o[1]=f32x16{};f32x16 negm=f32x16{};asm volatile("":"+v"(negm));
  #define CMASK(P0,P1,t) do{}while(0)
  bool resc=false;
  #define START(P0,P1) do{ const float rm=rowmax(P0,P1); resc=false; \
    { const float dl=rm; mhat=fadd_s(mhat,dl); \
      _Pragma("unroll") for(int r=0;r<16;++r){P0[r]=fsub_s(P0[r],dl);P1[r]=fsub_s(P1[r],dl);} \
      _Pragma("unroll") for(int r=0;r<16;++r)negm[r]=-mhat; asm volatile("":"+v"(negm)); } \
    _Pragma("unroll") for(int r=0;r<16;++r)P0[r]=__builtin_amdgcn_exp2f(P0[r]); }while(0)
  #define RESC() do{ if(resc){ asm volatile("s_waitcnt lgkmcnt(0)":::"memory"); \
      _Pragma("unroll") for(int d_=0;d_<2;++d_) _Pragma("unroll") for(int r=0;r<16;++r)o[d_][r]*=wsf[crow(r,hi)]; } }while(0)
  f32x16 pA0,pA1,pB0,pB1;
  int sl_prev=0,sl_cur=0,sl_next=SLOTB;
  #define ROT() do{sl_prev=sl_cur;sl_cur=sl_next;sl_next=(sl_next==(NSLOT-1)*SLOTB)?0:sl_next+SLOTB;}while(0)
  DMA_K(2,2*SLOTB);
  WAIT_BAR(3);
  qkt(pA0,pA1,Kbase,qr,negm,r32,hi);asm volatile("s_nop 15\n\ts_nop 7":"+v"(pA0),"+v"(pA1));CMASK(pA0,pA1,0);
  START(pA0,pA1);
  _Pragma("unroll") for(int r=0;r<16;++r)pA1[r]=__builtin_amdgcn_exp2f(pA1[r]);
  WAIT_BAR(0);
  DMA_K(3,0);DMA_V(1,SLOTB);
  ROT();
  kload8(kf,kp0+sl_cur);
  WAIT_BAR(2);
  s16x4 vlo[8],vhi[8]; u32x4 pw0,pw1,pw2,pw3;
  #define PKW(P,B) cvtpk_s(P[B],P[B+1])
  #define PAF(k) __builtin_bit_cast(bf16x8,pw##k)
  #define VFR(i) (bf16x8){vlo[i][0],vlo[i][1],vlo[i][2],vlo[i][3],vhi[i][0],vhi[i][1],vhi[i][2],vhi[i][3]}
  #define PIN(x) asm volatile("":"+v"(x))
  #define MX3(a,b,c) __builtin_fmaxf(__builtin_fmaxf((a),(b)),(c))
  #define GAPA(MF,A0,A1,A2,A3,W0,W1,PW) do{ MF; sacc+=A0; sacc+=A1; sacc+=A2; sacc+=A3; PIN(sacc); W0; W1; PIN(PW); SBAR(); }while(0)
  #define EX(v) __builtin_amdgcn_exp2f(v)
  #define GAPB(MF,X,B) do{ MF; X[B]=EX(X[B]); X[B+1]=EX(X[B+1]); X[B+2]=EX(X[B+2]); X[B+3]=EX(X[B+3]); PIN(X); SBAR(); }while(0)
  #define VRD(i) do{ vlo[i]=vtr(vp_+(((i)>>2)*4096+((i)&3)*1024)); vhi[i]=vtr(vp_+(((i)>>2)*4096+((i)&3)*1024+512)); }while(0)
  #define KRD(G,j) do{ if(G){ kload2(kf,kp0+sl_next,j); SBAR(); } }while(0)
  #define STEP(C0,C1,P0,P1,t,GK,GV,GL) do{ SBAR(); \
    const lds_cptr vp_=vp0+sl_prev; \
    VRD(0); SBAR(); float sacc=(P0[0]+P0[1]); \
    GAPA(C0=__builtin_amdgcn_mfma_f32_32x32x16_bf16(kf[0],qr[0],negm,0,0,0), P0[2],P0[3],P0[4],P0[5],     pw0[0]=PKW(P0,0), pw0[1]=PKW(P0,2), pw0); \
    VRD(4); SBAR(); GAPA(C1=__builtin_amdgcn_mfma_f32_32x32x16_bf16(kf[1],qr[0],negm,0,0,0), P0[6],P0[7],P0[8],P0[9],     pw0[2]=PKW(P0,4), pw0[3]=PKW(P0,6), pw0); \
    VRD(1); SBAR(); GAPA(C0=__builtin_amdgcn_mfma_f32_32x32x16_bf16(kf[2],qr[1],C0,0,0,0),   P0[10],P0[11],P0[12],P0[13], pw1[0]=PKW(P0,8), pw1[1]=PKW(P0,10), pw1); \
    VRD(5); SBAR(); GAPA(C1=__builtin_amdgcn_mfma_f32_32x32x16_bf16(kf[3],qr[1],C1,0,0,0),   P0[14],P0[15],P1[0],P1[1],   pw1[2]=PKW(P0,12),pw1[3]=PKW(P0,14), pw1); \
    VRD(2); SBAR(); GAPA(C0=__builtin_amdgcn_mfma_f32_32x32x16_bf16(kf[4],qr[2],C0,0,0,0),   P1[2],P1[3],P1[4],P1[5],     pw2[0]=PKW(P1,0), pw2[1]=PKW(P1,2), pw2); \
    VRD(6); SBAR(); GAPA(C1=__builtin_amdgcn_mfma_f32_32x32x16_bf16(kf[5],qr[2],C1,0,0,0),   P1[6],P1[7],P1[8],P1[9],     pw2[2]=PKW(P1,4), pw2[3]=PKW(P1,6), pw2); \
    VRD(3); SBAR(); GAPA(C0=__builtin_amdgcn_mfma_f32_32x32x16_bf16(kf[6],qr[3],C0,0,0,0),   P1[10],P1[11],P1[12],P1[13], pw3[0]=PKW(P1,8), pw3[1]=PKW(P1,10), pw3); \
    VRD(7); SBAR(); GAPA(C1=__builtin_amdgcn_mfma_f32_32x32x16_bf16(kf[7],qr[3],C1,0,0,0),   P1[14],P1[15],0.f,0.f,       pw3[2]=PKW(P1,12),pw3[3]=PKW(P1,14), pw3); \
    l_reg+=sacc; \
    if(GK){DMA_K((t)+3,sl_cur);} if(GV){DMA_V((t)+1,sl_next);} \
    CMASK(C0,C1,t); \
    { float a=MX3(C0[0],C0[1],C1[0]),b=MX3(C0[2],C0[3],C1[1]); a=MX3(a,C1[2],C1[3]); \
      _Pragma("unroll") for(int r=4;r<16;r+=4){a=MX3(a,C0[r],C0[r+1]);b=MX3(b,C0[r+2],C0[r+3]);a=MX3(a,C1[r],C1[r+1]);b=MX3(b,C1[r+2],C1[r+3]);} \
      float rm=__builtin_fmaxf(a,b); { auto rr=__builtin_amdgcn_permlane32_swap(__float_as_uint(rm),__float_as_uint(rm),false,false); rm=__builtin_fmaxf(__uint_as_float(rr[0]),__uint_as_float(rr[1])); } \
      resc=false; \
      if(__builtin_expect(__any(rm>(float)THRL),0)){ const float dl=__builtin_fmaxf(rm,0.f); mhat+=dl; \
        _Pragma("unroll") for(int r=0;r<16;++r){C0[r]-=dl;C1[r]-=dl;} \
        _Pragma("unroll") for(int r=0;r<16;++r)negm[r]=-mhat; asm volatile("":"+v"(negm)); \
        const float f=__builtin_amdgcn_exp2f(-dl); l_reg*=f; if(hi==0)wsf[r32]=f; resc=true; } } \
    SBAR(); \
    GAPB(o[0]=__builtin_amdgcn_mfma_f32_32x32x16_bf16(PAF(0),VFR(0),o[0],0,0,0), C0,0); \
    GAPB(o[1]=__builtin_amdgcn_mfma_f32_32x32x16_bf16(PAF(0),VFR(4),o[1],0,0,0), C0,4); \
    KRD(GL,0); GAPB(o[0]=__builtin_amdgcn_mfma_f32_32x32x16_bf16(PAF(1),VFR(1),o[0],0,0,0), C0,8); \
    KRD(GL,1); GAPB(o[1]=__builtin_amdgcn_mfma_f32_32x32x16_bf16(PAF(1),VFR(5),o[1],0,0,0), C0,12); \
    KRD(GL,2); GAPB(o[0]=__builtin_amdgcn_mfma_f32_32x32x16_bf16(PAF(2),VFR(2),o[0],0,0,0), C1,0); \
    KRD(GL,3); GAPB(o[1]=__builtin_amdgcn_mfma_f32_32x32x16_bf16(PAF(2),VFR(6),o[1],0,0,0), C1,4); \
    GAPB(o[0]=__builtin_amdgcn_mfma_f32_32x32x16_bf16(PAF(3),VFR(3),o[0],0,0,0), C1,8); \
    GAPB(o[1]=__builtin_amdgcn_mfma_f32_32x32x16_bf16(PAF(3),VFR(7),o[1],0,0,0), C1,12); \
    }while(0)
  int t=1;
  #undef CMASK
  #define CMASK(P0,P1,t) do{}while(0)
  for(;t+5<NT;t+=2){
    STEP(pB0,pB1,pA0,pA1,t,true,true,true);     WAIT_BAR(2); RESC(); ROT();
    STEP(pA0,pA1,pB0,pB1,t+1,true,true,true);   WAIT_BAR(2); RESC(); ROT();
  }
  #undef CMASK
  #define CMASK(P0,P1,t) do{}while(0)
  #define ENDW(tt) do{ if((tt)+3<NT){WAIT_BAR(2);} else if((tt)+2<NT){WAIT_BAR(1);} else {WAIT_BAR(0);} }while(0)
  for(;t+1<NT;t+=2){
    STEP(pB0,pB1,pA0,pA1,t,(t+3<NT),(t+1<NT),(t+1<NT));       ENDW(t);   RESC(); ROT();
    STEP(pA0,pA1,pB0,pB1,t+1,(t+4<NT),(t+2<NT),(t+2<NT));     ENDW(t+1); RESC(); ROT();
  }
  STEP(pB0,pB1,pA0,pA1,NT-1,false,false,false); RESC();
  { float sacc=pB0[0]+pB0[1]; _Pragma("unroll") for(int r=2;r<16;++r)sacc+=pB0[r]; _Pragma("unroll") for(int r=0;r<16;++r)sacc+=pB1[r]; l_reg+=sacc;
    pw0=(u32x4){PKW(pB0,0),PKW(pB0,2),PKW(pB0,4),PKW(pB0,6)};pw1=(u32x4){PKW(pB0,8),PKW(pB0,10),PKW(pB0,12),PKW(pB0,14)};pw2=(u32x4){PKW(pB1,0),PKW(pB1,2),PKW(pB1,4),PKW(pB1,6)};pw3=(u32x4){PKW(pB1,8),PKW(pB1,10),PKW(pB1,12),PKW(pB1,14)};
    SBAR(); pv(o,vb0+sl_cur,PAF(0),PAF(1),PAF(2),PAF(3)); }
  #undef PKW
  #undef PAF
  #undef VFR
  #undef PIN
  #undef MX3
  #undef GAPA
  #undef GAPB
  #undef EX
  #undef VRD
  #undef KRD
  #undef STEP
  #undef ENDW
  {auto rr=__builtin_amdgcn_permlane32_swap(__float_as_uint(l_reg),__float_as_uint(l_reg),false,false);l_reg=__uint_as_float(rr[0])+__uint_as_float(rr[1]);}
  if(hi==0)wsf[32+r32]=l_reg;asm volatile("s_waitcnt lgkmcnt(0)":::"memory");
  float rli[16];
  #pragma unroll
  for(int r=0;r<16;++r)rli[r]=__builtin_amdgcn_rcpf(wsf[32+crow(r,hi)]);
  bf16*Ow=Ou+(long)(wid*QBLK)*PO;
  { bf16*stg=(bf16*)(shm+LDS_OST)+wid*2048;
    #pragma unroll
    for(int r=0;r<16;++r){const int orow=crow(r,hi);
      #pragma unroll
      for(int d0=0;d0<2;++d0)stg[orow*64+d0*32+r32]=__float2bfloat16(o[d0][r]*rli[r]);}
    asm volatile("s_waitcnt lgkmcnt(0)":::"memory");
    #pragma unroll
    for(int i=0;i<4;++i){const int row=i*8+(lane>>3),ch=lane&7; const u32x4 v=*(const u32x4*)(stg+row*64+ch*8); ATTN_STORE16(Ow+(long)row*PO+ch*8,v);} }
  asm volatile("s_waitcnt lgkmcnt(0)\n\ts_barrier":::"memory");
  #undef DMA_K
  #undef DMA_V
  #undef CMASK
  #undef START
  #undef RESC
  #undef ROT
}
constexpr int ATTN_LDS_BYTES=LDS_BYTES;
#undef SBAR
#undef WAIT_BAR
}

constexpr int NWAVES = 8, NTHREADS = NWAVES * 64;
constexpr int DM = 1024, NB = 4, SEQ = 8192, CTXL = 256, DEPTH = 4;
constexpr int TPB = SEQ + CTXL;
constexpr int MROWS = NB * TPB;
constexpr int PROJ = 2304, DFF = 2816, KMIX = 1280;
constexpr int OFF_Q = 256, OFF_K = 768, OFF_V = 896, OFF_FF = 1024, OFF_FB = 1280, OFF_I = 1536, OFF_HQ = 1792, OFF_G = 2048;
constexpr int MIX_P = 0, MIX_Q = 256, MIX_A = 512, MIX_R = 1024;
constexpr float EPS = 1e-6f;
constexpr float QSCALE = 0.125f * 1.4426950408889634f;
constexpr int MOD_SH_A = 0, MOD_SC_A = 1024, MOD_G_A = 2048, MOD_SH_F = 3072, MOD_SC_F = 4096, MOD_G_F = 5120;

constexpr size_t MiB = 1u << 20;
constexpr size_t WS_CTL = 0, CTL_ZERO_BYTES = 1 * MiB;
constexpr size_t WS_MODS = 1 * MiB;
constexpr size_t WS_LB = WS_MODS + 512 * 1024;
constexpr size_t WS_TW = WS_LB + 65536;
constexpr size_t WS_FT128 = WS_TW + 65536;
constexpr size_t WS_W64F = WS_FT128 + 65536;
constexpr size_t WS_CT256 = WS_W64F + 16384;
static_assert(WS_CT256 + 262144 <= 2 * MiB, "tables");
constexpr size_t WS_ROPE = 2 * MiB;
constexpr size_t WS_TF = 4 * MiB;
constexpr size_t WS_XC = 6 * MiB;
constexpr size_t WS_WIN = 10 * MiB;
constexpr size_t WS_WOUT = 28 * MiB;
constexpr size_t WS_WGU = 38 * MiB;
constexpr size_t WS_WDN = 82 * MiB;
constexpr size_t WS_XB = 104 * MiB;
constexpr size_t WS_HGS = 170 * MiB;
constexpr size_t WS_UX = 236 * MiB;
constexpr size_t WS_MIX = 385 * MiB;
constexpr size_t WS_H = WS_UX;
constexpr size_t WS_HGG = 468 * MiB;
constexpr size_t WS_ROWSS = 470 * MiB;
constexpr size_t WS_BIASA = 473 * MiB;
constexpr size_t WS_BIASF = 474 * MiB;
constexpr size_t WS_END = 475 * MiB;
static_assert(WS_UX + (size_t)MROWS * PROJ * 2 <= WS_MIX && WS_MIX + (size_t)MROWS * KMIX * 2 <= WS_END && WS_H + (size_t)MROWS * DFF * 2 <= WS_END, "d_ws map");
static_assert(WS_XB + (size_t)MROWS * DM * 2 <= WS_HGS && WS_HGS + (size_t)2 * MROWS * 256 * 4 <= WS_UX, "d_ws map 2");
constexpr int CW_TMO = 0, CW_CODE = 1, CW_BAR = 4096;

constexpr int RING_OFF = 0, RING_BYTES = 131072;
constexpr int LDSCTL_OFF = RING_BYTES, MISC_OFF = LDSCTL_OFF + 320;
constexpr int LDS_BYTES = 147456;

#define GAS __attribute__((address_space(1)))
#define LAS __attribute__((address_space(3)))
typedef unsigned short bf16;
typedef unsigned v4u __attribute__((ext_vector_type(4)));
typedef float f32x4 __attribute__((ext_vector_type(4)));
typedef short bf16x8 __attribute__((ext_vector_type(8)));
typedef GAS unsigned gu32;
typedef GAS unsigned long long gu64;
#define RLX_AGENT __ATOMIC_RELAXED, __HIP_MEMORY_SCOPE_AGENT
#define LDS_WAIT() asm volatile("s_waitcnt lgkmcnt(0)" ::: "memory")
#define VM_WAIT() asm volatile("s_waitcnt vmcnt(0)" ::: "memory")
__device__ __forceinline__ unsigned long long rt() { return __builtin_amdgcn_s_memrealtime(); }
__device__ __forceinline__ unsigned f2bf(float f) { unsigned u = __builtin_bit_cast(unsigned, f); return (u + 0x7fffu + ((u >> 16) & 1u)) >> 16; }
__device__ __forceinline__ unsigned pk2(float lo, float hi) { return f2bf(lo) | (f2bf(hi) << 16); }

#define XB_TMO      128
#define XB_XCNT(j)  (256  + 64 * (j))
#define XB_XSUB(j)  (1280 + 64 * (j))
#define XB_XGEN(j)  (2304 + 64 * (j))
#define XB_TOP      3328
#define XB_TOPGEN   3392
#define XCD_BAR_WORDS 3456
#define XB_SPIN_CAP (1u << 18)

__device__ __forceinline__ unsigned xb_ld(unsigned* p)              { return __hip_atomic_load(p, __ATOMIC_RELAXED, __HIP_MEMORY_SCOPE_AGENT); }
__device__ __forceinline__ unsigned xb_add(unsigned* p, unsigned v) { return __hip_atomic_fetch_add(p, v, __ATOMIC_RELAXED, __HIP_MEMORY_SCOPE_AGENT); }
__device__ __forceinline__ unsigned xb_xcc_id() { return (unsigned)__builtin_amdgcn_s_getreg((3 << 11) | 20) & 0xFu; }
#define XB_SPIN(cond, bar) do { unsigned _sp = 0; while (cond) { __builtin_amdgcn_s_sleep(1); \
    if ((++_sp & 255u) == 0u) { if (xb_ld(&(bar)[XB_TMO])) break; if (_sp > XB_SPIN_CAP) { atomicAdd(&(bar)[XB_TMO], 1u); break; } } } } while (0)

struct XcdBarrier {
    unsigned* bar; unsigned x;
    volatile LAS unsigned* st;
};

__device__ __forceinline__ XcdBarrier xcd_barrier_post(unsigned* bar, volatile LAS unsigned* st) {
    XcdBarrier b; b.bar = bar; b.x = xb_xcc_id(); b.st = st;
    if (threadIdx.x == 0) (void)xb_add(&bar[XB_XCNT(b.x)], 1u);
    return b;
}
__device__ __forceinline__ void xcd_barrier_complete(unsigned* bar, unsigned x, unsigned& nloc, unsigned& nx) {
    const unsigned G = gridDim.x * gridDim.y * gridDim.z;
    unsigned sum, cnt, mine, sp = 0u;
    for (;;) {
        sum = 0u; cnt = 0u; mine = 0u;
#pragma unroll
        for (unsigned j = 0; j < 16; ++j) { const unsigned c = xb_ld(&bar[XB_XCNT(j)]); sum += c; cnt += (c > 0u) ? 1u : 0u; mine = (j == x) ? c : mine; }
        if (sum == G) break;
        __builtin_amdgcn_s_sleep(1);
        if ((++sp & 255u) == 0u) { if (xb_ld(&bar[XB_TMO])) break; if (sp > XB_SPIN_CAP) { atomicAdd(&bar[XB_TMO], 1u); break; } }
    }
    nloc = mine > 0u ? mine : 1u; nx = cnt > 0u ? cnt : 1u;
}

__device__ __forceinline__ void xcd_barrier(const XcdBarrier& b) {
    asm volatile("s_waitcnt vmcnt(0)" ::: "memory");
    __syncthreads();
    if (threadIdx.x == 0) {
        unsigned* bar = b.bar;
        __builtin_amdgcn_s_waitcnt(0);
        unsigned nloc = b.st[0], nx = b.st[1];
        if (nloc == 0u) { xcd_barrier_complete(bar, b.x, nloc, nx); b.st[0] = nloc; b.st[1] = nx; }
        const unsigned old = xb_add(&bar[XB_XSUB(b.x)], 1u);
        const unsigned gen = old / nloc;
        if (old + 1u == (gen + 1u) * nloc) {
            __builtin_amdgcn_fence(__ATOMIC_RELEASE, "agent");
            asm volatile("s_waitcnt vmcnt(0)" ::: "memory");
            const unsigned og = xb_add(&bar[XB_TOP], 1u);
            const unsigned tg = og / nx;
            if (og + 1u == (tg + 1u) * nx) xb_add(&bar[XB_TOPGEN], 1u);
            else XB_SPIN(xb_ld(&bar[XB_TOPGEN]) == tg, bar);
            __builtin_amdgcn_fence(__ATOMIC_ACQUIRE, "agent");
            xb_add(&bar[XB_XGEN(b.x)], 1u);
            asm volatile("s_waitcnt vmcnt(0)" ::: "memory");
        } else {
            XB_SPIN(xb_ld(&bar[XB_XGEN(b.x)]) == gen, bar);
            __builtin_amdgcn_fence(__ATOMIC_ACQUIRE, "agent");
            asm volatile("s_waitcnt vmcnt(0)" ::: "memory");
        }
    }
    __syncthreads();
}

typedef float f32x2 __attribute__((ext_vector_type(2)));
typedef unsigned u32x2 __attribute__((ext_vector_type(2)));
typedef const GAS float* const __attribute__((address_space(4)))* kargs_t;
struct Frame {
    LAS unsigned char* lds;
    volatile LAS unsigned* MISC;
    int tid, lane, wave, vcu, G;
    unsigned long long dt, da;
    GAS unsigned char* ws; GAS float* outg;
    __device__ __forceinline__ float* out_() const { return (float*)outg; }
    __device__ __forceinline__ bf16* HN() const { return (bf16*)outg; }
    __device__ __forceinline__ const float* in(int i) const { return (const float*)(((kargs_t)__builtin_amdgcn_kernarg_segment_ptr())[i]); }
#define FIN(name, idx) __device__ __forceinline__ const float* name() const { return in(idx); }
    FIN(x, 0) FIN(c, 1) FIN(ctx, 2) FIN(c_ctx, 3) FIN(w_ada, 4) FIN(b_ada, 5) FIN(w_in, 6) FIN(w_four, 7) FIN(q_norm, 8) FIN(k_norm, 9) FIN(hg_lb, 10) FIN(hg_norm, 11) FIN(w_out, 12) FIN(w_gate, 13) FIN(w_up, 14) FIN(w_down, 15) FIN(final_norm, 16)
#undef FIN
#define FWS(type, name, off) __device__ __forceinline__ type* name() const { return (type*)(ws + (off)); }
    FWS(unsigned, ctlw, WS_CTL) FWS(float, MODS, WS_MODS) FWS(float, LB, WS_LB) FWS(f32x2, ROPE, WS_ROPE) FWS(float, TF, WS_TF) FWS(float, XC, WS_XC) FWS(float, HGS, WS_HGS) FWS(float, HGG, WS_HGG) FWS(float, ROWSS, WS_ROWSS) FWS(float, BIASA, WS_BIASA) FWS(float, BIASF, WS_BIASF)
    FWS(f32x2, TW, WS_TW) FWS(bf16, FT128, WS_FT128) FWS(bf16, W64F, WS_W64F) FWS(bf16, CT256, WS_CT256)
    FWS(bf16, WIN, WS_WIN) FWS(bf16, WOUT, WS_WOUT) FWS(bf16, WGU, WS_WGU) FWS(bf16, WDN, WS_WDN) FWS(bf16, XB, WS_XB) FWS(bf16, UX, WS_UX) FWS(bf16, MIX, WS_MIX) FWS(bf16, HB, WS_H)
#undef FWS
};
__device__ __forceinline__ float bf2f(unsigned short h) { return __builtin_bit_cast(float, (unsigned)h << 16); }
__device__ __forceinline__ float bflo(unsigned w) { return __builtin_bit_cast(float, w << 16); }
__device__ __forceinline__ float bfhi(unsigned w) { return __builtin_bit_cast(float, w & 0xffff0000u); }
__device__ __forceinline__ float wave_sum(float v) { return xl_sum64(v); }
__device__ __forceinline__ float sigmoidf_(float z) { return __builtin_amdgcn_rcpf(1.0f + __builtin_amdgcn_exp2f(-1.44269504089f * z)); }
__device__ __forceinline__ float siluf_(float z) { return z * sigmoidf_(z); }
__device__ __forceinline__ const float* xrow_ptr(const float* lat, const float* ctx, int R) {
    const int b = R / TPB, t = R - b * TPB;
    return (t < CTXL) ? ctx + ((size_t)b * CTXL + t) * DM : lat + ((size_t)b * SEQ + (t - CTXL)) * DM;
}

__host__ __device__ __forceinline__ int win_row(int c) {
    if (c < 256 || c >= 1024) return c;
    const int hh = (c - 256) >> 6, d = (c - 256) & 63, bj = (d >> 4) & 1, p = (d & 15) + ((d >> 5) << 4);
    return 256 * (1 + (hh >> 2)) + 128 * bj + 32 * (hh & 3) + p;
}
__device__ __forceinline__ void tr_item(const float* src, int ldsrc, bf16* dst, int ldt, LAS float* scr, int lane, int row16 = 16) {
#pragma unroll 1
    for (int h = 0; h < 4; ++h) { float tv[8];
#pragma unroll
        for (int i = 0; i < 8; ++i) tv[i] = src[(size_t)(2 * (8 * h + i) + (lane >> 5)) * ldsrc + (lane & 31)];
#pragma unroll
        for (int i = 0; i < 8; ++i) scr[(2 * (8 * h + i) + (lane >> 5)) * 33 + (lane & 31)] = tv[i]; }
    LDS_WAIT(); asm volatile("" ::: "memory");
    const int c = lane & 7;
#pragma unroll
    for (int j = 0; j < 4; ++j) { const int n = (lane >> 3) + 8 * j; const LAS float* s = scr + (8 * c) * 33 + n;
        v4u o; o.x = pk2(s[0 * 33], s[1 * 33]); o.y = pk2(s[2 * 33], s[3 * 33]); o.z = pk2(s[4 * 33], s[5 * 33]); o.w = pk2(s[6 * 33], s[7 * 33]);
        *(GAS v4u*)(dst + (size_t)(j < 2 ? n : n - 16 + row16) * ldt + 8 * c) = o; }
    LDS_WAIT(); asm volatile("" ::: "memory");
}
__device__ __forceinline__ void p0a_prologue(Frame& F) {
    const int gw = F.vcu * NWAVES + F.wave, NGW = F.G * NWAVES;
    const int gt = F.vcu * NTHREADS + F.tid, NGT = F.G * NTHREADS;
    LAS float* scr = (LAS float*)(F.lds + RING_OFF + F.wave * 12288);
    LAS float* sil = (LAS float*)(F.lds + RING_OFF + 98304);
    LAS f32x2* cs64 = (LAS f32x2*)(F.lds + RING_OFF + 98304 + 20480 + 10240);
    if (F.tid < 64) { const float a = (float)F.tid * (1.0f / 32.0f); cs64[F.tid] = (f32x2){cospif(a), sinpif(a)}; }
    for (int i = F.tid; i < 5 * DM; i += NTHREADS) { const int bb = i >> 10, k = i & 1023; const float v = (bb < 4) ? F.c()[bb * DM + k] : F.c_ctx()[k]; sil[i] = v / (1.0f + expf(-v)); }
    __syncthreads();
    {
        LAS float* part = (LAS float*)(F.lds + RING_OFF + 98304 + 20480);
        for (int it = F.vcu; it < DEPTH * 96; it += F.G) {
            const int l = it / 96, j = (it % 96) * 64 + F.lane;
            const float* wp = F.w_ada() + (size_t)l * DM * 6144 + (size_t)(128 * F.wave) * 6144 + j;
            float a0 = 0.f, a1 = 0.f, a2 = 0.f, a3 = 0.f, a4 = 0.f;
            for (int k0 = 0; k0 < 128; k0 += 16) {
                float w[16];
#pragma unroll
                for (int i = 0; i < 16; ++i) w[i] = wp[(size_t)(k0 + i) * 6144];
#pragma unroll
                for (int i = 0; i < 16; ++i) { const int k = 128 * F.wave + k0 + i; a0 += sil[k] * w[i]; a1 += sil[1024 + k] * w[i]; a2 += sil[2048 + k] * w[i]; a3 += sil[3072 + k] * w[i]; a4 += sil[4096 + k] * w[i]; }
            }
            LAS float* pw = part + F.wave * 320 + F.lane;
            pw[0] = a0; pw[64] = a1; pw[128] = a2; pw[192] = a3; pw[256] = a4;
            __syncthreads();
            if (F.tid < 320) { float s = 0.f;
#pragma unroll
                for (int ww = 0; ww < 8; ++ww) s += part[ww * 320 + F.tid];
                const int bb = F.tid >> 6, jj = (it % 96) * 64 + (F.tid & 63);
                F.MODS()[(size_t)l * 5 * 6144 + bb * 6144 + jj] = s + F.b_ada()[l * 6144 + jj]; }
            __syncthreads();
        }
    }
    constexpr int I_IN = 16 * 72, I_OUT = 12 * 32, I_G = 16 * 88, I_D = 44 * 32, I_L = I_IN + I_OUT + 2 * I_G + I_D;
    for (int it = gw; it < DEPTH * I_L; it += NGW) {
        const int l = it / I_L; int r = it % I_L;
        if (r < I_IN) { const int kb = r / 72, nb = r % 72;
            const int r0 = win_row(32 * nb), r16 = win_row(32 * nb + 16);
            tr_item(F.w_in() + (size_t)l * DM * PROJ + (size_t)(64 * kb) * PROJ + 32 * nb, PROJ, F.WIN() + (size_t)l * PROJ * DM + (size_t)r0 * DM + 64 * kb, DM, scr, F.lane, r16 - r0); continue; }
        r -= I_IN;
        if (r < I_OUT) { const int kb = r / 32, nb = r % 32;
            tr_item(F.w_out() + (size_t)l * DM * DM + (size_t)(256 + 64 * kb) * DM + 32 * nb, DM, F.WOUT() + (size_t)l * DM * KMIX + (size_t)(32 * nb) * KMIX + 512 + 64 * kb, KMIX, scr, F.lane); continue; }
        r -= I_OUT;
        if (r < 2 * I_G) { const int up = r / I_G, rr = r % I_G, kb = rr / 88, nb = rr % 88, n0 = 32 * nb;
            const float* W = (up ? F.w_up() : F.w_gate()) + (size_t)l * DM * DFF;
            const int drow = (n0 >> 7) * 256 + up * 128 + (n0 & 127);
            tr_item(W + (size_t)(64 * kb) * DFF + n0, DFF, F.WGU() + (size_t)l * 5632 * DM + (size_t)drow * DM + 64 * kb, DM, scr, F.lane); continue; }
        r -= 2 * I_G;
        { const int kb = r / 32, nb = r % 32;
            tr_item(F.w_down() + (size_t)l * DFF * DM + (size_t)(64 * kb) * DM + 32 * nb, DM, F.WDN() + (size_t)l * DM * DFF + (size_t)(32 * nb) * DFF + 64 * kb, DFF, scr, F.lane); }
    }
    for (int it = gt; it < DEPTH * 2 * 256 * 256; it += NGT) {
        const int jp = it & 255, gc = (it >> 8) & 255, s = (it >> 16) & 1, l = it >> 17, g = gc >> 6, cc = gc & 63;
        const float* wf = F.w_four() + (size_t)l * 65536 + (size_t)(g * 64) * 256 + jp;
        float a = 0.f;
        for (int m = 0; m < 64; ++m) { const f32x2 cs = cs64[(cc * m) & 63]; a += (s ? -cs.y : cs.x) * wf[m * 256]; }
        F.TF()[it] = a * 0.125f;
    }
    for (int it = gt; it < 2 * 256; it += NGT) {
        const int d = it >> 8, cc = it & 255; float v[DEPTH], mx = -INFINITY, sm = 0.f;
#pragma unroll
        for (int l = 0; l < DEPTH; ++l) { v[l] = F.hg_lb()[(d * DEPTH + l) * 256 + cc]; mx = fmaxf(mx, v[l]); }
#pragma unroll
        for (int l = 0; l < DEPTH; ++l) { v[l] = expf(v[l] - mx); sm += v[l]; }
        float cum = 0.f;
#pragma unroll
        for (int l = 0; l < DEPTH; ++l) { if (l > 0) cum += v[l] / sm; F.LB()[(d * DEPTH + l) * 256 + cc] = cum; }
    }
    for (int it = gt; it < SEQ * 32; it += NGT) {
        const int p = it >> 5, i = it & 31; const float pos = (float)((i < 16) ? (p >> 6) : (p & 63));
        const float fr = powf(10000.0f, -(float)(2 * (i & 15)) / 32.0f); const float ang = pos * fr;
        F.ROPE()[it] = (f32x2){cosf(ang), sinf(ang)};
    }
    for (int it = gt; it < SEQ; it += NGT) { const float a = (float)it * (1.0f / 4096.0f); F.TW()[it] = (f32x2){cospif(a), sinpif(a)}; }
    for (int it = gt; it < 2 * 128 * 128; it += NGT) { const int s = it >> 14, k = (it >> 7) & 127, n = it & 127; const float a = (float)((k * n) & 127) * (1.0f / 64.0f); F.FT128()[it] = (bf16)f2bf(s ? sinpif(a) : cospif(a)); }
    for (int it = gt; it < 2 * 2 * 4 * 64 * 8; it += NGT) { const int jj = it & 7, ln = (it >> 3) & 63, T = (it >> 9) & 3, a2 = (it >> 11) & 1, s = it >> 12;
        const int k2 = 16 * T + (ln & 15), g = ln >> 4, n2 = 32 * a2 + (jj < 4 ? 4 * g + jj : 16 + 4 * g + (jj - 4)); const float a = (float)((k2 * n2) & 63) * (1.0f / 32.0f);
        F.W64F()[it] = (bf16)f2bf(s ? sinpif(a) : cospif(a)); }
    for (int it = gt; it < 2 * 256 * 256; it += NGT) { const int jj = it & 7, ln = (it >> 3) & 63, ks = (it >> 9) & 7, T = (it >> 12) & 15, s = it >> 16;
        const int k = 16 * T + (ln & 15), g = ln >> 4, n = 32 * ks + (jj < 4 ? 4 * g + jj : 16 + 4 * g + (jj - 4)); const float a = (float)((k * n) & 255) * (1.0f / 128.0f); F.CT256()[it] = (bf16)f2bf(s ? sinpif(a) : cospif(a)); }
}
__device__ __forceinline__ void p0b_fold(Frame& F) {
    {
        LAS float* tfl = (LAS float*)(F.lds + RING_OFF + 16384);
        for (int it = F.vcu; it < DEPTH * 64 * 2; it += F.G) {
            const int jh = it & 1, kg = (it >> 1) & 63, l = it >> 7, j = jh * 512 + F.tid;
            const float* tf = F.TF() + (size_t)l * 131072 + (size_t)(kg * 8) * 256;
            for (int i = F.tid; i < 2048; i += NTHREADS) tfl[(i & 255) * 8 + (i >> 8)] = tf[i];
            __syncthreads();
            const float* wo = F.w_out() + (size_t)l * DM * DM + j;
            float a[8] = {0.f, 0.f, 0.f, 0.f, 0.f, 0.f, 0.f, 0.f};
            for (int jp0 = 0; jp0 < 256; jp0 += 8) {
                float w[8];
#pragma unroll
                for (int i = 0; i < 8; ++i) w[i] = wo[(size_t)(jp0 + i) * DM];
#pragma unroll
                for (int i = 0; i < 8; ++i) { const f32x4 t0 = *(const LAS f32x4*)(tfl + (jp0 + i) * 8), t1 = *(const LAS f32x4*)(tfl + (jp0 + i) * 8 + 4);
                    a[0] += t0[0] * w[i]; a[1] += t0[1] * w[i]; a[2] += t0[2] * w[i]; a[3] += t0[3] * w[i]; a[4] += t1[0] * w[i]; a[5] += t1[1] * w[i]; a[6] += t1[2] * w[i]; a[7] += t1[3] * w[i]; }
            }
            v4u o; o.x = pk2(a[0], a[1]); o.y = pk2(a[2], a[3]); o.z = pk2(a[4], a[5]); o.w = pk2(a[6], a[7]);
            *(GAS v4u*)(F.WOUT() + (size_t)l * DM * KMIX + (size_t)j * KMIX + kg * 8) = o;
            __syncthreads();
        }
    }
    {
        LAS float* part = (LAS float*)(F.lds + RING_OFF);
        for (int it = F.vcu; it < DEPTH * 124; it += F.G) {
            const int l = it / 124, v0 = (it % 124) * 64;
            const float* W; int ldw, col, shoff; float* dst; int dstride;
            if (v0 < 2304) { W = F.w_in() + (size_t)l * DM * PROJ; ldw = PROJ; col = v0 + F.lane; shoff = MOD_SH_A; dst = F.BIASA() + (size_t)l * 5 * 2304 + win_row(col); dstride = 2304; }
            else { const int up = v0 >= 2304 + DFF, hid = v0 - 2304 - up * DFF + F.lane; W = (up ? F.w_up() : F.w_gate()) + (size_t)l * DM * DFF; ldw = DFF; col = hid; shoff = MOD_SH_F;
                dst = F.BIASF() + (size_t)l * 5 * 5632 + (hid >> 7) * 256 + up * 128 + (hid & 127); dstride = 5632; }
            const float* wp = W + (size_t)(128 * F.wave) * ldw + col; const float* shp = F.MODS() + (size_t)l * 5 * 6144 + shoff + 128 * F.wave;
            float a0 = 0.f, a1 = 0.f, a2 = 0.f, a3 = 0.f, a4 = 0.f;
            for (int k0 = 0; k0 < 128; k0 += 16) {
                float w[16];
#pragma unroll
                for (int i = 0; i < 16; ++i) w[i] = wp[(size_t)(k0 + i) * ldw];
#pragma unroll
                for (int i = 0; i < 16; ++i) { const int k = k0 + i; a0 += shp[k] * w[i]; a1 += shp[6144 + k] * w[i]; a2 += shp[2 * 6144 + k] * w[i]; a3 += shp[3 * 6144 + k] * w[i]; a4 += shp[4 * 6144 + k] * w[i]; }
            }
            LAS float* pw = part + F.wave * 320 + F.lane;
            pw[0] = a0; pw[64] = a1; pw[128] = a2; pw[192] = a3; pw[256] = a4;
            __syncthreads();
            float s = 0.f;
            if (F.tid < 320) {
#pragma unroll
                for (int ww = 0; ww < 8; ++ww) s += part[ww * 320 + F.tid]; }
            if (F.tid < 320) dst[(size_t)(F.tid >> 6) * dstride] = s;
            __syncthreads();
        }
    }
    {
        const int gw = F.vcu * NWAVES + F.wave, NGW = F.G * NWAVES;
        for (int R = gw; R < MROWS; R += NGW) {
            const int b = R / TPB, t = R - b * TPB, bb = (t < CTXL) ? 4 : b;
            const GAS f32x4* xr = (const GAS f32x4*)xrow_ptr(F.x(), F.ctx(), R) + F.lane;
            const GAS f32x4* scp = (const GAS f32x4*)(F.MODS() + bb * 6144 + MOD_SC_A) + F.lane;
            f32x4 v[4]; float s = 0.f;
#pragma unroll
            for (int j = 0; j < 4; ++j) { v[j] = xr[64 * j]; s += (v[j].x * v[j].x + v[j].y * v[j].y) + (v[j].z * v[j].z + v[j].w * v[j].w); }
            s = wave_sum(s);
            GAS u32x2* o8 = (GAS u32x2*)(F.HN() + (size_t)R * DM) + F.lane; GAS u32x2* x8 = (GAS u32x2*)(F.XB() + (size_t)R * DM) + F.lane;
#pragma unroll
            for (int j = 0; j < 4; ++j) { const f32x4 y = v[j] * (scp[64 * j] + 1.0f); u32x2 w; w.x = pk2(y.x, y.y); w.y = pk2(y.z, y.w); o8[64 * j] = w;
                u32x2 xw; xw.x = pk2(v[j].x, v[j].y); xw.y = pk2(v[j].z, v[j].w); x8[64 * j] = xw; }
            if (F.lane < 16) F.ROWSS()[(size_t)R * 16 + F.lane] = (F.lane == 0) ? s : 0.f;
        }
    }
}

template <int NSPLIT>
__device__ __forceinline__ void ctx_reduce_pass(Frame& F, const float* P, const float* gate, const float* scn) {
    const int gw = F.vcu * NWAVES + F.wave, NGW = F.G * NWAVES;
    for (int cr = gw; cr < NB * CTXL; cr += NGW) {
        const int b = cr >> 8, t = cr & 255; const size_t R = (size_t)b * TPB + t;
        float ss = 0.f;
#pragma unroll 1
        for (int j = 0; j < 4; ++j) { const int col = 4 * F.lane + 256 * j;
            f32x4 pv[NSPLIT];
#pragma unroll
            for (int s = 0; s < NSPLIT; ++s) pv[s] = *(const GAS f32x4*)(P + ((size_t)s * 1024 + cr) * 1024 + col);
            f32x4 a = pv[0];
#pragma unroll
            for (int s = 1; s < NSPLIT; ++s) a += pv[s];
            const u32x2 xo = *(const GAS u32x2*)(F.XB() + R * DM + col);
            const f32x4 xn = (f32x4){bflo(xo.x), bfhi(xo.x), bflo(xo.y), bfhi(xo.y)} + *(const GAS f32x4*)(gate + 4 * 6144 + col) * a;
            u32x2 xw; xw.x = pk2(xn.x, xn.y); xw.y = pk2(xn.z, xn.w); *(GAS u32x2*)(F.XB() + R * DM + col) = xw;
            ss += (xn.x * xn.x + xn.y * xn.y) + (xn.z * xn.z + xn.w * xn.w);
            if (scn) { const f32x4 y = xn * (*(const GAS f32x4*)(scn + 4 * 6144 + col) + 1.0f); u32x2 w; w.x = pk2(y.x, y.y); w.y = pk2(y.z, y.w); *(GAS u32x2*)(F.HN() + R * DM + col) = w; } }
        ss = wave_sum(ss);
        if (F.lane < 16) F.ROWSS()[R * 16 + F.lane] = (F.lane == 0) ? ss : 0.f;
    }
}
__device__ __forceinline__ void final_norm_phase(Frame& F) {
    const int gw = F.vcu * NWAVES + F.wave, NGW = F.G * NWAVES;
    for (int r = gw; r < NB * SEQ; r += NGW) {
        const int b = r >> 13, n = r & (SEQ - 1); const size_t R = (size_t)b * TPB + CTXL + n;
        float s = (F.lane < 16) ? F.ROWSS()[R * 16 + F.lane] : 0.f;
        s = wave_sum(s);
        const float rinv = 1.0f / sqrtf(s * (1.0f / DM) + EPS);
        const GAS u32x2* xr = (const GAS u32x2*)(F.XB() + R * DM) + F.lane; const GAS f32x4* gp = (const GAS f32x4*)F.final_norm() + F.lane;
        GAS f32x4* orow = (GAS f32x4*)(F.out_() + (size_t)r * DM) + F.lane;
#pragma unroll
        for (int j = 0; j < 4; ++j) { const u32x2 w = xr[64 * j]; orow[64 * j] = (f32x4){bflo(w.x), bfhi(w.x), bflo(w.y), bfhi(w.y)} * rinv * gp[64 * j]; }
    }
}

__device__ __forceinline__ void attn_fast_phase(Frame& F, int l) {
    char* shm = (char*)(F.lds + RING_OFF);
    const attn_body::bf16* UXp = (const attn_body::bf16*)F.UX(); attn_body::bf16* MIXp = (attn_body::bf16*)F.MIX();
    for (int base = F.vcu * 4; base < NB * 8 * 32 + F.G * 4; base += F.G * 4) {
        for (int i = 0; i < 5; ++i) {
            int bh, q0, NT;
            if (base < NB * 8 * 32) { if (i == 4) break; const int U = base + i; bh = U >> 5; q0 = CTXL + (U & 31) * 256; NT = TPB / 64; }
            else { const int c = base - NB * 8 * 32 + i * 0; if (i > 0 || l == DEPTH - 1) break; const int cu = c / 4; if ((cu & 7) != 0 || cu >= 256) break; bh = cu >> 3; q0 = 0; NT = CTXL / 64; }
            const int b = bh >> 3, h = bh & 7, kvh = h >> 2; const size_t rb = (size_t)b * TPB;
            attn_body::attn_unit<8>(UXp + (rb + q0) * PROJ + OFF_Q + h * 64, UXp + rb * PROJ + OFF_K + kvh * 64, UXp + rb * PROJ + OFF_V + kvh * 64, MIXp + (rb + q0) * KMIX + MIX_A + h * 64, NT, shm, F.tid);
        }
    }
}

namespace fft {
typedef short v4i16_t __attribute__((ext_vector_type(4)));
constexpr int ZP = 544;
__device__ __forceinline__ v4i16_t trrd(const LAS char* p) { return __builtin_amdgcn_ds_read_tr16_b64_v4i16((LAS v4i16_t*)p); }
__device__ __forceinline__ bf16x8 cat8(v4i16_t lo, v4i16_t hi) { return (bf16x8){lo[0], lo[1], lo[2], lo[3], hi[0], hi[1], hi[2], hi[3]}; }
__device__ __forceinline__ bf16x8 ld_frag2(const bf16* p0, const bf16* p1) { const u32x2 a = *(const GAS u32x2*)p0, b = *(const GAS u32x2*)p1; v4u w; w.x = a.x; w.y = a.y; w.z = b.x; w.w = b.y; return __builtin_bit_cast(bf16x8, w); }
#define MFMA16(a, b, c) __builtin_amdgcn_mfma_f32_16x16x32_bf16((a), (b), (c), 0, 0, 0)
}
__device__ __forceinline__ void fourier_fast_phase(Frame& F) {
    using namespace fft;
    LAS char* Z = (LAS char*)(F.lds + RING_OFF);
    LAS char* Zc = Z + 128 * ZP;
    const int tid = F.tid, lane = F.lane, w = F.wave, l16 = lane & 15, g = lane >> 4, q = l16 >> 2, p = l16 & 3;
    const bf16* UXp = F.UX(); bf16* MIXp = F.MIX();
    for (int unit = F.vcu; unit < NB * 64; unit += F.G) {
        const int b = unit >> 6, cg = unit & 63;
        { const bf16* zsrc = UXp + ((size_t)b * TPB + CTXL) * PROJ + cg * 4;
#pragma unroll 4
          for (int i = 0; i < 16; ++i) { const int n = tid + 512 * i; const u32x2 v = *(const GAS u32x2*)(zsrc + (size_t)n * PROJ);
              LAS char* d = Z + (n >> 6) * ZP + (n & 63) * 2;
              *(LAS unsigned short*)(d) = (unsigned short)(v.x & 0xffffu); *(LAS unsigned short*)(d + 128) = (unsigned short)(v.x >> 16);
              *(LAS unsigned short*)(d + 256) = (unsigned short)(v.y & 0xffffu); *(LAS unsigned short*)(d + 384) = (unsigned short)(v.y >> 16); }
          if (tid < CTXL) *(LAS u32x2*)(Zc + tid * 8) = *(const GAS u32x2*)(UXp + ((size_t)b * TPB + tid) * PROJ + cg * 4); }
        __syncthreads(); STAMP(40);
        const int k1 = 16 * w + l16;
        bf16x8 Bre[4][2], Bim[4][2];
        {
            bf16x8 Fc[4], Fs[4];
            const bf16* ftc = F.FT128() + k1 * 128; const bf16* fts = ftc + 128 * 128;
#pragma unroll
            for (int ks = 0; ks < 4; ++ks) { Fc[ks] = ld_frag2(ftc + 32 * ks + 4 * g, ftc + 32 * ks + 16 + 4 * g); Fs[ks] = ld_frag2(fts + 32 * ks + 4 * g, fts + 32 * ks + 16 + 4 * g); }
            f32x2 tw[4][4];
#pragma unroll
            for (int be = 0; be < 4; ++be)
#pragma unroll
                for (int r = 0; r < 4; ++r) tw[be][r] = F.TW()[k1 * (16 * be + 4 * g + r)];
            const LAS char* zrd = Z + (4 * g + q) * ZP + 8 * p;
#pragma unroll
            for (int c = 0; c < 4; ++c) {
                f32x4 ar[4], ai[4];
#pragma unroll
                for (int be = 0; be < 4; ++be) { ar[be] = (f32x4){0.f, 0.f, 0.f, 0.f}; ai[be] = (f32x4){0.f, 0.f, 0.f, 0.f}; }
#pragma unroll
                for (int ks = 0; ks < 4; ++ks)
#pragma unroll
                    for (int be = 0; be < 4; ++be) { const LAS char* a0 = zrd + (32 * ks) * ZP + (c * 64 + 16 * be) * 2;
                        const bf16x8 A = cat8(trrd(a0), trrd(a0 + 16 * ZP));
                        ar[be] = MFMA16(A, Fc[ks], ar[be]); ai[be] = MFMA16(A, Fs[ks], ai[be]); }
                float br[4][4], bi[4][4];
#pragma unroll
                for (int be = 0; be < 4; ++be)
#pragma unroll
                    for (int r = 0; r < 4; ++r) { const float ct = tw[be][r].x, st = tw[be][r].y; br[be][r] = ar[be][r] * ct - ai[be][r] * st; bi[be][r] = ar[be][r] * st + ai[be][r] * ct; }
#pragma unroll
                for (int a = 0; a < 2; ++a) { v4u wr_, wi_;
                    wr_.x = pk2(br[2 * a][0], br[2 * a][1]); wr_.y = pk2(br[2 * a][2], br[2 * a][3]); wr_.z = pk2(br[2 * a + 1][0], br[2 * a + 1][1]); wr_.w = pk2(br[2 * a + 1][2], br[2 * a + 1][3]);
                    wi_.x = pk2(bi[2 * a][0], bi[2 * a][1]); wi_.y = pk2(bi[2 * a][2], bi[2 * a][3]); wi_.z = pk2(bi[2 * a + 1][0], bi[2 * a + 1][1]); wi_.w = pk2(bi[2 * a + 1][2], bi[2 * a + 1][3]);
                    Bre[c][a] = __builtin_bit_cast(bf16x8, wr_); Bim[c][a] = __builtin_bit_cast(bf16x8, wi_); }
                __builtin_amdgcn_sched_barrier(0);
            }
        }
        STAMP(41);
        {
            const float sc = 0.011048543456039806f;
#pragma unroll 1
            for (int T = 0; T < 4; ++T) {
                bf16x8 Wc[2], Ws[2];
#pragma unroll
                for (int a = 0; a < 2; ++a) { Wc[a] = *(const GAS bf16x8*)(F.W64F() + (((0 * 2 + a) * 4 + T) * 64 + lane) * 8); Ws[a] = *(const GAS bf16x8*)(F.W64F() + (((1 * 2 + a) * 4 + T) * 64 + lane) * 8); }
                f32x4 P[4], Q[4];
#pragma unroll
                for (int c = 0; c < 4; ++c) {
                    bf16x8 nim[2];
#pragma unroll
                    for (int a = 0; a < 2; ++a) { v4u t = __builtin_bit_cast(v4u, Bim[c][a]); t.x ^= 0x80008000u; t.y ^= 0x80008000u; t.z ^= 0x80008000u; t.w ^= 0x80008000u; nim[a] = __builtin_bit_cast(bf16x8, t); }
                    f32x4 pp = (f32x4){0.f, 0.f, 0.f, 0.f}, qq = (f32x4){0.f, 0.f, 0.f, 0.f};
#pragma unroll
                    for (int a = 0; a < 2; ++a) { pp = MFMA16(Bre[c][a], Wc[a], pp); pp = MFMA16(nim[a], Ws[a], pp); qq = MFMA16(Bre[c][a], Ws[a], qq); qq = MFMA16(Bim[c][a], Wc[a], qq); }
                    P[c] = pp; Q[c] = qq;
                }
#pragma unroll
                for (int r = 0; r < 4; ++r) { const int k = (16 * w + 4 * g + r) + 128 * (16 * T + l16);
                    bf16* mp = MIXp + ((size_t)b * TPB + CTXL + k) * KMIX + cg * 4;
                    u32x2 o; o.x = pk2(P[0][r] * sc, P[1][r] * sc); o.y = pk2(P[2][r] * sc, P[3][r] * sc); *(GAS u32x2*)(mp + MIX_P) = o;
                    o.x = pk2(Q[0][r] * sc, Q[1][r] * sc); o.y = pk2(Q[2][r] * sc, Q[3][r] * sc); *(GAS u32x2*)(mp + MIX_Q) = o; }
            }
        }
        STAMP(42);
        {
            f32x4 aP[2], aQ[2];
#pragma unroll
            for (int tt = 0; tt < 2; ++tt) { aP[tt] = (f32x4){0.f, 0.f, 0.f, 0.f}; aQ[tt] = (f32x4){0.f, 0.f, 0.f, 0.f}; }
            const bf16* ctc = F.CT256() + (size_t)(2 * w) * 8 * 512 + lane * 8; const bf16* cts = ctc + 256 * 256;
#pragma unroll 1
            for (int hk = 0; hk < 4; ++hk) {
                bf16x8 Bc[2][2], Bs[2][2];
#pragma unroll
                for (int tt = 0; tt < 2; ++tt)
#pragma unroll
                    for (int kk = 0; kk < 2; ++kk) { const int ks = 2 * hk + kk; Bc[tt][kk] = *(const GAS bf16x8*)(ctc + (tt * 8 + ks) * 512); Bs[tt][kk] = *(const GAS bf16x8*)(cts + (tt * 8 + ks) * 512); }
#pragma unroll
                for (int kk = 0; kk < 2; ++kk) { const int ks = 2 * hk + kk;
                    const LAS char* a0 = Zc + (32 * ks + 4 * g + q) * 8;
                    const bf16x8 A = cat8(trrd(a0), trrd(a0 + 16 * 8));
#pragma unroll
                    for (int tt = 0; tt < 2; ++tt) { aP[tt] = MFMA16(A, Bc[tt][kk], aP[tt]); aQ[tt] = MFMA16(A, Bs[tt][kk], aQ[tt]); } }
            }
            if (g == 0) {
#pragma unroll
                for (int tt = 0; tt < 2; ++tt) { const int k = 16 * (2 * w + tt) + l16; bf16* mp = MIXp + ((size_t)b * TPB + k) * KMIX + cg * 4;
                    u32x2 o; o.x = pk2(aP[tt][0] * 0.0625f, aP[tt][1] * 0.0625f); o.y = pk2(aP[tt][2] * 0.0625f, aP[tt][3] * 0.0625f); *(GAS u32x2*)(mp + MIX_P) = o;
                    o.x = pk2(aQ[tt][0] * 0.0625f, aQ[tt][1] * 0.0625f); o.y = pk2(aQ[tt][2] * 0.0625f, aQ[tt][3] * 0.0625f); *(GAS u32x2*)(mp + MIX_Q) = o; }
            }
        }
        STAMP(43);
        __syncthreads(); STAMP(44);
    }
}

__device__ __forceinline__ float hg_exp(float x) { return __builtin_amdgcn_exp2f(x); }
#define LDS_BAR() asm volatile("s_waitcnt lgkmcnt(0)\n\ts_barrier" ::: "memory")
namespace hg {
using fft::trrd; using fft::cat8;
constexpr int IP = 160;
constexpr int IMG = 64 * IP;
__device__ __forceinline__ int scan_pos(int c, int dir) { return dir == 0 ? c : (c < 4 ? 3 - c : 135 - c); }
__device__ __forceinline__ float dpp_shr(float v, int n) {
    const int x = __builtin_bit_cast(int, v); int r;
    switch (n) { case 1: r = __builtin_amdgcn_update_dpp(0, x, 0x111, 0xF, 0xF, true); break; case 2: r = __builtin_amdgcn_update_dpp(0, x, 0x112, 0xF, 0xF, true); break;
                 case 4: r = __builtin_amdgcn_update_dpp(0, x, 0x114, 0xF, 0xF, true); break; default: r = __builtin_amdgcn_update_dpp(0, x, 0x118, 0xF, 0xF, true); break; }
    return __builtin_bit_cast(float, r);
}
__device__ __forceinline__ float scan_incl(float v, int lane) {
    v += dpp_shr(v, 1); v += dpp_shr(v, 2); v += dpp_shr(v, 4); v += dpp_shr(v, 8);
    v += __builtin_bit_cast(float, __builtin_amdgcn_update_dpp(0, __builtin_bit_cast(int, v), 0x142, 0xA, 0xF, false));
    v += __builtin_bit_cast(float, __builtin_amdgcn_update_dpp(0, __builtin_bit_cast(int, v), 0x143, 0xC, 0xF, false));
    (void)lane; return v;
}
__device__ __forceinline__ float lane_bcast(float v, int src) { return __builtin_bit_cast(float, __builtin_amdgcn_readlane(__builtin_bit_cast(int, v), src)); }
__device__ __forceinline__ void gates16(const v4u z0, const v4u z1, const float lbl  , int lane, float (&kk)[16], float (&cum)[16]) {
    const unsigned zw[8] = {z0.x, z0.y, z0.z, z0.w, z1.x, z1.y, z1.z, z1.w};
#pragma unroll
    for (int i = 0; i < 16; ++i) { const float z = (i & 1) ? bfhi(zw[i >> 1]) : bflo(zw[i >> 1]); const float lb = lane_bcast(lbl, i);
        const float sg = sigmoidf_(z), f = fmaxf(lb + (1.0f - lb) * sg, 1e-30f); kk[i] = (1.0f - lb) * (1.0f - sg);     cum[i] = scan_incl(__builtin_amdgcn_logf(f), lane); }
}
__device__ __forceinline__ void st16(LAS char* p, const float (&v)[16]) {
    v4u a, b; a.x = pk2(v[0], v[1]); a.y = pk2(v[2], v[3]); a.z = pk2(v[4], v[5]); a.w = pk2(v[6], v[7]); b.x = pk2(v[8], v[9]); b.y = pk2(v[10], v[11]); b.z = pk2(v[12], v[13]); b.w = pk2(v[14], v[15]);
    *(LAS v4u*)p = a; *(LAS v4u*)(p + 16) = b;
}
}
struct HgInA { v4u z0, z1, v0, v1; float lb; };
__device__ __forceinline__ HgInA hg_load_a(const bf16* UXp, const float* LBl  , int unit, int dir, int wd, int lane) {
    const int c = unit % (TPB / 64), bh = unit / (TPB / 64), b = bh >> 2, h = bh & 3;
    const size_t row = (size_t)b * TPB + 64 * c + (dir ? 63 - lane : lane);
    const bf16* rp = UXp + row * PROJ + h * 64 + 16 * wd; HgInA r;
    r.z0 = *(const GAS v4u*)(rp + (dir ? OFF_FB : OFF_FF)); r.z1 = *(const GAS v4u*)(rp + (dir ? OFF_FB : OFF_FF) + 8);
    r.v0 = *(const GAS v4u*)(rp + OFF_I); r.v1 = *(const GAS v4u*)(rp + OFF_I + 8); r.lb = *(const GAS float*)(LBl + h * 64 + 16 * wd + (lane & 15)); return r;
}
__device__ __forceinline__ void hgrn_a_phase(Frame& F, int l) {
    using namespace hg;
    const int lane = F.lane, w = F.wave, dir = w >> 2, wd = w & 3, l16 = lane & 15, g = lane >> 4, q = l16 >> 2, p = l16 & 3;
    LAS char* KI = (LAS char*)(F.lds + RING_OFF) + dir * 2 * IMG; LAS char* VI = KI + IMG;
    const bf16* UXp = F.UX();
    constexpr int NU = NB * 4 * (TPB / 64);
    const float* LBl = F.LB() + (dir * DEPTH + l) * 256;
    HgInA nx = hg_load_a(UXp, LBl, F.vcu < NU ? F.vcu : 0, dir, wd, lane);
    for (int unit = F.vcu; unit < NU; unit += F.G) {
        const int c = unit % (TPB / 64), bh = unit / (TPB / 64), b = bh >> 2, h = bh & 3;
        const HgInA in = nx;
        if (unit + F.G < NU) nx = hg_load_a(UXp, LBl, unit + F.G, dir, wd, lane);
        float kk[16], cum[16];
        gates16(in.z0, in.z1, in.lb, lane, kk, cum);
        float ko[16], gl[16];
#pragma unroll
        for (int i = 0; i < 16; ++i) { const float last = lane_bcast(cum[i], 63); gl[i] = last; ko[i] = kk[i] * hg_exp(last - cum[i]); }
        st16(KI + lane * IP + 32 * wd, ko);
        *(LAS v4u*)(VI + lane * IP + 32 * wd) = in.v0; *(LAS v4u*)(VI + lane * IP + 32 * wd + 16) = in.v1;
        const int ch = (b * 4 + h) * 2 + dir, pp = scan_pos(c, dir);
        if (lane < 16) { float gv = 0.f;
#pragma unroll
            for (int i = 0; i < 16; ++i) gv = (lane == i) ? gl[i] : gv;
            F.HGG()[((size_t)ch * 132 + pp) * 64 + 16 * wd + lane] = hg_exp(gv); }
        LDS_BAR();
        bf16x8 Af[2];
#pragma unroll
        for (int ks = 0; ks < 2; ++ks) { const LAS char* a0 = KI + (32 * ks + 4 * g + q) * IP + (16 * wd + 4 * p) * 2; Af[ks] = cat8(trrd(a0), trrd(a0 + 16 * IP)); }
        bf16* sp = (bf16*)F.HGS() + ((size_t)ch * 132 + pp) * 4096;
#pragma unroll
        for (int et = 0; et < 4; ++et) { f32x4 acc = (f32x4){0.f, 0.f, 0.f, 0.f};
#pragma unroll
            for (int ks = 0; ks < 2; ++ks) { const LAS char* b0 = VI + (32 * ks + 4 * g + q) * IP + (16 * et + 4 * p) * 2; acc = MFMA16(Af[ks], cat8(trrd(b0), trrd(b0 + 16 * IP)), acc); }
            u32x2 o2; o2.x = pk2(acc[0], acc[1]); o2.y = pk2(acc[2], acc[3]); *(GAS u32x2*)(sp + (16 * et + l16) * 64 + 16 * wd + 4 * g) = o2; }
        LDS_BAR();
    }
}
__device__ __forceinline__ void hgrn_b_phase(Frame& F) {
    const int gt = F.vcu * NTHREADS + F.tid, NGT = F.G * NTHREADS;
    for (int it = gt; it < 32 * 2048; it += NGT) {
        const int ch = it >> 11, idx = (it & 2047) * 2, d = idx & 63;
        unsigned* sp = (unsigned*)((bf16*)F.HGS() + (size_t)ch * 132 * 4096 + idx); const f32x2* gp = (const f32x2*)(F.HGG() + (size_t)ch * 132 * 64 + d);
        float s0 = 0.f, s1 = 0.f;
        for (int p0 = 0; p0 < 132; p0 += 6) {
            unsigned kv[6]; f32x2 gg[6];
#pragma unroll
            for (int i = 0; i < 6; ++i) { kv[i] = sp[(size_t)(p0 + i) * 2048]; gg[i] = gp[(p0 + i) * 32]; }
#pragma unroll
            for (int i = 0; i < 6; ++i) { sp[(size_t)(p0 + i) * 2048] = pk2(s0, s1); s0 = gg[i].x * s0 + bflo(kv[i]); s1 = gg[i].y * s1 + bfhi(kv[i]); }
        }
    }
}
struct HgInC { v4u z0, z1, q0, q1, v0, v1; v4u s[2]; u32x2 gr[2]; float lb; };
__device__ __forceinline__ HgInC hg_load_c(const bf16* UXp, const bf16* HGSp, const float* LBl, int unit, int nch, int c0, int dir, int wd, int lane, int w) {
    const int c = c0 + unit % nch, bh = unit / nch, b = bh >> 2, h = bh & 3, l16 = lane & 15, g = lane >> 4;
    const size_t R0 = (size_t)b * TPB + 64 * c, row = R0 + (dir ? 63 - lane : lane);
    const bf16* rp = UXp + row * PROJ + h * 64 + 16 * wd; HgInC r;
    r.z0 = *(const GAS v4u*)(rp + (dir ? OFF_FB : OFF_FF)); r.z1 = *(const GAS v4u*)(rp + (dir ? OFF_FB : OFF_FF) + 8);
    r.q0 = *(const GAS v4u*)(rp + OFF_HQ); r.q1 = *(const GAS v4u*)(rp + OFF_HQ + 8);
    r.v0 = *(const GAS v4u*)(rp + OFF_I); r.v1 = *(const GAS v4u*)(rp + OFF_I + 8);
    const int ch = (b * 4 + h) * 2 + dir, pp = hg::scan_pos(c, dir);
    const bf16* sp = HGSp + ((size_t)ch * 132 + pp) * 4096 + (size_t)(16 * wd + l16) * 64;
#pragma unroll
    for (int ks = 0; ks < 2; ++ks) r.s[ks] = *(const GAS v4u*)(sp + 32 * ks + 8 * g);
#pragma unroll
    for (int ps = 0; ps < 2; ++ps) r.gr[ps] = *(const GAS u32x2*)(UXp + (R0 + 8 * w + 4 * ps + g) * PROJ + OFF_G + h * 64 + 4 * l16);
    r.lb = *(const GAS float*)(LBl + h * 64 + 16 * wd + l16);
    return r;
}
__device__ __forceinline__ void hgrn_c_phase(Frame& F, int l) {
    using namespace hg;
    const int lane = F.lane, w = F.wave, dir = w >> 2, wd = w & 3, l16 = lane & 15, g = lane >> 4, q = l16 >> 2, p = l16 & 3;
    LAS char* base = (LAS char*)(F.lds + RING_OFF);
    LAS char* QI = base + dir * 3 * IMG; LAS char* KI = QI + IMG; LAS char* VI = KI + IMG;
    LAS float* ES = (LAS float*)(base + 6 * IMG) + dir * 64;
    LAS float* OF = (LAS float*)(base + 6 * IMG + 512);
    const bf16* UXp = F.UX(); bf16* MIXp = F.MIX(); const bf16* HGSp = (const bf16*)F.HGS();
    const f32x4 gn = *(const GAS f32x4*)(F.hg_norm() + l * 64 + 4 * l16);
    const int c0 = (l == DEPTH - 1) ? 4 : 0, nch = TPB / 64 - c0, NU = NB * 4 * nch;
    const float* LBl = F.LB() + (dir * DEPTH + l) * 256;
    HgInC nx = hg_load_c(UXp, HGSp, LBl, F.vcu < NU ? F.vcu : 0, nch, c0, dir, wd, lane, w);
    for (int unit = F.vcu; unit < NU; unit += F.G) {
        const int c = c0 + unit % nch, bh = unit / nch, b = bh >> 2, h = bh & 3;
        const size_t R0 = (size_t)b * TPB + 64 * c;
        STAMP(23);
        const HgInC in = nx;
        if (unit + F.G < NU) nx = hg_load_c(UXp, HGSp, LBl, unit + F.G, nch, c0, dir, wd, lane, w);
        {
            float kk[16], cum[16];
            gates16(in.z0, in.z1, in.lb, lane, kk, cum);
            const unsigned qw[8] = {in.q0.x, in.q0.y, in.q0.z, in.q0.w, in.q1.x, in.q1.y, in.q1.z, in.q1.w};
            float qo[16], ko[16], ev = 0.f;
#pragma unroll
            for (int i = 0; i < 16; ++i) { const float ref = lane_bcast(cum[i], 31); const float qv = (i & 1) ? bfhi(qw[i >> 1]) : bflo(qw[i >> 1]);
                qo[i] = qv * hg_exp(fminf(cum[i] - ref, 115.f)); ko[i] = kk[i] * hg_exp(fminf(ref - cum[i], 115.f)); ev = (lane == i) ? ref : ev; }
            st16(QI + lane * IP + 32 * wd, qo); st16(KI + lane * IP + 32 * wd, ko);
            *(LAS v4u*)(VI + lane * IP + 32 * wd) = in.v0; *(LAS v4u*)(VI + lane * IP + 32 * wd + 16) = in.v1;
            if (lane < 16) ES[16 * wd + lane] = hg_exp(ev);
        }
        LDS_BAR(); STAMP(20);
        {
            const int et = wd;
            bf16x8 Sf[2], Vf[2];
#pragma unroll
            for (int ks = 0; ks < 2; ++ks) { const v4u sw = in.s[ks];
                const f32x4 e0 = *(const LAS f32x4*)(ES + 32 * ks + 8 * g), e1 = *(const LAS f32x4*)(ES + 32 * ks + 8 * g + 4);
                v4u t; t.x = pk2(bflo(sw.x) * e0.x, bfhi(sw.x) * e0.y); t.y = pk2(bflo(sw.y) * e0.z, bfhi(sw.y) * e0.w); t.z = pk2(bflo(sw.z) * e1.x, bfhi(sw.z) * e1.y); t.w = pk2(bflo(sw.w) * e1.z, bfhi(sw.w) * e1.w); Sf[ks] = __builtin_bit_cast(bf16x8, t);
                const LAS char* b0 = VI + (32 * ks + 4 * g + q) * IP + (16 * et + 4 * p) * 2; Vf[ks] = cat8(trrd(b0), trrd(b0 + 16 * IP)); }
#pragma unroll
            for (int jb = 0; jb < 4; ++jb) {
                bf16x8 Qf[2];
#pragma unroll
                for (int ks = 0; ks < 2; ++ks) Qf[ks] = *(const LAS bf16x8*)(QI + (16 * jb + l16) * IP + (32 * ks + 8 * g) * 2);
                f32x4 o = (f32x4){0.f, 0.f, 0.f, 0.f};
#pragma unroll
                for (int ks = 0; ks < 2; ++ks) o = MFMA16(Qf[ks], Sf[ks], o);
#pragma unroll
                for (int a = 0; a <= (jb >> 1); ++a) {
                    f32x4 X[2];
#pragma unroll
                    for (int hh = 0; hh < 2; ++hh) { const int sb = 2 * a + hh; X[hh] = (f32x4){0.f, 0.f, 0.f, 0.f};
                        if (sb <= jb) {
#pragma unroll
                            for (int ks = 0; ks < 2; ++ks) X[hh] = MFMA16(*(const LAS bf16x8*)(KI + (16 * sb + l16) * IP + (32 * ks + 8 * g) * 2), Qf[ks], X[hh]);
                            if (sb == jb) {
#pragma unroll
                                for (int r = 0; r < 4; ++r) X[hh][r] = (4 * g + r <= l16) ? X[hh][r] : 0.f; } } }
                    v4u t; t.x = pk2(X[0][0], X[0][1]); t.y = pk2(X[0][2], X[0][3]); t.z = pk2(X[1][0], X[1][1]); t.w = pk2(X[1][2], X[1][3]);
                    o = MFMA16(__builtin_bit_cast(bf16x8, t), Vf[a], o);
                }
#pragma unroll
                for (int r = 0; r < 4; ++r) { const int j = 16 * jb + 4 * g + r, tok = dir ? 63 - j : j; OF[(dir * 64 + tok) * 64 + 16 * et + l16] = o[r]; }
            }
        }
        LDS_BAR(); STAMP(21);
        {
#pragma unroll
            for (int ps = 0; ps < 2; ++ps) { const int tok = 8 * w + 4 * ps + g;
                const f32x4 a = *(const LAS f32x4*)(OF + tok * 64 + 4 * l16), bq = *(const LAS f32x4*)(OF + (64 + tok) * 64 + 4 * l16); const f32x4 o = a + bq;
                float ss = (o.x * o.x + o.y * o.y) + (o.z * o.z + o.w * o.w);
                ss = xl_sum16(ss);
                const float rinv = 1.0f / sqrtf(ss * (1.0f / 64.0f) + EPS);
                const u32x2 graw = in.gr[ps];
                u32x2 wv; wv.x = pk2(o.x * rinv * gn.x * siluf_(bflo(graw.x)), o.y * rinv * gn.y * siluf_(bfhi(graw.x))); wv.y = pk2(o.z * rinv * gn.z * siluf_(bflo(graw.y)), o.w * rinv * gn.w * siluf_(bfhi(graw.y)));
                *(GAS u32x2*)(MIXp + (R0 + tok) * KMIX + MIX_R + h * 64 + 4 * l16) = wv; }
        }
        LDS_BAR(); STAMP(22);
    }
}

#ifndef R_P0A
#define R_P0A 1
#endif
#ifndef R_FFT
#define R_FFT 1
#endif
#ifndef R_HGA
#define R_HGA 1
#endif
#ifndef R_HGC
#define R_HGC 1
#endif
#ifndef R_ATT
#define R_ATT 1
#endif
#ifndef MK_MULTI
#define MK_MULTI 0
#endif
constexpr int PH_L0 = 2, NPL = 7, PH_FINAL = PH_L0 + NPL, NPH = PH_FINAL + 1;
struct Args { const float* in[17]; float* out; unsigned char* ws; int l_lo, l_hi; };
template <int PH_LO, int PH_HI>
__global__ void __launch_bounds__(NTHREADS, 2) fwd_kernel(Args args) {
    extern __shared__ __attribute__((aligned(16))) unsigned char lds[];
    Frame F;
    F.lds = (LAS unsigned char*)lds;
    F.MISC = (volatile LAS unsigned*)(F.lds + MISC_OFF);
    F.tid = threadIdx.x; F.lane = F.tid & 63; F.wave = __builtin_amdgcn_readfirstlane(F.tid >> 6);
    const int wave0 = F.wave;
    F.G = gridDim.x; { const int bx = blockIdx.x; F.vcu = (F.G % 8 == 0) ? (bx % 8) * (F.G / 8) + bx / 8 : bx; }
    F.ws = (GAS unsigned char*)args.ws; F.outg = (GAS float*)args.out;
    for (int u = F.tid; u < (LDS_BYTES - LDSCTL_OFF) / 4; u += NTHREADS) ((LAS unsigned*)(F.lds + LDSCTL_OFF))[u] = 0u;
    __syncthreads();
    if (!MK_MULTI) (void)xcd_barrier_post((F.ctlw() + CW_BAR), F.MISC + 8);
#define IN(k) (PH_LO <= (k) && (k) < PH_HI)
#define RELANE() do { int ln_; asm volatile("v_mbcnt_lo_u32_b32 %0, -1, 0\n\tv_mbcnt_hi_u32_b32 %0, -1, %0" : "=v"(ln_)); F.lane = ln_; F.tid = wave0 * 64 + ln_; F.wave = wave0; unsigned long long w_ = (unsigned long long)F.ws, o_ = (unsigned long long)F.outg; asm volatile("" : "+s"(w_), "+s"(o_), "+s"(F.vcu), "+s"(F.G)); F.ws = (GAS unsigned char*)w_; F.outg = (GAS float*)o_; } while (0)
#define bx_() ({ int b_ = (int)blockIdx.x; asm volatile("" : "+s"(b_)); b_; })
#define SEAM(tag) do { if (!MK_MULTI) { unsigned long long w_ = (unsigned long long)F.ws; asm volatile("" : "+s"(w_)); XcdBarrier bar_; bar_.bar = (unsigned*)((GAS unsigned char*)w_ + WS_CTL) + CW_BAR; bar_.x = xb_xcc_id(); bar_.st = (volatile LAS unsigned*)(F.lds + MISC_OFF) + 8; xcd_barrier(bar_); }     \
    STAMP(tag); } while (0)
    F.dt = (DIAG_J >= 0) ? rt() : 0ull; F.da = 0ull;

    if (IN(0)) { for (int rep = 0; rep < R_P0A; ++rep) { RELANE(); p0a_prologue(F); SEAM(7); } }
    if (IN(1)) { RELANE(); p0b_fold(F); SEAM(8); }

    for (int l_it = args.l_lo; l_it < args.l_hi; ++l_it) {
        int l = l_it; asm volatile("" : "+s"(l));
        constexpr int s0 = PH_L0;
#define MODS_L (F.MODS() + (size_t)l * 5 * 6144)
        if (IN(s0 + 0)) { RELANE();
            pg8::Gemm g{F.HN(), F.WIN() + (size_t)l * PROJ * DM, MROWS, PROJ, DM, DM}; pg8::StaticOrder S; S.init(MROWS, PROJ, F.G, bx_());
            pg8::EpiBf16N E{F.UX(), PROJ, F.BIASA() + (size_t)l * 5 * 2304, 2304, F.ROWSS(), F.q_norm() + l * 64, F.k_norm() + l * 64, (const float*)F.ROPE(), QSCALE};
            pg8::gemm_phase<pg8::EpiBf16N, pg8::StaticOrder, PG8_ALIGN, PG8_SP2, DM, DM, Frame>(F.lds + RING_OFF, g, S, E, F.tid, F);
            SEAM(0);
        }
        if (IN(s0 + 1)) { STAMP(10); for (int rep = 0; rep < R_FFT; ++rep) { RELANE(); fourier_fast_phase(F); } STAMP(11); for (int rep = 0; rep < R_HGA; ++rep) { RELANE(); hgrn_a_phase(F, l); } SEAM(1); }
        if (IN(s0 + 2)) { RELANE(); hgrn_b_phase(F); SEAM(2); }
        if (IN(s0 + 3)) { for (int rep = 0; rep < R_ATT; ++rep) { RELANE(); attn_fast_phase(F, l); } STAMP(12); for (int rep = 0; rep < R_HGC; ++rep) { RELANE(); hgrn_c_phase(F, l); } SEAM(3); }
        if (IN(s0 + 4)) { RELANE();
            const int lastl = (l == DEPTH - 1);
            {
                pg8::Gemm g{F.MIX(), F.WOUT() + (size_t)l * DM * KMIX, MROWS, DM, KMIX, KMIX}; pg8::StaticOrder S; S.init(NB * SEQ, DM, F.G, bx_(), 1);
                pg8::EpiResGate E{F.XB(), MODS_L + MOD_G_A, MODS_L + MOD_SC_F, F.HN(), F.ROWSS()};
                pg8::gemm_phase<pg8::EpiResGate, pg8::StaticOrder, PG8_ALIGN, PG8_SP2, KMIX, KMIX, Frame>(F.lds + RING_OFF, g, S, E, F.tid, F);
            }
            if (!lastl) {
                RELANE();
                pg8::Gemm g{F.MIX(), F.WOUT() + (size_t)l * DM * KMIX, MROWS, DM, 256, KMIX}; pg8::CtxSplitOrder S; S.init(DM, KMIX, 256, F.G, bx_());
                pg8::EpiPartial E{F.HGS(), 256};
                pg8::gemm_phase<pg8::EpiPartial, pg8::CtxSplitOrder, PG8_ALIGN, PG8_SP2, 256, KMIX, Frame>(F.lds + RING_OFF, g, S, E, F.tid, F);
                SEAM(4); RELANE();
                { const float* m2 = F.MODS() + (size_t)l * 5 * 6144; ctx_reduce_pass<KMIX / 256>(F, F.HGS(), m2 + MOD_G_A, m2 + MOD_SC_F); }
            }
            SEAM(4);
        }
        if (IN(s0 + 5)) { RELANE();
            const int lastl = (l == DEPTH - 1);
            pg8::Gemm g{F.HN(), F.WGU() + (size_t)l * 5632 * DM, MROWS, 5632, DM, DM}; pg8::StaticOrder S; S.init(lastl ? NB * SEQ : MROWS, 5632, F.G, bx_(), lastl);
            pg8::EpiSwiGLU E{F.HB(), DFF, F.BIASF() + (size_t)l * 5 * 5632, 5632, F.ROWSS()};
            pg8::gemm_phase<pg8::EpiSwiGLU, pg8::StaticOrder, PG8_ALIGN, PG8_SP2, DM, DM, Frame>(F.lds + RING_OFF, g, S, E, F.tid, F);
            SEAM(5);
        }
        if (IN(s0 + 6)) { RELANE();
            const int lastl = (l == DEPTH - 1);
            {
                pg8::Gemm g{F.HB(), F.WDN() + (size_t)l * DM * DFF, MROWS, DM, DFF, DFF}; pg8::StaticOrder S; S.init(NB * SEQ, DM, F.G, bx_(), 1);
                pg8::EpiResGate E{F.XB(), MODS_L + MOD_G_F, (l + 1 < DEPTH) ? MODS_L + 5 * 6144 + MOD_SC_A : nullptr, F.HN(), F.ROWSS()};
                pg8::gemm_phase<pg8::EpiResGate, pg8::StaticOrder, PG8_ALIGN, PG8_SP2, DFF, DFF, Frame>(F.lds + RING_OFF, g, S, E, F.tid, F);
            }
            if (!lastl) {
                RELANE();
                pg8::Gemm g{F.HB(), F.WDN() + (size_t)l * DM * DFF, MROWS, DM, 256, DFF}; pg8::CtxSplitOrder S; S.init(DM, DFF, 256, F.G, bx_());
                pg8::EpiPartial E{F.HGS(), 256};
                pg8::gemm_phase<pg8::EpiPartial, pg8::CtxSplitOrder, PG8_ALIGN, PG8_SP2, 256, DFF, Frame>(F.lds + RING_OFF, g, S, E, F.tid, F);
                SEAM(6); RELANE();
                { const float* m2 = F.MODS() + (size_t)l * 5 * 6144; ctx_reduce_pass<DFF / 256>(F, F.HGS(), m2 + MOD_G_F, (l + 1 < DEPTH) ? m2 + 5 * 6144 + MOD_SC_A : nullptr); }
            }
            SEAM(6);
        }
    }
    if (IN(PH_FINAL)) { RELANE(); final_norm_phase(F); if (DIAG_J >= 0) { asm volatile("s_waitcnt vmcnt(0)" ::: "memory"); const unsigned long long t_ = rt(); if (DIAG_J == 9) F.da += t_ - F.dt;
        if (blockIdx.x == 0) { const unsigned long long tend = t_ + (unsigned long long)DIAG_A * F.da; while (rt() < tend) __builtin_amdgcn_s_sleep(32); } } }
#undef IN
#undef SEAM
}

#if MK_MULTI
#define MAIN_KERNEL (fwd_kernel<3, 4>)
#define LAUNCH(p) hipLaunchKernelGGL((fwd_kernel<p, p + 1>), dim3(grid), dim3(NTHREADS), LDS_BYTES, stream, a)
template <int P> static bool set_lds_one() { return hipFuncSetAttribute((const void*)fwd_kernel<P, P + 1>, hipFuncAttributeMaxDynamicSharedMemorySize, LDS_BYTES) == hipSuccess; }
static bool set_lds_all() { return set_lds_one<0>() && set_lds_one<1>() && set_lds_one<2>() && set_lds_one<3>() && set_lds_one<4>() && set_lds_one<5>() && set_lds_one<6>() && set_lds_one<7>() && set_lds_one<8>() && set_lds_one<9>() ; }
#else
#define MAIN_KERNEL (fwd_kernel<0, NPH>)
static bool set_lds_all() { return hipFuncSetAttribute((const void*)fwd_kernel<0, NPH>, hipFuncAttributeMaxDynamicSharedMemorySize, LDS_BYTES) == hipSuccess; }
#endif
extern "C" void kernel_launch(void* const* d_in, const int* in_sizes, int n_in, void* d_out, int out_size, void* d_ws, size_t ws_size, hipStream_t stream) {
    static int grid = 0;
    if (grid == 0) {
        if (n_in != 17 || in_sizes[0] != NB * SEQ * DM || out_size != NB * SEQ * DM || ws_size < WS_END) { fprintf(stderr, "kernel_launch: unexpected shapes (n_in %d, in0 %d, out %d, ws %zu < %zu); nothing launched\n", n_in, n_in > 0 ? in_sizes[0] : -1, out_size, ws_size, (size_t)WS_END); grid = -1; return; }
        int dev = 0, cus = 0, per_cu = 0;
        if (hipGetDevice(&dev) != hipSuccess || hipDeviceGetAttribute(&cus, hipDeviceAttributeMultiprocessorCount, dev) != hipSuccess) { grid = -1; return; }
        if (!set_lds_all()) { fprintf(stderr, "kernel_launch: hipFuncSetAttribute failed\n"); grid = -1; return; }
        if (hipOccupancyMaxActiveBlocksPerMultiprocessor(&per_cu, (const void*)MAIN_KERNEL, NTHREADS, LDS_BYTES) != hipSuccess || per_cu < 1) { fprintf(stderr, "kernel_launch: occupancy query says %d blocks per CU; nothing launched\n", per_cu); (void)hipGetLastError(); grid = -1; return; }
        grid = cus;
    }
    if (grid < 0) return;
    if (hipMemsetAsync((char*)d_ws + WS_CTL, 0, CTL_ZERO_BYTES, stream) != hipSuccess) return;
    Args a{};
    for (int i = 0; i < 17; ++i) a.in[i] = (const float*)d_in[i];
    a.out = (float*)d_out; a.ws = (unsigned char*)d_ws;
#if MK_MULTI
    a.l_lo = 0; a.l_hi = 0;
    LAUNCH(0); LAUNCH(1);
    for (int l = 0; l < DEPTH; ++l) { a.l_lo = l; a.l_hi = l + 1; LAUNCH(2); LAUNCH(3); LAUNCH(4); LAUNCH(5); LAUNCH(6); LAUNCH(7); LAUNCH(8); }
    a.l_lo = 0; a.l_hi = 0; LAUNCH(9);
#else
    a.l_lo = 0; a.l_hi = DEPTH;
    hipLaunchKernelGGL((fwd_kernel<0, NPH>), dim3(grid), dim3(NTHREADS), LDS_BYTES, stream, a);
#endif
}
```

```cpp
#include <hip/hip_runtime.h>
#include <hip/hip_bf16.h>
#include <cstdio>
#include <cstdint>
#include <cmath>
#ifndef DIAG_J
#define DIAG_J -1
#endif
#ifndef DIAG_A
#define DIAG_A 4
#endif
#define STAMP(tag) do { if (DIAG_J >= 0) { const unsigned long long t_ = __builtin_amdgcn_s_memrealtime(); if ((tag) == DIAG_J) F.da += t_ - F.dt; F.dt = t_; } } while (0)
#ifndef XL_DPP
#define XL_DPP 1
#endif
#ifndef XL_P32
#define XL_P32 0
#endif
__device__ __forceinline__ float xl_bperm_xor(float v, int mask) {
    int ln_; asm volatile("v_mbcnt_lo_u32_b32 %0, -1, 0\n\tv_mbcnt_hi_u32_b32 %0, -1, %0" : "=v"(ln_));
    return __builtin_bit_cast(float, __builtin_amdgcn_ds_bpermute((ln_ ^ mask) << 2, __builtin_bit_cast(int, v)));
}
#if !XL_DPP
__device__ __forceinline__ float xl_dpp_qp2301(float v) { return xl_bperm_xor(v, 2); }
__device__ __forceinline__ float xl_sum4(float v) { v += xl_bperm_xor(v, 1); v += xl_bperm_xor(v, 2); return v; }
__device__ __forceinline__ float xl_sum8(float v) { v = xl_sum4(v); v += xl_bperm_xor(v, 4); return v; }
__device__ __forceinline__ float xl_sum16(float v) { v = xl_sum8(v); v += xl_bperm_xor(v, 8); return v; }
#else
__device__ __forceinline__ float xl_dpp_qp1032(float v) { return __builtin_bit_cast(float, __builtin_amdgcn_update_dpp(0, __builtin_bit_cast(int, v), 0xB1, 0xF, 0xF, false)); }
__device__ __forceinline__ float xl_dpp_qp2301(float v) { return __builtin_bit_cast(float, __builtin_amdgcn_update_dpp(0, __builtin_bit_cast(int, v), 0x4E, 0xF, 0xF, false)); }
__device__ __forceinline__ float xl_dpp_hmirror(float v) { return __builtin_bit_cast(float, __builtin_amdgcn_update_dpp(0, __builtin_bit_cast(int, v), 0x141, 0xF, 0xF, false)); }
__device__ __forceinline__ float xl_dpp_mirror(float v) { return __builtin_bit_cast(float, __builtin_amdgcn_update_dpp(0, __builtin_bit_cast(int, v), 0x140, 0xF, 0xF, false)); }
__device__ __forceinline__ float xl_sum4(float v) { v += xl_dpp_qp1032(v); v += xl_dpp_qp2301(v); return v; }
__device__ __forceinline__ float xl_sum8(float v) { v = xl_sum4(v); v += xl_dpp_hmirror(v); return v; }
__device__ __forceinline__ float xl_sum16(float v) { v = xl_sum8(v); v += xl_dpp_mirror(v); return v; }
#endif
__device__ __forceinline__ float xl_sumx16(float v) { return v + xl_bperm_xor(v, 16); }
#if XL_P32
__device__ __forceinline__ float xl_sumx32(float v) { const auto r = __builtin_amdgcn_permlane32_swap(__builtin_bit_cast(unsigned, v), __builtin_bit_cast(unsigned, v), false, false); return __builtin_bit_cast(float, r[0]) + __builtin_bit_cast(float, r[1]); }
#else
__device__ __forceinline__ float xl_sumx32(float v) { return v + xl_bperm_xor(v, 32); }
#endif
__device__ __forceinline__ float xl_sum64(float v) { return xl_sumx32(xl_sumx16(xl_sum16(v))); }
namespace pg8 {
#define PG8_LAS __attribute__((address_space(3)))
typedef unsigned short bf16_t;
typedef short bf16x8 __attribute__((ext_vector_type(8)));
typedef float f32x4 __attribute__((ext_vector_type(4)));
typedef unsigned u32x4 __attribute__((ext_vector_type(4)));
constexpr int BM = 256, BK = 64, HALF = 128, HTB = HALF * BK * 2  , STAGE_BYTES = 8 * HTB, NXCD = 8, WGM = 8;

__host__ __device__ __forceinline__ int lds_byte(int r, int c) { const int st = (r >> 4) * 2 + (c >> 5), rr = r & 15, cc = c & 31, ob = rr * 64 + cc * 2; return st * 1024 + (ob ^ (((ob >> 9) & 1) << 5)); }
__host__ __device__ __forceinline__ void stage_rc(int b, int& R, int& C) { const int st = b / 1024, sb = b % 1024, swz = sb ^ (((sb >> 9) & 1) << 5); R = (st >> 1) * 16 + swz / 64; C = (st & 1) * 32 + (swz % 64) / 2; }
__host__ __device__ __forceinline__ int perm32(int rho) { const int n = rho >> 4, i = rho & 15; return 8 * (i >> 2) + 4 * n + (i & 3); }

struct Unit { int pm, pn, ko; };
struct Gemm { const bf16_t* A; const bf16_t* Bt; int M, N, K, ld; };

struct StaticOrder {
    int nM, nN, nwg, G, c, skipc;
    __host__ __device__ void init(int M, int N, int G_, int c_, int skipc_ = 0) { nM = M / BM; nN = N / BM; nwg = nM * nN; G = G_; c = c_; skipc = skipc_; }
    __host__ __device__ bool next(int i, Unit& u) const {
        const long L = (long)i * G + c; if (L >= nwg) return false;
        int wgid = (int)L; { const int q = nwg / NXCD, r = nwg % NXCD, xcd = wgid % NXCD, off = wgid / NXCD; wgid = (xcd < r ? xcd * (q + 1) : r * (q + 1) + (xcd - r) * q) + off; }
        const int nig = WGM * nN, gid = wgid / nig, fm = gid * WGM, gsz = (nM - fm) < WGM ? (nM - fm) : WGM;
        u.pm = fm + ((wgid % nig) % gsz); u.pn = (wgid % nig) / gsz; if (skipc) u.pm += u.pm / 32 + 1; u.ko = 0; return true;
    }
    __device__ __forceinline__ void a_ready(const Unit&) const {}
    __device__ __forceinline__ void done(const Unit&) const {}
};

struct CtxSplitOrder {
    int nsplit, kslice, G, c;
    __host__ __device__ void init(int N, int K, int kslice_, int G_, int c_) { kslice = kslice_; nsplit = K / kslice_; G = G_; c = c_; (void)N; }
    __host__ __device__ bool next(int i, Unit& u) const {
        const int L = i * G + c; if (L >= 16 * nsplit) return false;
        const int ks = L >> 4, r = L & 15; u.pm = 33 * (r >> 2); u.pn = r & 3; u.ko = ks * kslice; return true;
    }
    __device__ __forceinline__ void a_ready(const Unit&) const {}
    __device__ __forceinline__ void done(const Unit&) const {}
};
__device__ __forceinline__ unsigned cvt_pk_bf16(float lo, float hi) { unsigned r; asm volatile("v_cvt_pk_bf16_f32 %0, %1, %2" : "=v"(r) : "v"(lo), "v"(hi)); return r; }
typedef float f32x2 __attribute__((ext_vector_type(2)));
__device__ __forceinline__ f32x2 gelu_pk(f32x2 v) {
    const f32x2 av = __builtin_elementwise_abs(v), d = av * 0.2316418882f + 1.0f;
    f32x2 t; t.x = __builtin_amdgcn_rcpf(d.x); t.y = __builtin_amdgcn_rcpf(d.y);
    f32x2 q = t * 0.5307027145f + (-0.7265760135f); q = q * t + 0.7107068705f; q = q * t + (-0.142248368f); q = q * t + 0.127414796f; q = q * t;
    const f32x2 s = (v * v) * (-0.72134752044f);
    f32x2 e; e.x = __builtin_amdgcn_exp2f(s.x); e.y = __builtin_amdgcn_exp2f(s.y);
    const f32x2 m = v * (q * e), r = v - m;
    f32x2 o; o.x = v.x < 0.f ? m.x : r.x; o.y = v.y < 0.f ? m.y : r.y; return o;
}

template <int ACT  > struct EpiBf16 {
    static constexpr bool PERM = true, AFTER_DRAIN = false; static_assert(ACT == 0 || ACT == 1, "EpiBf16: ACT is 0 (none) or 1 (gelu_pk)");
    bf16_t* O; int ldc; const float* bias; int split_cols; size_t split_stride; float scale0;
    __device__ __forceinline__ void operator()(const f32x4 (&acc)[2][2][4][2], const Unit& u, int wr, int wc, int fr, int fq) const {
        const int row0 = u.pm * BM + wr * 64 + fr; int colt = u.pn * BM; bf16_t* base = O;
        float sc = 1.f; if (split_cols) { const int t = colt / split_cols; base += (size_t)t * split_stride; colt -= t * split_cols; if (t == 0) sc = scale0; }
        const int col0 = colt + wc * 32 + 8 * fq, bcol0 = u.pn * BM + wc * 32 + 8 * fq;
        f32x4 bv[2][2];
#pragma unroll
        for (int bj = 0; bj < 2; ++bj)
#pragma unroll
            for (int n = 0; n < 2; ++n) bv[bj][n] = bias ? *(const f32x4*)(bias + bcol0 + bj * HALF + 4 * n) : (f32x4){0.f, 0.f, 0.f, 0.f};
#pragma unroll
        for (int ai = 0; ai < 2; ++ai)
#pragma unroll
            for (int m = 0; m < 4; ++m) { bf16_t* rowp = base + (size_t)(row0 + ai * HALF + m * 16) * ldc + col0;
#pragma unroll
                for (int bj = 0; bj < 2; ++bj) { f32x4 v0 = acc[ai][bj][m][0] + bv[bj][0], v1 = acc[ai][bj][m][1] + bv[bj][1];
                    if (ACT == 1) { f32x2 a = gelu_pk((f32x2){v0[0], v0[1]}), b = gelu_pk((f32x2){v0[2], v0[3]}), c = gelu_pk((f32x2){v1[0], v1[1]}), d = gelu_pk((f32x2){v1[2], v1[3]});
                        v0 = (f32x4){a.x, a.y, b.x, b.y}; v1 = (f32x4){c.x, c.y, d.x, d.y}; }
                    v0 = v0 * sc; v1 = v1 * sc; u32x4 w; w.x = cvt_pk_bf16(v0[0], v0[1]); w.y = cvt_pk_bf16(v0[2], v0[3]); w.z = cvt_pk_bf16(v1[0], v1[1]); w.w = cvt_pk_bf16(v1[2], v1[3]);
                    *(u32x4*)(rowp + bj * HALF) = w; } }
    }
};
template <class Epi, class Sched, bool ALIGN_EPI = false, bool SP2 = false, int KC = 0, int LDC = 0, class Dg = int>
__device__ __forceinline__ void gemm_phase(PG8_LAS unsigned char* lds, const Gemm g, const Sched& S, const Epi& E, int tid_in, Dg& F) {
    int tid_ = tid_in; asm volatile("" : "+v"(tid_));
    const int tid = tid_, wid = __builtin_amdgcn_readfirstlane(tid >> 6), lane = tid & 63, wr = wid >> 2, wc = wid & 3, fr = lane & 15, fq = lane >> 4;
    const int K = KC ? KC : g.K, nt = K / BK, LD = LDC ? LDC : g.ld;
    unsigned voffA[2], voffB[2];
#pragma unroll
    for (int i = 0; i < 2; ++i) { int R, C; stage_rc(tid * 16 + i * 8192, R, C); const int Rb = Epi::PERM ? ((R & ~31) + perm32(R & 31)) : R;
        voffA[i] = (unsigned)(R * LD + C) * 2u; voffB[i] = (unsigned)(Rb * LD + C) * 2u; }
    const size_t kstep = (size_t)(BK * 2);
    const size_t hstep = (size_t)HALF * LD * 2;
    const size_t tstep = 2 * hstep;
    const int aoff = lds_byte(wr * 64 + fr, fq * 8), boff = lds_byte(wc * 32 + fr, fq * 8);
    const unsigned ldsw = (unsigned)wid * 1024u;
#define PG8_SA(b, h) (((b) * 2 + (h)) * HTB)
#define PG8_SB(b, h) ((4 + (b) * 2 + (h)) * HTB)
#define PG8_STAGE(bufoff, gbase, voff) do { _Pragma("unroll") for (int _i = 0; _i < 2; ++_i) \
        __builtin_amdgcn_global_load_lds((const unsigned*)((const char*)(gbase) + (voff)[_i]), (PG8_LAS unsigned*)(lds + (bufoff) + ldsw + _i * 8192), 16, 0, 0); } while (0)
#define PG8_LDA(dst, b, h) do { _Pragma("unroll") for (int m = 0; m < 4; ++m) _Pragma("unroll") for (int k = 0; k < 2; ++k) dst[m][k] = *(const PG8_LAS bf16x8*)(lds + PG8_SA(b, h) + aoff + m * 2048 + k * 1024); } while (0)
#define PG8_LDB(dst, b, h) do { _Pragma("unroll") for (int n = 0; n < 2; ++n) _Pragma("unroll") for (int k = 0; k < 2; ++k) dst[n][k] = *(const PG8_LAS bf16x8*)(lds + PG8_SB(b, h) + boff + n * 2048 + k * 1024); } while (0)
#define PG8_MMA(ai, bj, At, Bt) do { __builtin_amdgcn_s_setprio(1); _Pragma("unroll") for (int m = 0; m < 4; ++m) _Pragma("unroll") for (int n = 0; n < 2; ++n) _Pragma("unroll") for (int k = 0; k < 2; ++k) \
        acc[ai][bj][m][n] = __builtin_amdgcn_mfma_f32_16x16x32_bf16(Bt[n][k], At[m][k], acc[ai][bj][m][n], 0, 0, 0); __builtin_amdgcn_s_setprio(0); } while (0)
#define PG8_WAIT_V(n) asm volatile("s_waitcnt vmcnt(" #n ")" ::: "memory")
#define PG8_WAIT_L(n) asm volatile("s_waitcnt lgkmcnt(" #n ")" ::: "memory")
#define PG8_BAR __builtin_amdgcn_s_barrier()
#define PG8_SCHED __builtin_amdgcn_sched_barrier(0)
    Unit cur, nxt; int ui = 0;
    if (!S.next(0, cur)) return;
    f32x4 acc[2][2][4][2];
#pragma unroll
    for (int a = 0; a < 2; ++a)
#pragma unroll
        for (int b = 0; b < 2; ++b)
#pragma unroll
            for (int m = 0; m < 4; ++m)
#pragma unroll
                for (int n = 0; n < 2; ++n) acc[a][b][m][n] = (f32x4){0.f, 0.f, 0.f, 0.f};
    bf16x8 At[4][2], B0[2][2], B1[2][2];
    const char* cA = (const char*)g.A + (size_t)cur.pm * tstep + (size_t)cur.ko * 2; const char* cB = (const char*)g.Bt + (size_t)cur.pn * tstep + (size_t)cur.ko * 2;
    S.a_ready(cur);
    if constexpr (SP2) {
        PG8_STAGE(PG8_SB(0, 0), cB, voffB); PG8_STAGE(PG8_SB(0, 1), cB + hstep, voffB); PG8_STAGE(PG8_SA(0, 0), cA, voffA); PG8_STAGE(PG8_SA(0, 1), cA + hstep, voffA);
        if (wr == 1) PG8_BAR;
        PG8_WAIT_V(2); PG8_BAR;
        PG8_STAGE(PG8_SB(1, 0), cB + kstep, voffB); PG8_STAGE(PG8_SA(1, 0), cA + kstep, voffA); PG8_STAGE(PG8_SB(1, 1), cB + hstep + kstep, voffB);
        PG8_WAIT_V(6); PG8_BAR;
    } else {
        PG8_STAGE(PG8_SB(0, 0), cB, voffB); PG8_STAGE(PG8_SA(0, 0), cA, voffA); PG8_STAGE(PG8_SB(0, 1), cB + hstep, voffB); PG8_STAGE(PG8_SA(0, 1), cA + hstep, voffA);
        if (wr == 1) PG8_BAR;
        PG8_WAIT_V(4); PG8_BAR;
        PG8_STAGE(PG8_SB(1, 0), cB + kstep, voffB); PG8_STAGE(PG8_SA(1, 0), cA + kstep, voffA); PG8_STAGE(PG8_SB(1, 1), cB + hstep + kstep, voffB);
        PG8_WAIT_V(6); PG8_BAR;
    }
    for (;;) {
        const bool has_next = S.next(ui + 1, nxt);
        const char* nA = has_next ? (const char*)g.A + (size_t)nxt.pm * tstep + (size_t)nxt.ko * 2 : cA; const char* nB = has_next ? (const char*)g.Bt + (size_t)nxt.pn * tstep + (size_t)nxt.ko * 2 : cB;
        for (int t = 0; t < nt; t += 2) {
            const bool last = (t == nt - 2);
            const char* a1 = cA + (size_t)(t + 1) * kstep;
            const char* a2 = last ? nA : cA + (size_t)(t + 2) * kstep; const char* b2 = last ? nB : cB + (size_t)(t + 2) * kstep;
            const char* a3 = a2 + kstep; const char* b3 = b2 + kstep;
            if (last && has_next) S.a_ready(nxt);
            if constexpr (SP2) {
            PG8_LDB(B0, 0, 0); PG8_LDB(B1, 0, 1); PG8_SCHED; PG8_LDA(At, 0, 0); PG8_STAGE(PG8_SA(1, 1), a1 + hstep, voffA);
            PG8_WAIT_V(8); PG8_WAIT_L(0); PG8_BAR; PG8_MMA(0, 0, At, B0); PG8_MMA(0, 1, At, B1); PG8_BAR; PG8_SCHED;
            PG8_LDA(At, 0, 1); PG8_STAGE(PG8_SB(0, 0), b2, voffB); PG8_STAGE(PG8_SB(0, 1), b2 + hstep, voffB); PG8_STAGE(PG8_SA(0, 0), a2, voffA);
            PG8_WAIT_V(8); PG8_WAIT_L(0); PG8_BAR; PG8_MMA(1, 0, At, B0); PG8_MMA(1, 1, At, B1); PG8_BAR; PG8_SCHED;
            PG8_LDB(B0, 1, 0); PG8_LDB(B1, 1, 1); PG8_SCHED; PG8_LDA(At, 1, 0); PG8_STAGE(PG8_SA(0, 1), a2 + hstep, voffA);
            PG8_WAIT_V(8); PG8_WAIT_L(0); PG8_BAR; PG8_MMA(0, 0, At, B0); PG8_MMA(0, 1, At, B1); PG8_BAR; PG8_SCHED;
            PG8_LDA(At, 1, 1); PG8_STAGE(PG8_SB(1, 0), b3, voffB); PG8_STAGE(PG8_SB(1, 1), b3 + hstep, voffB); PG8_STAGE(PG8_SA(1, 0), a3, voffA);
            PG8_WAIT_V(8); PG8_WAIT_L(0); PG8_BAR; PG8_MMA(1, 0, At, B0); PG8_MMA(1, 1, At, B1); PG8_BAR; PG8_SCHED;
            } else {
            PG8_LDB(B0, 0, 0); PG8_SCHED; PG8_LDA(At, 0, 0); PG8_STAGE(PG8_SA(1, 1), a1 + hstep, voffA);
            PG8_WAIT_L(8); PG8_BAR; PG8_WAIT_L(0); PG8_MMA(0, 0, At, B0); PG8_BAR; PG8_SCHED;
            PG8_LDB(B1, 0, 1); PG8_STAGE(PG8_SB(0, 0), b2, voffB);
            PG8_BAR; PG8_WAIT_L(0); PG8_MMA(0, 1, At, B1); PG8_BAR;
            PG8_LDA(At, 0, 1); PG8_STAGE(PG8_SA(0, 0), a2, voffA);
            PG8_BAR; PG8_WAIT_L(0); PG8_MMA(1, 0, At, B0); PG8_BAR; PG8_SCHED;
            PG8_STAGE(PG8_SB(0, 1), b2 + hstep, voffB);
            PG8_WAIT_V(6); PG8_BAR; PG8_MMA(1, 1, At, B1); PG8_BAR;
            PG8_LDB(B0, 1, 0); PG8_SCHED; PG8_LDA(At, 1, 0); PG8_STAGE(PG8_SA(0, 1), a2 + hstep, voffA);
            PG8_WAIT_L(8); PG8_BAR; PG8_WAIT_L(0); PG8_MMA(0, 0, At, B0); PG8_BAR; PG8_SCHED;
            PG8_LDB(B1, 1, 1); PG8_STAGE(PG8_SB(1, 0), b3, voffB);
            PG8_BAR; PG8_WAIT_L(0); PG8_MMA(0, 1, At, B1); PG8_BAR;
            PG8_LDA(At, 1, 1); PG8_STAGE(PG8_SA(1, 0), a3, voffA);
            PG8_BAR; PG8_WAIT_L(0); PG8_MMA(1, 0, At, B0); PG8_BAR; PG8_SCHED;
            PG8_STAGE(PG8_SB(1, 1), b3 + hstep, voffB);
            PG8_WAIT_V(6); PG8_BAR; PG8_MMA(1, 1, At, B1); PG8_BAR;
            }
        }
        STAMP(30);
        if constexpr (ALIGN_EPI) { if (wr == 0) PG8_BAR; }
        STAMP(31);
        if constexpr (!Epi::AFTER_DRAIN) { E(acc, cur, wr, wc, fr, fq); S.done(cur); }
        STAMP(32);
        if (!has_next) break;
#pragma unroll
        for (int a = 0; a < 2; ++a)
#pragma unroll
            for (int b = 0; b < 2; ++b)
#pragma unroll
                for (int m = 0; m < 4; ++m)
#pragma unroll
                    for (int n = 0; n < 2; ++n) acc[a][b][m][n] = (f32x4){0.f, 0.f, 0.f, 0.f};
        cur = nxt; cA = nA; cB = nB; ++ui;
        if constexpr (ALIGN_EPI) { if (wr == 1) PG8_BAR; }
    }
    PG8_WAIT_V(0);
    if constexpr (!ALIGN_EPI) { if (wr == 0) PG8_BAR; }
    PG8_BAR;
    if constexpr (Epi::AFTER_DRAIN) { E.fused(acc, cur, wr, wc, fr, fq, lds, wid, lane); S.done(cur); }
#undef PG8_SA
#undef PG8_SB
#undef PG8_STAGE
#undef PG8_LDA
#undef PG8_LDB
#undef PG8_MMA
#undef PG8_WAIT_V
#undef PG8_WAIT_L
#undef PG8_BAR
#undef PG8_SCHED
}
}
namespace pg8 {
__device__ __forceinline__ float row_rinv(const float* rowss, size_t R, int fq) {
    const f32x4 v = *(const f32x4*)(rowss + R * 16 + 4 * fq); float s = (v[0] + v[1]) + (v[2] + v[3]);
    s = xl_sumx32(xl_sumx16(s));
    return 1.0f / sqrtf(s * (1.0f / 1024.0f) + 1e-6f);
}
struct EpiResGate {
    static constexpr bool PERM = true, AFTER_DRAIN = false;
    bf16_t* XB; const float* gate; const float* scn; bf16_t* XM; float* rowss;
    __device__ __forceinline__ void operator()(const f32x4 (&acc)[2][2][4][2], const Unit& u, int wr, int wc, int fr, int fq) const {
        asm volatile("" : "+v"(fr), "+v"(fq));
        const int b = u.pm / 33, p = u.pm % 33, bb = (p == 0) ? 4 : b;
        const int col0 = u.pn * BM + wc * 32 + 8 * fq;
        f32x4 (&accw)[2][2][4][2] = const_cast<f32x4 (&)[2][2][4][2]>(acc);
        unsigned sp[2][4];
#pragma unroll
        for (int bj = 0; bj < 2; ++bj)
#pragma unroll
            for (int n = 0; n < 2; ++n) { const f32x4 gq = *(const f32x4*)(gate + bb * 6144 + col0 + bj * HALF + 4 * n);
#pragma unroll
                for (int ai = 0; ai < 2; ++ai)
#pragma unroll
                    for (int m = 0; m < 4; ++m) accw[ai][bj][m][n] *= gq;
                if (scn) { const f32x4 sq = *(const f32x4*)(scn + bb * 6144 + col0 + bj * HALF + 4 * n) + 1.0f; sp[bj][2 * n] = cvt_pk_bf16(sq[0], sq[1]); sp[bj][2 * n + 1] = cvt_pk_bf16(sq[2], sq[3]); }
                else { sp[bj][2 * n] = 0x3f803f80u; sp[bj][2 * n + 1] = 0x3f803f80u; } }
#define PG8_LO(w) __builtin_bit_cast(float, (w) << 16)
#define PG8_HI(w) __builtin_bit_cast(float, (w) & 0xffff0000u)
#pragma unroll
        for (int ai = 0; ai < 2; ++ai) {
            u32x4 xin[4][2];
#pragma unroll
            for (int m = 0; m < 4; ++m) { const size_t R = (size_t)u.pm * BM + ai * HALF + wr * 64 + m * 16 + fr;
#pragma unroll
                for (int bj = 0; bj < 2; ++bj) xin[m][bj] = *(const u32x4*)(XB + R * 1024 + col0 + bj * HALF); }
            asm volatile("" ::: "memory");
#pragma unroll
            for (int m = 0; m < 4; ++m) { const size_t R = (size_t)u.pm * BM + ai * HALF + wr * 64 + m * 16 + fr;
                float ss = 0.f;
#pragma unroll
                for (int bj = 0; bj < 2; ++bj) { const u32x4 xw = xin[m][bj];
                    const f32x4 o0 = (f32x4){PG8_LO(xw.x), PG8_HI(xw.x), PG8_LO(xw.y), PG8_HI(xw.y)} + acc[ai][bj][m][0], o1 = (f32x4){PG8_LO(xw.z), PG8_HI(xw.z), PG8_LO(xw.w), PG8_HI(xw.w)} + acc[ai][bj][m][1];
                    u32x4 w; w.x = cvt_pk_bf16(o0[0], o0[1]); w.y = cvt_pk_bf16(o0[2], o0[3]); w.z = cvt_pk_bf16(o1[0], o1[1]); w.w = cvt_pk_bf16(o1[2], o1[3]);
                    *(u32x4*)(XB + R * 1024 + col0 + bj * HALF) = w;
                    ss += ((o0[0] * o0[0] + o0[1] * o0[1]) + (o0[2] * o0[2] + o0[3] * o0[3])) + ((o1[0] * o1[0] + o1[1] * o1[1]) + (o1[2] * o1[2] + o1[3] * o1[3]));
                    if (scn) { const f32x4 s0 = (f32x4){PG8_LO(sp[bj][0]), PG8_HI(sp[bj][0]), PG8_LO(sp[bj][1]), PG8_HI(sp[bj][1])}, s1 = (f32x4){PG8_LO(sp[bj][2]), PG8_HI(sp[bj][2]), PG8_LO(sp[bj][3]), PG8_HI(sp[bj][3])};
                        const f32x4 y0 = o0 * s0, y1 = o1 * s1; w.x = cvt_pk_bf16(y0[0], y0[1]); w.y = cvt_pk_bf16(y0[2], y0[3]); w.z = cvt_pk_bf16(y1[0], y1[1]); w.w = cvt_pk_bf16(y1[2], y1[3]);
                        *(u32x4*)(XM + R * 1024 + col0 + bj * HALF) = w; } }
                ss = xl_sumx32(xl_sumx16(ss));
                if (fq == 0) rowss[R * 16 + u.pn * 4 + wc] = ss; }
            asm volatile("" ::: "memory");
        }
#undef PG8_LO
#undef PG8_HI
    }
};
struct EpiPartial {
    static constexpr bool PERM = false, AFTER_DRAIN = false;
    float* P; int kslice;
    __device__ __forceinline__ void operator()(const f32x4 (&acc)[2][2][4][2], const Unit& u, int wr, int wc, int fr, int fq) const {
        asm volatile("" : "+v"(fr), "+v"(fq));
        const int b = u.pm / 33, ks = u.ko / kslice; const int col0 = u.pn * BM + wc * 32 + 4 * fq;
        float* rp = P + ((size_t)ks * 1024 + (size_t)b * 256 + wr * 64 + fr) * 1024 + col0;
#pragma unroll
        for (int ai = 0; ai < 2; ++ai)
#pragma unroll
            for (int m = 0; m < 4; ++m) {
#pragma unroll
                for (int bj = 0; bj < 2; ++bj)
#pragma unroll
                    for (int n = 0; n < 2; ++n) *(f32x4*)(rp + bj * HALF + n * 16) = acc[ai][bj][m][n];
                rp += (m == 3 ? 80 : 16) * 1024; asm volatile("" : "+v"(rp)); }
    }
};
struct EpiBf16N {
    static constexpr bool PERM = true, AFTER_DRAIN = false;
    bf16_t* O; int ldc; const float* bias; int nb; const float* rowss; const float* qn; const float* kn; const float* rope; float qscale;
    __device__ __forceinline__ void operator()(const f32x4 (&acc)[2][2][4][2], const Unit& u, int wr, int wc, int fr, int fq) const {
        asm volatile("" : "+v"(fr), "+v"(fq));
        const int b = u.pm / 33, p = u.pm % 33, bb = (p == 0) ? 4 : b;
        const int row0 = u.pm * BM + wr * 64 + fr, col0 = u.pn * BM + wc * 32 + 8 * fq;
        f32x4 bv[2][2];
#pragma unroll
        for (int bj = 0; bj < 2; ++bj)
#pragma unroll
            for (int n = 0; n < 2; ++n) bv[bj][n] = *(const f32x4*)(bias + (size_t)bb * nb + col0 + bj * HALF + 4 * n);
        if (u.pn >= 1 && u.pn <= 3) {
            const int hh = 4 * (u.pn - 1) + wc;
            const int dlo = (fq < 2) ? 8 * fq : 8 * fq + 16;
            bf16_t* obase = O + 256 + hh * 64 + dlo;
            const bool normed = hh < 10, isq = hh < 8;
            f32x4 g1[2], g2[2];
#pragma unroll
            for (int n = 0; n < 2; ++n) { const float* gp = (isq ? qn : kn) + dlo + 4 * n; const float sc = isq ? qscale : 1.0f;
                g1[n] = normed ? *(const f32x4*)gp * sc : (f32x4){1.f, 1.f, 1.f, 1.f}; g2[n] = normed ? *(const f32x4*)(gp + 16) * sc : (f32x4){1.f, 1.f, 1.f, 1.f}; }
#pragma unroll
            for (int ai = 0; ai < 2; ++ai)
#pragma unroll
                for (int m = 0; m < 4; ++m) { const int rl = ai * HALF + wr * 64 + m * 16 + fr; const size_t R = (size_t)u.pm * BM + rl; const float ri = row_rinv(rowss, R, fq);
                    f32x4 v1[2], v2[2];
#pragma unroll
                    for (int n = 0; n < 2; ++n) { v1[n] = acc[ai][0][m][n] * ri + bv[0][n]; v2[n] = acc[ai][1][m][n] * ri + bv[1][n]; }
                    if (normed) {
                        float ss = 0.f;
#pragma unroll
                        for (int n = 0; n < 2; ++n) ss += ((v1[n][0] * v1[n][0] + v1[n][1] * v1[n][1]) + (v1[n][2] * v1[n][2] + v1[n][3] * v1[n][3])) + ((v2[n][0] * v2[n][0] + v2[n][1] * v2[n][1]) + (v2[n][2] * v2[n][2] + v2[n][3] * v2[n][3]));
                        ss = xl_sumx32(xl_sumx16(ss));
                        const float hr = 1.0f / sqrtf(ss * (1.0f / 64.0f) + 1e-6f);
#pragma unroll
                        for (int n = 0; n < 2; ++n) { v1[n] = v1[n] * hr * g1[n]; v2[n] = v2[n] * hr * g2[n]; }
                        if (p != 0) {
                            const float* rp = rope + ((size_t)(256 * (p - 1) + rl) * 32 + 8 * fq) * 2;
#pragma unroll
                            for (int n = 0; n < 2; ++n) { const f32x4 c0 = *(const f32x4*)(rp + 8 * n), c1 = *(const f32x4*)(rp + 8 * n + 4);
                                const f32x4 cs = (f32x4){c0[0], c0[2], c1[0], c1[2]}, sn = (f32x4){c0[1], c0[3], c1[1], c1[3]};
                                const f32x4 o1 = v1[n] * cs - v2[n] * sn, o2 = v1[n] * sn + v2[n] * cs; v1[n] = o1; v2[n] = o2; }
                        }
                    }
                    u32x4 w; w.x = cvt_pk_bf16(v1[0][0], v1[0][1]); w.y = cvt_pk_bf16(v1[0][2], v1[0][3]); w.z = cvt_pk_bf16(v1[1][0], v1[1][1]); w.w = cvt_pk_bf16(v1[1][2], v1[1][3]);
                    *(u32x4*)(obase + R * ldc) = w;
                    w.x = cvt_pk_bf16(v2[0][0], v2[0][1]); w.y = cvt_pk_bf16(v2[0][2], v2[0][3]); w.z = cvt_pk_bf16(v2[1][0], v2[1][1]); w.w = cvt_pk_bf16(v2[1][2], v2[1][3]);
                    *(u32x4*)(obase + R * ldc + 16) = w; }
            return;
        }
#pragma unroll
        for (int ai = 0; ai < 2; ++ai)
#pragma unroll
            for (int m = 0; m < 4; ++m) { const size_t R = (size_t)(row0 + ai * HALF + m * 16); const float ri = row_rinv(rowss, R, fq); bf16_t* rowp = O + R * ldc + col0;
#pragma unroll
                for (int bj = 0; bj < 2; ++bj) { const f32x4 v0 = acc[ai][bj][m][0] * ri + bv[bj][0], v1 = acc[ai][bj][m][1] * ri + bv[bj][1];
                    u32x4 w; w.x = cvt_pk_bf16(v0[0], v0[1]); w.y = cvt_pk_bf16(v0[2], v0[3]); w.z = cvt_pk_bf16(v1[0], v1[1]); w.w = cvt_pk_bf16(v1[2], v1[3]);
                    *(u32x4*)(rowp + bj * HALF) = w; } }
    }
};
struct EpiSwiGLU {
    static constexpr bool PERM = true, AFTER_DRAIN = false;
    bf16_t* O; int ldc; const float* bias; int nb; const float* rowss;
    __device__ __forceinline__ void operator()(const f32x4 (&acc)[2][2][4][2], const Unit& u, int wr, int wc, int fr, int fq) const {
        asm volatile("" : "+v"(fr), "+v"(fq));
        const int b = u.pm / 33, p = u.pm % 33, bb = (p == 0) ? 4 : b;
        const int row0 = u.pm * BM + wr * 64 + fr, col0 = u.pn * HALF + wc * 32 + 8 * fq, bcol0 = u.pn * BM + wc * 32 + 8 * fq;
        f32x4 bv[2][2];
#pragma unroll
        for (int bj = 0; bj < 2; ++bj)
#pragma unroll
            for (int n = 0; n < 2; ++n) bv[bj][n] = *(const f32x4*)(bias + (size_t)bb * nb + bcol0 + bj * HALF + 4 * n);
#pragma unroll
        for (int ai = 0; ai < 2; ++ai)
#pragma unroll
            for (int m = 0; m < 4; ++m) { const size_t R = (size_t)(row0 + ai * HALF + m * 16); const float ri = row_rinv(rowss, R, fq); bf16_t* rowp = O + R * ldc + col0;
                float hv[8];
#pragma unroll
                for (int n = 0; n < 2; ++n)
#pragma unroll
                    for (int e = 0; e < 4; ++e) { const float g = acc[ai][0][m][n][e] * ri + bv[0][n][e], up = acc[ai][1][m][n][e] * ri + bv[1][n][e];
                        hv[n * 4 + e] = g * up * __builtin_amdgcn_rcpf(1.0f + __builtin_amdgcn_exp2f(-1.44269504089f * g)); }
                u32x4 w; w.x = cvt_pk_bf16(hv[0], hv[1]); w.y = cvt_pk_bf16(hv[2], hv[3]); w.z = cvt_pk_bf16(hv[4], hv[5]); w.w = cvt_pk_bf16(hv[6], hv[7]);
                *(u32x4*)rowp = w; }
    }
};
}
#ifndef PG8_SP2
#define PG8_SP2 true
#endif
#ifndef PG8_ALIGN
#define PG8_ALIGN true
#endif
#include <hip/hip_bf16.h>
#include <cmath>
namespace attn_body {
using bf16=__hip_bfloat16;
using bf16x8=__attribute__((ext_vector_type(8)))short;
using s16x4=__attribute__((ext_vector_type(4)))short;
using f32x16=__attribute__((ext_vector_type(16)))float;
using u32x4=__attribute__((ext_vector_type(4)))unsigned;
constexpr int D=64,PQ=2304,PO=1280;
constexpr int NW=8,QBLK=32,QB=QBLK*NW,KVBLK=64;
constexpr int ATTN_UNIT_ROWS=QB;
__device__ __forceinline__ int crow(int r,int hi){return (r&3)+8*(r>>2)+4*hi;}
#define SBAR() __builtin_amdgcn_sched_barrier(0)
constexpr int NSLOT=3, SLOTB=8192;
constexpr int LDS_K=0, LDS_V=NSLOT*SLOTB, LDS_WS=2*NSLOT*SLOTB, LDS_OST=LDS_WS+NW*64*4, LDS_BYTES=LDS_OST+NW*4096;
constexpr float C2=0.125f*1.4426950408889634f;
__device__ __forceinline__ void glds16(const void*gsrc,unsigned lds_dst){unsigned keep;
  asm volatile("s_mov_b32 %0, m0\n\ts_mov_b32 m0, %2\n\ts_nop 0\n\tglobal_load_lds_dwordx4 %1, off\n\ts_mov_b32 m0, %0":"=&s"(keep):"v"(gsrc),"s"(lds_dst):"memory");}
__device__ __forceinline__ float max3f(float a,float b,float c){float r;asm("v_max3_f32 %0, %1, %2, %3":"=v"(r):"v"(a),"v"(b),"v"(c));return r;}
__device__ __forceinline__ float max2f(float a,float b){float r;asm("v_max_f32_e32 %0, %1, %2":"=v"(r):"v"(a),"v"(b));return r;}
__device__ __forceinline__ float fadd_s(float a,float b){float r;asm("v_add_f32_e32 %0, %1, %2":"=v"(r):"v"(a),"v"(b));return r;}
__device__ __forceinline__ float fsub_s(float a,float b){float r;asm("v_sub_f32_e32 %0, %1, %2":"=v"(r):"v"(a),"v"(b));return r;}
typedef float f32x2_t __attribute__((ext_vector_type(2))); typedef __bf16 bf16x2_t __attribute__((ext_vector_type(2)));
__device__ __forceinline__ unsigned cvtpk_s(float lo,float hi){f32x2_t v={lo,hi};bf16x2_t b=__builtin_convertvector(v,bf16x2_t);return __builtin_bit_cast(unsigned,b);}
#define WAIT_BAR(N) asm volatile("s_waitcnt vmcnt(" #N ") lgkmcnt(0)\n\ts_barrier":::"memory")

__device__ __forceinline__ void qkt(f32x16&p0,f32x16&p1,const char*Kslot,const bf16x8*qr,const f32x16&negm,int r32,int hi){
  const char*kb=Kslot+hi*1024+r32*16;
  #pragma unroll
  for(int d0=0;d0<4;++d0){
    const bf16x8 b0=*reinterpret_cast<const bf16x8*>(kb+d0*2048);
    const bf16x8 b1=*reinterpret_cast<const bf16x8*>(kb+d0*2048+512);
    if(d0==0){p0=__builtin_amdgcn_mfma_f32_32x32x16_bf16(b0,qr[0],negm,0,0,0);p1=__builtin_amdgcn_mfma_f32_32x32x16_bf16(b1,qr[0],negm,0,0,0);}
    else{p0=__builtin_amdgcn_mfma_f32_32x32x16_bf16(b0,qr[d0],p0,0,0,0);p1=__builtin_amdgcn_mfma_f32_32x32x16_bf16(b1,qr[d0],p1,0,0,0);}}
}
typedef __attribute__((address_space(3))) const char* lds_cptr;
typedef short v4i16_t __attribute__((ext_vector_type(4)));
__device__ __forceinline__ void kload8(bf16x8*kf,lds_cptr kp){
  kf[0]=*(const __attribute__((address_space(3))) bf16x8*)(kp);      kf[1]=*(const __attribute__((address_space(3))) bf16x8*)(kp+512);
  kf[2]=*(const __attribute__((address_space(3))) bf16x8*)(kp+2048); kf[3]=*(const __attribute__((address_space(3))) bf16x8*)(kp+2560);
  kf[4]=*(const __attribute__((address_space(3))) bf16x8*)(kp+4096); kf[5]=*(const __attribute__((address_space(3))) bf16x8*)(kp+4608);
  kf[6]=*(const __attribute__((address_space(3))) bf16x8*)(kp+6144); kf[7]=*(const __attribute__((address_space(3))) bf16x8*)(kp+6656);
}
__device__ __forceinline__ void kload2(bf16x8*kf,lds_cptr kp,int j){ kf[2*j]=*(const __attribute__((address_space(3))) bf16x8*)(kp+j*2048); kf[2*j+1]=*(const __attribute__((address_space(3))) bf16x8*)(kp+j*2048+512); }
__device__ __forceinline__ s16x4 vtr(lds_cptr p){ return __builtin_bit_cast(s16x4,__builtin_amdgcn_ds_read_tr16_b64_v4i16((__attribute__((address_space(3))) v4i16_t*)p)); }
__device__ __forceinline__ float rowmax(const f32x16&p0,const f32x16&p1){
  float a=max3f(p0[0],p0[1],p1[0]),b=max3f(p0[2],p0[3],p1[1]);a=max3f(a,p1[2],p1[3]);
  #pragma unroll
  for(int r=4;r<16;r+=4){a=max3f(a,p0[r],p0[r+1]);b=max3f(b,p0[r+2],p0[r+3]);a=max3f(a,p1[r],p1[r+1]);b=max3f(b,p1[r+2],p1[r+3]);}
  const float m=max2f(a,b);
  auto rr=__builtin_amdgcn_permlane32_swap(__float_as_uint(m),__float_as_uint(m),false,false);
  return max2f(__uint_as_float(rr[0]),__uint_as_float(rr[1]));
}
__device__ __forceinline__ void pv(f32x16*o,int vb,bf16x8 pa0,bf16x8 pa1,bf16x8 pa2,bf16x8 pa3){
  #pragma unroll
  for(int d0=0;d0<2;++d0){s16x4 lo[4],hi[4];
    #pragma unroll
    for(int ks=0;ks<4;++ks){
      asm volatile("ds_read_b64_tr_b16 %0,%1 offset:%c2":"=&v"(lo[ks]):"v"(vb),"i"(d0*4096+ks*1024):"memory");
      asm volatile("ds_read_b64_tr_b16 %0,%1 offset:%c2":"=&v"(hi[ks]):"v"(vb),"i"(d0*4096+ks*1024+512):"memory");}
    asm volatile("s_waitcnt lgkmcnt(0)":::"memory");SBAR();
    #define PK(k) (bf16x8){lo[k][0],lo[k][1],lo[k][2],lo[k][3],hi[k][0],hi[k][1],hi[k][2],hi[k][3]}
    o[d0]=__builtin_amdgcn_mfma_f32_32x32x16_bf16(pa0,PK(0),o[d0],0,0,0);
    o[d0]=__builtin_amdgcn_mfma_f32_32x32x16_bf16(pa1,PK(1),o[d0],0,0,0);
    o[d0]=__builtin_amdgcn_mfma_f32_32x32x16_bf16(pa2,PK(2),o[d0],0,0,0);
    o[d0]=__builtin_amdgcn_mfma_f32_32x32x16_bf16(pa3,PK(3),o[d0],0,0,0);
    #undef PK
  }
}

#ifndef ATTN_STORE16
#define ATTN_STORE16(p,v) (*(u32x4*)(p)=(v))
#endif
template<int THRL> __device__ __forceinline__ void attn_unit(const bf16*Qu,const bf16*__restrict__ Kh,const bf16*__restrict__ Vh,bf16*Ou,const int NT,char*shm,int tid){
  const int lane=tid&63,r32=lane&31,hi=lane>>5; const int wid=__builtin_amdgcn_readfirstlane(tid>>6);
  const bf16*Qw=Qu+(long)(wid*QBLK)*PQ;
  const unsigned lds0=(unsigned)(uintptr_t)shm;
  float*wsf=(float*)(shm+LDS_WS)+wid*64;
  const bf16*ksrc=Kh+(long)lane*PQ+wid*8;
  const bf16*vsrc=Vh+(long)(16*(wid&3)+(lane>>2))*PQ+(wid>>2)*32+(lane&3)*8;
  const unsigned kdst=lds0+LDS_K+wid*1024, vdst=lds0+LDS_V+wid*1024;
  #define DMA_K(t,slot) glds16(ksrc+(long)(t)*KVBLK*PQ,(unsigned)__builtin_amdgcn_readfirstlane(kdst+(slot)))
  #define DMA_V(t,slot) glds16(vsrc+(long)(t)*KVBLK*PQ,(unsigned)__builtin_amdgcn_readfirstlane(vdst+(slot)))
  const int vb0=(int)(lds0+LDS_V)+((lane>>4)&1)*32+(lane&3)*8+(4*hi+((lane&15)>>2))*64;
  const char*Kbase=shm+LDS_K; bf16x8 kf[8];
  const lds_cptr shm3=(lds_cptr)shm; const lds_cptr kp0=shm3+LDS_K+hi*1024+r32*16; const lds_cptr vp0=shm3+LDS_V+((lane>>4)&1)*32+(lane&3)*8+(4*hi+((lane&15)>>2))*64;
  DMA_K(0,0);DMA_V(0,0);DMA_K(1,SLOTB);
  bf16x8 qr[4];
  #pragma unroll
  for(int d0=0;d0<4;++d0)qr[d0]=*reinterpret_cast<const bf16x8*>(&Qw[(long)r32*PQ+d0*16+hi*8]);
  float mhat=0.f,l_reg=0.f;f32x16 o[2];o[0]=f32x16{};o[1]=f32x16{};f32x16 negm=f32x16{};asm volatile("":"+v"(negm));
  #define CMASK(P0,P1,t) do{}while(0)
  bool resc=false;
  #define START(P0,P1) do{ const float rm=rowmax(P0,P1); resc=false; \
    { const float dl=rm; mhat=fadd_s(mhat,dl); \
      _Pragma("unroll") for(int r=0;r<16;++r){P0[r]=fsub_s(P0[r],dl);P1[r]=fsub_s(P1[r],dl);} \
      _Pragma("unroll") for(int r=0;r<16;++r)negm[r]=-mhat; asm volatile("":"+v"(negm)); } \
    _Pragma("unroll") for(int r=0;r<16;++r)P0[r]=__builtin_amdgcn_exp2f(P0[r]); }while(0)
  #define RESC() do{ if(resc){ asm volatile("s_waitcnt lgkmcnt(0)":::"memory"); \
      _Pragma("unroll") for(int d_=0;d_<2;++d_) _Pragma("unroll") for(int r=0;r<16;++r)o[d_][r]*=wsf[crow(r,hi)]; } }while(0)
  f32x16 pA0,pA1,pB0,pB1;
  int sl_prev=0,sl_cur=0,sl_next=SLOTB;
  #define ROT() do{sl_prev=sl_cur;sl_cur=sl_next;sl_next=(sl_next==(NSLOT-1)*SLOTB)?0:sl_next+SLOTB;}while(0)
  DMA_K(2,2*SLOTB);
  WAIT_BAR(3);
  qkt(pA0,pA1,Kbase,qr,negm,r32,hi);asm volatile("s_nop 15\n\ts_nop 7":"+v"(pA0),"+v"(pA1));CMASK(pA0,pA1,0);
  START(pA0,pA1);
  _Pragma("unroll") for(int r=0;r<16;++r)pA1[r]=__builtin_amdgcn_exp2f(pA1[r]);
  WAIT_BAR(0);
  DMA_K(3,0);DMA_V(1,SLOTB);
  ROT();
  kload8(kf,kp0+sl_cur);
  WAIT_BAR(2);
  s16x4 vlo[8],vhi[8]; u32x4 pw0,pw1,pw2,pw3;
  #define PKW(P,B) cvtpk_s(P[B],P[B+1])
  #define PAF(k) __builtin_bit_cast(bf16x8,pw##k)
  #define VFR(i) (bf16x8){vlo[i][0],vlo[i][1],vlo[i][2],vlo[i][3],vhi[i][0],vhi[i][1],vhi[i][2],vhi[i][3]}
  #define PIN(x) asm volatile("":"+v"(x))
  #define MX3(a,b,c) __builtin_fmaxf(__builtin_fmaxf((a),(b)),(c))
  #define GAPA(MF,A0,A1,A2,A3,W0,W1,PW) do{ MF; sacc+=A0; sacc+=A1; sacc+=A2; sacc+=A3; PIN(sacc); W0; W1; PIN(PW); SBAR(); }while(0)
  #define EX(v) __builtin_amdgcn_exp2f(v)
  #define GAPB(MF,X,B) do{ MF; X[B]=EX(X[B]); X[B+1]=EX(X[B+1]); X[B+2]=EX(X[B+2]); X[B+3]=EX(X[B+3]); PIN(X); SBAR(); }while(0)
  #define VRD(i) do{ vlo[i]=vtr(vp_+(((i)>>2)*4096+((i)&3)*1024)); vhi[i]=vtr(vp_+(((i)>>2)*4096+((i)&3)*1024+512)); }while(0)
  #define KRD(G,j) do{ if(G){ kload2(kf,kp0+sl_next,j); SBAR(); } }while(0)
  #define STEP(C0,C1,P0,P1,t,GK,GV,GL) do{ SBAR(); \
    const lds_cptr vp_=vp0+sl_prev; \
    VRD(0); SBAR(); float sacc=(P0[0]+P0[1]); \
    GAPA(C0=__builtin_amdgcn_mfma_f32_32x32x16_bf16(kf[0],qr[0],negm,0,0,0), P0[2],P0[3],P0[4],P0[5],     pw0[0]=PKW(P0,0), pw0[1]=PKW(P0,2), pw0); \
    VRD(4); SBAR(); GAPA(C1=__builtin_amdgcn_mfma_f32_32x32x16_bf16(kf[1],qr[0],negm,0,0,0), P0[6],P0[7],P0[8],P0[9],     pw0[2]=PKW(P0,4), pw0[3]=PKW(P0,6), pw0); \
    VRD(1); SBAR(); GAPA(C0=__builtin_amdgcn_mfma_f32_32x32x16_bf16(kf[2],qr[1],C0,0,0,0),   P0[10],P0[11],P0[12],P0[13], pw1[0]=PKW(P0,8), pw1[1]=PKW(P0,10), pw1); \
    VRD(5); SBAR(); GAPA(C1=__builtin_amdgcn_mfma_f32_32x32x16_bf16(kf[3],qr[1],C1,0,0,0),   P0[14],P0[15],P1[0],P1[1],   pw1[2]=PKW(P0,12),pw1[3]=PKW(P0,14), pw1); \
    VRD(2); SBAR(); GAPA(C0=__builtin_amdgcn_mfma_f32_32x32x16_bf16(kf[4],qr[2],C0,0,0,0),   P1[2],P1[3],P1[4],P1[5],     pw2[0]=PKW(P1,0), pw2[1]=PKW(P1,2), pw2); \
    VRD(6); SBAR(); GAPA(C1=__builtin_amdgcn_mfma_f32_32x32x16_bf16(kf[5],qr[2],C1,0,0,0),   P1[6],P1[7],P1[8],P1[9],     pw2[2]=PKW(P1,4), pw2[3]=PKW(P1,6), pw2); \
    VRD(3); SBAR(); GAPA(C0=__builtin_amdgcn_mfma_f32_32x32x16_bf16(kf[6],qr[3],C0,0,0,0),   P1[10],P1[11],P1[12],P1[13], pw3[0]=PKW(P1,8), pw3[1]=PKW(P1,10), pw3); \
    VRD(7); SBAR(); GAPA(C1=__builtin_amdgcn_mfma_f32_32x32x16_bf16(kf[7],qr[3],C1,0,0,0),   P1[14],P1[15],0.f,0.f,       pw3[2]=PKW(P1,12),pw3[3]=PKW(P1,14), pw3); \
    l_reg+=sacc; \
    if(GK){DMA_K((t)+3,sl_cur);} if(GV){DMA_V((t)+1,sl_next);} \
    CMASK(C0,C1,t); \
    { float a=MX3(C0[0],C0[1],C1[0]),b=MX3(C0[2],C0[3],C1[1]); a=MX3(a,C1[2],C1[3]); \
      _Pragma("unroll") for(int r=4;r<16;r+=4){a=MX3(a,C0[r],C0[r+1]);b=MX3(b,C0[r+2],C0[r+3]);a=MX3(a,C1[r],C1[r+1]);b=MX3(b,C1[r+2],C1[r+3]);} \
      float rm=__builtin_fmaxf(a,b); { auto rr=__builtin_amdgcn_permlane32_swap(__float_as_uint(rm),__float_as_uint(rm),false,false); rm=__builtin_fmaxf(__uint_as_float(rr[0]),__uint_as_float(rr[1])); } \
      resc=false; \
      if(__builtin_expect(__any(rm>(float)THRL),0)){ const float dl=__builtin_fmaxf(rm,0.f); mhat+=dl; \
        _Pragma("unroll") for(int r=0;r<16;++r){C0[r]-=dl;C1[r]-=dl;} \
        _Pragma("unroll") for(int r=0;r<16;++r)negm[r]=-mhat; asm volatile("":"+v"(negm)); \
        const float f=__builtin_amdgcn_exp2f(-dl); l_reg*=f; if(hi==0)wsf[r32]=f; resc=true; } } \
    SBAR(); \
    GAPB(o[0]=__builtin_amdgcn_mfma_f32_32x32x16_bf16(PAF(0),VFR(0),o[0],0,0,0), C0,0); \
    GAPB(o[1]=__builtin_amdgcn_mfma_f32_32x32x16_bf16(PAF(0),VFR(4),o[1],0,0,0), C0,4); \
    KRD(GL,0); GAPB(o[0]=__builtin_amdgcn_mfma_f32_32x32x16_bf16(PAF(1),VFR(1),o[0],0,0,0), C0,8); \
    KRD(GL,1); GAPB(o[1]=__builtin_amdgcn_mfma_f32_32x32x16_bf16(PAF(1),VFR(5),o[1],0,0,0), C0,12); \
    KRD(GL,2); GAPB(o[0]=__builtin_amdgcn_mfma_f32_32x32x16_bf16(PAF(2),VFR(2),o[0],0,0,0), C1,0); \
    KRD(GL,3); GAPB(o[1]=__builtin_amdgcn_mfma_f32_32x32x16_bf16(PAF(2),VFR(6),o[1],0,0,0), C1,4); \
    GAPB(o[0]=__builtin_amdgcn_mfma_f32_32x32x16_bf16(PAF(3),VFR(3),o[0],0,0,0), C1,8); \
    GAPB(o[1]=__builtin_amdgcn_mfma_f32_32x32x16_bf16(PAF(3),VFR(7),o[1],0,0,0), C1,12); \
    }while(0)
  int t=1;
  #undef CMASK
  #define CMASK(P0,P1,t) do{}while(0)
  for(;t+5<NT;t+=2){
    STEP(pB0,pB1,pA0,pA1,t,true,true,true);     WAIT_BAR(2); RESC(); ROT();
    STEP(pA0,pA1,pB0,pB1,t+1,true,true,true);   WAIT_BAR(2); RESC(); ROT();
  }
  #undef CMASK
  #define CMASK(P0,P1,t) do{}while(0)
  #define ENDW(tt) do{ if((tt)+3<NT){WAIT_BAR(2);} else if((tt)+2<NT){WAIT_BAR(1);} else {WAIT_BAR(0);} }while(0)
  for(;t+1<NT;t+=2){
    STEP(pB0,pB1,pA0,pA1,t,(t+3<NT),(t+1<NT),(t+1<NT));       ENDW(t);   RESC(); ROT();
    STEP(pA0,pA1,pB0,pB1,t+1,(t+4<NT),(t+2<NT),(t+2<NT));     ENDW(t+1); RESC(); ROT();
  }
  STEP(pB0,pB1,pA0,pA1,NT-1,false,false,false); RESC();
  { float sacc=pB0[0]+pB0[1]; _Pragma("unroll") for(int r=2;r<16;++r)sacc+=pB0[r]; _Pragma("unroll") for(int r=0;r<16;++r)sacc+=pB1[r]; l_reg+=sacc;
    pw0=(u32x4){PKW(pB0,0),PKW(pB0,2),PKW(pB0,4),PKW(pB0,6)};pw1=(u32x4){PKW(pB0,8),PKW(pB0,10),PKW(pB0,12),PKW(pB0,14)};pw2=(u32x4){PKW(pB1,0),PKW(pB1,2),PKW(pB1,4),PKW(pB1,6)};pw3=(u32x4){PKW(pB1,8),PKW(pB1,10),PKW(pB1,12),PKW(pB1,14)};
    SBAR(); pv(o,vb0+sl_cur,PAF(0),PAF(1),PAF(2),PAF(3)); }
  #undef PKW
  #undef PAF
  #undef VFR
  #undef PIN
  #undef MX3
  #undef GAPA
  #undef GAPB
  #undef EX
  #undef VRD
  #undef KRD
  #undef STEP
  #undef ENDW
  {auto rr=__builtin_amdgcn_permlane32_swap(__float_as_uint(l_reg),__float_as_uint(l_reg),false,false);l_reg=__uint_as_float(rr[0])+__uint_as_float(rr[1]);}
  if(hi==0)wsf[32+r32]=l_reg;asm volatile("s_waitcnt lgkmcnt(0)":::"memory");
  float rli[16];
  #pragma unroll
  for(int r=0;r<16;++r)rli[r]=__builtin_amdgcn_rcpf(wsf[32+crow(r,hi)]);
  bf16*Ow=Ou+(long)(wid*QBLK)*PO;
  { bf16*stg=(bf16*)(shm+LDS_OST)+wid*2048;
    #pragma unroll
    for(int r=0;r<16;++r){const int orow=crow(r,hi);
      #pragma unroll
      for(int d0=0;d0<2;++d0)stg[orow*64+d0*32+r32]=__float2bfloat16(o[d0][r]*rli[r]);}
    asm volatile("s_waitcnt lgkmcnt(0)":::"memory");
    #pragma unroll
    for(int i=0;i<4;++i){const int row=i*8+(lane>>3),ch=lane&7; const u32x4 v=*(const u32x4*)(stg+row*64+ch*8); ATTN_STORE16(Ow+(long)row*PO+ch*8,v);} }
  asm volatile("s_waitcnt lgkmcnt(0)\n\ts_barrier":::"memory");
  #undef DMA_K
  #undef DMA_V
  #undef CMASK
  #undef START
  #undef RESC
  #undef ROT
}
constexpr int ATTN_LDS_BYTES=LDS_BYTES;
#undef SBAR
#undef WAIT_BAR
}

constexpr int NWAVES = 8, NTHREADS = NWAVES * 64;
constexpr int DM = 1024, NB = 4, SEQ = 8192, CTXL = 256, DEPTH = 4;
constexpr int TPB = SEQ + CTXL;
constexpr int MROWS = NB * TPB;
constexpr int PROJ = 2304, DFF = 2816, KMIX = 1280;
constexpr int OFF_Q = 256, OFF_K = 768, OFF_V = 896, OFF_FF = 1024, OFF_FB = 1280, OFF_I = 1536, OFF_HQ = 1792, OFF_G = 2048;
constexpr int MIX_P = 0, MIX_Q = 256, MIX_A = 512, MIX_R = 1024;
constexpr float EPS = 1e-6f;
constexpr float QSCALE = 0.125f * 1.4426950408889634f;
constexpr int MOD_SH_A = 0, MOD_SC_A = 1024, MOD_G_A = 2048, MOD_SH_F = 3072, MOD_SC_F = 4096, MOD_G_F = 5120;

constexpr size_t MiB = 1u << 20;
constexpr size_t WS_CTL = 0, CTL_ZERO_BYTES = 1 * MiB;
constexpr size_t WS_MODS = 1 * MiB;
constexpr size_t WS_LB = WS_MODS + 512 * 1024;
constexpr size_t WS_TW = WS_LB + 65536;
constexpr size_t WS_FT128 = WS_TW + 65536;
constexpr size_t WS_W64F = WS_FT128 + 65536;
constexpr size_t WS_CT256 = WS_W64F + 16384;
static_assert(WS_CT256 + 262144 <= 2 * MiB, "tables");
constexpr size_t WS_ROPE = 2 * MiB;
constexpr size_t WS_TF = 4 * MiB;
constexpr size_t WS_XC = 6 * MiB;
constexpr size_t WS_WIN = 10 * MiB;
constexpr size_t WS_WOUT = 28 * MiB;
constexpr size_t WS_WGU = 38 * MiB;
constexpr size_t WS_WDN = 82 * MiB;
constexpr size_t WS_XB = 104 * MiB;
constexpr size_t WS_HGS = 170 * MiB;
constexpr size_t WS_UX = 236 * MiB;
constexpr size_t WS_MIX = 385 * MiB;
constexpr size_t WS_H = WS_UX;
constexpr size_t WS_HGG = 468 * MiB;
constexpr size_t WS_ROWSS = 470 * MiB;
constexpr size_t WS_BIASA = 473 * MiB;
constexpr size_t WS_BIASF = 474 * MiB;
constexpr size_t WS_END = 475 * MiB;
static_assert(WS_UX + (size_t)MROWS * PROJ * 2 <= WS_MIX && WS_MIX + (size_t)MROWS * KMIX * 2 <= WS_END && WS_H + (size_t)MROWS * DFF * 2 <= WS_END, "d_ws map");
static_assert(WS_XB + (size_t)MROWS * DM * 2 <= WS_HGS && WS_HGS + (size_t)2 * MROWS * 256 * 4 <= WS_UX, "d_ws map 2");
constexpr int CW_TMO = 0, CW_CODE = 1, CW_BAR = 4096;

constexpr int RING_OFF = 0, RING_BYTES = 131072;
constexpr int LDSCTL_OFF = RING_BYTES, MISC_OFF = LDSCTL_OFF + 320;
constexpr int LDS_BYTES = 147456;

#define GAS __attribute__((address_space(1)))
#define LAS __attribute__((address_space(3)))
typedef unsigned short bf16;
typedef unsigned v4u __attribute__((ext_vector_type(4)));
typedef float f32x4 __attribute__((ext_vector_type(4)));
typedef short bf16x8 __attribute__((ext_vector_type(8)));
typedef GAS unsigned gu32;
typedef GAS unsigned long long gu64;
#define RLX_AGENT __ATOMIC_RELAXED, __HIP_MEMORY_SCOPE_AGENT
#define LDS_WAIT() asm volatile("s_waitcnt lgkmcnt(0)" ::: "memory")
#define VM_WAIT() asm volatile("s_waitcnt vmcnt(0)" ::: "memory")
__device__ __forceinline__ unsigned long long rt() { return __builtin_amdgcn_s_memrealtime(); }
__device__ __forceinline__ unsigned f2bf(float f) { unsigned u = __builtin_bit_cast(unsigned, f); return (u + 0x7fffu + ((u >> 16) & 1u)) >> 16; }
__device__ __forceinline__ unsigned pk2(float lo, float hi) { return f2bf(lo) | (f2bf(hi) << 16); }

#define XB_TMO      128
#define XB_XCNT(j)  (256  + 64 * (j))
#define XB_XSUB(j)  (1280 + 64 * (j))
#define XB_XGEN(j)  (2304 + 64 * (j))
#define XB_TOP      3328
#define XB_TOPGEN   3392
#define XCD_BAR_WORDS 3456
#define XB_SPIN_CAP (1u << 18)

__device__ __forceinline__ unsigned xb_ld(unsigned* p)              { return __hip_atomic_load(p, __ATOMIC_RELAXED, __HIP_MEMORY_SCOPE_AGENT); }
__device__ __forceinline__ unsigned xb_add(unsigned* p, unsigned v) { return __hip_atomic_fetch_add(p, v, __ATOMIC_RELAXED, __HIP_MEMORY_SCOPE_AGENT); }
__device__ __forceinline__ unsigned xb_xcc_id() { return (unsigned)__builtin_amdgcn_s_getreg((3 << 11) | 20) & 0xFu; }
#define XB_SPIN(cond, bar) do { unsigned _sp = 0; while (cond) { __builtin_amdgcn_s_sleep(1); \
    if ((++_sp & 255u) == 0u) { if (xb_ld(&(bar)[XB_TMO])) break; if (_sp > XB_SPIN_CAP) { atomicAdd(&(bar)[XB_TMO], 1u); break; } } } } while (0)

struct XcdBarrier {
    unsigned* bar; unsigned x;
    volatile LAS unsigned* st;
};

__device__ __forceinline__ XcdBarrier xcd_barrier_post(unsigned* bar, volatile LAS unsigned* st) {
    XcdBarrier b; b.bar = bar; b.x = xb_xcc_id(); b.st = st;
    if (threadIdx.x == 0) (void)xb_add(&bar[XB_XCNT(b.x)], 1u);
    return b;
}
__device__ __forceinline__ void xcd_barrier_complete(unsigned* bar, unsigned x, unsigned& nloc, unsigned& nx) {
    const unsigned G = gridDim.x * gridDim.y * gridDim.z;
    unsigned sum, cnt, mine, sp = 0u;
    for (;;) {
        sum = 0u; cnt = 0u; mine = 0u;
#pragma unroll
        for (unsigned j = 0; j < 16; ++j) { const unsigned c = xb_ld(&bar[XB_XCNT(j)]); sum += c; cnt += (c > 0u) ? 1u : 0u; mine = (j == x) ? c : mine; }
        if (sum == G) break;
        __builtin_amdgcn_s_sleep(1);
        if ((++sp & 255u) == 0u) { if (xb_ld(&bar[XB_TMO])) break; if (sp > XB_SPIN_CAP) { atomicAdd(&bar[XB_TMO], 1u); break; } }
    }
    nloc = mine > 0u ? mine : 1u; nx = cnt > 0u ? cnt : 1u;
}

__device__ __forceinline__ void xcd_barrier(const XcdBarrier& b) {
    asm volatile("s_waitcnt vmcnt(0)" ::: "memory");
    __syncthreads();
    if (threadIdx.x == 0) {
        unsigned* bar = b.bar;
        __builtin_amdgcn_s_waitcnt(0);
        unsigned nloc = b.st[0], nx = b.st[1];
        if (nloc == 0u) { xcd_barrier_complete(bar, b.x, nloc, nx); b.st[0] = nloc; b.st[1] = nx; }
        const unsigned old = xb_add(&bar[XB_XSUB(b.x)], 1u);
        const unsigned gen = old / nloc;
        if (old + 1u == (gen + 1u) * nloc) {
            __builtin_amdgcn_fence(__ATOMIC_RELEASE, "agent");
            asm volatile("s_waitcnt vmcnt(0)" ::: "memory");
            const unsigned og = xb_add(&bar[XB_TOP], 1u);
            const unsigned tg = og / nx;
            if (og + 1u == (tg + 1u) * nx) xb_add(&bar[XB_TOPGEN], 1u);
            else XB_SPIN(xb_ld(&bar[XB_TOPGEN]) == tg, bar);
            __builtin_amdgcn_fence(__ATOMIC_ACQUIRE, "agent");
            xb_add(&bar[XB_XGEN(b.x)], 1u);
            asm volatile("s_waitcnt vmcnt(0)" ::: "memory");
        } else {
            XB_SPIN(xb_ld(&bar[XB_XGEN(b.x)]) == gen, bar);
            __builtin_amdgcn_fence(__ATOMIC_ACQUIRE, "agent");
            asm volatile("s_waitcnt vmcnt(0)" ::: "memory");
        }
    }
    __syncthreads();
}

typedef float f32x2 __attribute__((ext_vector_type(2)));
typedef unsigned u32x2 __attribute__((ext_vector_type(2)));
typedef const GAS float* const __attribute__((address_space(4)))* kargs_t;
struct Frame {
    LAS unsigned char* lds;
    volatile LAS unsigned* MISC;
    int tid, lane, wave, vcu, G;
    unsigned long long dt, da;
    GAS unsigned char* ws; GAS float* outg;
    __device__ __forceinline__ float* out_() const { return (float*)outg; }
    __device__ __forceinline__ bf16* HN() const { return (bf16*)outg; }
    __device__ __forceinline__ const float* in(int i) const { return (const float*)(((kargs_t)__builtin_amdgcn_kernarg_segment_ptr())[i]); }
#define FIN(name, idx) __device__ __forceinline__ const float* name() const { return in(idx); }
    FIN(x, 0) FIN(c, 1) FIN(ctx, 2) FIN(c_ctx, 3) FIN(w_ada, 4) FIN(b_ada, 5) FIN(w_in, 6) FIN(w_four, 7) FIN(q_norm, 8) FIN(k_norm, 9) FIN(hg_lb, 10) FIN(hg_norm, 11) FIN(w_out, 12) FIN(w_gate, 13) FIN(w_up, 14) FIN(w_down, 15) FIN(final_norm, 16)
#undef FIN
#define FWS(type, name, off) __device__ __forceinline__ type* name() const { return (type*)(ws + (off)); }
    FWS(unsigned, ctlw, WS_CTL) FWS(float, MODS, WS_MODS) FWS(float, LB, WS_LB) FWS(f32x2, ROPE, WS_ROPE) FWS(float, TF, WS_TF) FWS(float, XC, WS_XC) FWS(float, HGS, WS_HGS) FWS(float, HGG, WS_HGG) FWS(float, ROWSS, WS_ROWSS) FWS(float, BIASA, WS_BIASA) FWS(float, BIASF, WS_BIASF)
    FWS(f32x2, TW, WS_TW) FWS(bf16, FT128, WS_FT128) FWS(bf16, W64F, WS_W64F) FWS(bf16, CT256, WS_CT256)
    FWS(bf16, WIN, WS_WIN) FWS(bf16, WOUT, WS_WOUT) FWS(bf16, WGU, WS_WGU) FWS(bf16, WDN, WS_WDN) FWS(bf16, XB, WS_XB) FWS(bf16, UX, WS_UX) FWS(bf16, MIX, WS_MIX) FWS(bf16, HB, WS_H)
#undef FWS
};
__device__ __forceinline__ float bf2f(unsigned short h) { return __builtin_bit_cast(float, (unsigned)h << 16); }
__device__ __forceinline__ float bflo(unsigned w) { return __builtin_bit_cast(float, w << 16); }
__device__ __forceinline__ float bfhi(unsigned w) { return __builtin_bit_cast(float, w & 0xffff0000u); }
__device__ __forceinline__ float wave_sum(float v) { return xl_sum64(v); }
__device__ __forceinline__ float sigmoidf_(float z) { return __builtin_amdgcn_rcpf(1.0f + __builtin_amdgcn_exp2f(-1.44269504089f * z)); }
__device__ __forceinline__ float siluf_(float z) { return z * sigmoidf_(z); }
__device__ __forceinline__ const float* xrow_ptr(const float* lat, const float* ctx, int R) {
    const int b = R / TPB, t = R - b * TPB;
    return (t < CTXL) ? ctx + ((size_t)b * CTXL + t) * DM : lat + ((size_t)b * SEQ + (t - CTXL)) * DM;
}

__host__ __device__ __forceinline__ int win_row(int c) {
    if (c < 256 || c >= 1024) return c;
    const int hh = (c - 256) >> 6, d = (c - 256) & 63, bj = (d >> 4) & 1, p = (d & 15) + ((d >> 5) << 4);
    return 256 * (1 + (hh >> 2)) + 128 * bj + 32 * (hh & 3) + p;
}
__device__ __forceinline__ void tr_item(const float* src, int ldsrc, bf16* dst, int ldt, LAS float* scr, int lane, int row16 = 16) {
#pragma unroll 1
    for (int h = 0; h < 4; ++h) { float tv[8];
#pragma unroll
        for (int i = 0; i < 8; ++i) tv[i] = src[(size_t)(2 * (8 * h + i) + (lane >> 5)) * ldsrc + (lane & 31)];
#pragma unroll
        for (int i = 0; i < 8; ++i) scr[(2 * (8 * h + i) + (lane >> 5)) * 33 + (lane & 31)] = tv[i]; }
    LDS_WAIT(); asm volatile("" ::: "memory");
    const int c = lane & 7;
#pragma unroll
    for (int j = 0; j < 4; ++j) { const int n = (lane >> 3) + 8 * j; const LAS float* s = scr + (8 * c) * 33 + n;
        v4u o; o.x = pk2(s[0 * 33], s[1 * 33]); o.y = pk2(s[2 * 33], s[3 * 33]); o.z = pk2(s[4 * 33], s[5 * 33]); o.w = pk2(s[6 * 33], s[7 * 33]);
        *(GAS v4u*)(dst + (size_t)(j < 2 ? n : n - 16 + row16) * ldt + 8 * c) = o; }
    LDS_WAIT(); asm volatile("" ::: "memory");
}
__device__ __forceinline__ void p0a_prologue(Frame& F) {
    const int gw = F.vcu * NWAVES + F.wave, NGW = F.G * NWAVES;
    const int gt = F.vcu * NTHREADS + F.tid, NGT = F.G * NTHREADS;
    LAS float* scr = (LAS float*)(F.lds + RING_OFF + F.wave * 12288);
    LAS float* sil = (LAS float*)(F.lds + RING_OFF + 98304);
    LAS f32x2* cs64 = (LAS f32x2*)(F.lds + RING_OFF + 98304 + 20480 + 10240);
    if (F.tid < 64) { const float a = (float)F.tid * (1.0f / 32.0f); cs64[F.tid] = (f32x2){cospif(a), sinpif(a)}; }
    for (int i = F.tid; i < 5 * DM; i += NTHREADS) { const int bb = i >> 10, k = i & 1023; const float v = (bb < 4) ? F.c()[bb * DM + k] : F.c_ctx()[k]; sil[i] = v / (1.0f + expf(-v)); }
    __syncthreads();
    {
        LAS float* part = (LAS float*)(F.lds + RING_OFF + 98304 + 20480);
        for (int it = F.vcu; it < DEPTH * 96; it += F.G) {
            const int l = it / 96, j = (it % 96) * 64 + F.lane;
            const float* wp = F.w_ada() + (size_t)l * DM * 6144 + (size_t)(128 * F.wave) * 6144 + j;
            float a0 = 0.f, a1 = 0.f, a2 = 0.f, a3 = 0.f, a4 = 0.f;
            float wn[16];
#pragma unroll
            for (int i = 0; i < 16; ++i) wn[i] = wp[(size_t)i * 6144];
            for (int k0 = 0; k0 < 128; k0 += 16) {
                float w[16];
#pragma unroll
                for (int i = 0; i < 16; ++i) w[i] = wn[i];
                if (k0 + 16 < 128) {
#pragma unroll
                    for (int i = 0; i < 16; ++i) wn[i] = wp[(size_t)(k0 + 16 + i) * 6144]; }
#pragma unroll
                for (int i = 0; i < 16; ++i) { const int k = 128 * F.wave + k0 + i; a0 += sil[k] * w[i]; a1 += sil[1024 + k] * w[i]; a2 += sil[2048 + k] * w[i]; a3 += sil[3072 + k] * w[i]; a4 += sil[4096 + k] * w[i]; }
            }
            LAS float* pw = part + F.wave * 320 + F.lane;
            pw[0] = a0; pw[64] = a1; pw[128] = a2; pw[192] = a3; pw[256] = a4;
            __syncthreads();
            if (F.tid < 320) { float s = 0.f;
#pragma unroll
                for (int ww = 0; ww < 8; ++ww) s += part[ww * 320 + F.tid];
                const int bb = F.tid >> 6, jj = (it % 96) * 64 + (F.tid & 63);
                F.MODS()[(size_t)l * 5 * 6144 + bb * 6144 + jj] = s + F.b_ada()[l * 6144 + jj]; }
            __syncthreads();
        }
    }
    constexpr int I_IN = 16 * 72, I_OUT = 12 * 32, I_G = 16 * 88, I_D = 44 * 32, I_L = I_IN + I_OUT + 2 * I_G + I_D;
    for (int it = gw; it < DEPTH * I_L; it += NGW) {
        const int l = it / I_L; int r = it % I_L;
        if (r < I_IN) { const int kb = r / 72, nb = r % 72;
            const int r0 = win_row(32 * nb), r16 = win_row(32 * nb + 16);
            tr_item(F.w_in() + (size_t)l * DM * PROJ + (size_t)(64 * kb) * PROJ + 32 * nb, PROJ, F.WIN() + (size_t)l * PROJ * DM + (size_t)r0 * DM + 64 * kb, DM, scr, F.lane, r16 - r0); continue; }
        r -= I_IN;
        if (r < I_OUT) { const int kb = r / 32, nb = r % 32;
            tr_item(F.w_out() + (size_t)l * DM * DM + (size_t)(256 + 64 * kb) * DM + 32 * nb, DM, F.WOUT() + (size_t)l * DM * KMIX + (size_t)(32 * nb) * KMIX + 512 + 64 * kb, KMIX, scr, F.lane); continue; }
        r -= I_OUT;
        if (r < 2 * I_G) { const int up = r / I_G, rr = r % I_G, kb = rr / 88, nb = rr % 88, n0 = 32 * nb;
            const float* W = (up ? F.w_up() : F.w_gate()) + (size_t)l * DM * DFF;
            const int drow = (n0 >> 7) * 256 + up * 128 + (n0 & 127);
            tr_item(W + (size_t)(64 * kb) * DFF + n0, DFF, F.WGU() + (size_t)l * 5632 * DM + (size_t)drow * DM + 64 * kb, DM, scr, F.lane); continue; }
        r -= 2 * I_G;
        { const int kb = r / 32, nb = r % 32;
            tr_item(F.w_down() + (size_t)l * DFF * DM + (size_t)(64 * kb) * DM + 32 * nb, DM, F.WDN() + (size_t)l * DM * DFF + (size_t)(32 * nb) * DFF + 64 * kb, DFF, scr, F.lane); }
    }
    for (int it = gt; it < DEPTH * 2 * 256 * 256; it += NGT) {
        const int jp = it & 255, gc = (it >> 8) & 255, s = (it >> 16) & 1, l = it >> 17, g = gc >> 6, cc = gc & 63;
        const float* wf = F.w_four() + (size_t)l * 65536 + (size_t)(g * 64) * 256 + jp;
        float a = 0.f;
        for (int m = 0; m < 64; ++m) { const f32x2 cs = cs64[(cc * m) & 63]; a += (s ? -cs.y : cs.x) * wf[m * 256]; }
        F.TF()[it] = a * 0.125f;
    }
    for (int it = gt; it < 2 * 256; it += NGT) {
        const int d = it >> 8, cc = it & 255; float v[DEPTH], mx = -INFINITY, sm = 0.f;
#pragma unroll
        for (int l = 0; l < DEPTH; ++l) { v[l] = F.hg_lb()[(d * DEPTH + l) * 256 + cc]; mx = fmaxf(mx, v[l]); }
#pragma unroll
        for (int l = 0; l < DEPTH; ++l) { v[l] = expf(v[l] - mx); sm += v[l]; }
        float cum = 0.f;
#pragma unroll
        for (int l = 0; l < DEPTH; ++l) { if (l > 0) cum += v[l] / sm; F.LB()[(d * DEPTH + l) * 256 + cc] = cum; }
    }
    for (int it = gt; it < SEQ * 32; it += NGT) {
        const int p = it >> 5, i = it & 31; const float pos = (float)((i < 16) ? (p >> 6) : (p & 63));
        const float fr = powf(10000.0f, -(float)(2 * (i & 15)) / 32.0f); const float ang = pos * fr;
        F.ROPE()[it] = (f32x2){cosf(ang), sinf(ang)};
    }
    for (int it = gt; it < SEQ; it += NGT) { const float a = (float)it * (1.0f / 4096.0f); F.TW()[it] = (f32x2){cospif(a), sinpif(a)}; }
    for (int it = gt; it < 2 * 128 * 128; it += NGT) { const int s = it >> 14, k = (it >> 7) & 127, n = it & 127; const float a = (float)((k * n) & 127) * (1.0f / 64.0f); F.FT128()[it] = (bf16)f2bf(s ? sinpif(a) : cospif(a)); }
    for (int it = gt; it < 2 * 2 * 4 * 64 * 8; it += NGT) { const int jj = it & 7, ln = (it >> 3) & 63, T = (it >> 9) & 3, a2 = (it >> 11) & 1, s = it >> 12;
        const int k2 = 16 * T + (ln & 15), g = ln >> 4, n2 = 32 * a2 + (jj < 4 ? 4 * g + jj : 16 + 4 * g + (jj - 4)); const float a = (float)((k2 * n2) & 63) * (1.0f / 32.0f);
        F.W64F()[it] = (bf16)f2bf(s ? sinpif(a) : cospif(a)); }
    for (int it = gt; it < 2 * 256 * 256; it += NGT) { const int jj = it & 7, ln = (it >> 3) & 63, ks = (it >> 9) & 7, T = (it >> 12) & 15, s = it >> 16;
        const int k = 16 * T + (ln & 15), g = ln >> 4, n = 32 * ks + (jj < 4 ? 4 * g + jj : 16 + 4 * g + (jj - 4)); const float a = (float)((k * n) & 255) * (1.0f / 128.0f); F.CT256()[it] = (bf16)f2bf(s ? sinpif(a) : cospif(a)); }
}
__device__ __forceinline__ void p0b_fold(Frame& F) {
    {
        LAS float* tfl = (LAS float*)(F.lds + RING_OFF + 16384);
        for (int it = F.vcu; it < DEPTH * 64 * 2; it += F.G) {
            const int jh = it & 1, kg = (it >> 1) & 63, l = it >> 7, j = jh * 512 + F.tid;
            const float* tf = F.TF() + (size_t)l * 131072 + (size_t)(kg * 8) * 256;
            for (int i = F.tid; i < 2048; i += NTHREADS) tfl[(i & 255) * 8 + (i >> 8)] = tf[i];
            __syncthreads();
            const float* wo = F.w_out() + (size_t)l * DM * DM + j;
            float a[8] = {0.f, 0.f, 0.f, 0.f, 0.f, 0.f, 0.f, 0.f};
            for (int jp0 = 0; jp0 < 256; jp0 += 8) {
                float w[8];
#pragma unroll
                for (int i = 0; i < 8; ++i) w[i] = wo[(size_t)(jp0 + i) * DM];
#pragma unroll
                for (int i = 0; i < 8; ++i) { const f32x4 t0 = *(const LAS f32x4*)(tfl + (jp0 + i) * 8), t1 = *(const LAS f32x4*)(tfl + (jp0 + i) * 8 + 4);
                    a[0] += t0[0] * w[i]; a[1] += t0[1] * w[i]; a[2] += t0[2] * w[i]; a[3] += t0[3] * w[i]; a[4] += t1[0] * w[i]; a[5] += t1[1] * w[i]; a[6] += t1[2] * w[i]; a[7] += t1[3] * w[i]; }
            }
            v4u o; o.x = pk2(a[0], a[1]); o.y = pk2(a[2], a[3]); o.z = pk2(a[4], a[5]); o.w = pk2(a[6], a[7]);
            *(GAS v4u*)(F.WOUT() + (size_t)l * DM * KMIX + (size_t)j * KMIX + kg * 8) = o;
            __syncthreads();
        }
    }
    {
        LAS float* part = (LAS float*)(F.lds + RING_OFF);
        for (int it = F.vcu; it < DEPTH * 124; it += F.G) {
            const int l = it / 124, v0 = (it % 124) * 64;
            const float* W; int ldw, col, shoff; float* dst; int dstride;
            if (v0 < 2304) { W = F.w_in() + (size_t)l * DM * PROJ; ldw = PROJ; col = v0 + F.lane; shoff = MOD_SH_A; dst = F.BIASA() + (size_t)l * 5 * 2304 + win_row(col); dstride = 2304; }
            else { const int up = v0 >= 2304 + DFF, hid = v0 - 2304 - up * DFF + F.lane; W = (up ? F.w_up() : F.w_gate()) + (size_t)l * DM * DFF; ldw = DFF; col = hid; shoff = MOD_SH_F;
                dst = F.BIASF() + (size_t)l * 5 * 5632 + (hid >> 7) * 256 + up * 128 + (hid & 127); dstride = 5632; }
            const float* wp = W + (size_t)(128 * F.wave) * ldw + col; const float* shp = F.MODS() + (size_t)l * 5 * 6144 + shoff + 128 * F.wave;
            LAS float* shl = (LAS float*)(F.lds + RING_OFF + 32768) + F.wave * 640;
            for (int i = F.lane; i < 640; i += 64) shl[i] = shp[(size_t)(i >> 7) * 6144 + (i & 127)];
            asm volatile("s_waitcnt vmcnt(0) lgkmcnt(0)" ::: "memory");
            float a0 = 0.f, a1 = 0.f, a2 = 0.f, a3 = 0.f, a4 = 0.f;
            float wn[16];
#pragma unroll
            for (int i = 0; i < 16; ++i) wn[i] = wp[(size_t)i * ldw];
            for (int k0 = 0; k0 < 128; k0 += 16) {
                float w[16];
#pragma unroll
                for (int i = 0; i < 16; ++i) w[i] = wn[i];
                if (k0 + 16 < 128) {
#pragma unroll
                    for (int i = 0; i < 16; ++i) wn[i] = wp[(size_t)(k0 + 16 + i) * ldw]; }
#pragma unroll
                for (int i = 0; i < 16; ++i) { const int k = k0 + i; a0 += shl[k] * w[i]; a1 += shl[128 + k] * w[i]; a2 += shl[256 + k] * w[i]; a3 += shl[384 + k] * w[i]; a4 += shl[512 + k] * w[i]; }
            }
            LAS float* pw = part + F.wave * 320 + F.lane;
            pw[0] = a0; pw[64] = a1; pw[128] = a2; pw[192] = a3; pw[256] = a4;
            __syncthreads();
            float s = 0.f;
            if (F.tid < 320) {
#pragma unroll
                for (int ww = 0; ww < 8; ++ww) s += part[ww * 320 + F.tid]; }
            if (F.tid < 320) dst[(size_t)(F.tid >> 6) * dstride] = s;
            __syncthreads();
        }
    }
    {
        const int gw = F.vcu * NWAVES + F.wave, NGW = F.G * NWAVES;
        for (int R = gw; R < MROWS; R += NGW) {
            const int b = R / TPB, t = R - b * TPB, bb = (t < CTXL) ? 4 : b;
            const GAS f32x4* xr = (const GAS f32x4*)xrow_ptr(F.x(), F.ctx(), R) + F.lane;
            const GAS f32x4* scp = (const GAS f32x4*)(F.MODS() + bb * 6144 + MOD_SC_A) + F.lane;
            f32x4 v[4]; float s = 0.f;
#pragma unroll
            for (int j = 0; j < 4; ++j) { v[j] = xr[64 * j]; s += (v[j].x * v[j].x + v[j].y * v[j].y) + (v[j].z * v[j].z + v[j].w * v[j].w); }
            s = wave_sum(s);
            GAS u32x2* o8 = (GAS u32x2*)(F.HN() + (size_t)R * DM) + F.lane; GAS u32x2* x8 = (GAS u32x2*)(F.XB() + (size_t)R * DM) + F.lane;
#pragma unroll
            for (int j = 0; j < 4; ++j) { const f32x4 y = v[j] * (scp[64 * j] + 1.0f); u32x2 w; w.x = pk2(y.x, y.y); w.y = pk2(y.z, y.w); o8[64 * j] = w;
                u32x2 xw; xw.x = pk2(v[j].x, v[j].y); xw.y = pk2(v[j].z, v[j].w); x8[64 * j] = xw; }
            if (F.lane < 16) F.ROWSS()[(size_t)R * 16 + F.lane] = (F.lane == 0) ? s : 0.f;
        }
    }
}

template <int NSPLIT>
__device__ __forceinline__ void ctx_reduce_pass(Frame& F, const float* P, const float* gate, const float* scn) {
    const int gw = F.vcu * NWAVES + F.wave, NGW = F.G * NWAVES;
    for (int cr = gw; cr < NB * CTXL; cr += NGW) {
        const int b = cr >> 8, t = cr & 255; const size_t R = (size_t)b * TPB + t;
        float ss = 0.f;
#pragma unroll 1
        for (int j = 0; j < 4; ++j) { const int col = 4 * F.lane + 256 * j;
            f32x4 pv[NSPLIT];
#pragma unroll
            for (int s = 0; s < NSPLIT; ++s) pv[s] = *(const GAS f32x4*)(P + ((size_t)s * 1024 + cr) * 1024 + col);
            f32x4 a = pv[0];
#pragma unroll
            for (int s = 1; s < NSPLIT; ++s) a += pv[s];
            const u32x2 xo = *(const GAS u32x2*)(F.XB() + R * DM + col);
            const f32x4 xn = (f32x4){bflo(xo.x), bfhi(xo.x), bflo(xo.y), bfhi(xo.y)} + *(const GAS f32x4*)(gate + 4 * 6144 + col) * a;
            u32x2 xw; xw.x = pk2(xn.x, xn.y); xw.y = pk2(xn.z, xn.w); *(GAS u32x2*)(F.XB() + R * DM + col) = xw;
            ss += (xn.x * xn.x + xn.y * xn.y) + (xn.z * xn.z + xn.w * xn.w);
            if (scn) { const f32x4 y = xn * (*(const GAS f32x4*)(scn + 4 * 6144 + col) + 1.0f); u32x2 w; w.x = pk2(y.x, y.y); w.y = pk2(y.z, y.w); *(GAS u32x2*)(F.HN() + R * DM + col) = w; } }
        ss = wave_sum(ss);
        if (F.lane < 16) F.ROWSS()[R * 16 + F.lane] = (F.lane == 0) ? ss : 0.f;
    }
}
__device__ __forceinline__ void final_norm_phase(Frame& F) {
    const int gw = F.vcu * NWAVES + F.wave, NGW = F.G * NWAVES;
    for (int r = gw; r < NB * SEQ; r += NGW) {
        const int b = r >> 13, n = r & (SEQ - 1); const size_t R = (size_t)b * TPB + CTXL + n;
        float s = (F.lane < 16) ? F.ROWSS()[R * 16 + F.lane] : 0.f;
        s = wave_sum(s);
        const float rinv = 1.0f / sqrtf(s * (1.0f / DM) + EPS);
        const GAS u32x2* xr = (const GAS u32x2*)(F.XB() + R * DM) + F.lane; const GAS f32x4* gp = (const GAS f32x4*)F.final_norm() + F.lane;
        GAS f32x4* orow = (GAS f32x4*)(F.out_() + (size_t)r * DM) + F.lane;
#pragma unroll
        for (int j = 0; j < 4; ++j) { const u32x2 w = xr[64 * j]; orow[64 * j] = (f32x4){bflo(w.x), bfhi(w.x), bflo(w.y), bfhi(w.y)} * rinv * gp[64 * j]; }
    }
}

__device__ __forceinline__ void attn_fast_phase(Frame& F, int l) {
    char* shm = (char*)(F.lds + RING_OFF);
    const attn_body::bf16* UXp = (const attn_body::bf16*)F.UX(); attn_body::bf16* MIXp = (attn_body::bf16*)F.MIX();
    for (int base = F.vcu * 4; base < NB * 8 * 32 + F.G * 4; base += F.G * 4) {
        for (int i = 0; i < 5; ++i) {
            int bh, q0, NT;
            if (base < NB * 8 * 32) { if (i == 4) break; const int U = base + i; bh = U >> 5; q0 = CTXL + (U & 31) * 256; NT = TPB / 64; }
            else { const int c = base - NB * 8 * 32 + i * 0; if (i > 0 || l == DEPTH - 1) break; const int cu = c / 4; if ((cu & 7) != 0 || cu >= 256) break; bh = cu >> 3; q0 = 0; NT = CTXL / 64; }
            const int b = bh >> 3, h = bh & 7, kvh = h >> 2; const size_t rb = (size_t)b * TPB;
            attn_body::attn_unit<8>(UXp + (rb + q0) * PROJ + OFF_Q + h * 64, UXp + rb * PROJ + OFF_K + kvh * 64, UXp + rb * PROJ + OFF_V + kvh * 64, MIXp + (rb + q0) * KMIX + MIX_A + h * 64, NT, shm, F.tid);
        }
    }
}

namespace fft {
typedef short v4i16_t __attribute__((ext_vector_type(4)));
constexpr int ZP = 544;
__device__ __forceinline__ v4i16_t trrd(const LAS char* p) { return __builtin_amdgcn_ds_read_tr16_b64_v4i16((LAS v4i16_t*)p); }
__device__ __forceinline__ bf16x8 cat8(v4i16_t lo, v4i16_t hi) { return (bf16x8){lo[0], lo[1], lo[2], lo[3], hi[0], hi[1], hi[2], hi[3]}; }
__device__ __forceinline__ bf16x8 ld_frag2(const bf16* p0, const bf16* p1) { const u32x2 a = *(const GAS u32x2*)p0, b = *(const GAS u32x2*)p1; v4u w; w.x = a.x; w.y = a.y; w.z = b.x; w.w = b.y; return __builtin_bit_cast(bf16x8, w); }
#define MFMA16(a, b, c) __builtin_amdgcn_mfma_f32_16x16x32_bf16((a), (b), (c), 0, 0, 0)
}
__device__ __forceinline__ void fourier_fast_phase(Frame& F) {
    using namespace fft;
    LAS char* Z = (LAS char*)(F.lds + RING_OFF);
    LAS char* Zc = Z + 128 * ZP;
    const int tid = F.tid, lane = F.lane, w = F.wave, l16 = lane & 15, g = lane >> 4, q = l16 >> 2, p = l16 & 3;
    const bf16* UXp = F.UX(); bf16* MIXp = F.MIX();
    for (int unit = F.vcu; unit < NB * 64; unit += F.G) {
        const int b = unit >> 6, cg = unit & 63;
        { const bf16* zsrc = UXp + ((size_t)b * TPB + CTXL) * PROJ + cg * 4;
#pragma unroll 4
          for (int i = 0; i < 16; ++i) { const int n = tid + 512 * i; const u32x2 v = *(const GAS u32x2*)(zsrc + (size_t)n * PROJ);
              LAS char* d = Z + (n >> 6) * ZP + (n & 63) * 2;
              *(LAS unsigned short*)(d) = (unsigned short)(v.x & 0xffffu); *(LAS unsigned short*)(d + 128) = (unsigned short)(v.x >> 16);
              *(LAS unsigned short*)(d + 256) = (unsigned short)(v.y & 0xffffu); *(LAS unsigned short*)(d + 384) = (unsigned short)(v.y >> 16); }
          if (tid < CTXL) *(LAS u32x2*)(Zc + tid * 8) = *(const GAS u32x2*)(UXp + ((size_t)b * TPB + tid) * PROJ + cg * 4); }
        __syncthreads(); STAMP(40);
        const int k1 = 16 * w + l16;
        bf16x8 Bre[4][2], Bim[4][2];
        {
            bf16x8 Fc[4], Fs[4];
            const bf16* ftc = F.FT128() + k1 * 128; const bf16* fts = ftc + 128 * 128;
#pragma unroll
            for (int ks = 0; ks < 4; ++ks) { Fc[ks] = ld_frag2(ftc + 32 * ks + 4 * g, ftc + 32 * ks + 16 + 4 * g); Fs[ks] = ld_frag2(fts + 32 * ks + 4 * g, fts + 32 * ks + 16 + 4 * g); }
            f32x2 tw[4][4];
#pragma unroll
            for (int be = 0; be < 4; ++be)
#pragma unroll
                for (int r = 0; r < 4; ++r) tw[be][r] = F.TW()[k1 * (16 * be + 4 * g + r)];
            const LAS char* zrd = Z + (4 * g + q) * ZP + 8 * p;
#pragma unroll
            for (int c = 0; c < 4; ++c) {
                f32x4 ar[4], ai[4];
#pragma unroll
                for (int be = 0; be < 4; ++be) { ar[be] = (f32x4){0.f, 0.f, 0.f, 0.f}; ai[be] = (f32x4){0.f, 0.f, 0.f, 0.f}; }
#pragma unroll
                for (int ks = 0; ks < 4; ++ks)
#pragma unroll
                    for (int be = 0; be < 4; ++be) { const LAS char* a0 = zrd + (32 * ks) * ZP + (c * 64 + 16 * be) * 2;
                        const bf16x8 A = cat8(trrd(a0), trrd(a0 + 16 * ZP));
                        ar[be] = MFMA16(A, Fc[ks], ar[be]); ai[be] = MFMA16(A, Fs[ks], ai[be]); }
                float br[4][4], bi[4][4];
#pragma unroll
                for (int be = 0; be < 4; ++be)
#pragma unroll
                    for (int r = 0; r < 4; ++r) { const float ct = tw[be][r].x, st = tw[be][r].y; br[be][r] = ar[be][r] * ct - ai[be][r] * st; bi[be][r] = ar[be][r] * st + ai[be][r] * ct; }
#pragma unroll
                for (int a = 0; a < 2; ++a) { v4u wr_, wi_;
                    wr_.x = pk2(br[2 * a][0], br[2 * a][1]); wr_.y = pk2(br[2 * a][2], br[2 * a][3]); wr_.z = pk2(br[2 * a + 1][0], br[2 * a + 1][1]); wr_.w = pk2(br[2 * a + 1][2], br[2 * a + 1][3]);
                    wi_.x = pk2(bi[2 * a][0], bi[2 * a][1]); wi_.y = pk2(bi[2 * a][2], bi[2 * a][3]); wi_.z = pk2(bi[2 * a + 1][0], bi[2 * a + 1][1]); wi_.w = pk2(bi[2 * a + 1][2], bi[2 * a + 1][3]);
                    Bre[c][a] = __builtin_bit_cast(bf16x8, wr_); Bim[c][a] = __builtin_bit_cast(bf16x8, wi_); }
                __builtin_amdgcn_sched_barrier(0);
            }
        }
        STAMP(41);
        {
            const float sc = 0.011048543456039806f;
#pragma unroll 1
            for (int T = 0; T < 4; ++T) {
                bf16x8 Wc[2], Ws[2];
#pragma unroll
                for (int a = 0; a < 2; ++a) { Wc[a] = *(const GAS bf16x8*)(F.W64F() + (((0 * 2 + a) * 4 + T) * 64 + lane) * 8); Ws[a] = *(const GAS bf16x8*)(F.W64F() + (((1 * 2 + a) * 4 + T) * 64 + lane) * 8); }
                f32x4 P[4], Q[4];
#pragma unroll
                for (int c = 0; c < 4; ++c) {
                    bf16x8 nim[2];
#pragma unroll
                    for (int a = 0; a < 2; ++a) { v4u t = __builtin_bit_cast(v4u, Bim[c][a]); t.x ^= 0x80008000u; t.y ^= 0x80008000u; t.z ^= 0x80008000u; t.w ^= 0x80008000u; nim[a] = __builtin_bit_cast(bf16x8, t); }
                    f32x4 pp = (f32x4){0.f, 0.f, 0.f, 0.f}, qq = (f32x4){0.f, 0.f, 0.f, 0.f};
#pragma unroll
                    for (int a = 0; a < 2; ++a) { pp = MFMA16(Bre[c][a], Wc[a], pp); pp = MFMA16(nim[a], Ws[a], pp); qq = MFMA16(Bre[c][a], Ws[a], qq); qq = MFMA16(Bim[c][a], Wc[a], qq); }
                    P[c] = pp; Q[c] = qq;
                }
#pragma unroll
                for (int r = 0; r < 4; ++r) { const int k = (16 * w + 4 * g + r) + 128 * (16 * T + l16);
                    bf16* mp = MIXp + ((size_t)b * TPB + CTXL + k) * KMIX + cg * 4;
                    u32x2 o; o.x = pk2(P[0][r] * sc, P[1][r] * sc); o.y = pk2(P[2][r] * sc, P[3][r] * sc); *(GAS u32x2*)(mp + MIX_P) = o;
                    o.x = pk2(Q[0][r] * sc, Q[1][r] * sc); o.y = pk2(Q[2][r] * sc, Q[3][r] * sc); *(GAS u32x2*)(mp + MIX_Q) = o; }
            }
        }
        STAMP(42);
        {
            f32x4 aP[2], aQ[2];
#pragma unroll
            for (int tt = 0; tt < 2; ++tt) { aP[tt] = (f32x4){0.f, 0.f, 0.f, 0.f}; aQ[tt] = (f32x4){0.f, 0.f, 0.f, 0.f}; }
            const bf16* ctc = F.CT256() + (size_t)(2 * w) * 8 * 512 + lane * 8; const bf16* cts = ctc + 256 * 256;
#pragma unroll 1
            for (int hk = 0; hk < 4; ++hk) {
                bf16x8 Bc[2][2], Bs[2][2];
#pragma unroll
                for (int tt = 0; tt < 2; ++tt)
#pragma unroll
                    for (int kk = 0; kk < 2; ++kk) { const int ks = 2 * hk + kk; Bc[tt][kk] = *(const GAS bf16x8*)(ctc + (tt * 8 + ks) * 512); Bs[tt][kk] = *(const GAS bf16x8*)(cts + (tt * 8 + ks) * 512); }
#pragma unroll
                for (int kk = 0; kk < 2; ++kk) { const int ks = 2 * hk + kk;
                    const LAS char* a0 = Zc + (32 * ks + 4 * g + q) * 8;
                    const bf16x8 A = cat8(trrd(a0), trrd(a0 + 16 * 8));
#pragma unroll
                    for (int tt = 0; tt < 2; ++tt) { aP[tt] = MFMA16(A, Bc[tt][kk], aP[tt]); aQ[tt] = MFMA16(A, Bs[tt][kk], aQ[tt]); } }
            }
            if (g == 0) {
#pragma unroll
                for (int tt = 0; tt < 2; ++tt) { const int k = 16 * (2 * w + tt) + l16; bf16* mp = MIXp + ((size_t)b * TPB + k) * KMIX + cg * 4;
                    u32x2 o; o.x = pk2(aP[tt][0] * 0.0625f, aP[tt][1] * 0.0625f); o.y = pk2(aP[tt][2] * 0.0625f, aP[tt][3] * 0.0625f); *(GAS u32x2*)(mp + MIX_P) = o;
                    o.x = pk2(aQ[tt][0] * 0.0625f, aQ[tt][1] * 0.0625f); o.y = pk2(aQ[tt][2] * 0.0625f, aQ[tt][3] * 0.0625f); *(GAS u32x2*)(mp + MIX_Q) = o; }
            }
        }
        STAMP(43);
        __syncthreads(); STAMP(44);
    }
}

__device__ __forceinline__ float hg_exp(float x) { return __builtin_amdgcn_exp2f(x); }
#define LDS_BAR() asm volatile("s_waitcnt lgkmcnt(0)\n\ts_barrier" ::: "memory")
namespace hg {
using fft::trrd; using fft::cat8;
constexpr int IP = 160;
constexpr int IMG = 64 * IP;
__device__ __forceinline__ int scan_pos(int c, int dir) { return dir == 0 ? c : (c < 4 ? 3 - c : 135 - c); }
__device__ __forceinline__ float dpp_shr(float v, int n) {
    const int x = __builtin_bit_cast(int, v); int r;
    switch (n) { case 1: r = __builtin_amdgcn_update_dpp(0, x, 0x111, 0xF, 0xF, true); break; case 2: r = __builtin_amdgcn_update_dpp(0, x, 0x112, 0xF, 0xF, true); break;
                 case 4: r = __builtin_amdgcn_update_dpp(0, x, 0x114, 0xF, 0xF, true); break; default: r = __builtin_amdgcn_update_dpp(0, x, 0x118, 0xF, 0xF, true); break; }
    return __builtin_bit_cast(float, r);
}
__device__ __forceinline__ float scan_incl(float v, int lane) {
    v += dpp_shr(v, 1); v += dpp_shr(v, 2); v += dpp_shr(v, 4); v += dpp_shr(v, 8);
    v += __builtin_bit_cast(float, __builtin_amdgcn_update_dpp(0, __builtin_bit_cast(int, v), 0x142, 0xA, 0xF, false));
    v += __builtin_bit_cast(float, __builtin_amdgcn_update_dpp(0, __builtin_bit_cast(int, v), 0x143, 0xC, 0xF, false));
    (void)lane; return v;
}
__device__ __forceinline__ float lane_bcast(float v, int src) { return __builtin_bit_cast(float, __builtin_amdgcn_readlane(__builtin_bit_cast(int, v), src)); }
__device__ __forceinline__ void gates16(const v4u z0, const v4u z1, const float lbl  , int lane, float (&kk)[16], float (&cum)[16]) {
    const unsigned zw[8] = {z0.x, z0.y, z0.z, z0.w, z1.x, z1.y, z1.z, z1.w};
#pragma unroll
    for (int i = 0; i < 16; ++i) { const float z = (i & 1) ? bfhi(zw[i >> 1]) : bflo(zw[i >> 1]); const float lb = lane_bcast(lbl, i);
        const float sg = sigmoidf_(z), f = fmaxf(lb + (1.0f - lb) * sg, 1e-30f); kk[i] = (1.0f - lb) * (1.0f - sg);     cum[i] = scan_incl(__builtin_amdgcn_logf(f), lane); }
}
__device__ __forceinline__ void st16(LAS char* p, const float (&v)[16]) {
    v4u a, b; a.x = pk2(v[0], v[1]); a.y = pk2(v[2], v[3]); a.z = pk2(v[4], v[5]); a.w = pk2(v[6], v[7]); b.x = pk2(v[8], v[9]); b.y = pk2(v[10], v[11]); b.z = pk2(v[12], v[13]); b.w = pk2(v[14], v[15]);
    *(LAS v4u*)p = a; *(LAS v4u*)(p + 16) = b;
}
}
struct HgInA { v4u z0, z1, v0, v1; float lb; };
__device__ __forceinline__ HgInA hg_load_a(const bf16* UXp, const float* LBl  , int unit, int dir, int wd, int lane) {
    const int c = unit % (TPB / 64), bh = unit / (TPB / 64), b = bh >> 2, h = bh & 3;
    const size_t row = (size_t)b * TPB + 64 * c + (dir ? 63 - lane : lane);
    const bf16* rp = UXp + row * PROJ + h * 64 + 16 * wd; HgInA r;
    r.z0 = *(const GAS v4u*)(rp + (dir ? OFF_FB : OFF_FF)); r.z1 = *(const GAS v4u*)(rp + (dir ? OFF_FB : OFF_FF) + 8);
    r.v0 = *(const GAS v4u*)(rp + OFF_I); r.v1 = *(const GAS v4u*)(rp + OFF_I + 8); r.lb = *(const GAS float*)(LBl + h * 64 + 16 * wd + (lane & 15)); return r;
}
__device__ __forceinline__ void hgrn_a_phase(Frame& F, int l) {
    using namespace hg;
    const int lane = F.lane, w = F.wave, dir = w >> 2, wd = w & 3, l16 = lane & 15, g = lane >> 4, q = l16 >> 2, p = l16 & 3;
    LAS char* KI = (LAS char*)(F.lds + RING_OFF) + dir * 2 * IMG; LAS char* VI = KI + IMG;
    const bf16* UXp = F.UX();
    constexpr int NU = NB * 4 * (TPB / 64);
    const float* LBl = F.LB() + (dir * DEPTH + l) * 256;
    HgInA nx = hg_load_a(UXp, LBl, F.vcu < NU ? F.vcu : 0, dir, wd, lane);
    for (int unit = F.vcu; unit < NU; unit += F.G) {
        const int c = unit % (TPB / 64), bh = unit / (TPB / 64), b = bh >> 2, h = bh & 3;
        const HgInA in = nx;
        if (unit + F.G < NU) nx = hg_load_a(UXp, LBl, unit + F.G, dir, wd, lane);
        float kk[16], cum[16];
        gates16(in.z0, in.z1, in.lb, lane, kk, cum);
        float ko[16], gl[16];
#pragma unroll
        for (int i = 0; i < 16; ++i) { const float last = lane_bcast(cum[i], 63); gl[i] = last; ko[i] = kk[i] * hg_exp(last - cum[i]); }
        st16(KI + lane * IP + 32 * wd, ko);
        *(LAS v4u*)(VI + lane * IP + 32 * wd) = in.v0; *(LAS v4u*)(VI + lane * IP + 32 * wd + 16) = in.v1;
        const int ch = (b * 4 + h) * 2 + dir, pp = scan_pos(c, dir);
        if (lane < 16) { float gv = 0.f;
#pragma unroll
            for (int i = 0; i < 16; ++i) gv = (lane == i) ? gl[i] : gv;
            F.HGG()[((size_t)ch * 132 + pp) * 64 + 16 * wd + lane] = hg_exp(gv); }
        LDS_BAR();
        bf16x8 Af[2];
#pragma unroll
        for (int ks = 0; ks < 2; ++ks) { const LAS char* a0 = KI + (32 * ks + 4 * g + q) * IP + (16 * wd + 4 * p) * 2; Af[ks] = cat8(trrd(a0), trrd(a0 + 16 * IP)); }
        bf16* sp = (bf16*)F.HGS() + ((size_t)ch * 132 + pp) * 4096;
#pragma unroll
        for (int et = 0; et < 4; ++et) { f32x4 acc = (f32x4){0.f, 0.f, 0.f, 0.f};
#pragma unroll
            for (int ks = 0; ks < 2; ++ks) { const LAS char* b0 = VI + (32 * ks + 4 * g + q) * IP + (16 * et + 4 * p) * 2; acc = MFMA16(Af[ks], cat8(trrd(b0), trrd(b0 + 16 * IP)), acc); }
            u32x2 o2; o2.x = pk2(acc[0], acc[1]); o2.y = pk2(acc[2], acc[3]); *(GAS u32x2*)(sp + (16 * et + l16) * 64 + 16 * wd + 4 * g) = o2; }
        LDS_BAR();
    }
}
__device__ __forceinline__ void hgrn_b_phase(Frame& F) {
    const int gt = F.vcu * NTHREADS + F.tid, NGT = F.G * NTHREADS;
    for (int it = gt; it < 32 * 2048; it += NGT) {
        const int ch = it >> 11, idx = (it & 2047) * 2, d = idx & 63;
        unsigned* sp = (unsigned*)((bf16*)F.HGS() + (size_t)ch * 132 * 4096 + idx); const f32x2* gp = (const f32x2*)(F.HGG() + (size_t)ch * 132 * 64 + d);
        float s0 = 0.f, s1 = 0.f;
        for (int p0 = 0; p0 < 132; p0 += 6) {
            unsigned kv[6]; f32x2 gg[6];
#pragma unroll
            for (int i = 0; i < 6; ++i) { kv[i] = sp[(size_t)(p0 + i) * 2048]; gg[i] = gp[(p0 + i) * 32]; }
#pragma unroll
            for (int i = 0; i < 6; ++i) { sp[(size_t)(p0 + i) * 2048] = pk2(s0, s1); s0 = gg[i].x * s0 + bflo(kv[i]); s1 = gg[i].y * s1 + bfhi(kv[i]); }
        }
    }
}
struct HgInC { v4u z0, z1, q0, q1, v0, v1; v4u s[2]; u32x2 gr[2]; float lb; };
__device__ __forceinline__ HgInC hg_load_c(const bf16* UXp, const bf16* HGSp, const float* LBl, int unit, int nch, int c0, int dir, int wd, int lane, int w) {
    const int c = c0 + unit % nch, bh = unit / nch, b = bh >> 2, h = bh & 3, l16 = lane & 15, g = lane >> 4;
    const size_t R0 = (size_t)b * TPB + 64 * c, row = R0 + (dir ? 63 - lane : lane);
    const bf16* rp = UXp + row * PROJ + h * 64 + 16 * wd; HgInC r;
    r.z0 = *(const GAS v4u*)(rp + (dir ? OFF_FB : OFF_FF)); r.z1 = *(const GAS v4u*)(rp + (dir ? OFF_FB : OFF_FF) + 8);
    r.q0 = *(const GAS v4u*)(rp + OFF_HQ); r.q1 = *(const GAS v4u*)(rp + OFF_HQ + 8);
    r.v0 = *(const GAS v4u*)(rp + OFF_I); r.v1 = *(const GAS v4u*)(rp + OFF_I + 8);
    const int ch = (b * 4 + h) * 2 + dir, pp = hg::scan_pos(c, dir);
    const bf16* sp = HGSp + ((size_t)ch * 132 + pp) * 4096 + (size_t)(16 * wd + l16) * 64;
#pragma unroll
    for (int ks = 0; ks < 2; ++ks) r.s[ks] = *(const GAS v4u*)(sp + 32 * ks + 8 * g);
#pragma unroll
    for (int ps = 0; ps < 2; ++ps) r.gr[ps] = *(const GAS u32x2*)(UXp + (R0 + 8 * w + 4 * ps + g) * PROJ + OFF_G + h * 64 + 4 * l16);
    r.lb = *(const GAS float*)(LBl + h * 64 + 16 * wd + l16);
    return r;
}
__device__ __forceinline__ void hgrn_c_phase(Frame& F, int l) {
    using namespace hg;
    const int lane = F.lane, w = F.wave, dir = w >> 2, wd = w & 3, l16 = lane & 15, g = lane >> 4, q = l16 >> 2, p = l16 & 3;
    LAS char* base = (LAS char*)(F.lds + RING_OFF);
    LAS char* QI = base + dir * 3 * IMG; LAS char* KI = QI + IMG; LAS char* VI = KI + IMG;
    LAS float* ES = (LAS float*)(base + 6 * IMG) + dir * 64;
    LAS float* OF = (LAS float*)(base + 6 * IMG + 512);
    const bf16* UXp = F.UX(); bf16* MIXp = F.MIX(); const bf16* HGSp = (const bf16*)F.HGS();
    const f32x4 gn = *(const GAS f32x4*)(F.hg_norm() + l * 64 + 4 * l16);
    const int c0 = (l == DEPTH - 1) ? 4 : 0, nch = TPB / 64 - c0, NU = NB * 4 * nch;
    const float* LBl = F.LB() + (dir * DEPTH + l) * 256;
    const int nfull = NU / F.G, rem = NU - nfull * F.G; const bool spread = rem <= F.G / 4;
    const int my_n = spread ? nfull + (((F.vcu & 3) == 2 && (F.vcu >> 2) < rem) ? 1 : 0) : nfull + (F.vcu < rem ? 1 : 0);
#define HGC_UNIT(i) (((i) < nfull) ? F.vcu + (i) * F.G : (spread ? nfull * F.G + (F.vcu >> 2) : F.vcu + (i) * F.G))
    HgInC nx = hg_load_c(UXp, HGSp, LBl, my_n > 0 ? HGC_UNIT(0) : 0, nch, c0, dir, wd, lane, w);
    for (int ui = 0; ui < my_n; ++ui) {
        const int unit = HGC_UNIT(ui);
        const int c = c0 + unit % nch, bh = unit / nch, b = bh >> 2, h = bh & 3;
        const size_t R0 = (size_t)b * TPB + 64 * c;
        STAMP(23);
        const HgInC in = nx;
        if (ui + 1 < my_n) nx = hg_load_c(UXp, HGSp, LBl, HGC_UNIT(ui + 1), nch, c0, dir, wd, lane, w);
        {
            float kk[16], cum[16];
            gates16(in.z0, in.z1, in.lb, lane, kk, cum);
            const unsigned qw[8] = {in.q0.x, in.q0.y, in.q0.z, in.q0.w, in.q1.x, in.q1.y, in.q1.z, in.q1.w};
            float qo[16], ko[16], ev = 0.f;
#pragma unroll
            for (int i = 0; i < 16; ++i) { const float ref = lane_bcast(cum[i], 31); const float qv = (i & 1) ? bfhi(qw[i >> 1]) : bflo(qw[i >> 1]);
                qo[i] = qv * hg_exp(fminf(cum[i] - ref, 115.f)); ko[i] = kk[i] * hg_exp(fminf(ref - cum[i], 115.f)); ev = (lane == i) ? ref : ev; }
            st16(QI + lane * IP + 32 * wd, qo); st16(KI + lane * IP + 32 * wd, ko);
            *(LAS v4u*)(VI + lane * IP + 32 * wd) = in.v0; *(LAS v4u*)(VI + lane * IP + 32 * wd + 16) = in.v1;
            if (lane < 16) ES[16 * wd + lane] = hg_exp(ev);
        }
        LDS_BAR(); STAMP(20);
        {
            const int et = wd;
            bf16x8 Sf[2], Vf[2];
#pragma unroll
            for (int ks = 0; ks < 2; ++ks) { const v4u sw = in.s[ks];
                const f32x4 e0 = *(const LAS f32x4*)(ES + 32 * ks + 8 * g), e1 = *(const LAS f32x4*)(ES + 32 * ks + 8 * g + 4);
                v4u t; t.x = pk2(bflo(sw.x) * e0.x, bfhi(sw.x) * e0.y); t.y = pk2(bflo(sw.y) * e0.z, bfhi(sw.y) * e0.w); t.z = pk2(bflo(sw.z) * e1.x, bfhi(sw.z) * e1.y); t.w = pk2(bflo(sw.w) * e1.z, bfhi(sw.w) * e1.w); Sf[ks] = __builtin_bit_cast(bf16x8, t);
                const LAS char* b0 = VI + (32 * ks + 4 * g + q) * IP + (16 * et + 4 * p) * 2; Vf[ks] = cat8(trrd(b0), trrd(b0 + 16 * IP)); }
#pragma unroll
            for (int jb = 0; jb < 4; ++jb) {
                bf16x8 Qf[2];
#pragma unroll
                for (int ks = 0; ks < 2; ++ks) Qf[ks] = *(const LAS bf16x8*)(QI + (16 * jb + l16) * IP + (32 * ks + 8 * g) * 2);
                f32x4 o = (f32x4){0.f, 0.f, 0.f, 0.f};
#pragma unroll
                for (int ks = 0; ks < 2; ++ks) o = MFMA16(Qf[ks], Sf[ks], o);
#pragma unroll
                for (int a = 0; a <= (jb >> 1); ++a) {
                    f32x4 X[2];
#pragma unroll
                    for (int hh = 0; hh < 2; ++hh) { const int sb = 2 * a + hh; X[hh] = (f32x4){0.f, 0.f, 0.f, 0.f};
                        if (sb <= jb) {
#pragma unroll
                            for (int ks = 0; ks < 2; ++ks) X[hh] = MFMA16(*(const LAS bf16x8*)(KI + (16 * sb + l16) * IP + (32 * ks + 8 * g) * 2), Qf[ks], X[hh]);
                            if (sb == jb) {
#pragma unroll
                                for (int r = 0; r < 4; ++r) X[hh][r] = (4 * g + r <= l16) ? X[hh][r] : 0.f; } } }
                    v4u t; t.x = pk2(X[0][0], X[0][1]); t.y = pk2(X[0][2], X[0][3]); t.z = pk2(X[1][0], X[1][1]); t.w = pk2(X[1][2], X[1][3]);
                    o = MFMA16(__builtin_bit_cast(bf16x8, t), Vf[a], o);
                }
#pragma unroll
                for (int r = 0; r < 4; ++r) { const int j = 16 * jb + 4 * g + r, tok = dir ? 63 - j : j; OF[(dir * 64 + tok) * 64 + 16 * et + l16] = o[r]; }
            }
        }
        LDS_BAR(); STAMP(21);
        {
#pragma unroll
            for (int ps = 0; ps < 2; ++ps) { const int tok = 8 * w + 4 * ps + g;
                const f32x4 a = *(const LAS f32x4*)(OF + tok * 64 + 4 * l16), bq = *(const LAS f32x4*)(OF + (64 + tok) * 64 + 4 * l16); const f32x4 o = a + bq;
                float ss = (o.x * o.x + o.y * o.y) + (o.z * o.z + o.w * o.w);
                ss = xl_sum16(ss);
                const float rinv = 1.0f / sqrtf(ss * (1.0f / 64.0f) + EPS);
                const u32x2 graw = in.gr[ps];
                u32x2 wv; wv.x = pk2(o.x * rinv * gn.x * siluf_(bflo(graw.x)), o.y * rinv * gn.y * siluf_(bfhi(graw.x))); wv.y = pk2(o.z * rinv * gn.z * siluf_(bflo(graw.y)), o.w * rinv * gn.w * siluf_(bfhi(graw.y)));
                *(GAS u32x2*)(MIXp + (R0 + tok) * KMIX + MIX_R + h * 64 + 4 * l16) = wv; }
        }
        LDS_BAR(); STAMP(22);
    }
}

#ifndef R_P0A
#define R_P0A 1
#endif
#ifndef R_FFT
#define R_FFT 1
#endif
#ifndef R_HGA
#define R_HGA 1
#endif
#ifndef R_HGC
#define R_HGC 1
#endif
#ifndef R_ATT
#define R_ATT 1
#endif
#ifndef STAGGER_US
#define STAGGER_US 0
#endif
#define STAGGER() do { if (STAGGER_US > 0 && (F.vcu & 1)) { const unsigned long long t0_ = rt(); while (rt() - t0_ < (unsigned long long)(STAGGER_US * 100)) __builtin_amdgcn_s_sleep(16); } } while (0)
#ifndef MK_MULTI
#define MK_MULTI 0
#endif
constexpr int PH_L0 = 2, NPL = 7, PH_FINAL = PH_L0 + NPL, NPH = PH_FINAL + 1;
struct Args { const float* in[17]; float* out; unsigned char* ws; int l_lo, l_hi; };
template <int PH_LO, int PH_HI>
__global__ void __launch_bounds__(NTHREADS, 2) fwd_kernel(Args args) {
    extern __shared__ __attribute__((aligned(16))) unsigned char lds[];
    Frame F;
    F.lds = (LAS unsigned char*)lds;
    F.MISC = (volatile LAS unsigned*)(F.lds + MISC_OFF);
    F.tid = threadIdx.x; F.lane = F.tid & 63; F.wave = __builtin_amdgcn_readfirstlane(F.tid >> 6);
    const int wave0 = F.wave;
    F.G = gridDim.x; { const int bx = blockIdx.x; F.vcu = (F.G % 8 == 0) ? (bx % 8) * (F.G / 8) + bx / 8 : bx; }
    F.ws = (GAS unsigned char*)args.ws; F.outg = (GAS float*)args.out;
    for (int u = F.tid; u < (LDS_BYTES - LDSCTL_OFF) / 4; u += NTHREADS) ((LAS unsigned*)(F.lds + LDSCTL_OFF))[u] = 0u;
    __syncthreads();
    if (!MK_MULTI) (void)xcd_barrier_post((F.ctlw() + CW_BAR), F.MISC + 8);
#define IN(k) (PH_LO <= (k) && (k) < PH_HI)
#define RELANE() do { int ln_; asm volatile("v_mbcnt_lo_u32_b32 %0, -1, 0\n\tv_mbcnt_hi_u32_b32 %0, -1, %0" : "=v"(ln_)); F.lane = ln_; F.tid = wave0 * 64 + ln_; F.wave = wave0; unsigned long long w_ = (unsigned long long)F.ws, o_ = (unsigned long long)F.outg; asm volatile("" : "+s"(w_), "+s"(o_), "+s"(F.vcu), "+s"(F.G)); F.ws = (GAS unsigned char*)w_; F.outg = (GAS float*)o_; } while (0)
#define bx_() ({ int b_ = (int)blockIdx.x; asm volatile("" : "+s"(b_)); b_; })
#define SEAM(tag) do { if (!MK_MULTI) { unsigned long long w_ = (unsigned long long)F.ws; asm volatile("" : "+s"(w_)); XcdBarrier bar_; bar_.bar = (unsigned*)((GAS unsigned char*)w_ + WS_CTL) + CW_BAR; bar_.x = xb_xcc_id(); bar_.st = (volatile LAS unsigned*)(F.lds + MISC_OFF) + 8; xcd_barrier(bar_); }     \
    STAMP(tag); } while (0)
    F.dt = (DIAG_J >= 0) ? rt() : 0ull; F.da = 0ull;

    if (IN(0)) { for (int rep = 0; rep < R_P0A; ++rep) { RELANE(); p0a_prologue(F); SEAM(7); } }
    if (IN(1)) { RELANE(); p0b_fold(F); SEAM(8); }

    for (int l_it = args.l_lo; l_it < args.l_hi; ++l_it) {
        int l = l_it; asm volatile("" : "+s"(l));
        constexpr int s0 = PH_L0;
#define MODS_L (F.MODS() + (size_t)l * 5 * 6144)
        if (IN(s0 + 0)) { RELANE();
            pg8::Gemm g{F.HN(), F.WIN() + (size_t)l * PROJ * DM, MROWS, PROJ, DM, DM}; pg8::StaticOrder S; S.init(MROWS, PROJ, F.G, bx_());
            pg8::EpiBf16N E{F.UX(), PROJ, F.BIASA() + (size_t)l * 5 * 2304, 2304, F.ROWSS(), F.q_norm() + l * 64, F.k_norm() + l * 64, (const float*)F.ROPE(), QSCALE};
            pg8::gemm_phase<pg8::EpiBf16N, pg8::StaticOrder, PG8_ALIGN, PG8_SP2, DM, DM, Frame>(F.lds + RING_OFF, g, S, E, F.tid, F);
            SEAM(0);
        }
        if (IN(s0 + 1)) { STAMP(10); for (int rep = 0; rep < R_FFT; ++rep) { RELANE(); fourier_fast_phase(F); } STAMP(11); for (int rep = 0; rep < R_HGA; ++rep) { RELANE(); hgrn_a_phase(F, l); } SEAM(1); }
        if (IN(s0 + 2)) { RELANE(); hgrn_b_phase(F); SEAM(2); }
        if (IN(s0 + 3)) { for (int rep = 0; rep < R_ATT; ++rep) { RELANE(); attn_fast_phase(F, l); } STAMP(12); for (int rep = 0; rep < R_HGC; ++rep) { RELANE(); hgrn_c_phase(F, l); } SEAM(3); }
        if (IN(s0 + 4)) { RELANE();
            const int lastl = (l == DEPTH - 1);
            {
                pg8::Gemm g{F.MIX(), F.WOUT() + (size_t)l * DM * KMIX, MROWS, DM, KMIX, KMIX}; pg8::StaticOrder S; S.init(NB * SEQ, DM, F.G, bx_(), 1);
                pg8::EpiResGate E{F.XB(), MODS_L + MOD_G_A, MODS_L + MOD_SC_F, F.HN(), F.ROWSS()};
                pg8::gemm_phase<pg8::EpiResGate, pg8::StaticOrder, PG8_ALIGN, PG8_SP2, KMIX, KMIX, Frame>(F.lds + RING_OFF, g, S, E, F.tid, F);
            }
            if (!lastl) {
                RELANE();
                pg8::Gemm g{F.MIX(), F.WOUT() + (size_t)l * DM * KMIX, MROWS, DM, 256, KMIX}; pg8::CtxSplitOrder S; S.init(DM, KMIX, 256, F.G, bx_());
                pg8::EpiPartial E{F.HGS(), 256};
                pg8::gemm_phase<pg8::EpiPartial, pg8::CtxSplitOrder, PG8_ALIGN, PG8_SP2, 256, KMIX, Frame>(F.lds + RING_OFF, g, S, E, F.tid, F);
                SEAM(4); RELANE();
                { const float* m2 = F.MODS() + (size_t)l * 5 * 6144; ctx_reduce_pass<KMIX / 256>(F, F.HGS(), m2 + MOD_G_A, m2 + MOD_SC_F); }
            }
            SEAM(4);
        }
        if (IN(s0 + 5)) { RELANE();
            const int lastl = (l == DEPTH - 1);
            STAGGER();
            pg8::Gemm g{F.HN(), F.WGU() + (size_t)l * 5632 * DM, MROWS, 5632, DM, DM}; pg8::StaticOrder S; S.init(lastl ? NB * SEQ : MROWS, 5632, F.G, bx_(), lastl);
            pg8::EpiSwiGLU E{F.HB(), DFF, F.BIASF() + (size_t)l * 5 * 5632, 5632, F.ROWSS()};
            pg8::gemm_phase<pg8::EpiSwiGLU, pg8::StaticOrder, PG8_ALIGN, PG8_SP2, DM, DM, Frame>(F.lds + RING_OFF, g, S, E, F.tid, F);
            SEAM(5);
        }
        if (IN(s0 + 6)) { RELANE();
            const int lastl = (l == DEPTH - 1);
            {
                pg8::Gemm g{F.HB(), F.WDN() + (size_t)l * DM * DFF, MROWS, DM, DFF, DFF}; pg8::StaticOrder S; S.init(NB * SEQ, DM, F.G, bx_(), 1);
                pg8::EpiResGate E{F.XB(), MODS_L + MOD_G_F, (l + 1 < DEPTH) ? MODS_L + 5 * 6144 + MOD_SC_A : nullptr, F.HN(), F.ROWSS()};
                pg8::gemm_phase<pg8::EpiResGate, pg8::StaticOrder, PG8_ALIGN, PG8_SP2, DFF, DFF, Frame>(F.lds + RING_OFF, g, S, E, F.tid, F);
            }
            if (!lastl) {
                RELANE();
                pg8::Gemm g{F.HB(), F.WDN() + (size_t)l * DM * DFF, MROWS, DM, 256, DFF}; pg8::CtxSplitOrder S; S.init(DM, DFF, 256, F.G, bx_());
                pg8::EpiPartial E{F.HGS(), 256};
                pg8::gemm_phase<pg8::EpiPartial, pg8::CtxSplitOrder, PG8_ALIGN, PG8_SP2, 256, DFF, Frame>(F.lds + RING_OFF, g, S, E, F.tid, F);
                SEAM(6); RELANE();
                { const float* m2 = F.MODS() + (size_t)l * 5 * 6144; ctx_reduce_pass<DFF / 256>(F, F.HGS(), m2 + MOD_G_F, (l + 1 < DEPTH) ? m2 + 5 * 6144 + MOD_SC_A : nullptr); }
            }
            SEAM(6);
        }
    }
    if (IN(PH_FINAL)) { RELANE(); final_norm_phase(F); if (DIAG_J >= 0) { asm volatile("s_waitcnt vmcnt(0)" ::: "memory"); const unsigned long long t_ = rt(); if (DIAG_J == 9) F.da += t_ - F.dt;
        if (blockIdx.x == 0) { const unsigned long long tend = t_ + (unsigned long long)DIAG_A * F.da; while (rt() < tend) __builtin_amdgcn_s_sleep(32); } } }
#undef IN
#undef SEAM
}

#if MK_MULTI
#define MAIN_KERNEL (fwd_kernel<3, 4>)
#define LAUNCH(p) hipLaunchKernelGGL((fwd_kernel<p, p + 1>), dim3(grid), dim3(NTHREADS), LDS_BYTES, stream, a)
template <int P> static bool set_lds_one() { return hipFuncSetAttribute((const void*)fwd_kernel<P, P + 1>, hipFuncAttributeMaxDynamicSharedMemorySize, LDS_BYTES) == hipSuccess; }
static bool set_lds_all() { return set_lds_one<0>() && set_lds_one<1>() && set_lds_one<2>() && set_lds_one<3>() && set_lds_one<4>() && set_lds_one<5>() && set_lds_one<6>() && set_lds_one<7>() && set_lds_one<8>() && set_lds_one<9>() ; }
#else
#define MAIN_KERNEL (fwd_kernel<0, NPH>)
static bool set_lds_all() { return hipFuncSetAttribute((const void*)fwd_kernel<0, NPH>, hipFuncAttributeMaxDynamicSharedMemorySize, LDS_BYTES) == hipSuccess; }
#endif
extern "C" void kernel_launch(void* const* d_in, const int* in_sizes, int n_in, void* d_out, int out_size, void* d_ws, size_t ws_size, hipStream_t stream) {
    static int grid = 0;
    if (grid == 0) {
        if (n_in != 17 || in_sizes[0] != NB * SEQ * DM || out_size != NB * SEQ * DM || ws_size < WS_END) { fprintf(stderr, "kernel_launch: unexpected shapes (n_in %d, in0 %d, out %d, ws %zu < %zu); nothing launched\n", n_in, n_in > 0 ? in_sizes[0] : -1, out_size, ws_size, (size_t)WS_END); grid = -1; return; }
        int dev = 0, cus = 0, per_cu = 0;
        if (hipGetDevice(&dev) != hipSuccess || hipDeviceGetAttribute(&cus, hipDeviceAttributeMultiprocessorCount, dev) != hipSuccess) { grid = -1; return; }
        if (!set_lds_all()) { fprintf(stderr, "kernel_launch: hipFuncSetAttribute failed\n"); grid = -1; return; }
        if (hipOccupancyMaxActiveBlocksPerMultiprocessor(&per_cu, (const void*)MAIN_KERNEL, NTHREADS, LDS_BYTES) != hipSuccess || per_cu < 1) { fprintf(stderr, "kernel_launch: occupancy query says %d blocks per CU; nothing launched\n", per_cu); (void)hipGetLastError(); grid = -1; return; }
        grid = cus;
    }
    if (grid < 0) return;
    if (hipMemsetAsync((char*)d_ws + WS_CTL, 0, CTL_ZERO_BYTES, stream) != hipSuccess) return;
    Args a{};
    for (int i = 0; i < 17; ++i) a.in[i] = (const float*)d_in[i];
    a.out = (float*)d_out; a.ws = (unsigned char*)d_ws;
#if MK_MULTI
    a.l_lo = 0; a.l_hi = 0;
    LAUNCH(0); LAUNCH(1);
    for (int l = 0; l < DEPTH; ++l) { a.l_lo = l; a.l_hi = l + 1; LAUNCH(2); LAUNCH(3); LAUNCH(4); LAUNCH(5); LAUNCH(6); LAUNCH(7); LAUNCH(8); }
    a.l_lo = 0; a.l_hi = 0; LAUNCH(9);
#else
    a.l_lo = 0; a.l_hi = DEPTH;
    hipLaunchKernelGGL((fwd_kernel<0, NPH>), dim3(grid), dim3(NTHREADS), LDS_BYTES, stream, a);
#endif
}
```

```cpp
#include <hip/hip_runtime.h>
#include <hip/hip_bf16.h>
#include <cstdio>
#include <cstdint>
#include <cmath>
#ifndef DIAG_J
#define DIAG_J -1
#endif
#ifndef DIAG_A
#define DIAG_A 4
#endif
#define STAMP(tag) do { if (DIAG_J >= 0) { const unsigned long long t_ = __builtin_amdgcn_s_memrealtime(); if ((tag) == DIAG_J) F.da += t_ - F.dt; F.dt = t_; } } while (0)
#ifndef XL_DPP
#define XL_DPP 1
#endif
#ifndef XL_P32
#define XL_P32 0
#endif
__device__ __forceinline__ float xl_bperm_xor(float v, int mask) {
    int ln_; asm volatile("v_mbcnt_lo_u32_b32 %0, -1, 0\n\tv_mbcnt_hi_u32_b32 %0, -1, %0" : "=v"(ln_));
    return __builtin_bit_cast(float, __builtin_amdgcn_ds_bpermute((ln_ ^ mask) << 2, __builtin_bit_cast(int, v)));
}
#if !XL_DPP
__device__ __forceinline__ float xl_dpp_qp2301(float v) { return xl_bperm_xor(v, 2); }
__device__ __forceinline__ float xl_sum4(float v) { v += xl_bperm_xor(v, 1); v += xl_bperm_xor(v, 2); return v; }
__device__ __forceinline__ float xl_sum8(float v) { v = xl_sum4(v); v += xl_bperm_xor(v, 4); return v; }
__device__ __forceinline__ float xl_sum16(float v) { v = xl_sum8(v); v += xl_bperm_xor(v, 8); return v; }
#else
__device__ __forceinline__ float xl_dpp_qp1032(float v) { return __builtin_bit_cast(float, __builtin_amdgcn_update_dpp(0, __builtin_bit_cast(int, v), 0xB1, 0xF, 0xF, false)); }
__device__ __forceinline__ float xl_dpp_qp2301(float v) { return __builtin_bit_cast(float, __builtin_amdgcn_update_dpp(0, __builtin_bit_cast(int, v), 0x4E, 0xF, 0xF, false)); }
__device__ __forceinline__ float xl_dpp_hmirror(float v) { return __builtin_bit_cast(float, __builtin_amdgcn_update_dpp(0, __builtin_bit_cast(int, v), 0x141, 0xF, 0xF, false)); }
__device__ __forceinline__ float xl_dpp_mirror(float v) { return __builtin_bit_cast(float, __builtin_amdgcn_update_dpp(0, __builtin_bit_cast(int, v), 0x140, 0xF, 0xF, false)); }
__device__ __forceinline__ float xl_sum4(float v) { v += xl_dpp_qp1032(v); v += xl_dpp_qp2301(v); return v; }
__device__ __forceinline__ float xl_sum8(float v) { v = xl_sum4(v); v += xl_dpp_hmirror(v); return v; }
__device__ __forceinline__ float xl_sum16(float v) { v = xl_sum8(v); v += xl_dpp_mirror(v); return v; }
#endif
__device__ __forceinline__ float xl_sumx16(float v) { return v + xl_bperm_xor(v, 16); }
#if XL_P32
__device__ __forceinline__ float xl_sumx32(float v) { const auto r = __builtin_amdgcn_permlane32_swap(__builtin_bit_cast(unsigned, v), __builtin_bit_cast(unsigned, v), false, false); return __builtin_bit_cast(float, r[0]) + __builtin_bit_cast(float, r[1]); }
#else
__device__ __forceinline__ float xl_sumx32(float v) { return v + xl_bperm_xor(v, 32); }
#endif
__device__ __forceinline__ float xl_sum64(float v) { return xl_sumx32(xl_sumx16(xl_sum16(v))); }
namespace pg8 {
#define PG8_LAS __attribute__((address_space(3)))
typedef unsigned short bf16_t;
typedef short bf16x8 __attribute__((ext_vector_type(8)));
typedef float f32x4 __attribute__((ext_vector_type(4)));
typedef unsigned u32x4 __attribute__((ext_vector_type(4)));
constexpr int BM = 256, BK = 64, HALF = 128, HTB = HALF * BK * 2  , STAGE_BYTES = 8 * HTB, NXCD = 8, WGM = 8;

__host__ __device__ __forceinline__ int lds_byte(int r, int c) { const int st = (r >> 4) * 2 + (c >> 5), rr = r & 15, cc = c & 31, ob = rr * 64 + cc * 2; return st * 1024 + (ob ^ (((ob >> 9) & 1) << 5)); }
__host__ __device__ __forceinline__ void stage_rc(int b, int& R, int& C) { const int st = b / 1024, sb = b % 1024, swz = sb ^ (((sb >> 9) & 1) << 5); R = (st >> 1) * 16 + swz / 64; C = (st & 1) * 32 + (swz % 64) / 2; }
__host__ __device__ __forceinline__ int perm32(int rho) { const int n = rho >> 4, i = rho & 15; return 8 * (i >> 2) + 4 * n + (i & 3); }

struct Unit { int pm, pn, ko, ord; };
struct Gemm { const bf16_t* A; const bf16_t* Bt; int M, N, K, ld; };

struct StaticOrder {
    int nM, nN, nwg, G, c, skipc;
    __host__ __device__ void init(int M, int N, int G_, int c_, int skipc_ = 0) { nM = M / BM; nN = N / BM; nwg = nM * nN; G = G_; c = c_; skipc = skipc_; }
    __host__ __device__ bool next(int i, Unit& u) const {
        const long L = (long)i * G + c; if (L >= nwg) return false;
        int wgid = (int)L; { const int q = nwg / NXCD, r = nwg % NXCD, xcd = wgid % NXCD, off = wgid / NXCD; wgid = (xcd < r ? xcd * (q + 1) : r * (q + 1) + (xcd - r) * q) + off; }
        const int nig = WGM * nN, gid = wgid / nig, fm = gid * WGM, gsz = (nM - fm) < WGM ? (nM - fm) : WGM;
        u.pm = fm + ((wgid % nig) % gsz); u.pn = (wgid % nig) / gsz; if (skipc) u.pm += u.pm / 32 + 1; u.ko = 0; u.ord = i; return true;
    }
    __device__ __forceinline__ void a_ready(const Unit&) const {}
    __device__ __forceinline__ void done(const Unit&) const {}
};

struct CtxSplitOrder {
    int nsplit, kslice, G, c;
    __host__ __device__ void init(int N, int K, int kslice_, int G_, int c_) { kslice = kslice_; nsplit = K / kslice_; G = G_; c = c_; (void)N; }
    __host__ __device__ bool next(int i, Unit& u) const {
        const int L = i * G + c; if (L >= 16 * nsplit) return false;
        const int ks = L >> 4, r = L & 15; u.pm = 33 * (r >> 2); u.pn = r & 3; u.ko = ks * kslice; u.ord = i; return true;
    }
    __device__ __forceinline__ void a_ready(const Unit&) const {}
    __device__ __forceinline__ void done(const Unit&) const {}
};
__device__ __forceinline__ unsigned cvt_pk_bf16(float lo, float hi) { unsigned r; asm volatile("v_cvt_pk_bf16_f32 %0, %1, %2" : "=v"(r) : "v"(lo), "v"(hi)); return r; }
typedef float f32x2 __attribute__((ext_vector_type(2)));
__device__ __forceinline__ f32x2 gelu_pk(f32x2 v) {
    const f32x2 av = __builtin_elementwise_abs(v), d = av * 0.2316418882f + 1.0f;
    f32x2 t; t.x = __builtin_amdgcn_rcpf(d.x); t.y = __builtin_amdgcn_rcpf(d.y);
    f32x2 q = t * 0.5307027145f + (-0.7265760135f); q = q * t + 0.7107068705f; q = q * t + (-0.142248368f); q = q * t + 0.127414796f; q = q * t;
    const f32x2 s = (v * v) * (-0.72134752044f);
    f32x2 e; e.x = __builtin_amdgcn_exp2f(s.x); e.y = __builtin_amdgcn_exp2f(s.y);
    const f32x2 m = v * (q * e), r = v - m;
    f32x2 o; o.x = v.x < 0.f ? m.x : r.x; o.y = v.y < 0.f ? m.y : r.y; return o;
}

template <int ACT  > struct EpiBf16 {
    static constexpr bool PERM = true, AFTER_DRAIN = false; static_assert(ACT == 0 || ACT == 1, "EpiBf16: ACT is 0 (none) or 1 (gelu_pk)");
    bf16_t* O; int ldc; const float* bias; int split_cols; size_t split_stride; float scale0;
    __device__ __forceinline__ void operator()(const f32x4 (&acc)[2][2][4][2], const Unit& u, int wr, int wc, int fr, int fq) const {
        const int row0 = u.pm * BM + wr * 64 + fr; int colt = u.pn * BM; bf16_t* base = O;
        float sc = 1.f; if (split_cols) { const int t = colt / split_cols; base += (size_t)t * split_stride; colt -= t * split_cols; if (t == 0) sc = scale0; }
        const int col0 = colt + wc * 32 + 8 * fq, bcol0 = u.pn * BM + wc * 32 + 8 * fq;
        f32x4 bv[2][2];
#pragma unroll
        for (int bj = 0; bj < 2; ++bj)
#pragma unroll
            for (int n = 0; n < 2; ++n) bv[bj][n] = bias ? *(const f32x4*)(bias + bcol0 + bj * HALF + 4 * n) : (f32x4){0.f, 0.f, 0.f, 0.f};
#pragma unroll
        for (int ai = 0; ai < 2; ++ai)
#pragma unroll
            for (int m = 0; m < 4; ++m) { bf16_t* rowp = base + (size_t)(row0 + ai * HALF + m * 16) * ldc + col0;
#pragma unroll
                for (int bj = 0; bj < 2; ++bj) { f32x4 v0 = acc[ai][bj][m][0] + bv[bj][0], v1 = acc[ai][bj][m][1] + bv[bj][1];
                    if (ACT == 1) { f32x2 a = gelu_pk((f32x2){v0[0], v0[1]}), b = gelu_pk((f32x2){v0[2], v0[3]}), c = gelu_pk((f32x2){v1[0], v1[1]}), d = gelu_pk((f32x2){v1[2], v1[3]});
                        v0 = (f32x4){a.x, a.y, b.x, b.y}; v1 = (f32x4){c.x, c.y, d.x, d.y}; }
                    v0 = v0 * sc; v1 = v1 * sc; u32x4 w; w.x = cvt_pk_bf16(v0[0], v0[1]); w.y = cvt_pk_bf16(v0[2], v0[3]); w.z = cvt_pk_bf16(v1[0], v1[1]); w.w = cvt_pk_bf16(v1[2], v1[3]);
                    *(u32x4*)(rowp + bj * HALF) = w; } }
    }
};
template <class Epi, class Sched, bool ALIGN_EPI = false, bool SP2 = false, int KC = 0, int LDC = 0, class Dg = int>
__device__ __forceinline__ void gemm_phase(PG8_LAS unsigned char* lds, const Gemm g, const Sched& S, const Epi& E, int tid_in, Dg& F) {
    int tid_ = tid_in; asm volatile("" : "+v"(tid_));
    const int tid = tid_, wid = __builtin_amdgcn_readfirstlane(tid >> 6), lane = tid & 63, wr = wid >> 2, wc = wid & 3, fr = lane & 15, fq = lane >> 4;
    const int K = KC ? KC : g.K, nt = K / BK, LD = LDC ? LDC : g.ld;
    unsigned voffA[2], voffB[2];
#pragma unroll
    for (int i = 0; i < 2; ++i) { int R, C; stage_rc(tid * 16 + i * 8192, R, C); const int Rb = Epi::PERM ? ((R & ~31) + perm32(R & 31)) : R;
        voffA[i] = (unsigned)(R * LD + C) * 2u; voffB[i] = (unsigned)(Rb * LD + C) * 2u; }
    const size_t kstep = (size_t)(BK * 2);
    const size_t hstep = (size_t)HALF * LD * 2;
    const size_t tstep = 2 * hstep;
    const int aoff = lds_byte(wr * 64 + fr, fq * 8), boff = lds_byte(wc * 32 + fr, fq * 8);
    const unsigned ldsw = (unsigned)wid * 1024u;
#define PG8_SA(b, h) (((b) * 2 + (h)) * HTB)
#define PG8_SB(b, h) ((4 + (b) * 2 + (h)) * HTB)
#define PG8_STAGE(bufoff, gbase, voff) do { _Pragma("unroll") for (int _i = 0; _i < 2; ++_i) \
        __builtin_amdgcn_global_load_lds((const unsigned*)((const char*)(gbase) + (voff)[_i]), (PG8_LAS unsigned*)(lds + (bufoff) + ldsw + _i * 8192), 16, 0, 0); } while (0)
#define PG8_LDA(dst, b, h) do { _Pragma("unroll") for (int m = 0; m < 4; ++m) _Pragma("unroll") for (int k = 0; k < 2; ++k) dst[m][k] = *(const PG8_LAS bf16x8*)(lds + PG8_SA(b, h) + aoff + m * 2048 + k * 1024); } while (0)
#define PG8_LDB(dst, b, h) do { _Pragma("unroll") for (int n = 0; n < 2; ++n) _Pragma("unroll") for (int k = 0; k < 2; ++k) dst[n][k] = *(const PG8_LAS bf16x8*)(lds + PG8_SB(b, h) + boff + n * 2048 + k * 1024); } while (0)
#define PG8_MMA(ai, bj, At, Bt) do { __builtin_amdgcn_s_setprio(1); _Pragma("unroll") for (int m = 0; m < 4; ++m) _Pragma("unroll") for (int n = 0; n < 2; ++n) _Pragma("unroll") for (int k = 0; k < 2; ++k) \
        acc[ai][bj][m][n] = __builtin_amdgcn_mfma_f32_16x16x32_bf16(Bt[n][k], At[m][k], acc[ai][bj][m][n], 0, 0, 0); __builtin_amdgcn_s_setprio(0); } while (0)
#define PG8_WAIT_V(n) asm volatile("s_waitcnt vmcnt(" #n ")" ::: "memory")
#define PG8_WAIT_L(n) asm volatile("s_waitcnt lgkmcnt(" #n ")" ::: "memory")
#define PG8_BAR __builtin_amdgcn_s_barrier()
#define PG8_SCHED __builtin_amdgcn_sched_barrier(0)
    Unit cur, nxt; int ui = 0;
    if (!S.next(0, cur)) return;
    f32x4 acc[2][2][4][2];
#pragma unroll
    for (int a = 0; a < 2; ++a)
#pragma unroll
        for (int b = 0; b < 2; ++b)
#pragma unroll
            for (int m = 0; m < 4; ++m)
#pragma unroll
                for (int n = 0; n < 2; ++n) acc[a][b][m][n] = (f32x4){0.f, 0.f, 0.f, 0.f};
    bf16x8 At[4][2], B0[2][2], B1[2][2];
    const char* cA = (const char*)g.A + (size_t)cur.pm * tstep + (size_t)cur.ko * 2; const char* cB = (const char*)g.Bt + (size_t)cur.pn * tstep + (size_t)cur.ko * 2;
    S.a_ready(cur);
    if constexpr (SP2) {
        PG8_STAGE(PG8_SB(0, 0), cB, voffB); PG8_STAGE(PG8_SB(0, 1), cB + hstep, voffB); PG8_STAGE(PG8_SA(0, 0), cA, voffA); PG8_STAGE(PG8_SA(0, 1), cA + hstep, voffA);
        if (wr == 1) PG8_BAR;
        PG8_WAIT_V(2); PG8_BAR;
        PG8_STAGE(PG8_SB(1, 0), cB + kstep, voffB); PG8_STAGE(PG8_SA(1, 0), cA + kstep, voffA); PG8_STAGE(PG8_SB(1, 1), cB + hstep + kstep, voffB);
        PG8_WAIT_V(6); PG8_BAR;
    } else {
        PG8_STAGE(PG8_SB(0, 0), cB, voffB); PG8_STAGE(PG8_SA(0, 0), cA, voffA); PG8_STAGE(PG8_SB(0, 1), cB + hstep, voffB); PG8_STAGE(PG8_SA(0, 1), cA + hstep, voffA);
        if (wr == 1) PG8_BAR;
        PG8_WAIT_V(4); PG8_BAR;
        PG8_STAGE(PG8_SB(1, 0), cB + kstep, voffB); PG8_STAGE(PG8_SA(1, 0), cA + kstep, voffA); PG8_STAGE(PG8_SB(1, 1), cB + hstep + kstep, voffB);
        PG8_WAIT_V(6); PG8_BAR;
    }
    for (;;) {
        const bool has_next = S.next(ui + 1, nxt);
        const char* nA = has_next ? (const char*)g.A + (size_t)nxt.pm * tstep + (size_t)nxt.ko * 2 : cA; const char* nB = has_next ? (const char*)g.Bt + (size_t)nxt.pn * tstep + (size_t)nxt.ko * 2 : cB;
        for (int t = 0; t < nt; t += 2) {
            const bool last = (t == nt - 2);
            const char* a1 = cA + (size_t)(t + 1) * kstep;
            const char* a2 = last ? nA : cA + (size_t)(t + 2) * kstep; const char* b2 = last ? nB : cB + (size_t)(t + 2) * kstep;
            const char* a3 = a2 + kstep; const char* b3 = b2 + kstep;
            if (last && has_next) S.a_ready(nxt);
            if constexpr (SP2) {
            PG8_LDB(B0, 0, 0); PG8_LDB(B1, 0, 1); PG8_SCHED; PG8_LDA(At, 0, 0); PG8_STAGE(PG8_SA(1, 1), a1 + hstep, voffA);
            PG8_WAIT_V(8); PG8_WAIT_L(0); PG8_BAR; PG8_MMA(0, 0, At, B0); PG8_MMA(0, 1, At, B1); PG8_BAR; PG8_SCHED;
            PG8_LDA(At, 0, 1); PG8_STAGE(PG8_SB(0, 0), b2, voffB); PG8_STAGE(PG8_SB(0, 1), b2 + hstep, voffB); PG8_STAGE(PG8_SA(0, 0), a2, voffA);
            PG8_WAIT_V(8); PG8_WAIT_L(0); PG8_BAR; PG8_MMA(1, 0, At, B0); PG8_MMA(1, 1, At, B1); PG8_BAR; PG8_SCHED;
            PG8_LDB(B0, 1, 0); PG8_LDB(B1, 1, 1); PG8_SCHED; PG8_LDA(At, 1, 0); PG8_STAGE(PG8_SA(0, 1), a2 + hstep, voffA);
            PG8_WAIT_V(8); PG8_WAIT_L(0); PG8_BAR; PG8_MMA(0, 0, At, B0); PG8_MMA(0, 1, At, B1); PG8_BAR; PG8_SCHED;
            PG8_LDA(At, 1, 1); PG8_STAGE(PG8_SB(1, 0), b3, voffB); PG8_STAGE(PG8_SB(1, 1), b3 + hstep, voffB); PG8_STAGE(PG8_SA(1, 0), a3, voffA);
            PG8_WAIT_V(8); PG8_WAIT_L(0); PG8_BAR; PG8_MMA(1, 0, At, B0); PG8_MMA(1, 1, At, B1); PG8_BAR; PG8_SCHED;
            } else {
            PG8_LDB(B0, 0, 0); PG8_SCHED; PG8_LDA(At, 0, 0); PG8_STAGE(PG8_SA(1, 1), a1 + hstep, voffA);
            PG8_WAIT_L(8); PG8_BAR; PG8_WAIT_L(0); PG8_MMA(0, 0, At, B0); PG8_BAR; PG8_SCHED;
            PG8_LDB(B1, 0, 1); PG8_STAGE(PG8_SB(0, 0), b2, voffB);
            PG8_BAR; PG8_WAIT_L(0); PG8_MMA(0, 1, At, B1); PG8_BAR;
            PG8_LDA(At, 0, 1); PG8_STAGE(PG8_SA(0, 0), a2, voffA);
            PG8_BAR; PG8_WAIT_L(0); PG8_MMA(1, 0, At, B0); PG8_BAR; PG8_SCHED;
            PG8_STAGE(PG8_SB(0, 1), b2 + hstep, voffB);
            PG8_WAIT_V(6); PG8_BAR; PG8_MMA(1, 1, At, B1); PG8_BAR;
            PG8_LDB(B0, 1, 0); PG8_SCHED; PG8_LDA(At, 1, 0); PG8_STAGE(PG8_SA(0, 1), a2 + hstep, voffA);
            PG8_WAIT_L(8); PG8_BAR; PG8_WAIT_L(0); PG8_MMA(0, 0, At, B0); PG8_BAR; PG8_SCHED;
            PG8_LDB(B1, 1, 1); PG8_STAGE(PG8_SB(1, 0), b3, voffB);
            PG8_BAR; PG8_WAIT_L(0); PG8_MMA(0, 1, At, B1); PG8_BAR;
            PG8_LDA(At, 1, 1); PG8_STAGE(PG8_SA(1, 0), a3, voffA);
            PG8_BAR; PG8_WAIT_L(0); PG8_MMA(1, 0, At, B0); PG8_BAR; PG8_SCHED;
            PG8_STAGE(PG8_SB(1, 1), b3 + hstep, voffB);
            PG8_WAIT_V(6); PG8_BAR; PG8_MMA(1, 1, At, B1); PG8_BAR;
            }
        }
        STAMP(30);
        if constexpr (ALIGN_EPI) { if (wr == 0) PG8_BAR; }
        STAMP(31);
        if constexpr (!Epi::AFTER_DRAIN) { E(acc, cur, wr, wc, fr, fq); S.done(cur); }
        STAMP(Epi::TAG);
        if (!has_next) break;
#pragma unroll
        for (int a = 0; a < 2; ++a)
#pragma unroll
            for (int b = 0; b < 2; ++b)
#pragma unroll
                for (int m = 0; m < 4; ++m)
#pragma unroll
                    for (int n = 0; n < 2; ++n) acc[a][b][m][n] = (f32x4){0.f, 0.f, 0.f, 0.f};
        cur = nxt; cA = nA; cB = nB; ++ui;
        if constexpr (ALIGN_EPI) { if (wr == 1) PG8_BAR; }
    }
    PG8_WAIT_V(0);
    if constexpr (!ALIGN_EPI) { if (wr == 0) PG8_BAR; }
    PG8_BAR;
    if constexpr (Epi::AFTER_DRAIN) { E.fused(acc, cur, wr, wc, fr, fq, lds, wid, lane); S.done(cur); }
#undef PG8_SA
#undef PG8_SB
#undef PG8_STAGE
#undef PG8_LDA
#undef PG8_LDB
#undef PG8_MMA
#undef PG8_WAIT_V
#undef PG8_WAIT_L
#undef PG8_BAR
#undef PG8_SCHED
}
}
namespace pg8 {
__device__ __forceinline__ float row_rinv(const float* rowss, size_t R, int fq) {
    const f32x4 v = *(const f32x4*)(rowss + R * 16 + 4 * fq); float s = (v[0] + v[1]) + (v[2] + v[3]);
    s = xl_sumx32(xl_sumx16(s));
    return 1.0f / sqrtf(s * (1.0f / 1024.0f) + 1e-6f);
}
struct EpiResGate {
    static constexpr bool PERM = true, AFTER_DRAIN = false; static constexpr int TAG = 35;
    bf16_t* XB; const float* gate; const float* scn; bf16_t* XM; float* rowss;
    __device__ __forceinline__ void operator()(const f32x4 (&acc)[2][2][4][2], const Unit& u, int wr, int wc, int fr, int fq) const {
        asm volatile("" : "+v"(fr), "+v"(fq));
        const int b = u.pm / 33, p = u.pm % 33, bb = (p == 0) ? 4 : b;
        const int col0 = u.pn * BM + wc * 32 + 8 * fq;
        f32x4 (&accw)[2][2][4][2] = const_cast<f32x4 (&)[2][2][4][2]>(acc);
        unsigned sp[2][4];
#pragma unroll
        for (int bj = 0; bj < 2; ++bj)
#pragma unroll
            for (int n = 0; n < 2; ++n) { const f32x4 gq = *(const f32x4*)(gate + bb * 6144 + col0 + bj * HALF + 4 * n);
#pragma unroll
                for (int ai = 0; ai < 2; ++ai)
#pragma unroll
                    for (int m = 0; m < 4; ++m) accw[ai][bj][m][n] *= gq;
                if (scn) { const f32x4 sq = *(const f32x4*)(scn + bb * 6144 + col0 + bj * HALF + 4 * n) + 1.0f; sp[bj][2 * n] = cvt_pk_bf16(sq[0], sq[1]); sp[bj][2 * n + 1] = cvt_pk_bf16(sq[2], sq[3]); }
                else { sp[bj][2 * n] = 0x3f803f80u; sp[bj][2 * n + 1] = 0x3f803f80u; } }
#define PG8_LO(w) __builtin_bit_cast(float, (w) << 16)
#define PG8_HI(w) __builtin_bit_cast(float, (w) & 0xffff0000u)
#pragma unroll
        for (int ai = 0; ai < 2; ++ai) {
            u32x4 xin[4][2];
#pragma unroll
            for (int m = 0; m < 4; ++m) { const size_t R = (size_t)u.pm * BM + ai * HALF + wr * 64 + m * 16 + fr;
#pragma unroll
                for (int bj = 0; bj < 2; ++bj) xin[m][bj] = *(const u32x4*)(XB + R * 1024 + col0 + bj * HALF); }
            asm volatile("" ::: "memory");
#pragma unroll
            for (int m = 0; m < 4; ++m) { const size_t R = (size_t)u.pm * BM + ai * HALF + wr * 64 + m * 16 + fr;
                float ss = 0.f;
#pragma unroll
                for (int bj = 0; bj < 2; ++bj) { const u32x4 xw = xin[m][bj];
                    const f32x4 o0 = (f32x4){PG8_LO(xw.x), PG8_HI(xw.x), PG8_LO(xw.y), PG8_HI(xw.y)} + acc[ai][bj][m][0], o1 = (f32x4){PG8_LO(xw.z), PG8_HI(xw.z), PG8_LO(xw.w), PG8_HI(xw.w)} + acc[ai][bj][m][1];
                    u32x4 w; w.x = cvt_pk_bf16(o0[0], o0[1]); w.y = cvt_pk_bf16(o0[2], o0[3]); w.z = cvt_pk_bf16(o1[0], o1[1]); w.w = cvt_pk_bf16(o1[2], o1[3]);
                    *(u32x4*)(XB + R * 1024 + col0 + bj * HALF) = w;
                    ss += ((o0[0] * o0[0] + o0[1] * o0[1]) + (o0[2] * o0[2] + o0[3] * o0[3])) + ((o1[0] * o1[0] + o1[1] * o1[1]) + (o1[2] * o1[2] + o1[3] * o1[3]));
                    if (scn) { const f32x4 s0 = (f32x4){PG8_LO(sp[bj][0]), PG8_HI(sp[bj][0]), PG8_LO(sp[bj][1]), PG8_HI(sp[bj][1])}, s1 = (f32x4){PG8_LO(sp[bj][2]), PG8_HI(sp[bj][2]), PG8_LO(sp[bj][3]), PG8_HI(sp[bj][3])};
                        const f32x4 y0 = o0 * s0, y1 = o1 * s1; w.x = cvt_pk_bf16(y0[0], y0[1]); w.y = cvt_pk_bf16(y0[2], y0[3]); w.z = cvt_pk_bf16(y1[0], y1[1]); w.w = cvt_pk_bf16(y1[2], y1[3]);
                        *(u32x4*)(XM + R * 1024 + col0 + bj * HALF) = w; } }
                ss = xl_sumx32(xl_sumx16(ss));
                if (fq == 0) rowss[R * 16 + u.pn * 4 + wc] = ss; }
            asm volatile("" ::: "memory");
        }
#undef PG8_LO
#undef PG8_HI
    }
};
struct EpiPartial {
    static constexpr bool PERM = false, AFTER_DRAIN = false; static constexpr int TAG = 36;
    float* P; int kslice;
    __device__ __forceinline__ void operator()(const f32x4 (&acc)[2][2][4][2], const Unit& u, int wr, int wc, int fr, int fq) const {
        asm volatile("" : "+v"(fr), "+v"(fq));
        const int b = u.pm / 33, ks = u.ko / kslice; const int col0 = u.pn * BM + wc * 32 + 4 * fq;
        float* rp = P + ((size_t)ks * 1024 + (size_t)b * 256 + wr * 64 + fr) * 1024 + col0;
#pragma unroll
        for (int ai = 0; ai < 2; ++ai)
#pragma unroll
            for (int m = 0; m < 4; ++m) {
#pragma unroll
                for (int bj = 0; bj < 2; ++bj)
#pragma unroll
                    for (int n = 0; n < 2; ++n) *(f32x4*)(rp + bj * HALF + n * 16) = acc[ai][bj][m][n];
                rp += (m == 3 ? 80 : 16) * 1024; asm volatile("" : "+v"(rp)); }
    }
};
struct EpiBf16N {
    static constexpr bool PERM = true, AFTER_DRAIN = false; static constexpr int TAG = 33;
    bf16_t* O; int ldc; const float* bias; int nb; const PG8_LAS float* rtab; const float* rowss; const float* qn; const float* kn; const float* rope; float qscale;
    __device__ __forceinline__ void operator()(const f32x4 (&acc)[2][2][4][2], const Unit& u, int wr, int wc, int fr, int fq) const {
        asm volatile("" : "+v"(fr), "+v"(fq));
        const int b = u.pm / 33, p = u.pm % 33, bb = (p == 0) ? 4 : b;
        const int row0 = u.pm * BM + wr * 64 + fr, col0 = u.pn * BM + wc * 32 + 8 * fq;
        f32x4 bv[2][2];
#pragma unroll
        for (int bj = 0; bj < 2; ++bj)
#pragma unroll
            for (int n = 0; n < 2; ++n) bv[bj][n] = *(const f32x4*)(bias + (size_t)bb * nb + col0 + bj * HALF + 4 * n);
        if (u.pn >= 1 && u.pn <= 3) {
            const int hh = 4 * (u.pn - 1) + wc;
            const int dlo = (fq < 2) ? 8 * fq : 8 * fq + 16;
            bf16_t* obase = O + 256 + hh * 64 + dlo;
            const bool normed = hh < 10, isq = hh < 8;
            f32x4 g1[2], g2[2];
#pragma unroll
            for (int n = 0; n < 2; ++n) { const float* gp = (isq ? qn : kn) + dlo + 4 * n; const float sc = isq ? qscale : 1.0f;
                g1[n] = normed ? *(const f32x4*)gp * sc : (f32x4){1.f, 1.f, 1.f, 1.f}; g2[n] = normed ? *(const f32x4*)(gp + 16) * sc : (f32x4){1.f, 1.f, 1.f, 1.f}; }
#pragma unroll
            for (int ai = 0; ai < 2; ++ai)
#pragma unroll
                for (int m = 0; m < 4; ++m) { const int rl = ai * HALF + wr * 64 + m * 16 + fr; const size_t R = (size_t)u.pm * BM + rl; const float ri = (u.ord < 12) ? rtab[u.ord * 256 + rl] : row_rinv(rowss, R, fq);
                    f32x4 v1[2], v2[2];
#pragma unroll
                    for (int n = 0; n < 2; ++n) { v1[n] = acc[ai][0][m][n] * ri + bv[0][n]; v2[n] = acc[ai][1][m][n] * ri + bv[1][n]; }
                    if (normed) {
                        float ss = 0.f;
#pragma unroll
                        for (int n = 0; n < 2; ++n) ss += ((v1[n][0] * v1[n][0] + v1[n][1] * v1[n][1]) + (v1[n][2] * v1[n][2] + v1[n][3] * v1[n][3])) + ((v2[n][0] * v2[n][0] + v2[n][1] * v2[n][1]) + (v2[n][2] * v2[n][2] + v2[n][3] * v2[n][3]));
                        ss = xl_sumx32(xl_sumx16(ss));
                        const float hr = 1.0f / sqrtf(ss * (1.0f / 64.0f) + 1e-6f);
#pragma unroll
                        for (int n = 0; n < 2; ++n) { v1[n] = v1[n] * hr * g1[n]; v2[n] = v2[n] * hr * g2[n]; }
                        if (p != 0) {
                            const float* rp = rope + ((size_t)(256 * (p - 1) + rl) * 32 + 8 * fq) * 2;
#pragma unroll
                            for (int n = 0; n < 2; ++n) { const f32x4 c0 = *(const f32x4*)(rp + 8 * n), c1 = *(const f32x4*)(rp + 8 * n + 4);
                                const f32x4 cs = (f32x4){c0[0], c0[2], c1[0], c1[2]}, sn = (f32x4){c0[1], c0[3], c1[1], c1[3]};
                                const f32x4 o1 = v1[n] * cs - v2[n] * sn, o2 = v1[n] * sn + v2[n] * cs; v1[n] = o1; v2[n] = o2; }
                        }
                    }
                    u32x4 w; w.x = cvt_pk_bf16(v1[0][0], v1[0][1]); w.y = cvt_pk_bf16(v1[0][2], v1[0][3]); w.z = cvt_pk_bf16(v1[1][0], v1[1][1]); w.w = cvt_pk_bf16(v1[1][2], v1[1][3]);
                    *(u32x4*)(obase + R * ldc) = w;
                    w.x = cvt_pk_bf16(v2[0][0], v2[0][1]); w.y = cvt_pk_bf16(v2[0][2], v2[0][3]); w.z = cvt_pk_bf16(v2[1][0], v2[1][1]); w.w = cvt_pk_bf16(v2[1][2], v2[1][3]);
                    *(u32x4*)(obase + R * ldc + 16) = w; }
            return;
        }
#pragma unroll
        for (int ai = 0; ai < 2; ++ai)
#pragma unroll
            for (int m = 0; m < 4; ++m) { const size_t R = (size_t)(row0 + ai * HALF + m * 16); const float ri = (u.ord < 12) ? rtab[u.ord * 256 + ai * HALF + wr * 64 + m * 16 + fr] : row_rinv(rowss, R, fq); bf16_t* rowp = O + R * ldc + col0;
#pragma unroll
                for (int bj = 0; bj < 2; ++bj) { const f32x4 v0 = acc[ai][bj][m][0] * ri + bv[bj][0], v1 = acc[ai][bj][m][1] * ri + bv[bj][1];
                    u32x4 w; w.x = cvt_pk_bf16(v0[0], v0[1]); w.y = cvt_pk_bf16(v0[2], v0[3]); w.z = cvt_pk_bf16(v1[0], v1[1]); w.w = cvt_pk_bf16(v1[2], v1[3]);
                    *(u32x4*)(rowp + bj * HALF) = w; } }
    }
};
struct EpiSwiGLU {
    static constexpr bool PERM = true, AFTER_DRAIN = false; static constexpr int TAG = 34;
    bf16_t* O; int ldc; const float* bias; int nb; const PG8_LAS float* rtab; const float* rowss;
    __device__ __forceinline__ void operator()(const f32x4 (&acc)[2][2][4][2], const Unit& u, int wr, int wc, int fr, int fq) const {
        asm volatile("" : "+v"(fr), "+v"(fq));
        const int b = u.pm / 33, p = u.pm % 33, bb = (p == 0) ? 4 : b;
        const int row0 = u.pm * BM + wr * 64 + fr, col0 = u.pn * HALF + wc * 32 + 8 * fq, bcol0 = u.pn * BM + wc * 32 + 8 * fq;
        f32x4 bv[2][2];
#pragma unroll
        for (int bj = 0; bj < 2; ++bj)
#pragma unroll
            for (int n = 0; n < 2; ++n) bv[bj][n] = *(const f32x4*)(bias + (size_t)bb * nb + bcol0 + bj * HALF + 4 * n);
#pragma unroll
        for (int ai = 0; ai < 2; ++ai)
#pragma unroll
            for (int m = 0; m < 4; ++m) { const size_t R = (size_t)(row0 + ai * HALF + m * 16); const float ri = (u.ord < 12) ? rtab[u.ord * 256 + ai * HALF + wr * 64 + m * 16 + fr] : row_rinv(rowss, R, fq); bf16_t* rowp = O + R * ldc + col0;
                float hv[8];
#pragma unroll
                for (int n = 0; n < 2; ++n)
#pragma unroll
                    for (int e = 0; e < 4; ++e) { const float g = acc[ai][0][m][n][e] * ri + bv[0][n][e], up = acc[ai][1][m][n][e] * ri + bv[1][n][e];
                        hv[n * 4 + e] = g * up * __builtin_amdgcn_rcpf(1.0f + __builtin_amdgcn_exp2f(-1.44269504089f * g)); }
                u32x4 w; w.x = cvt_pk_bf16(hv[0], hv[1]); w.y = cvt_pk_bf16(hv[2], hv[3]); w.z = cvt_pk_bf16(hv[4], hv[5]); w.w = cvt_pk_bf16(hv[6], hv[7]);
                *(u32x4*)rowp = w; }
    }
};
}
#ifndef PG8_SP2
#define PG8_SP2 true
#endif
#ifndef PG8_ALIGN
#define PG8_ALIGN true
#endif
#include <hip/hip_bf16.h>
#include <cmath>
namespace attn_body {
using bf16=__hip_bfloat16;
using bf16x8=__attribute__((ext_vector_type(8)))short;
using s16x4=__attribute__((ext_vector_type(4)))short;
using f32x16=__attribute__((ext_vector_type(16)))float;
using u32x4=__attribute__((ext_vector_type(4)))unsigned;
constexpr int D=64,PQ=2304,PO=1280;
constexpr int NW=8,QBLK=32,QB=QBLK*NW,KVBLK=64;
constexpr int ATTN_UNIT_ROWS=QB;
__device__ __forceinline__ int crow(int r,int hi){return (r&3)+8*(r>>2)+4*hi;}
#define SBAR() __builtin_amdgcn_sched_barrier(0)
constexpr int NSLOT=3, SLOTB=8192;
constexpr int LDS_K=0, LDS_V=NSLOT*SLOTB, LDS_WS=2*NSLOT*SLOTB, LDS_OST=LDS_WS+NW*64*4, LDS_BYTES=LDS_OST+NW*4096;
constexpr float C2=0.125f*1.4426950408889634f;
__device__ __forceinline__ void glds16(const void*gsrc,unsigned lds_dst){unsigned keep;
  asm volatile("s_mov_b32 %0, m0\n\ts_mov_b32 m0, %2\n\ts_nop 0\n\tglobal_load_lds_dwordx4 %1, off\n\ts_mov_b32 m0, %0":"=&s"(keep):"v"(gsrc),"s"(lds_dst):"memory");}
__device__ __forceinline__ float max3f(float a,float b,float c){float r;asm("v_max3_f32 %0, %1, %2, %3":"=v"(r):"v"(a),"v"(b),"v"(c));return r;}
__device__ __forceinline__ float max2f(float a,float b){float r;asm("v_max_f32_e32 %0, %1, %2":"=v"(r):"v"(a),"v"(b));return r;}
__device__ __forceinline__ float fadd_s(float a,float b){float r;asm("v_add_f32_e32 %0, %1, %2":"=v"(r):"v"(a),"v"(b));return r;}
__device__ __forceinline__ float fsub_s(float a,float b){float r;asm("v_sub_f32_e32 %0, %1, %2":"=v"(r):"v"(a),"v"(b));return r;}
typedef float f32x2_t __attribute__((ext_vector_type(2))); typedef __bf16 bf16x2_t __attribute__((ext_vector_type(2)));
__device__ __forceinline__ unsigned cvtpk_s(float lo,float hi){f32x2_t v={lo,hi};bf16x2_t b=__builtin_convertvector(v,bf16x2_t);return __builtin_bit_cast(unsigned,b);}
#define WAIT_BAR(N) asm volatile("s_waitcnt vmcnt(" #N ") lgkmcnt(0)\n\ts_barrier":::"memory")

__device__ __forceinline__ void qkt(f32x16&p0,f32x16&p1,const char*Kslot,const bf16x8*qr,const f32x16&negm,int r32,int hi){
  const char*kb=Kslot+hi*1024+r32*16;
  #pragma unroll
  for(int d0=0;d0<4;++d0){
    const bf16x8 b0=*reinterpret_cast<const bf16x8*>(kb+d0*2048);
    const bf16x8 b1=*reinterpret_cast<const bf16x8*>(kb+d0*2048+512);
    if(d0==0){p0=__builtin_amdgcn_mfma_f32_32x32x16_bf16(b0,qr[0],negm,0,0,0);p1=__builtin_amdgcn_mfma_f32_32x32x16_bf16(b1,qr[0],negm,0,0,0);}
    else{p0=__builtin_amdgcn_mfma_f32_32x32x16_bf16(b0,qr[d0],p0,0,0,0);p1=__builtin_amdgcn_mfma_f32_32x32x16_bf16(b1,qr[d0],p1,0,0,0);}}
}
typedef __attribute__((address_space(3))) const char* lds_cptr;
typedef short v4i16_t __attribute__((ext_vector_type(4)));
__device__ __forceinline__ void kload8(bf16x8*kf,lds_cptr kp){
  kf[0]=*(const __attribute__((address_space(3))) bf16x8*)(kp);      kf[1]=*(const __attribute__((address_space(3))) bf16x8*)(kp+512);
  kf[2]=*(const __attribute__((address_space(3))) bf16x8*)(kp+2048); kf[3]=*(const __attribute__((address_space(3))) bf16x8*)(kp+2560);
  kf[4]=*(const __attribute__((address_space(3))) bf16x8*)(kp+4096); kf[5]=*(const __attribute__((address_space(3))) bf16x8*)(kp+4608);
  kf[6]=*(const __attribute__((address_space(3))) bf16x8*)(kp+6144); kf[7]=*(const __attribute__((address_space(3))) bf16x8*)(kp+6656);
}
__device__ __forceinline__ void kload2(bf16x8*kf,lds_cptr kp,int j){ kf[2*j]=*(const __attribute__((address_space(3))) bf16x8*)(kp+j*2048); kf[2*j+1]=*(const __attribute__((address_space(3))) bf16x8*)(kp+j*2048+512); }
__device__ __forceinline__ s16x4 vtr(lds_cptr p){ return __builtin_bit_cast(s16x4,__builtin_amdgcn_ds_read_tr16_b64_v4i16((__attribute__((address_space(3))) v4i16_t*)p)); }
__device__ __forceinline__ float rowmax(const f32x16&p0,const f32x16&p1){
  float a=max3f(p0[0],p0[1],p1[0]),b=max3f(p0[2],p0[3],p1[1]);a=max3f(a,p1[2],p1[3]);
  #pragma unroll
  for(int r=4;r<16;r+=4){a=max3f(a,p0[r],p0[r+1]);b=max3f(b,p0[r+2],p0[r+3]);a=max3f(a,p1[r],p1[r+1]);b=max3f(b,p1[r+2],p1[r+3]);}
  const float m=max2f(a,b);
  auto rr=__builtin_amdgcn_permlane32_swap(__float_as_uint(m),__float_as_uint(m),false,false);
  return max2f(__uint_as_float(rr[0]),__uint_as_float(rr[1]));
}
__device__ __forceinline__ void pv(f32x16*o,int vb,bf16x8 pa0,bf16x8 pa1,bf16x8 pa2,bf16x8 pa3){
  #pragma unroll
  for(int d0=0;d0<2;++d0){s16x4 lo[4],hi[4];
    #pragma unroll
    for(int ks=0;ks<4;++ks){
      asm volatile("ds_read_b64_tr_b16 %0,%1 offset:%c2":"=&v"(lo[ks]):"v"(vb),"i"(d0*4096+ks*1024):"memory");
      asm volatile("ds_read_b64_tr_b16 %0,%1 offset:%c2":"=&v"(hi[ks]):"v"(vb),"i"(d0*4096+ks*1024+512):"memory");}
    asm volatile("s_waitcnt lgkmcnt(0)":::"memory");SBAR();
    #define PK(k) (bf16x8){lo[k][0],lo[k][1],lo[k][2],lo[k][3],hi[k][0],hi[k][1],hi[k][2],hi[k][3]}
    o[d0]=__builtin_amdgcn_mfma_f32_32x32x16_bf16(pa0,PK(0),o[d0],0,0,0);
    o[d0]=__builtin_amdgcn_mfma_f32_32x32x16_bf16(pa1,PK(1),o[d0],0,0,0);
    o[d0]=__builtin_amdgcn_mfma_f32_32x32x16_bf16(pa2,PK(2),o[d0],0,0,0);
    o[d0]=__builtin_amdgcn_mfma_f32_32x32x16_bf16(pa3,PK(3),o[d0],0,0,0);
    #undef PK
  }
}

#ifndef ATTN_STORE16
#define ATTN_STORE16(p,v) (*(u32x4*)(p)=(v))
#endif
template<int THRL> __device__ __forceinline__ void attn_unit(const bf16*Qu,const bf16*__restrict__ Kh,const bf16*__restrict__ Vh,bf16*Ou,const int NT,char*shm,int tid){
  const int lane=tid&63,r32=lane&31,hi=lane>>5; const int wid=__builtin_amdgcn_readfirstlane(tid>>6);
  const bf16*Qw=Qu+(long)(wid*QBLK)*PQ;
  const unsigned lds0=(unsigned)(uintptr_t)shm;
  float*wsf=(float*)(shm+LDS_WS)+wid*64;
  const bf16*ksrc=Kh+(long)lane*PQ+wid*8;
  const bf16*vsrc=Vh+(long)(16*(wid&3)+(lane>>2))*PQ+(wid>>2)*32+(lane&3)*8;
  const unsigned kdst=lds0+LDS_K+wid*1024, vdst=lds0+LDS_V+wid*1024;
  #define DMA_K(t,slot) glds16(ksrc+(long)(t)*KVBLK*PQ,(unsigned)__builtin_amdgcn_readfirstlane(kdst+(slot)))
  #define DMA_V(t,slot) glds16(vsrc+(long)(t)*KVBLK*PQ,(unsigned)__builtin_amdgcn_readfirstlane(vdst+(slot)))
  const int vb0=(int)(lds0+LDS_V)+((lane>>4)&1)*32+(lane&3)*8+(4*hi+((lane&15)>>2))*64;
  const char*Kbase=shm+LDS_K; bf16x8 kf[8];
  const lds_cptr shm3=(lds_cptr)shm; const lds_cptr kp0=shm3+LDS_K+hi*1024+r32*16; const lds_cptr vp0=shm3+LDS_V+((lane>>4)&1)*32+(lane&3)*8+(4*hi+((lane&15)>>2))*64;
  DMA_K(0,0);DMA_V(0,0);DMA_K(1,SLOTB);
  bf16x8 qr[4];
  #pragma unroll
  for(int d0=0;d0<4;++d0)qr[d0]=*reinterpret_cast<const bf16x8*>(&Qw[(long)r32*PQ+d0*16+hi*8]);
  float mhat=0.f,l_reg=0.f;f32x16 o[2];o[0]=f32x16{};o[1]=f32x16{};f32x16 negm=f32x16{};asm volatile("":"+v"(negm));
  #define CMASK(P0,P1,t) do{}while(0)
  bool resc=false;
  #define START(P0,P1) do{ const float rm=rowmax(P0,P1); resc=false; \
    { const float dl=rm; mhat=fadd_s(mhat,dl); \
      _Pragma("unroll") for(int r=0;r<16;++r){P0[r]=fsub_s(P0[r],dl);P1[r]=fsub_s(P1[r],dl);} \
      _Pragma("unroll") for(int r=0;r<16;++r)negm[r]=-mhat; asm volatile("":"+v"(negm)); } \
    _Pragma("unroll") for(int r=0;r<16;++r)P0[r]=__builtin_amdgcn_exp2f(P0[r]); }while(0)
  #define RESC() do{ if(resc){ asm volatile("s_waitcnt lgkmcnt(0)":::"memory"); \
      _Pragma("unroll") for(int d_=0;d_<2;++d_) _Pragma("unroll") for(int r=0;r<16;++r)o[d_][r]*=wsf[crow(r,hi)]; } }while(0)
  f32x16 pA0,pA1,pB0,pB1;
  int sl_prev=0,sl_cur=0,sl_next=SLOTB;
  #define ROT() do{sl_prev=sl_cur;sl_cur=sl_next;sl_next=(sl_next==(NSLOT-1)*SLOTB)?0:sl_next+SLOTB;}while(0)
  DMA_K(2,2*SLOTB);
  WAIT_BAR(3);
  qkt(pA0,pA1,Kbase,qr,negm,r32,hi);asm volatile("s_nop 15\n\ts_nop 7":"+v"(pA0),"+v"(pA1));CMASK(pA0,pA1,0);
  START(pA0,pA1);
  _Pragma("unroll") for(int r=0;r<16;++r)pA1[r]=__builtin_amdgcn_exp2f(pA1[r]);
  WAIT_BAR(0);
  DMA_K(3,0);DMA_V(1,SLOTB);
  ROT();
  kload8(kf,kp0+sl_cur);
  WAIT_BAR(2);
  s16x4 vlo[8],vhi[8]; u32x4 pw0,pw1,pw2,pw3;
  #define PKW(P,B) cvtpk_s(P[B],P[B+1])
  #define PAF(k) __builtin_bit_cast(bf16x8,pw##k)
  #define VFR(i) (bf16x8){vlo[i][0],vlo[i][1],vlo[i][2],vlo[i][3],vhi[i][0],vhi[i][1],vhi[i][2],vhi[i][3]}
  #define PIN(x) asm volatile("":"+v"(x))
  #define MX3(a,b,c) __builtin_fmaxf(__builtin_fmaxf((a),(b)),(c))
  #define GAPA(MF,A0,A1,A2,A3,W0,W1,PW) do{ MF; sacc+=A0; sacc+=A1; sacc+=A2; sacc+=A3; PIN(sacc); W0; W1; PIN(PW); SBAR(); }while(0)
  #define EX(v) __builtin_amdgcn_exp2f(v)
  #define GAPB(MF,X,B) do{ MF; X[B]=EX(X[B]); X[B+1]=EX(X[B+1]); X[B+2]=EX(X[B+2]); X[B+3]=EX(X[B+3]); PIN(X); SBAR(); }while(0)
  #define VRD(i) do{ vlo[i]=vtr(vp_+(((i)>>2)*4096+((i)&3)*1024)); vhi[i]=vtr(vp_+(((i)>>2)*4096+((i)&3)*1024+512)); }while(0)
  #define KRD(G,j) do{ if(G){ kload2(kf,kp0+sl_next,j); SBAR(); } }while(0)
  #define STEP(C0,C1,P0,P1,t,GK,GV,GL) do{ SBAR(); \
    const lds_cptr vp_=vp0+sl_prev; \
    VRD(0); SBAR(); float sacc=(P0[0]+P0[1]); \
    GAPA(C0=__builtin_amdgcn_mfma_f32_32x32x16_bf16(kf[0],qr[0],negm,0,0,0), P0[2],P0[3],P0[4],P0[5],     pw0[0]=PKW(P0,0), pw0[1]=PKW(P0,2), pw0); \
    VRD(4); SBAR(); GAPA(C1=__builtin_amdgcn_mfma_f32_32x32x16_bf16(kf[1],qr[0],negm,0,0,0), P0[6],P0[7],P0[8],P0[9],     pw0[2]=PKW(P0,4), pw0[3]=PKW(P0,6), pw0); \
    VRD(1); SBAR(); GAPA(C0=__builtin_amdgcn_mfma_f32_32x32x16_bf16(kf[2],qr[1],C0,0,0,0),   P0[10],P0[11],P0[12],P0[13], pw1[0]=PKW(P0,8), pw1[1]=PKW(P0,10), pw1); \
    VRD(5); SBAR(); GAPA(C1=__builtin_amdgcn_mfma_f32_32x32x16_bf16(kf[3],qr[1],C1,0,0,0),   P0[14],P0[15],P1[0],P1[1],   pw1[2]=PKW(P0,12),pw1[3]=PKW(P0,14), pw1); \
    VRD(2); SBAR(); GAPA(C0=__builtin_amdgcn_mfma_f32_32x32x16_bf16(kf[4],qr[2],C0,0,0,0),   P1[2],P1[3],P1[4],P1[5],     pw2[0]=PKW(P1,0), pw2[1]=PKW(P1,2), pw2); \
    VRD(6); SBAR(); GAPA(C1=__builtin_amdgcn_mfma_f32_32x32x16_bf16(kf[5],qr[2],C1,0,0,0),   P1[6],P1[7],P1[8],P1[9],     pw2[2]=PKW(P1,4), pw2[3]=PKW(P1,6), pw2); \
    VRD(3); SBAR(); GAPA(C0=__builtin_amdgcn_mfma_f32_32x32x16_bf16(kf[6],qr[3],C0,0,0,0),   P1[10],P1[11],P1[12],P1[13], pw3[0]=PKW(P1,8), pw3[1]=PKW(P1,10), pw3); \
    VRD(7); SBAR(); GAPA(C1=__builtin_amdgcn_mfma_f32_32x32x16_bf16(kf[7],qr[3],C1,0,0,0),   P1[14],P1[15],0.f,0.f,       pw3[2]=PKW(P1,12),pw3[3]=PKW(P1,14), pw3); \
    l_reg+=sacc; \
    if(GK){DMA_K((t)+3,sl_cur);} if(GV){DMA_V((t)+1,sl_next);} \
    CMASK(C0,C1,t); \
    { float a=MX3(C0[0],C0[1],C1[0]),b=MX3(C0[2],C0[3],C1[1]); a=MX3(a,C1[2],C1[3]); \
      _Pragma("unroll") for(int r=4;r<16;r+=4){a=MX3(a,C0[r],C0[r+1]);b=MX3(b,C0[r+2],C0[r+3]);a=MX3(a,C1[r],C1[r+1]);b=MX3(b,C1[r+2],C1[r+3]);} \
      float rm=__builtin_fmaxf(a,b); { auto rr=__builtin_amdgcn_permlane32_swap(__float_as_uint(rm),__float_as_uint(rm),false,false); rm=__builtin_fmaxf(__uint_as_float(rr[0]),__uint_as_float(rr[1])); } \
      resc=false; \
      if(__builtin_expect(__any(rm>(float)THRL),0)){ const float dl=__builtin_fmaxf(rm,0.f); mhat+=dl; \
        _Pragma("unroll") for(int r=0;r<16;++r){C0[r]-=dl;C1[r]-=dl;} \
        _Pragma("unroll") for(int r=0;r<16;++r)negm[r]=-mhat; asm volatile("":"+v"(negm)); \
        const float f=__builtin_amdgcn_exp2f(-dl); l_reg*=f; if(hi==0)wsf[r32]=f; resc=true; } } \
    SBAR(); \
    GAPB(o[0]=__builtin_amdgcn_mfma_f32_32x32x16_bf16(PAF(0),VFR(0),o[0],0,0,0), C0,0); \
    GAPB(o[1]=__builtin_amdgcn_mfma_f32_32x32x16_bf16(PAF(0),VFR(4),o[1],0,0,0), C0,4); \
    KRD(GL,0); GAPB(o[0]=__builtin_amdgcn_mfma_f32_32x32x16_bf16(PAF(1),VFR(1),o[0],0,0,0), C0,8); \
    KRD(GL,1); GAPB(o[1]=__builtin_amdgcn_mfma_f32_32x32x16_bf16(PAF(1),VFR(5),o[1],0,0,0), C0,12); \
    KRD(GL,2); GAPB(o[0]=__builtin_amdgcn_mfma_f32_32x32x16_bf16(PAF(2),VFR(2),o[0],0,0,0), C1,0); \
    KRD(GL,3); GAPB(o[1]=__builtin_amdgcn_mfma_f32_32x32x16_bf16(PAF(2),VFR(6),o[1],0,0,0), C1,4); \
    GAPB(o[0]=__builtin_amdgcn_mfma_f32_32x32x16_bf16(PAF(3),VFR(3),o[0],0,0,0), C1,8); \
    GAPB(o[1]=__builtin_amdgcn_mfma_f32_32x32x16_bf16(PAF(3),VFR(7),o[1],0,0,0), C1,12); \
    }while(0)
  int t=1;
  #undef CMASK
  #define CMASK(P0,P1,t) do{}while(0)
  for(;t+5<NT;t+=2){
    STEP(pB0,pB1,pA0,pA1,t,true,true,true);     WAIT_BAR(2); RESC(); ROT();
    STEP(pA0,pA1,pB0,pB1,t+1,true,true,true);   WAIT_BAR(2); RESC(); ROT();
  }
  #undef CMASK
  #define CMASK(P0,P1,t) do{}while(0)
  #define ENDW(tt) do{ if((tt)+3<NT){WAIT_BAR(2);} else if((tt)+2<NT){WAIT_BAR(1);} else {WAIT_BAR(0);} }while(0)
  for(;t+1<NT;t+=2){
    STEP(pB0,pB1,pA0,pA1,t,(t+3<NT),(t+1<NT),(t+1<NT));       ENDW(t);   RESC(); ROT();
    STEP(pA0,pA1,pB0,pB1,t+1,(t+4<NT),(t+2<NT),(t+2<NT));     ENDW(t+1); RESC(); ROT();
  }
  STEP(pB0,pB1,pA0,pA1,NT-1,false,false,false); RESC();
  { float sacc=pB0[0]+pB0[1]; _Pragma("unroll") for(int r=2;r<16;++r)sacc+=pB0[r]; _Pragma("unroll") for(int r=0;r<16;++r)sacc+=pB1[r]; l_reg+=sacc;
    pw0=(u32x4){PKW(pB0,0),PKW(pB0,2),PKW(pB0,4),PKW(pB0,6)};pw1=(u32x4){PKW(pB0,8),PKW(pB0,10),PKW(pB0,12),PKW(pB0,14)};pw2=(u32x4){PKW(pB1,0),PKW(pB1,2),PKW(pB1,4),PKW(pB1,6)};pw3=(u32x4){PKW(pB1,8),PKW(pB1,10),PKW(pB1,12),PKW(pB1,14)};
    SBAR(); pv(o,vb0+sl_cur,PAF(0),PAF(1),PAF(2),PAF(3)); }
  #undef PKW
  #undef PAF
  #undef VFR
  #undef PIN
  #undef MX3
  #undef GAPA
  #undef GAPB
  #undef EX
  #undef VRD
  #undef KRD
  #undef STEP
  #undef ENDW
  {auto rr=__builtin_amdgcn_permlane32_swap(__float_as_uint(l_reg),__float_as_uint(l_reg),false,false);l_reg=__uint_as_float(rr[0])+__uint_as_float(rr[1]);}
  if(hi==0)wsf[32+r32]=l_reg;asm volatile("s_waitcnt lgkmcnt(0)":::"memory");
  float rli[16];
  #pragma unroll
  for(int r=0;r<16;++r)rli[r]=__builtin_amdgcn_rcpf(wsf[32+crow(r,hi)]);
  bf16*Ow=Ou+(long)(wid*QBLK)*PO;
  { bf16*stg=(bf16*)(shm+LDS_OST)+wid*2048;
    #pragma unroll
    for(int r=0;r<16;++r){const int orow=crow(r,hi);
      #pragma unroll
      for(int d0=0;d0<2;++d0)stg[orow*64+d0*32+r32]=__float2bfloat16(o[d0][r]*rli[r]);}
    asm volatile("s_waitcnt lgkmcnt(0)":::"memory");
    #pragma unroll
    for(int i=0;i<4;++i){const int row=i*8+(lane>>3),ch=lane&7; const u32x4 v=*(const u32x4*)(stg+row*64+ch*8); ATTN_STORE16(Ow+(long)row*PO+ch*8,v);} }
  asm volatile("s_waitcnt lgkmcnt(0)\n\ts_barrier":::"memory");
  #undef DMA_K
  #undef DMA_V
  #undef CMASK
  #undef START
  #undef RESC
  #undef ROT
}
constexpr int ATTN_LDS_BYTES=LDS_BYTES;
#undef SBAR
#undef WAIT_BAR
}

constexpr int NWAVES = 8, NTHREADS = NWAVES * 64;
constexpr int DM = 1024, NB = 4, SEQ = 8192, CTXL = 256, DEPTH = 4;
constexpr int TPB = SEQ + CTXL;
constexpr int MROWS = NB * TPB;
constexpr int PROJ = 2304, DFF = 2816, KMIX = 1280;
constexpr int OFF_Q = 256, OFF_K = 768, OFF_V = 896, OFF_FF = 1024, OFF_FB = 1280, OFF_I = 1536, OFF_HQ = 1792, OFF_G = 2048;
constexpr int MIX_P = 0, MIX_Q = 256, MIX_A = 512, MIX_R = 1024;
constexpr float EPS = 1e-6f;
constexpr float QSCALE = 0.125f * 1.4426950408889634f;
constexpr int MOD_SH_A = 0, MOD_SC_A = 1024, MOD_G_A = 2048, MOD_SH_F = 3072, MOD_SC_F = 4096, MOD_G_F = 5120;

constexpr size_t MiB = 1u << 20;
constexpr size_t WS_CTL = 0, CTL_ZERO_BYTES = 1 * MiB;
constexpr size_t WS_MODS = 1 * MiB;
constexpr size_t WS_LB = WS_MODS + 512 * 1024;
constexpr size_t WS_TW = WS_LB + 65536;
constexpr size_t WS_FT128 = WS_TW + 65536;
constexpr size_t WS_W64F = WS_FT128 + 65536;
constexpr size_t WS_CT256 = WS_W64F + 16384;
static_assert(WS_CT256 + 262144 <= 2 * MiB, "tables");
constexpr size_t WS_ROPE = 2 * MiB;
constexpr size_t WS_TF = 4 * MiB;
constexpr size_t WS_XC = 6 * MiB;
constexpr size_t WS_WIN = 10 * MiB;
constexpr size_t WS_WOUT = 28 * MiB;
constexpr size_t WS_WGU = 38 * MiB;
constexpr size_t WS_WDN = 82 * MiB;
constexpr size_t WS_XB = 104 * MiB;
constexpr size_t WS_HGS = 170 * MiB;
constexpr size_t WS_UX = 236 * MiB;
constexpr size_t WS_MIX = 385 * MiB;
constexpr size_t WS_H = WS_UX;
constexpr size_t WS_HGG = 468 * MiB;
constexpr size_t WS_ROWSS = 470 * MiB;
constexpr size_t WS_BIASA = 473 * MiB;
constexpr size_t WS_BIASF = 474 * MiB;
constexpr size_t WS_END = 475 * MiB;
static_assert(WS_UX + (size_t)MROWS * PROJ * 2 <= WS_MIX && WS_MIX + (size_t)MROWS * KMIX * 2 <= WS_END && WS_H + (size_t)MROWS * DFF * 2 <= WS_END, "d_ws map");
static_assert(WS_XB + (size_t)MROWS * DM * 2 <= WS_HGS && WS_HGS + (size_t)2 * MROWS * 256 * 4 <= WS_UX, "d_ws map 2");
constexpr int CW_TMO = 0, CW_CODE = 1, CW_BAR = 4096;

constexpr int RING_OFF = 0, RING_BYTES = 131072;
constexpr int LDSCTL_OFF = RING_BYTES, MISC_OFF = LDSCTL_OFF + 320;
constexpr int RINV_OFF = LDSCTL_OFF + 512, RINV_SLOTS = 12;
constexpr int LDS_BYTES = 147456;
static_assert(RINV_OFF + RINV_SLOTS * 1024 <= LDS_BYTES, "LDS map");

#define GAS __attribute__((address_space(1)))
#define LAS __attribute__((address_space(3)))
typedef unsigned short bf16;
typedef unsigned v4u __attribute__((ext_vector_type(4)));
typedef float f32x4 __attribute__((ext_vector_type(4)));
typedef short bf16x8 __attribute__((ext_vector_type(8)));
typedef GAS unsigned gu32;
typedef GAS unsigned long long gu64;
#define RLX_AGENT __ATOMIC_RELAXED, __HIP_MEMORY_SCOPE_AGENT
#define LDS_WAIT() asm volatile("s_waitcnt lgkmcnt(0)" ::: "memory")
#define VM_WAIT() asm volatile("s_waitcnt vmcnt(0)" ::: "memory")
__device__ __forceinline__ unsigned long long rt() { return __builtin_amdgcn_s_memrealtime(); }
__device__ __forceinline__ unsigned f2bf(float f) { unsigned u = __builtin_bit_cast(unsigned, f); return (u + 0x7fffu + ((u >> 16) & 1u)) >> 16; }
__device__ __forceinline__ unsigned pk2(float lo, float hi) { return f2bf(lo) | (f2bf(hi) << 16); }

#define XB_TMO      128
#define XB_XCNT(j)  (256  + 64 * (j))
#define XB_XSUB(j)  (1280 + 64 * (j))
#define XB_XGEN(j)  (2304 + 64 * (j))
#define XB_TOP      3328
#define XB_TOPGEN   3392
#define XCD_BAR_WORDS 3456
#define XB_SPIN_CAP (1u << 18)

__device__ __forceinline__ unsigned xb_ld(unsigned* p)              { return __hip_atomic_load(p, __ATOMIC_RELAXED, __HIP_MEMORY_SCOPE_AGENT); }
__device__ __forceinline__ unsigned xb_add(unsigned* p, unsigned v) { return __hip_atomic_fetch_add(p, v, __ATOMIC_RELAXED, __HIP_MEMORY_SCOPE_AGENT); }
__device__ __forceinline__ unsigned xb_xcc_id() { return (unsigned)__builtin_amdgcn_s_getreg((3 << 11) | 20) & 0xFu; }
#define XB_SPIN(cond, bar) do { unsigned _sp = 0; while (cond) { __builtin_amdgcn_s_sleep(1); \
    if ((++_sp & 255u) == 0u) { if (xb_ld(&(bar)[XB_TMO])) break; if (_sp > XB_SPIN_CAP) { atomicAdd(&(bar)[XB_TMO], 1u); break; } } } } while (0)

struct XcdBarrier {
    unsigned* bar; unsigned x;
    volatile LAS unsigned* st;
};

__device__ __forceinline__ XcdBarrier xcd_barrier_post(unsigned* bar, volatile LAS unsigned* st) {
    XcdBarrier b; b.bar = bar; b.x = xb_xcc_id(); b.st = st;
    if (threadIdx.x == 0) (void)xb_add(&bar[XB_XCNT(b.x)], 1u);
    return b;
}
__device__ __forceinline__ void xcd_barrier_complete(unsigned* bar, unsigned x, unsigned& nloc, unsigned& nx) {
    const unsigned G = gridDim.x * gridDim.y * gridDim.z;
    unsigned sum, cnt, mine, sp = 0u;
    for (;;) {
        sum = 0u; cnt = 0u; mine = 0u;
#pragma unroll
        for (unsigned j = 0; j < 16; ++j) { const unsigned c = xb_ld(&bar[XB_XCNT(j)]); sum += c; cnt += (c > 0u) ? 1u : 0u; mine = (j == x) ? c : mine; }
        if (sum == G) break;
        __builtin_amdgcn_s_sleep(1);
        if ((++sp & 255u) == 0u) { if (xb_ld(&bar[XB_TMO])) break; if (sp > XB_SPIN_CAP) { atomicAdd(&bar[XB_TMO], 1u); break; } }
    }
    nloc = mine > 0u ? mine : 1u; nx = cnt > 0u ? cnt : 1u;
}

__device__ __forceinline__ void xcd_barrier(const XcdBarrier& b) {
    asm volatile("s_waitcnt vmcnt(0)" ::: "memory");
    __syncthreads();
    if (threadIdx.x == 0) {
        unsigned* bar = b.bar;
        __builtin_amdgcn_s_waitcnt(0);
        unsigned nloc = b.st[0], nx = b.st[1];
        if (nloc == 0u) { xcd_barrier_complete(bar, b.x, nloc, nx); b.st[0] = nloc; b.st[1] = nx; }
        const unsigned old = xb_add(&bar[XB_XSUB(b.x)], 1u);
        const unsigned gen = old / nloc;
        if (old + 1u == (gen + 1u) * nloc) {
            __builtin_amdgcn_fence(__ATOMIC_RELEASE, "agent");
            asm volatile("s_waitcnt vmcnt(0)" ::: "memory");
            const unsigned og = xb_add(&bar[XB_TOP], 1u);
            const unsigned tg = og / nx;
            if (og + 1u == (tg + 1u) * nx) xb_add(&bar[XB_TOPGEN], 1u);
            else XB_SPIN(xb_ld(&bar[XB_TOPGEN]) == tg, bar);
            __builtin_amdgcn_fence(__ATOMIC_ACQUIRE, "agent");
            xb_add(&bar[XB_XGEN(b.x)], 1u);
            asm volatile("s_waitcnt vmcnt(0)" ::: "memory");
        } else {
            XB_SPIN(xb_ld(&bar[XB_XGEN(b.x)]) == gen, bar);
            __builtin_amdgcn_fence(__ATOMIC_ACQUIRE, "agent");
            asm volatile("s_waitcnt vmcnt(0)" ::: "memory");
        }
    }
    __syncthreads();
}

typedef float f32x2 __attribute__((ext_vector_type(2)));
typedef unsigned u32x2 __attribute__((ext_vector_type(2)));
typedef const GAS float* const __attribute__((address_space(4)))* kargs_t;
struct Frame {
    LAS unsigned char* lds;
    volatile LAS unsigned* MISC;
    int tid, lane, wave, vcu, G;
    unsigned long long dt, da;
    GAS unsigned char* ws; GAS float* outg;
    __device__ __forceinline__ float* out_() const { return (float*)outg; }
    __device__ __forceinline__ bf16* HN() const { return (bf16*)outg; }
    __device__ __forceinline__ const float* in(int i) const { return (const float*)(((kargs_t)__builtin_amdgcn_kernarg_segment_ptr())[i]); }
#define FIN(name, idx) __device__ __forceinline__ const float* name() const { return in(idx); }
    FIN(x, 0) FIN(c, 1) FIN(ctx, 2) FIN(c_ctx, 3) FIN(w_ada, 4) FIN(b_ada, 5) FIN(w_in, 6) FIN(w_four, 7) FIN(q_norm, 8) FIN(k_norm, 9) FIN(hg_lb, 10) FIN(hg_norm, 11) FIN(w_out, 12) FIN(w_gate, 13) FIN(w_up, 14) FIN(w_down, 15) FIN(final_norm, 16)
#undef FIN
#define FWS(type, name, off) __device__ __forceinline__ type* name() const { return (type*)(ws + (off)); }
    FWS(unsigned, ctlw, WS_CTL) FWS(float, MODS, WS_MODS) FWS(float, LB, WS_LB) FWS(f32x2, ROPE, WS_ROPE) FWS(float, TF, WS_TF) FWS(float, XC, WS_XC) FWS(float, HGS, WS_HGS) FWS(float, HGG, WS_HGG) FWS(float, ROWSS, WS_ROWSS) FWS(float, BIASA, WS_BIASA) FWS(float, BIASF, WS_BIASF)
    FWS(f32x2, TW, WS_TW) FWS(bf16, FT128, WS_FT128) FWS(bf16, W64F, WS_W64F) FWS(bf16, CT256, WS_CT256)
    FWS(bf16, WIN, WS_WIN) FWS(bf16, WOUT, WS_WOUT) FWS(bf16, WGU, WS_WGU) FWS(bf16, WDN, WS_WDN) FWS(bf16, XB, WS_XB) FWS(bf16, UX, WS_UX) FWS(bf16, MIX, WS_MIX) FWS(bf16, HB, WS_H)
#undef FWS
};
__device__ __forceinline__ float bf2f(unsigned short h) { return __builtin_bit_cast(float, (unsigned)h << 16); }
__device__ __forceinline__ float bflo(unsigned w) { return __builtin_bit_cast(float, w << 16); }
__device__ __forceinline__ float bfhi(unsigned w) { return __builtin_bit_cast(float, w & 0xffff0000u); }
__device__ __forceinline__ float wave_sum(float v) { return xl_sum64(v); }
__device__ __forceinline__ float sigmoidf_(float z) { return __builtin_amdgcn_rcpf(1.0f + __builtin_amdgcn_exp2f(-1.44269504089f * z)); }
__device__ __forceinline__ float siluf_(float z) { return z * sigmoidf_(z); }
__device__ __forceinline__ const float* xrow_ptr(const float* lat, const float* ctx, int R) {
    const int b = R / TPB, t = R - b * TPB;
    return (t < CTXL) ? ctx + ((size_t)b * CTXL + t) * DM : lat + ((size_t)b * SEQ + (t - CTXL)) * DM;
}

__host__ __device__ __forceinline__ int win_row(int c) {
    if (c < 256 || c >= 1024) return c;
    const int hh = (c - 256) >> 6, d = (c - 256) & 63, bj = (d >> 4) & 1, p = (d & 15) + ((d >> 5) << 4);
    return 256 * (1 + (hh >> 2)) + 128 * bj + 32 * (hh & 3) + p;
}
__device__ __forceinline__ void tr_item(const float* src, int ldsrc, bf16* dst, int ldt, LAS float* scr, int lane, int row16 = 16) {
#pragma unroll 1
    for (int h = 0; h < 4; ++h) { float tv[8];
#pragma unroll
        for (int i = 0; i < 8; ++i) tv[i] = src[(size_t)(2 * (8 * h + i) + (lane >> 5)) * ldsrc + (lane & 31)];
#pragma unroll
        for (int i = 0; i < 8; ++i) scr[(2 * (8 * h + i) + (lane >> 5)) * 33 + (lane & 31)] = tv[i]; }
    LDS_WAIT(); asm volatile("" ::: "memory");
    const int c = lane & 7;
#pragma unroll
    for (int j = 0; j < 4; ++j) { const int n = (lane >> 3) + 8 * j; const LAS float* s = scr + (8 * c) * 33 + n;
        v4u o; o.x = pk2(s[0 * 33], s[1 * 33]); o.y = pk2(s[2 * 33], s[3 * 33]); o.z = pk2(s[4 * 33], s[5 * 33]); o.w = pk2(s[6 * 33], s[7 * 33]);
        *(GAS v4u*)(dst + (size_t)(j < 2 ? n : n - 16 + row16) * ldt + 8 * c) = o; }
    LDS_WAIT(); asm volatile("" ::: "memory");
}
__device__ __forceinline__ void p0a_prologue(Frame& F) {
    const int gw = F.vcu * NWAVES + F.wave, NGW = F.G * NWAVES;
    const int gt = F.vcu * NTHREADS + F.tid, NGT = F.G * NTHREADS;
    LAS float* scr = (LAS float*)(F.lds + RING_OFF + F.wave * 12288);
    LAS float* sil = (LAS float*)(F.lds + RING_OFF + 98304);
    LAS f32x2* cs64 = (LAS f32x2*)(F.lds + RING_OFF + 98304 + 20480 + 10240);
    if (F.tid < 64) { const float a = (float)F.tid * (1.0f / 32.0f); cs64[F.tid] = (f32x2){cospif(a), sinpif(a)}; }
    for (int i = F.tid; i < 5 * DM; i += NTHREADS) { const int bb = i >> 10, k = i & 1023; const float v = (bb < 4) ? F.c()[bb * DM + k] : F.c_ctx()[k]; sil[i] = v / (1.0f + expf(-v)); }
    __syncthreads();
    {
        LAS float* part = (LAS float*)(F.lds + RING_OFF + 98304 + 20480);
        for (int it = F.vcu; it < DEPTH * 96; it += F.G) {
            const int l = it / 96, j = (it % 96) * 64 + F.lane;
            const float* wp = F.w_ada() + (size_t)l * DM * 6144 + (size_t)(128 * F.wave) * 6144 + j;
            float a0 = 0.f, a1 = 0.f, a2 = 0.f, a3 = 0.f, a4 = 0.f;
            float wn[16];
#pragma unroll
            for (int i = 0; i < 16; ++i) wn[i] = wp[(size_t)i * 6144];
            for (int k0 = 0; k0 < 128; k0 += 16) {
                float w[16];
#pragma unroll
                for (int i = 0; i < 16; ++i) w[i] = wn[i];
                if (k0 + 16 < 128) {
#pragma unroll
                    for (int i = 0; i < 16; ++i) wn[i] = wp[(size_t)(k0 + 16 + i) * 6144]; }
#pragma unroll
                for (int i = 0; i < 16; ++i) { const int k = 128 * F.wave + k0 + i; a0 += sil[k] * w[i]; a1 += sil[1024 + k] * w[i]; a2 += sil[2048 + k] * w[i]; a3 += sil[3072 + k] * w[i]; a4 += sil[4096 + k] * w[i]; }
            }
            LAS float* pw = part + F.wave * 320 + F.lane;
            pw[0] = a0; pw[64] = a1; pw[128] = a2; pw[192] = a3; pw[256] = a4;
            __syncthreads();
            if (F.tid < 320) { float s = 0.f;
#pragma unroll
                for (int ww = 0; ww < 8; ++ww) s += part[ww * 320 + F.tid];
                const int bb = F.tid >> 6, jj = (it % 96) * 64 + (F.tid & 63);
                F.MODS()[(size_t)l * 5 * 6144 + bb * 6144 + jj] = s + F.b_ada()[l * 6144 + jj]; }
            __syncthreads();
        }
    }
    constexpr int I_IN = 16 * 72, I_OUT = 12 * 32, I_G = 16 * 88, I_D = 44 * 32, I_L = I_IN + I_OUT + 2 * I_G + I_D;
    for (int it = gw; it < DEPTH * I_L; it += NGW) {
        const int l = it / I_L; int r = it % I_L;
        if (r < I_IN) { const int kb = r / 72, nb = r % 72;
            const int r0 = win_row(32 * nb), r16 = win_row(32 * nb + 16);
            tr_item(F.w_in() + (size_t)l * DM * PROJ + (size_t)(64 * kb) * PROJ + 32 * nb, PROJ, F.WIN() + (size_t)l * PROJ * DM + (size_t)r0 * DM + 64 * kb, DM, scr, F.lane, r16 - r0); continue; }
        r -= I_IN;
        if (r < I_OUT) { const int kb = r / 32, nb = r % 32;
            tr_item(F.w_out() + (size_t)l * DM * DM + (size_t)(256 + 64 * kb) * DM + 32 * nb, DM, F.WOUT() + (size_t)l * DM * KMIX + (size_t)(32 * nb) * KMIX + 512 + 64 * kb, KMIX, scr, F.lane); continue; }
        r -= I_OUT;
        if (r < 2 * I_G) { const int up = r / I_G, rr = r % I_G, kb = rr / 88, nb = rr % 88, n0 = 32 * nb;
            const float* W = (up ? F.w_up() : F.w_gate()) + (size_t)l * DM * DFF;
            const int drow = (n0 >> 7) * 256 + up * 128 + (n0 & 127);
            tr_item(W + (size_t)(64 * kb) * DFF + n0, DFF, F.WGU() + (size_t)l * 5632 * DM + (size_t)drow * DM + 64 * kb, DM, scr, F.lane); continue; }
        r -= 2 * I_G;
        { const int kb = r / 32, nb = r % 32;
            tr_item(F.w_down() + (size_t)l * DFF * DM + (size_t)(64 * kb) * DM + 32 * nb, DM, F.WDN() + (size_t)l * DM * DFF + (size_t)(32 * nb) * DFF + 64 * kb, DFF, scr, F.lane); }
    }
    for (int it = gt; it < DEPTH * 2 * 256 * 256; it += NGT) {
        const int jp = it & 255, gc = (it >> 8) & 255, s = (it >> 16) & 1, l = it >> 17, g = gc >> 6, cc = gc & 63;
        const float* wf = F.w_four() + (size_t)l * 65536 + (size_t)(g * 64) * 256 + jp;
        float a = 0.f;
        for (int m = 0; m < 64; ++m) { const f32x2 cs = cs64[(cc * m) & 63]; a += (s ? -cs.y : cs.x) * wf[m * 256]; }
        F.TF()[it] = a * 0.125f;
    }
    for (int it = gt; it < 2 * 256; it += NGT) {
        const int d = it >> 8, cc = it & 255; float v[DEPTH], mx = -INFINITY, sm = 0.f;
#pragma unroll
        for (int l = 0; l < DEPTH; ++l) { v[l] = F.hg_lb()[(d * DEPTH + l) * 256 + cc]; mx = fmaxf(mx, v[l]); }
#pragma unroll
        for (int l = 0; l < DEPTH; ++l) { v[l] = expf(v[l] - mx); sm += v[l]; }
        float cum = 0.f;
#pragma unroll
        for (int l = 0; l < DEPTH; ++l) { if (l > 0) cum += v[l] / sm; F.LB()[(d * DEPTH + l) * 256 + cc] = cum; }
    }
    for (int it = gt; it < SEQ * 32; it += NGT) {
        const int p = it >> 5, i = it & 31; const float pos = (float)((i < 16) ? (p >> 6) : (p & 63));
        const float fr = powf(10000.0f, -(float)(2 * (i & 15)) / 32.0f); const float ang = pos * fr;
        F.ROPE()[it] = (f32x2){cosf(ang), sinf(ang)};
    }
    for (int it = gt; it < SEQ; it += NGT) { const float a = (float)it * (1.0f / 4096.0f); F.TW()[it] = (f32x2){cospif(a), sinpif(a)}; }
    for (int it = gt; it < 2 * 128 * 128; it += NGT) { const int s = it >> 14, k = (it >> 7) & 127, n = it & 127; const float a = (float)((k * n) & 127) * (1.0f / 64.0f); F.FT128()[it] = (bf16)f2bf(s ? sinpif(a) : cospif(a)); }
    for (int it = gt; it < 2 * 2 * 4 * 64 * 8; it += NGT) { const int jj = it & 7, ln = (it >> 3) & 63, T = (it >> 9) & 3, a2 = (it >> 11) & 1, s = it >> 12;
        const int k2 = 16 * T + (ln & 15), g = ln >> 4, n2 = 32 * a2 + (jj < 4 ? 4 * g + jj : 16 + 4 * g + (jj - 4)); const float a = (float)((k2 * n2) & 63) * (1.0f / 32.0f);
        F.W64F()[it] = (bf16)f2bf(s ? sinpif(a) : cospif(a)); }
    for (int it = gt; it < 2 * 256 * 256; it += NGT) { const int jj = it & 7, ln = (it >> 3) & 63, ks = (it >> 9) & 7, T = (it >> 12) & 15, s = it >> 16;
        const int k = 16 * T + (ln & 15), g = ln >> 4, n = 32 * ks + (jj < 4 ? 4 * g + jj : 16 + 4 * g + (jj - 4)); const float a = (float)((k * n) & 255) * (1.0f / 128.0f); F.CT256()[it] = (bf16)f2bf(s ? sinpif(a) : cospif(a)); }
}
__device__ __forceinline__ void p0b_fold(Frame& F) {
    {
        LAS float* tfl = (LAS float*)(F.lds + RING_OFF + 16384);
        for (int it = F.vcu; it < DEPTH * 64 * 2; it += F.G) {
            const int jh = it & 1, kg = (it >> 1) & 63, l = it >> 7, j = jh * 512 + F.tid;
            const float* tf = F.TF() + (size_t)l * 131072 + (size_t)(kg * 8) * 256;
            for (int i = F.tid; i < 2048; i += NTHREADS) tfl[(i & 255) * 8 + (i >> 8)] = tf[i];
            __syncthreads();
            const float* wo = F.w_out() + (size_t)l * DM * DM + j;
            float a[8] = {0.f, 0.f, 0.f, 0.f, 0.f, 0.f, 0.f, 0.f};
            for (int jp0 = 0; jp0 < 256; jp0 += 8) {
                float w[8];
#pragma unroll
                for (int i = 0; i < 8; ++i) w[i] = wo[(size_t)(jp0 + i) * DM];
#pragma unroll
                for (int i = 0; i < 8; ++i) { const f32x4 t0 = *(const LAS f32x4*)(tfl + (jp0 + i) * 8), t1 = *(const LAS f32x4*)(tfl + (jp0 + i) * 8 + 4);
                    a[0] += t0[0] * w[i]; a[1] += t0[1] * w[i]; a[2] += t0[2] * w[i]; a[3] += t0[3] * w[i]; a[4] += t1[0] * w[i]; a[5] += t1[1] * w[i]; a[6] += t1[2] * w[i]; a[7] += t1[3] * w[i]; }
            }
            v4u o; o.x = pk2(a[0], a[1]); o.y = pk2(a[2], a[3]); o.z = pk2(a[4], a[5]); o.w = pk2(a[6], a[7]);
            *(GAS v4u*)(F.WOUT() + (size_t)l * DM * KMIX + (size_t)j * KMIX + kg * 8) = o;
            __syncthreads();
        }
    }
    {
        LAS float* part = (LAS float*)(F.lds + RING_OFF);
        for (int it = F.vcu; it < DEPTH * 124; it += F.G) {
            const int l = it / 124, v0 = (it % 124) * 64;
            const float* W; int ldw, col, shoff; float* dst; int dstride;
            if (v0 < 2304) { W = F.w_in() + (size_t)l * DM * PROJ; ldw = PROJ; col = v0 + F.lane; shoff = MOD_SH_A; dst = F.BIASA() + (size_t)l * 5 * 2304 + win_row(col); dstride = 2304; }
            else { const int up = v0 >= 2304 + DFF, hid = v0 - 2304 - up * DFF + F.lane; W = (up ? F.w_up() : F.w_gate()) + (size_t)l * DM * DFF; ldw = DFF; col = hid; shoff = MOD_SH_F;
                dst = F.BIASF() + (size_t)l * 5 * 5632 + (hid >> 7) * 256 + up * 128 + (hid & 127); dstride = 5632; }
            const float* wp = W + (size_t)(128 * F.wave) * ldw + col; const float* shp = F.MODS() + (size_t)l * 5 * 6144 + shoff + 128 * F.wave;
            LAS float* shl = (LAS float*)(F.lds + RING_OFF + 32768) + F.wave * 640;
            for (int i = F.lane; i < 640; i += 64) shl[i] = shp[(size_t)(i >> 7) * 6144 + (i & 127)];
            asm volatile("s_waitcnt vmcnt(0) lgkmcnt(0)" ::: "memory");
            float a0 = 0.f, a1 = 0.f, a2 = 0.f, a3 = 0.f, a4 = 0.f;
            float wn[16];
#pragma unroll
            for (int i = 0; i < 16; ++i) wn[i] = wp[(size_t)i * ldw];
            for (int k0 = 0; k0 < 128; k0 += 16) {
                float w[16];
#pragma unroll
                for (int i = 0; i < 16; ++i) w[i] = wn[i];
                if (k0 + 16 < 128) {
#pragma unroll
                    for (int i = 0; i < 16; ++i) wn[i] = wp[(size_t)(k0 + 16 + i) * ldw]; }
#pragma unroll
                for (int i = 0; i < 16; ++i) { const int k = k0 + i; a0 += shl[k] * w[i]; a1 += shl[128 + k] * w[i]; a2 += shl[256 + k] * w[i]; a3 += shl[384 + k] * w[i]; a4 += shl[512 + k] * w[i]; }
            }
            LAS float* pw = part + F.wave * 320 + F.lane;
            pw[0] = a0; pw[64] = a1; pw[128] = a2; pw[192] = a3; pw[256] = a4;
            __syncthreads();
            float s = 0.f;
            if (F.tid < 320) {
#pragma unroll
                for (int ww = 0; ww < 8; ++ww) s += part[ww * 320 + F.tid]; }
            if (F.tid < 320) dst[(size_t)(F.tid >> 6) * dstride] = s;
            __syncthreads();
        }
    }
    {
        const int gw = F.vcu * NWAVES + F.wave, NGW = F.G * NWAVES;
        for (int R = gw; R < MROWS; R += NGW) {
            const int b = R / TPB, t = R - b * TPB, bb = (t < CTXL) ? 4 : b;
            const GAS f32x4* xr = (const GAS f32x4*)xrow_ptr(F.x(), F.ctx(), R) + F.lane;
            const GAS f32x4* scp = (const GAS f32x4*)(F.MODS() + bb * 6144 + MOD_SC_A) + F.lane;
            f32x4 v[4]; float s = 0.f;
#pragma unroll
            for (int j = 0; j < 4; ++j) { v[j] = xr[64 * j]; s += (v[j].x * v[j].x + v[j].y * v[j].y) + (v[j].z * v[j].z + v[j].w * v[j].w); }
            s = wave_sum(s);
            GAS u32x2* o8 = (GAS u32x2*)(F.HN() + (size_t)R * DM) + F.lane; GAS u32x2* x8 = (GAS u32x2*)(F.XB() + (size_t)R * DM) + F.lane;
#pragma unroll
            for (int j = 0; j < 4; ++j) { const f32x4 y = v[j] * (scp[64 * j] + 1.0f); u32x2 w; w.x = pk2(y.x, y.y); w.y = pk2(y.z, y.w); o8[64 * j] = w;
                u32x2 xw; xw.x = pk2(v[j].x, v[j].y); xw.y = pk2(v[j].z, v[j].w); x8[64 * j] = xw; }
            if (F.lane < 16) F.ROWSS()[(size_t)R * 16 + F.lane] = (F.lane == 0) ? s : 0.f;
        }
    }
}

template <class Sched>
__device__ __forceinline__ void rinv_fill(Frame& F, const Sched& S) {
    LAS float* tab = (LAS float*)(F.lds + RINV_OFF); LAS int* pml = (LAS int*)(F.lds + RINV_OFF + RINV_SLOTS * 1024 - 64);
    __syncthreads();
    int n = 0;
    if (F.tid < RINV_SLOTS) { pg8::Unit u; pml[F.tid] = S.next(F.tid, u) ? u.pm : -1; }
    __syncthreads();
#pragma unroll 1
    for (int i = 0; i < RINV_SLOTS; ++i) if (pml[i] >= 0) n = i + 1;
    float rv[RINV_SLOTS / 2];
#pragma unroll
    for (int k = 0; k < RINV_SLOTS / 2; ++k) { const int it = F.tid + k * NTHREADS, i = it >> 8, rl = it & 255; rv[k] = 0.f;
        if (i < n) { const GAS f32x4* p = (const GAS f32x4*)(F.ROWSS() + ((size_t)pml[i] * 256 + rl) * 16); const f32x4 a = p[0], b = p[1], c = p[2], d = p[3];
            const float s = ((a[0] + a[1]) + (a[2] + a[3])) + ((b[0] + b[1]) + (b[2] + b[3])) + ((c[0] + c[1]) + (c[2] + c[3])) + ((d[0] + d[1]) + (d[2] + d[3]));
            rv[k] = 1.0f / sqrtf(s * (1.0f / DM) + EPS); } }
    __syncthreads();
#pragma unroll
    for (int k = 0; k < RINV_SLOTS / 2; ++k) { const int it = F.tid + k * NTHREADS; if ((it >> 8) < n) tab[it] = rv[k]; }
    __syncthreads();
}
template <int NSPLIT>
__device__ __forceinline__ void ctx_reduce_pass(Frame& F, const float* P, const float* gate, const float* scn) {
    const int gw = F.vcu * NWAVES + F.wave, NGW = F.G * NWAVES;
    for (int cr = gw; cr < NB * CTXL; cr += NGW) {
        const int b = cr >> 8, t = cr & 255; const size_t R = (size_t)b * TPB + t;
        float ss = 0.f;
#pragma unroll 1
        for (int j = 0; j < 4; ++j) { const int col = 4 * F.lane + 256 * j;
            f32x4 pv[NSPLIT];
#pragma unroll
            for (int s = 0; s < NSPLIT; ++s) pv[s] = *(const GAS f32x4*)(P + ((size_t)s * 1024 + cr) * 1024 + col);
            f32x4 a = pv[0];
#pragma unroll
            for (int s = 1; s < NSPLIT; ++s) a += pv[s];
            const u32x2 xo = *(const GAS u32x2*)(F.XB() + R * DM + col);
            const f32x4 xn = (f32x4){bflo(xo.x), bfhi(xo.x), bflo(xo.y), bfhi(xo.y)} + *(const GAS f32x4*)(gate + 4 * 6144 + col) * a;
            u32x2 xw; xw.x = pk2(xn.x, xn.y); xw.y = pk2(xn.z, xn.w); *(GAS u32x2*)(F.XB() + R * DM + col) = xw;
            ss += (xn.x * xn.x + xn.y * xn.y) + (xn.z * xn.z + xn.w * xn.w);
            if (scn) { const f32x4 y = xn * (*(const GAS f32x4*)(scn + 4 * 6144 + col) + 1.0f); u32x2 w; w.x = pk2(y.x, y.y); w.y = pk2(y.z, y.w); *(GAS u32x2*)(F.HN() + R * DM + col) = w; } }
        ss = wave_sum(ss);
        if (F.lane < 16) F.ROWSS()[R * 16 + F.lane] = (F.lane == 0) ? ss : 0.f;
    }
}
__device__ __forceinline__ void final_norm_phase(Frame& F) {
    const int gw = F.vcu * NWAVES + F.wave, NGW = F.G * NWAVES;
    for (int r = gw; r < NB * SEQ; r += NGW) {
        const int b = r >> 13, n = r & (SEQ - 1); const size_t R = (size_t)b * TPB + CTXL + n;
        float s = (F.lane < 16) ? F.ROWSS()[R * 16 + F.lane] : 0.f;
        s = wave_sum(s);
        const float rinv = 1.0f / sqrtf(s * (1.0f / DM) + EPS);
        const GAS u32x2* xr = (const GAS u32x2*)(F.XB() + R * DM) + F.lane; const GAS f32x4* gp = (const GAS f32x4*)F.final_norm() + F.lane;
        GAS f32x4* orow = (GAS f32x4*)(F.out_() + (size_t)r * DM) + F.lane;
#pragma unroll
        for (int j = 0; j < 4; ++j) { const u32x2 w = xr[64 * j]; orow[64 * j] = (f32x4){bflo(w.x), bfhi(w.x), bflo(w.y), bfhi(w.y)} * rinv * gp[64 * j]; }
    }
}

__device__ __forceinline__ void attn_fast_phase(Frame& F, int l) {
    char* shm = (char*)(F.lds + RING_OFF);
    const attn_body::bf16* UXp = (const attn_body::bf16*)F.UX(); attn_body::bf16* MIXp = (attn_body::bf16*)F.MIX();
    for (int base = F.vcu * 4; base < NB * 8 * 32 + F.G * 4; base += F.G * 4) {
        for (int i = 0; i < 5; ++i) {
            int bh, q0, NT;
            if (base < NB * 8 * 32) { if (i == 4) break; const int U = base + i; bh = U >> 5; q0 = CTXL + (U & 31) * 256; NT = TPB / 64; }
            else { const int c = base - NB * 8 * 32 + i * 0; if (i > 0 || l == DEPTH - 1) break; const int cu = c / 4; if ((cu & 7) != 0 || cu >= 256) break; bh = cu >> 3; q0 = 0; NT = CTXL / 64; }
            const int b = bh >> 3, h = bh & 7, kvh = h >> 2; const size_t rb = (size_t)b * TPB;
            attn_body::attn_unit<8>(UXp + (rb + q0) * PROJ + OFF_Q + h * 64, UXp + rb * PROJ + OFF_K + kvh * 64, UXp + rb * PROJ + OFF_V + kvh * 64, MIXp + (rb + q0) * KMIX + MIX_A + h * 64, NT, shm, F.tid);
        }
    }
}

namespace fft {
typedef short v4i16_t __attribute__((ext_vector_type(4)));
constexpr int ZP = 544;
__device__ __forceinline__ v4i16_t trrd(const LAS char* p) { return __builtin_amdgcn_ds_read_tr16_b64_v4i16((LAS v4i16_t*)p); }
__device__ __forceinline__ bf16x8 cat8(v4i16_t lo, v4i16_t hi) { return (bf16x8){lo[0], lo[1], lo[2], lo[3], hi[0], hi[1], hi[2], hi[3]}; }
__device__ __forceinline__ bf16x8 ld_frag2(const bf16* p0, const bf16* p1) { const u32x2 a = *(const GAS u32x2*)p0, b = *(const GAS u32x2*)p1; v4u w; w.x = a.x; w.y = a.y; w.z = b.x; w.w = b.y; return __builtin_bit_cast(bf16x8, w); }
#define MFMA16(a, b, c) __builtin_amdgcn_mfma_f32_16x16x32_bf16((a), (b), (c), 0, 0, 0)
}
__device__ __forceinline__ void fourier_fast_phase(Frame& F) {
    using namespace fft;
    LAS char* Z = (LAS char*)(F.lds + RING_OFF);
    LAS char* Zc = Z + 128 * ZP;
    const int tid = F.tid, lane = F.lane, w = F.wave, l16 = lane & 15, g = lane >> 4, q = l16 >> 2, p = l16 & 3;
    const bf16* UXp = F.UX(); bf16* MIXp = F.MIX();
    for (int unit = F.vcu; unit < NB * 64; unit += F.G) {
        const int b = unit >> 6, cg = unit & 63;
        { const bf16* zsrc = UXp + ((size_t)b * TPB + CTXL) * PROJ + cg * 4;
#pragma unroll 4
          for (int i = 0; i < 16; ++i) { const int n = tid + 512 * i; const u32x2 v = *(const GAS u32x2*)(zsrc + (size_t)n * PROJ);
              LAS char* d = Z + (n >> 6) * ZP + (n & 63) * 2;
              *(LAS unsigned short*)(d) = (unsigned short)(v.x & 0xffffu); *(LAS unsigned short*)(d + 128) = (unsigned short)(v.x >> 16);
              *(LAS unsigned short*)(d + 256) = (unsigned short)(v.y & 0xffffu); *(LAS unsigned short*)(d + 384) = (unsigned short)(v.y >> 16); }
          if (tid < CTXL) *(LAS u32x2*)(Zc + tid * 8) = *(const GAS u32x2*)(UXp + ((size_t)b * TPB + tid) * PROJ + cg * 4); }
        __syncthreads(); STAMP(40);
        const int k1 = 16 * w + l16;
        bf16x8 Bre[4][2], Bim[4][2];
        {
            bf16x8 Fc[4], Fs[4];
            const bf16* ftc = F.FT128() + k1 * 128; const bf16* fts = ftc + 128 * 128;
#pragma unroll
            for (int ks = 0; ks < 4; ++ks) { Fc[ks] = ld_frag2(ftc + 32 * ks + 4 * g, ftc + 32 * ks + 16 + 4 * g); Fs[ks] = ld_frag2(fts + 32 * ks + 4 * g, fts + 32 * ks + 16 + 4 * g); }
            f32x2 tw[4][4];
#pragma unroll
            for (int be = 0; be < 4; ++be)
#pragma unroll
                for (int r = 0; r < 4; ++r) tw[be][r] = F.TW()[k1 * (16 * be + 4 * g + r)];
            const LAS char* zrd = Z + (4 * g + q) * ZP + 8 * p;
#pragma unroll
            for (int c = 0; c < 4; ++c) {
                f32x4 ar[4], ai[4];
#pragma unroll
                for (int be = 0; be < 4; ++be) { ar[be] = (f32x4){0.f, 0.f, 0.f, 0.f}; ai[be] = (f32x4){0.f, 0.f, 0.f, 0.f}; }
#pragma unroll
                for (int ks = 0; ks < 4; ++ks)
#pragma unroll
                    for (int be = 0; be < 4; ++be) { const LAS char* a0 = zrd + (32 * ks) * ZP + (c * 64 + 16 * be) * 2;
                        const bf16x8 A = cat8(trrd(a0), trrd(a0 + 16 * ZP));
                        ar[be] = MFMA16(A, Fc[ks], ar[be]); ai[be] = MFMA16(A, Fs[ks], ai[be]); }
                float br[4][4], bi[4][4];
#pragma unroll
                for (int be = 0; be < 4; ++be)
#pragma unroll
                    for (int r = 0; r < 4; ++r) { const float ct = tw[be][r].x, st = tw[be][r].y; br[be][r] = ar[be][r] * ct - ai[be][r] * st; bi[be][r] = ar[be][r] * st + ai[be][r] * ct; }
#pragma unroll
                for (int a = 0; a < 2; ++a) { v4u wr_, wi_;
                    wr_.x = pk2(br[2 * a][0], br[2 * a][1]); wr_.y = pk2(br[2 * a][2], br[2 * a][3]); wr_.z = pk2(br[2 * a + 1][0], br[2 * a + 1][1]); wr_.w = pk2(br[2 * a + 1][2], br[2 * a + 1][3]);
                    wi_.x = pk2(bi[2 * a][0], bi[2 * a][1]); wi_.y = pk2(bi[2 * a][2], bi[2 * a][3]); wi_.z = pk2(bi[2 * a + 1][0], bi[2 * a + 1][1]); wi_.w = pk2(bi[2 * a + 1][2], bi[2 * a + 1][3]);
                    Bre[c][a] = __builtin_bit_cast(bf16x8, wr_); Bim[c][a] = __builtin_bit_cast(bf16x8, wi_); }
                __builtin_amdgcn_sched_barrier(0);
            }
        }
        STAMP(41);
        {
            const float sc = 0.011048543456039806f;
#pragma unroll 1
            for (int T = 0; T < 4; ++T) {
                bf16x8 Wc[2], Ws[2];
#pragma unroll
                for (int a = 0; a < 2; ++a) { Wc[a] = *(const GAS bf16x8*)(F.W64F() + (((0 * 2 + a) * 4 + T) * 64 + lane) * 8); Ws[a] = *(const GAS bf16x8*)(F.W64F() + (((1 * 2 + a) * 4 + T) * 64 + lane) * 8); }
                f32x4 P[4], Q[4];
#pragma unroll
                for (int c = 0; c < 4; ++c) {
                    bf16x8 nim[2];
#pragma unroll
                    for (int a = 0; a < 2; ++a) { v4u t = __builtin_bit_cast(v4u, Bim[c][a]); t.x ^= 0x80008000u; t.y ^= 0x80008000u; t.z ^= 0x80008000u; t.w ^= 0x80008000u; nim[a] = __builtin_bit_cast(bf16x8, t); }
                    f32x4 pp = (f32x4){0.f, 0.f, 0.f, 0.f}, qq = (f32x4){0.f, 0.f, 0.f, 0.f};
#pragma unroll
                    for (int a = 0; a < 2; ++a) { pp = MFMA16(Bre[c][a], Wc[a], pp); pp = MFMA16(nim[a], Ws[a], pp); qq = MFMA16(Bre[c][a], Ws[a], qq); qq = MFMA16(Bim[c][a], Wc[a], qq); }
                    P[c] = pp; Q[c] = qq;
                }
#pragma unroll
                for (int r = 0; r < 4; ++r) { const int k = (16 * w + 4 * g + r) + 128 * (16 * T + l16);
                    bf16* mp = MIXp + ((size_t)b * TPB + CTXL + k) * KMIX + cg * 4;
                    u32x2 o; o.x = pk2(P[0][r] * sc, P[1][r] * sc); o.y = pk2(P[2][r] * sc, P[3][r] * sc); *(GAS u32x2*)(mp + MIX_P) = o;
                    o.x = pk2(Q[0][r] * sc, Q[1][r] * sc); o.y = pk2(Q[2][r] * sc, Q[3][r] * sc); *(GAS u32x2*)(mp + MIX_Q) = o; }
            }
        }
        STAMP(42);
        {
            f32x4 aP[2], aQ[2];
#pragma unroll
            for (int tt = 0; tt < 2; ++tt) { aP[tt] = (f32x4){0.f, 0.f, 0.f, 0.f}; aQ[tt] = (f32x4){0.f, 0.f, 0.f, 0.f}; }
            const bf16* ctc = F.CT256() + (size_t)(2 * w) * 8 * 512 + lane * 8; const bf16* cts = ctc + 256 * 256;
#pragma unroll 1
            for (int hk = 0; hk < 4; ++hk) {
                bf16x8 Bc[2][2], Bs[2][2];
#pragma unroll
                for (int tt = 0; tt < 2; ++tt)
#pragma unroll
                    for (int kk = 0; kk < 2; ++kk) { const int ks = 2 * hk + kk; Bc[tt][kk] = *(const GAS bf16x8*)(ctc + (tt * 8 + ks) * 512); Bs[tt][kk] = *(const GAS bf16x8*)(cts + (tt * 8 + ks) * 512); }
#pragma unroll
                for (int kk = 0; kk < 2; ++kk) { const int ks = 2 * hk + kk;
                    const LAS char* a0 = Zc + (32 * ks + 4 * g + q) * 8;
                    const bf16x8 A = cat8(trrd(a0), trrd(a0 + 16 * 8));
#pragma unroll
                    for (int tt = 0; tt < 2; ++tt) { aP[tt] = MFMA16(A, Bc[tt][kk], aP[tt]); aQ[tt] = MFMA16(A, Bs[tt][kk], aQ[tt]); } }
            }
            if (g == 0) {
#pragma unroll
                for (int tt = 0; tt < 2; ++tt) { const int k = 16 * (2 * w + tt) + l16; bf16* mp = MIXp + ((size_t)b * TPB + k) * KMIX + cg * 4;
                    u32x2 o; o.x = pk2(aP[tt][0] * 0.0625f, aP[tt][1] * 0.0625f); o.y = pk2(aP[tt][2] * 0.0625f, aP[tt][3] * 0.0625f); *(GAS u32x2*)(mp + MIX_P) = o;
                    o.x = pk2(aQ[tt][0] * 0.0625f, aQ[tt][1] * 0.0625f); o.y = pk2(aQ[tt][2] * 0.0625f, aQ[tt][3] * 0.0625f); *(GAS u32x2*)(mp + MIX_Q) = o; }
            }
        }
        STAMP(43);
        __syncthreads(); STAMP(44);
    }
}

__device__ __forceinline__ float hg_exp(float x) { return __builtin_amdgcn_exp2f(x); }
#define LDS_BAR() asm volatile("s_waitcnt lgkmcnt(0)\n\ts_barrier" ::: "memory")
namespace hg {
using fft::trrd; using fft::cat8;
constexpr int IP = 160;
constexpr int IMG = 64 * IP;
__device__ __forceinline__ int scan_pos(int c, int dir) { return dir == 0 ? c : (c < 4 ? 3 - c : 135 - c); }
__device__ __forceinline__ float dpp_shr(float v, int n) {
    const int x = __builtin_bit_cast(int, v); int r;
    switch (n) { case 1: r = __builtin_amdgcn_update_dpp(0, x, 0x111, 0xF, 0xF, true); break; case 2: r = __builtin_amdgcn_update_dpp(0, x, 0x112, 0xF, 0xF, true); break;
                 case 4: r = __builtin_amdgcn_update_dpp(0, x, 0x114, 0xF, 0xF, true); break; default: r = __builtin_amdgcn_update_dpp(0, x, 0x118, 0xF, 0xF, true); break; }
    return __builtin_bit_cast(float, r);
}
__device__ __forceinline__ float scan_incl(float v, int lane) {
    v += dpp_shr(v, 1); v += dpp_shr(v, 2); v += dpp_shr(v, 4); v += dpp_shr(v, 8);
    v += __builtin_bit_cast(float, __builtin_amdgcn_update_dpp(0, __builtin_bit_cast(int, v), 0x142, 0xA, 0xF, false));
    v += __builtin_bit_cast(float, __builtin_amdgcn_update_dpp(0, __builtin_bit_cast(int, v), 0x143, 0xC, 0xF, false));
    (void)lane; return v;
}
__device__ __forceinline__ float lane_bcast(float v, int src) { return __builtin_bit_cast(float, __builtin_amdgcn_readlane(__builtin_bit_cast(int, v), src)); }
__device__ __forceinline__ void gates16(const v4u z0, const v4u z1, const float lbl  , int lane, float (&kk)[16], float (&cum)[16]) {
    const unsigned zw[8] = {z0.x, z0.y, z0.z, z0.w, z1.x, z1.y, z1.z, z1.w};
#pragma unroll
    for (int i = 0; i < 16; ++i) { const float z = (i & 1) ? bfhi(zw[i >> 1]) : bflo(zw[i >> 1]); const float lb = lane_bcast(lbl, i);
        const float sg = sigmoidf_(z), f = fmaxf(lb + (1.0f - lb) * sg, 1e-30f); kk[i] = (1.0f - lb) * (1.0f - sg);     cum[i] = scan_incl(__builtin_amdgcn_logf(f), lane); }
}
__device__ __forceinline__ void st16(LAS char* p, const float (&v)[16]) {
    v4u a, b; a.x = pk2(v[0], v[1]); a.y = pk2(v[2], v[3]); a.z = pk2(v[4], v[5]); a.w = pk2(v[6], v[7]); b.x = pk2(v[8], v[9]); b.y = pk2(v[10], v[11]); b.z = pk2(v[12], v[13]); b.w = pk2(v[14], v[15]);
    *(LAS v4u*)p = a; *(LAS v4u*)(p + 16) = b;
}
}
struct HgInA { v4u z0, z1, v0, v1; float lb; };
__device__ __forceinline__ HgInA hg_load_a(const bf16* UXp, const float* LBl  , int unit, int dir, int wd, int lane) {
    const int c = unit % (TPB / 64), bh = unit / (TPB / 64), b = bh >> 2, h = bh & 3;
    const size_t row = (size_t)b * TPB + 64 * c + (dir ? 63 - lane : lane);
    const bf16* rp = UXp + row * PROJ + h * 64 + 16 * wd; HgInA r;
    r.z0 = *(const GAS v4u*)(rp + (dir ? OFF_FB : OFF_FF)); r.z1 = *(const GAS v4u*)(rp + (dir ? OFF_FB : OFF_FF) + 8);
    r.v0 = *(const GAS v4u*)(rp + OFF_I); r.v1 = *(const GAS v4u*)(rp + OFF_I + 8); r.lb = *(const GAS float*)(LBl + h * 64 + 16 * wd + (lane & 15)); return r;
}
__device__ __forceinline__ void hgrn_a_phase(Frame& F, int l) {
    using namespace hg;
    const int lane = F.lane, w = F.wave, dir = w >> 2, wd = w & 3, l16 = lane & 15, g = lane >> 4, q = l16 >> 2, p = l16 & 3;
    LAS char* KI = (LAS char*)(F.lds + RING_OFF) + dir * 2 * IMG; LAS char* VI = KI + IMG;
    const bf16* UXp = F.UX();
    constexpr int NU = NB * 4 * (TPB / 64);
    const float* LBl = F.LB() + (dir * DEPTH + l) * 256;
    HgInA nx = hg_load_a(UXp, LBl, F.vcu < NU ? F.vcu : 0, dir, wd, lane);
    for (int unit = F.vcu; unit < NU; unit += F.G) {
        const int c = unit % (TPB / 64), bh = unit / (TPB / 64), b = bh >> 2, h = bh & 3;
        const HgInA in = nx;
        if (unit + F.G < NU) nx = hg_load_a(UXp, LBl, unit + F.G, dir, wd, lane);
        float kk[16], cum[16];
        gates16(in.z0, in.z1, in.lb, lane, kk, cum);
        float ko[16], gl[16];
#pragma unroll
        for (int i = 0; i < 16; ++i) { const float last = lane_bcast(cum[i], 63); gl[i] = last; ko[i] = kk[i] * hg_exp(last - cum[i]); }
        st16(KI + lane * IP + 32 * wd, ko);
        *(LAS v4u*)(VI + lane * IP + 32 * wd) = in.v0; *(LAS v4u*)(VI + lane * IP + 32 * wd + 16) = in.v1;
        const int ch = (b * 4 + h) * 2 + dir, pp = scan_pos(c, dir);
        if (lane < 16) { float gv = 0.f;
#pragma unroll
            for (int i = 0; i < 16; ++i) gv = (lane == i) ? gl[i] : gv;
            F.HGG()[((size_t)ch * 132 + pp) * 64 + 16 * wd + lane] = hg_exp(gv); }
        LDS_BAR();
        bf16x8 Af[2];
#pragma unroll
        for (int ks = 0; ks < 2; ++ks) { const LAS char* a0 = KI + (32 * ks + 4 * g + q) * IP + (16 * wd + 4 * p) * 2; Af[ks] = cat8(trrd(a0), trrd(a0 + 16 * IP)); }
        bf16* sp = (bf16*)F.HGS() + ((size_t)ch * 132 + pp) * 4096;
#pragma unroll
        for (int et = 0; et < 4; ++et) { f32x4 acc = (f32x4){0.f, 0.f, 0.f, 0.f};
#pragma unroll
            for (int ks = 0; ks < 2; ++ks) { const LAS char* b0 = VI + (32 * ks + 4 * g + q) * IP + (16 * et + 4 * p) * 2; acc = MFMA16(Af[ks], cat8(trrd(b0), trrd(b0 + 16 * IP)), acc); }
            u32x2 o2; o2.x = pk2(acc[0], acc[1]); o2.y = pk2(acc[2], acc[3]); *(GAS u32x2*)(sp + (16 * et + l16) * 64 + 16 * wd + 4 * g) = o2; }
        LDS_BAR();
    }
}
__device__ __forceinline__ void hgrn_b_phase(Frame& F) {
    const int gt = F.vcu * NTHREADS + F.tid, NGT = F.G * NTHREADS;
    for (int it = gt; it < 32 * 2048; it += NGT) {
        const int ch = it >> 11, idx = (it & 2047) * 2, d = idx & 63;
        unsigned* sp = (unsigned*)((bf16*)F.HGS() + (size_t)ch * 132 * 4096 + idx); const f32x2* gp = (const f32x2*)(F.HGG() + (size_t)ch * 132 * 64 + d);
        float s0 = 0.f, s1 = 0.f;
        for (int p0 = 0; p0 < 132; p0 += 6) {
            unsigned kv[6]; f32x2 gg[6];
#pragma unroll
            for (int i = 0; i < 6; ++i) { kv[i] = sp[(size_t)(p0 + i) * 2048]; gg[i] = gp[(p0 + i) * 32]; }
#pragma unroll
            for (int i = 0; i < 6; ++i) { sp[(size_t)(p0 + i) * 2048] = pk2(s0, s1); s0 = gg[i].x * s0 + bflo(kv[i]); s1 = gg[i].y * s1 + bfhi(kv[i]); }
        }
    }
}
struct HgInC { v4u z0, z1, q0, q1, v0, v1; v4u s[2]; u32x2 gr[2]; float lb; };
__device__ __forceinline__ HgInC hg_load_c(const bf16* UXp, const bf16* HGSp, const float* LBl, int unit, int nch, int c0, int dir, int wd, int lane, int w) {
    const int c = c0 + unit % nch, bh = unit / nch, b = bh >> 2, h = bh & 3, l16 = lane & 15, g = lane >> 4;
    const size_t R0 = (size_t)b * TPB + 64 * c, row = R0 + (dir ? 63 - lane : lane);
    const bf16* rp = UXp + row * PROJ + h * 64 + 16 * wd; HgInC r;
    r.z0 = *(const GAS v4u*)(rp + (dir ? OFF_FB : OFF_FF)); r.z1 = *(const GAS v4u*)(rp + (dir ? OFF_FB : OFF_FF) + 8);
    r.q0 = *(const GAS v4u*)(rp + OFF_HQ); r.q1 = *(const GAS v4u*)(rp + OFF_HQ + 8);
    r.v0 = *(const GAS v4u*)(rp + OFF_I); r.v1 = *(const GAS v4u*)(rp + OFF_I + 8);
    const int ch = (b * 4 + h) * 2 + dir, pp = hg::scan_pos(c, dir);
    const bf16* sp = HGSp + ((size_t)ch * 132 + pp) * 4096 + (size_t)(16 * wd + l16) * 64;
#pragma unroll
    for (int ks = 0; ks < 2; ++ks) r.s[ks] = *(const GAS v4u*)(sp + 32 * ks + 8 * g);
#pragma unroll
    for (int ps = 0; ps < 2; ++ps) r.gr[ps] = *(const GAS u32x2*)(UXp + (R0 + 8 * w + 4 * ps + g) * PROJ + OFF_G + h * 64 + 4 * l16);
    r.lb = *(const GAS float*)(LBl + h * 64 + 16 * wd + l16);
    return r;
}
__device__ __forceinline__ void hgrn_c_phase(Frame& F, int l) {
    using namespace hg;
    const int lane = F.lane, w = F.wave, dir = w >> 2, wd = w & 3, l16 = lane & 15, g = lane >> 4, q = l16 >> 2, p = l16 & 3;
    LAS char* base = (LAS char*)(F.lds + RING_OFF);
    LAS char* QI = base + dir * 3 * IMG; LAS char* KI = QI + IMG; LAS char* VI = KI + IMG;
    LAS float* ES = (LAS float*)(base + 6 * IMG) + dir * 64;
    LAS float* OF = (LAS float*)(base + 6 * IMG + 512);
    const bf16* UXp = F.UX(); bf16* MIXp = F.MIX(); const bf16* HGSp = (const bf16*)F.HGS();
    const f32x4 gn = *(const GAS f32x4*)(F.hg_norm() + l * 64 + 4 * l16);
    const int c0 = (l == DEPTH - 1) ? 4 : 0, nch = TPB / 64 - c0, NU = NB * 4 * nch;
    const float* LBl = F.LB() + (dir * DEPTH + l) * 256;
    const int nfull = NU / F.G, rem = NU - nfull * F.G; const bool spread = rem <= F.G / 4;
    const int my_n = spread ? nfull + (((F.vcu & 3) == 2 && (F.vcu >> 2) < rem) ? 1 : 0) : nfull + (F.vcu < rem ? 1 : 0);
#define HGC_UNIT(i) (((i) < nfull) ? F.vcu + (i) * F.G : (spread ? nfull * F.G + (F.vcu >> 2) : F.vcu + (i) * F.G))
    HgInC nx = hg_load_c(UXp, HGSp, LBl, my_n > 0 ? HGC_UNIT(0) : 0, nch, c0, dir, wd, lane, w);
    for (int ui = 0; ui < my_n; ++ui) {
        const int unit = HGC_UNIT(ui);
        const int c = c0 + unit % nch, bh = unit / nch, b = bh >> 2, h = bh & 3;
        const size_t R0 = (size_t)b * TPB + 64 * c;
        STAMP(23);
        const HgInC in = nx;
        if (ui + 1 < my_n) nx = hg_load_c(UXp, HGSp, LBl, HGC_UNIT(ui + 1), nch, c0, dir, wd, lane, w);
        {
            float kk[16], cum[16];
            gates16(in.z0, in.z1, in.lb, lane, kk, cum);
            const unsigned qw[8] = {in.q0.x, in.q0.y, in.q0.z, in.q0.w, in.q1.x, in.q1.y, in.q1.z, in.q1.w};
            float qo[16], ko[16], ev = 0.f;
#pragma unroll
            for (int i = 0; i < 16; ++i) { const float ref = lane_bcast(cum[i], 31); const float qv = (i & 1) ? bfhi(qw[i >> 1]) : bflo(qw[i >> 1]);
                qo[i] = qv * hg_exp(fminf(cum[i] - ref, 115.f)); ko[i] = kk[i] * hg_exp(fminf(ref - cum[i], 115.f)); ev = (lane == i) ? ref : ev; }
            st16(QI + lane * IP + 32 * wd, qo); st16(KI + lane * IP + 32 * wd, ko);
            *(LAS v4u*)(VI + lane * IP + 32 * wd) = in.v0; *(LAS v4u*)(VI + lane * IP + 32 * wd + 16) = in.v1;
            if (lane < 16) ES[16 * wd + lane] = hg_exp(ev);
        }
        LDS_BAR(); STAMP(20);
        {
            const int et = wd;
            bf16x8 Sf[2], Vf[2];
#pragma unroll
            for (int ks = 0; ks < 2; ++ks) { const v4u sw = in.s[ks];
                const f32x4 e0 = *(const LAS f32x4*)(ES + 32 * ks + 8 * g), e1 = *(const LAS f32x4*)(ES + 32 * ks + 8 * g + 4);
                v4u t; t.x = pk2(bflo(sw.x) * e0.x, bfhi(sw.x) * e0.y); t.y = pk2(bflo(sw.y) * e0.z, bfhi(sw.y) * e0.w); t.z = pk2(bflo(sw.z) * e1.x, bfhi(sw.z) * e1.y); t.w = pk2(bflo(sw.w) * e1.z, bfhi(sw.w) * e1.w); Sf[ks] = __builtin_bit_cast(bf16x8, t);
                const LAS char* b0 = VI + (32 * ks + 4 * g + q) * IP + (16 * et + 4 * p) * 2; Vf[ks] = cat8(trrd(b0), trrd(b0 + 16 * IP)); }
#pragma unroll
            for (int jb = 0; jb < 4; ++jb) {
                bf16x8 Qf[2];
#pragma unroll
                for (int ks = 0; ks < 2; ++ks) Qf[ks] = *(const LAS bf16x8*)(QI + (16 * jb + l16) * IP + (32 * ks + 8 * g) * 2);
                f32x4 o = (f32x4){0.f, 0.f, 0.f, 0.f};
#pragma unroll
                for (int ks = 0; ks < 2; ++ks) o = MFMA16(Qf[ks], Sf[ks], o);
#pragma unroll
                for (int a = 0; a <= (jb >> 1); ++a) {
                    f32x4 X[2];
#pragma unroll
                    for (int hh = 0; hh < 2; ++hh) { const int sb = 2 * a + hh; X[hh] = (f32x4){0.f, 0.f, 0.f, 0.f};
                        if (sb <= jb) {
#pragma unroll
                            for (int ks = 0; ks < 2; ++ks) X[hh] = MFMA16(*(const LAS bf16x8*)(KI + (16 * sb + l16) * IP + (32 * ks + 8 * g) * 2), Qf[ks], X[hh]);
                            if (sb == jb) {
#pragma unroll
                                for (int r = 0; r < 4; ++r) X[hh][r] = (4 * g + r <= l16) ? X[hh][r] : 0.f; } } }
                    v4u t; t.x = pk2(X[0][0], X[0][1]); t.y = pk2(X[0][2], X[0][3]); t.z = pk2(X[1][0], X[1][1]); t.w = pk2(X[1][2], X[1][3]);
                    o = MFMA16(__builtin_bit_cast(bf16x8, t), Vf[a], o);
                }
#pragma unroll
                for (int r = 0; r < 4; ++r) { const int j = 16 * jb + 4 * g + r, tok = dir ? 63 - j : j; OF[(dir * 64 + tok) * 64 + 16 * et + l16] = o[r]; }
            }
        }
        LDS_BAR(); STAMP(21);
        {
#pragma unroll
            for (int ps = 0; ps < 2; ++ps) { const int tok = 8 * w + 4 * ps + g;
                const f32x4 a = *(const LAS f32x4*)(OF + tok * 64 + 4 * l16), bq = *(const LAS f32x4*)(OF + (64 + tok) * 64 + 4 * l16); const f32x4 o = a + bq;
                float ss = (o.x * o.x + o.y * o.y) + (o.z * o.z + o.w * o.w);
                ss = xl_sum16(ss);
                const float rinv = 1.0f / sqrtf(ss * (1.0f / 64.0f) + EPS);
                const u32x2 graw = in.gr[ps];
                u32x2 wv; wv.x = pk2(o.x * rinv * gn.x * siluf_(bflo(graw.x)), o.y * rinv * gn.y * siluf_(bfhi(graw.x))); wv.y = pk2(o.z * rinv * gn.z * siluf_(bflo(graw.y)), o.w * rinv * gn.w * siluf_(bfhi(graw.y)));
                *(GAS u32x2*)(MIXp + (R0 + tok) * KMIX + MIX_R + h * 64 + 4 * l16) = wv; }
        }
        LDS_BAR(); STAMP(22);
    }
}

#ifndef R_P0A
#define R_P0A 1
#endif
#ifndef R_FFT
#define R_FFT 1
#endif
#ifndef R_HGA
#define R_HGA 1
#endif
#ifndef R_HGC
#define R_HGC 1
#endif
#ifndef R_ATT
#define R_ATT 1
#endif
#ifndef STAGGER_US
#define STAGGER_US 0
#endif
#define STAGGER() do { if (STAGGER_US > 0 && (F.vcu & 1)) { const unsigned long long t0_ = rt(); while (rt() - t0_ < (unsigned long long)(STAGGER_US * 100)) __builtin_amdgcn_s_sleep(16); } } while (0)
#ifndef MK_MULTI
#define MK_MULTI 0
#endif
constexpr int PH_L0 = 2, NPL = 7, PH_FINAL = PH_L0 + NPL, NPH = PH_FINAL + 1;
struct Args { const float* in[17]; float* out; unsigned char* ws; int l_lo, l_hi; };
template <int PH_LO, int PH_HI>
__global__ void __launch_bounds__(NTHREADS, 2) fwd_kernel(Args args) {
    extern __shared__ __attribute__((aligned(16))) unsigned char lds[];
    Frame F;
    F.lds = (LAS unsigned char*)lds;
    F.MISC = (volatile LAS unsigned*)(F.lds + MISC_OFF);
    F.tid = threadIdx.x; F.lane = F.tid & 63; F.wave = __builtin_amdgcn_readfirstlane(F.tid >> 6);
    const int wave0 = F.wave;
    F.G = gridDim.x; { const int bx = blockIdx.x; F.vcu = (F.G % 8 == 0) ? (bx % 8) * (F.G / 8) + bx / 8 : bx; }
    F.ws = (GAS unsigned char*)args.ws; F.outg = (GAS float*)args.out;
    for (int u = F.tid; u < (LDS_BYTES - LDSCTL_OFF) / 4; u += NTHREADS) ((LAS unsigned*)(F.lds + LDSCTL_OFF))[u] = 0u;
    __syncthreads();
    if (!MK_MULTI) (void)xcd_barrier_post((F.ctlw() + CW_BAR), F.MISC + 8);
#define IN(k) (PH_LO <= (k) && (k) < PH_HI)
#define RELANE() do { int ln_; asm volatile("v_mbcnt_lo_u32_b32 %0, -1, 0\n\tv_mbcnt_hi_u32_b32 %0, -1, %0" : "=v"(ln_)); F.lane = ln_; F.tid = wave0 * 64 + ln_; F.wave = wave0; unsigned long long w_ = (unsigned long long)F.ws, o_ = (unsigned long long)F.outg; asm volatile("" : "+s"(w_), "+s"(o_), "+s"(F.vcu), "+s"(F.G)); F.ws = (GAS unsigned char*)w_; F.outg = (GAS float*)o_; } while (0)
#define bx_() ({ int b_ = (int)blockIdx.x; asm volatile("" : "+s"(b_)); b_; })
#define SEAM(tag) do { if (!MK_MULTI) { unsigned long long w_ = (unsigned long long)F.ws; asm volatile("" : "+s"(w_)); XcdBarrier bar_; bar_.bar = (unsigned*)((GAS unsigned char*)w_ + WS_CTL) + CW_BAR; bar_.x = xb_xcc_id(); bar_.st = (volatile LAS unsigned*)(F.lds + MISC_OFF) + 8; xcd_barrier(bar_); }     \
    STAMP(tag); } while (0)
    F.dt = (DIAG_J >= 0) ? rt() : 0ull; F.da = 0ull;

    if (IN(0)) { for (int rep = 0; rep < R_P0A; ++rep) { RELANE(); p0a_prologue(F); SEAM(7); } }
    if (IN(1)) { RELANE(); p0b_fold(F); SEAM(8); }

    for (int l_it = args.l_lo; l_it < args.l_hi; ++l_it) {
        int l = l_it; asm volatile("" : "+s"(l));
        constexpr int s0 = PH_L0;
#define MODS_L (F.MODS() + (size_t)l * 5 * 6144)
        if (IN(s0 + 0)) { RELANE();
            pg8::Gemm g{F.HN(), F.WIN() + (size_t)l * PROJ * DM, MROWS, PROJ, DM, DM}; pg8::StaticOrder S; S.init(MROWS, PROJ, F.G, bx_());
            rinv_fill(F, S);
            pg8::EpiBf16N E{F.UX(), PROJ, F.BIASA() + (size_t)l * 5 * 2304, 2304, (const LAS float*)(F.lds + RINV_OFF), F.ROWSS(), F.q_norm() + l * 64, F.k_norm() + l * 64, (const float*)F.ROPE(), QSCALE};
            pg8::gemm_phase<pg8::EpiBf16N, pg8::StaticOrder, PG8_ALIGN, PG8_SP2, DM, DM, Frame>(F.lds + RING_OFF, g, S, E, F.tid, F);
            SEAM(0);
        }
        if (IN(s0 + 1)) { STAMP(10); for (int rep = 0; rep < R_FFT; ++rep) { RELANE(); fourier_fast_phase(F); } STAMP(11); for (int rep = 0; rep < R_HGA; ++rep) { RELANE(); hgrn_a_phase(F, l); } SEAM(1); }
        if (IN(s0 + 2)) { RELANE(); hgrn_b_phase(F); SEAM(2); }
        if (IN(s0 + 3)) { for (int rep = 0; rep < R_ATT; ++rep) { RELANE(); attn_fast_phase(F, l); } STAMP(12); for (int rep = 0; rep < R_HGC; ++rep) { RELANE(); hgrn_c_phase(F, l); } SEAM(3); }
        if (IN(s0 + 4)) { RELANE();
            const int lastl = (l == DEPTH - 1);
            {
                pg8::Gemm g{F.MIX(), F.WOUT() + (size_t)l * DM * KMIX, MROWS, DM, KMIX, KMIX}; pg8::StaticOrder S; S.init(NB * SEQ, DM, F.G, bx_(), 1);
                pg8::EpiResGate E{F.XB(), MODS_L + MOD_G_A, MODS_L + MOD_SC_F, F.HN(), F.ROWSS()};
                pg8::gemm_phase<pg8::EpiResGate, pg8::StaticOrder, PG8_ALIGN, PG8_SP2, KMIX, KMIX, Frame>(F.lds + RING_OFF, g, S, E, F.tid, F);
            }
            if (!lastl) {
                RELANE();
                pg8::Gemm g{F.MIX(), F.WOUT() + (size_t)l * DM * KMIX, MROWS, DM, 256, KMIX}; pg8::CtxSplitOrder S; S.init(DM, KMIX, 256, F.G, bx_());
                pg8::EpiPartial E{F.HGS(), 256};
                pg8::gemm_phase<pg8::EpiPartial, pg8::CtxSplitOrder, PG8_ALIGN, PG8_SP2, 256, KMIX, Frame>(F.lds + RING_OFF, g, S, E, F.tid, F);
                SEAM(4); RELANE();
                { const float* m2 = F.MODS() + (size_t)l * 5 * 6144; ctx_reduce_pass<KMIX / 256>(F, F.HGS(), m2 + MOD_G_A, m2 + MOD_SC_F); }
            }
            SEAM(4);
        }
        if (IN(s0 + 5)) { RELANE();
            const int lastl = (l == DEPTH - 1);
            STAGGER();
            pg8::Gemm g{F.HN(), F.WGU() + (size_t)l * 5632 * DM, MROWS, 5632, DM, DM}; pg8::StaticOrder S; S.init(lastl ? NB * SEQ : MROWS, 5632, F.G, bx_(), lastl);
            rinv_fill(F, S);
            pg8::EpiSwiGLU E{F.HB(), DFF, F.BIASF() + (size_t)l * 5 * 5632, 5632, (const LAS float*)(F.lds + RINV_OFF), F.ROWSS()};
            pg8::gemm_phase<pg8::EpiSwiGLU, pg8::StaticOrder, PG8_ALIGN, PG8_SP2, DM, DM, Frame>(F.lds + RING_OFF, g, S, E, F.tid, F);
            SEAM(5);
        }
        if (IN(s0 + 6)) { RELANE();
            const int lastl = (l == DEPTH - 1);
            {
                pg8::Gemm g{F.HB(), F.WDN() + (size_t)l * DM * DFF, MROWS, DM, DFF, DFF}; pg8::StaticOrder S; S.init(NB * SEQ, DM, F.G, bx_(), 1);
                pg8::EpiResGate E{F.XB(), MODS_L + MOD_G_F, (l + 1 < DEPTH) ? MODS_L + 5 * 6144 + MOD_SC_A : nullptr, F.HN(), F.ROWSS()};
                pg8::gemm_phase<pg8::EpiResGate, pg8::StaticOrder, PG8_ALIGN, PG8_SP2, DFF, DFF, Frame>(F.lds + RING_OFF, g, S, E, F.tid, F);
            }
            if (!lastl) {
                RELANE();
                pg8::Gemm g{F.HB(), F.WDN() + (size_t)l * DM * DFF, MROWS, DM, 256, DFF}; pg8::CtxSplitOrder S; S.init(DM, DFF, 256, F.G, bx_());
                pg8::EpiPartial E{F.HGS(), 256};
                pg8::gemm_phase<pg8::EpiPartial, pg8::CtxSplitOrder, PG8_ALIGN, PG8_SP2, 256, DFF, Frame>(F.lds + RING_OFF, g, S, E, F.tid, F);
                SEAM(6); RELANE();
                { const float* m2 = F.MODS() + (size_t)l * 5 * 6144; ctx_reduce_pass<DFF / 256>(F, F.HGS(), m2 + MOD_G_F, (l + 1 < DEPTH) ? m2 + 5 * 6144 + MOD_SC_A : nullptr); }
            }
            SEAM(6);
        }
    }
    if (IN(PH_FINAL)) { RELANE(); final_norm_phase(F); if (DIAG_J >= 0) { asm volatile("s_waitcnt vmcnt(0)" ::: "memory"); const unsigned long long t_ = rt(); if (DIAG_J == 9) F.da += t_ - F.dt;
        if (blockIdx.x == 0) { const unsigned long long tend = t_ + (unsigned long long)DIAG_A * F.da; while (rt() < tend) __builtin_amdgcn_s_sleep(32); } } }
#undef IN
#undef SEAM
}

#if MK_MULTI
#define MAIN_KERNEL (fwd_kernel<3, 4>)
#define LAUNCH(p) hipLaunchKernelGGL((fwd_kernel<p, p + 1>), dim3(grid), dim3(NTHREADS), LDS_BYTES, stream, a)
template <int P> static bool set_lds_one() { return hipFuncSetAttribute((const void*)fwd_kernel<P, P + 1>, hipFuncAttributeMaxDynamicSharedMemorySize, LDS_BYTES) == hipSuccess; }
static bool set_lds_all() { return set_lds_one<0>() && set_lds_one<1>() && set_lds_one<2>() && set_lds_one<3>() && set_lds_one<4>() && set_lds_one<5>() && set_lds_one<6>() && set_lds_one<7>() && set_lds_one<8>() && set_lds_one<9>() ; }
#else
#define MAIN_KERNEL (fwd_kernel<0, NPH>)
static bool set_lds_all() { return hipFuncSetAttribute((const void*)fwd_kernel<0, NPH>, hipFuncAttributeMaxDynamicSharedMemorySize, LDS_BYTES) == hipSuccess; }
#endif
extern "C" void kernel_launch(void* const* d_in, const int* in_sizes, int n_in, void* d_out, int out_size, void* d_ws, size_t ws_size, hipStream_t stream) {
    static int grid = 0;
    if (grid == 0) {
        if (n_in != 17 || in_sizes[0] != NB * SEQ * DM || out_size != NB * SEQ * DM || ws_size < WS_END) { fprintf(stderr, "kernel_launch: unexpected shapes (n_in %d, in0 %d, out %d, ws %zu < %zu); nothing launched\n", n_in, n_in > 0 ? in_sizes[0] : -1, out_size, ws_size, (size_t)WS_END); grid = -1; return; }
        int dev = 0, cus = 0, per_cu = 0;
        if (hipGetDevice(&dev) != hipSuccess || hipDeviceGetAttribute(&cus, hipDeviceAttributeMultiprocessorCount, dev) != hipSuccess) { grid = -1; return; }
        if (!set_lds_all()) { fprintf(stderr, "kernel_launch: hipFuncSetAttribute failed\n"); grid = -1; return; }
        if (hipOccupancyMaxActiveBlocksPerMultiprocessor(&per_cu, (const void*)MAIN_KERNEL, NTHREADS, LDS_BYTES) != hipSuccess || per_cu < 1) { fprintf(stderr, "kernel_launch: occupancy query says %d blocks per CU; nothing launched\n", per_cu); (void)hipGetLastError(); grid = -1; return; }
        grid = cus;
    }
    if (grid < 0) return;
    if (hipMemsetAsync((char*)d_ws + WS_CTL, 0, CTL_ZERO_BYTES, stream) != hipSuccess) return;
    Args a{};
    for (int i = 0; i < 17; ++i) a.in[i] = (const float*)d_in[i];
    a.out = (float*)d_out; a.ws = (unsigned char*)d_ws;
#if MK_MULTI
    a.l_lo = 0; a.l_hi = 0;
    LAUNCH(0); LAUNCH(1);
    for (int l = 0; l < DEPTH; ++l) { a.l_lo = l; a.l_hi = l + 1; LAUNCH(2); LAUNCH(3); LAUNCH(4); LAUNCH(5); LAUNCH(6); LAUNCH(7); LAUNCH(8); }
    a.l_lo = 0; a.l_hi = 0; LAUNCH(9);
#else
    a.l_lo = 0; a.l_hi = DEPTH;
    hipLaunchKernelGGL((fwd_kernel<0, NPH>), dim3(grid), dim3(NTHREADS), LDS_BYTES, stream, a);
#endif
}
```

```cpp
#include <hip/hip_runtime.h>
#include <hip/hip_bf16.h>
#include <cstdio>
#include <cstdint>
#include <cmath>
#ifndef DIAG_J
#define DIAG_J -1
#endif
#ifndef DIAG_A
#define DIAG_A 4
#endif
#define STAMP(tag) do { if (DIAG_J >= 0) { const unsigned long long t_ = __builtin_amdgcn_s_memrealtime(); if ((tag) == DIAG_J) F.da += t_ - F.dt; F.dt = t_; } } while (0)
#ifndef XL_DPP
#define XL_DPP 1
#endif
#ifndef XL_P32
#define XL_P32 0
#endif
__device__ __forceinline__ float xl_bperm_xor(float v, int mask) {
    int ln_; asm volatile("v_mbcnt_lo_u32_b32 %0, -1, 0\n\tv_mbcnt_hi_u32_b32 %0, -1, %0" : "=v"(ln_));
    return __builtin_bit_cast(float, __builtin_amdgcn_ds_bpermute((ln_ ^ mask) << 2, __builtin_bit_cast(int, v)));
}
#if !XL_DPP
__device__ __forceinline__ float xl_dpp_qp2301(float v) { return xl_bperm_xor(v, 2); }
__device__ __forceinline__ float xl_sum4(float v) { v += xl_bperm_xor(v, 1); v += xl_bperm_xor(v, 2); return v; }
__device__ __forceinline__ float xl_sum8(float v) { v = xl_sum4(v); v += xl_bperm_xor(v, 4); return v; }
__device__ __forceinline__ float xl_sum16(float v) { v = xl_sum8(v); v += xl_bperm_xor(v, 8); return v; }
#else
__device__ __forceinline__ float xl_dpp_qp1032(float v) { return __builtin_bit_cast(float, __builtin_amdgcn_update_dpp(0, __builtin_bit_cast(int, v), 0xB1, 0xF, 0xF, false)); }
__device__ __forceinline__ float xl_dpp_qp2301(float v) { return __builtin_bit_cast(float, __builtin_amdgcn_update_dpp(0, __builtin_bit_cast(int, v), 0x4E, 0xF, 0xF, false)); }
__device__ __forceinline__ float xl_dpp_hmirror(float v) { return __builtin_bit_cast(float, __builtin_amdgcn_update_dpp(0, __builtin_bit_cast(int, v), 0x141, 0xF, 0xF, false)); }
__device__ __forceinline__ float xl_dpp_mirror(float v) { return __builtin_bit_cast(float, __builtin_amdgcn_update_dpp(0, __builtin_bit_cast(int, v), 0x140, 0xF, 0xF, false)); }
__device__ __forceinline__ float xl_sum4(float v) { v += xl_dpp_qp1032(v); v += xl_dpp_qp2301(v); return v; }
__device__ __forceinline__ float xl_sum8(float v) { v = xl_sum4(v); v += xl_dpp_hmirror(v); return v; }
__device__ __forceinline__ float xl_sum16(float v) { v = xl_sum8(v); v += xl_dpp_mirror(v); return v; }
#endif
__device__ __forceinline__ float xl_sumx16(float v) { return v + xl_bperm_xor(v, 16); }
#if XL_P32
__device__ __forceinline__ float xl_sumx32(float v) { const auto r = __builtin_amdgcn_permlane32_swap(__builtin_bit_cast(unsigned, v), __builtin_bit_cast(unsigned, v), false, false); return __builtin_bit_cast(float, r[0]) + __builtin_bit_cast(float, r[1]); }
#else
__device__ __forceinline__ float xl_sumx32(float v) { return v + xl_bperm_xor(v, 32); }
#endif
__device__ __forceinline__ float xl_sum64(float v) { return xl_sumx32(xl_sumx16(xl_sum16(v))); }
namespace pg8 {
#define PG8_LAS __attribute__((address_space(3)))
typedef unsigned short bf16_t;
typedef short bf16x8 __attribute__((ext_vector_type(8)));
typedef float f32x4 __attribute__((ext_vector_type(4)));
typedef unsigned u32x4 __attribute__((ext_vector_type(4)));
constexpr int BM = 256, BK = 64, HALF = 128, HTB = HALF * BK * 2  , STAGE_BYTES = 8 * HTB, NXCD = 8, WGM = 8;

__host__ __device__ __forceinline__ int lds_byte(int r, int c) { const int st = (r >> 4) * 2 + (c >> 5), rr = r & 15, cc = c & 31, ob = rr * 64 + cc * 2; return st * 1024 + (ob ^ (((ob >> 9) & 1) << 5)); }
__host__ __device__ __forceinline__ void stage_rc(int b, int& R, int& C) { const int st = b / 1024, sb = b % 1024, swz = sb ^ (((sb >> 9) & 1) << 5); R = (st >> 1) * 16 + swz / 64; C = (st & 1) * 32 + (swz % 64) / 2; }
__host__ __device__ __forceinline__ int perm32(int rho) { const int n = rho >> 4, i = rho & 15; return 8 * (i >> 2) + 4 * n + (i & 3); }

struct Unit { int pm, pn, ko, ord; };
struct Gemm { const bf16_t* A; const bf16_t* Bt; int M, N, K, ld; };

struct StaticOrder {
    int nM, nN, nwg, G, c, skipc;
    __host__ __device__ void init(int M, int N, int G_, int c_, int skipc_ = 0) { nM = M / BM; nN = N / BM; nwg = nM * nN; G = G_; c = c_; skipc = skipc_; }
    __host__ __device__ bool next(int i, Unit& u) const {
        const long L = (long)i * G + c; if (L >= nwg) return false;
        int wgid = (int)L; { const int q = nwg / NXCD, r = nwg % NXCD, xcd = wgid % NXCD, off = wgid / NXCD; wgid = (xcd < r ? xcd * (q + 1) : r * (q + 1) + (xcd - r) * q) + off; }
        const int nig = WGM * nN, gid = wgid / nig, fm = gid * WGM, gsz = (nM - fm) < WGM ? (nM - fm) : WGM;
        u.pm = fm + ((wgid % nig) % gsz); u.pn = (wgid % nig) / gsz; if (skipc) u.pm += u.pm / 32 + 1; u.ko = 0; u.ord = i; return true;
    }
    __device__ __forceinline__ void a_ready(const Unit&) const {}
    __device__ __forceinline__ void done(const Unit&) const {}
};

struct CtxSplitOrder {
    int nsplit, kslice, G, c;
    __host__ __device__ void init(int N, int K, int kslice_, int G_, int c_) { kslice = kslice_; nsplit = K / kslice_; G = G_; c = c_; (void)N; }
    __host__ __device__ bool next(int i, Unit& u) const {
        const int L = i * G + c; if (L >= 16 * nsplit) return false;
        const int ks = L >> 4, r = L & 15; u.pm = 33 * (r >> 2); u.pn = r & 3; u.ko = ks * kslice; u.ord = i; return true;
    }
    __device__ __forceinline__ void a_ready(const Unit&) const {}
    __device__ __forceinline__ void done(const Unit&) const {}
};
__device__ __forceinline__ unsigned cvt_pk_bf16(float lo, float hi) { unsigned r; asm volatile("v_cvt_pk_bf16_f32 %0, %1, %2" : "=v"(r) : "v"(lo), "v"(hi)); return r; }
typedef float f32x2 __attribute__((ext_vector_type(2)));
__device__ __forceinline__ f32x2 gelu_pk(f32x2 v) {
    const f32x2 av = __builtin_elementwise_abs(v), d = av * 0.2316418882f + 1.0f;
    f32x2 t; t.x = __builtin_amdgcn_rcpf(d.x); t.y = __builtin_amdgcn_rcpf(d.y);
    f32x2 q = t * 0.5307027145f + (-0.7265760135f); q = q * t + 0.7107068705f; q = q * t + (-0.142248368f); q = q * t + 0.127414796f; q = q * t;
    const f32x2 s = (v * v) * (-0.72134752044f);
    f32x2 e; e.x = __builtin_amdgcn_exp2f(s.x); e.y = __builtin_amdgcn_exp2f(s.y);
    const f32x2 m = v * (q * e), r = v - m;
    f32x2 o; o.x = v.x < 0.f ? m.x : r.x; o.y = v.y < 0.f ? m.y : r.y; return o;
}

template <int ACT  > struct EpiBf16 {
    static constexpr bool PERM = true, AFTER_DRAIN = false; static_assert(ACT == 0 || ACT == 1, "EpiBf16: ACT is 0 (none) or 1 (gelu_pk)");
    bf16_t* O; int ldc; const float* bias; int split_cols; size_t split_stride; float scale0;
    __device__ __forceinline__ void operator()(const f32x4 (&acc)[2][2][4][2], const Unit& u, int wr, int wc, int fr, int fq) const {
        const int row0 = u.pm * BM + wr * 64 + fr; int colt = u.pn * BM; bf16_t* base = O;
        float sc = 1.f; if (split_cols) { const int t = colt / split_cols; base += (size_t)t * split_stride; colt -= t * split_cols; if (t == 0) sc = scale0; }
        const int col0 = colt + wc * 32 + 8 * fq, bcol0 = u.pn * BM + wc * 32 + 8 * fq;
        f32x4 bv[2][2];
#pragma unroll
        for (int bj = 0; bj < 2; ++bj)
#pragma unroll
            for (int n = 0; n < 2; ++n) bv[bj][n] = bias ? *(const f32x4*)(bias + bcol0 + bj * HALF + 4 * n) : (f32x4){0.f, 0.f, 0.f, 0.f};
#pragma unroll
        for (int ai = 0; ai < 2; ++ai)
#pragma unroll
            for (int m = 0; m < 4; ++m) { bf16_t* rowp = base + (size_t)(row0 + ai * HALF + m * 16) * ldc + col0;
#pragma unroll
                for (int bj = 0; bj < 2; ++bj) { f32x4 v0 = acc[ai][bj][m][0] + bv[bj][0], v1 = acc[ai][bj][m][1] + bv[bj][1];
                    if (ACT == 1) { f32x2 a = gelu_pk((f32x2){v0[0], v0[1]}), b = gelu_pk((f32x2){v0[2], v0[3]}), c = gelu_pk((f32x2){v1[0], v1[1]}), d = gelu_pk((f32x2){v1[2], v1[3]});
                        v0 = (f32x4){a.x, a.y, b.x, b.y}; v1 = (f32x4){c.x, c.y, d.x, d.y}; }
                    v0 = v0 * sc; v1 = v1 * sc; u32x4 w; w.x = cvt_pk_bf16(v0[0], v0[1]); w.y = cvt_pk_bf16(v0[2], v0[3]); w.z = cvt_pk_bf16(v1[0], v1[1]); w.w = cvt_pk_bf16(v1[2], v1[3]);
                    *(u32x4*)(rowp + bj * HALF) = w; } }
    }
};
template <class Epi, class Sched, bool ALIGN_EPI = false, bool SP2 = false, int KC = 0, int LDC = 0, class Dg = int>
__device__ __forceinline__ void gemm_phase(PG8_LAS unsigned char* lds, const Gemm g, const Sched& S, const Epi& E, int tid_in, Dg& F) {
    int tid_ = tid_in; asm volatile("" : "+v"(tid_));
    const int tid = tid_, wid = __builtin_amdgcn_readfirstlane(tid >> 6), lane = tid & 63, wr = wid >> 2, wc = wid & 3, fr = lane & 15, fq = lane >> 4;
    const int K = KC ? KC : g.K, nt = K / BK, LD = LDC ? LDC : g.ld;
    unsigned voffA[2], voffB[2];
#pragma unroll
    for (int i = 0; i < 2; ++i) { int R, C; stage_rc(tid * 16 + i * 8192, R, C); const int Rb = Epi::PERM ? ((R & ~31) + perm32(R & 31)) : R;
        voffA[i] = (unsigned)(R * LD + C) * 2u; voffB[i] = (unsigned)(Rb * LD + C) * 2u; }
    const size_t kstep = (size_t)(BK * 2);
    const size_t hstep = (size_t)HALF * LD * 2;
    const size_t tstep = 2 * hstep;
    const int aoff = lds_byte(wr * 64 + fr, fq * 8), boff = lds_byte(wc * 32 + fr, fq * 8);
    const unsigned ldsw = (unsigned)wid * 1024u;
#define PG8_SA(b, h) (((b) * 2 + (h)) * HTB)
#define PG8_SB(b, h) ((4 + (b) * 2 + (h)) * HTB)
#define PG8_STAGE(bufoff, gbase, voff) do { _Pragma("unroll") for (int _i = 0; _i < 2; ++_i) \
        __builtin_amdgcn_global_load_lds((const unsigned*)((const char*)(gbase) + (voff)[_i]), (PG8_LAS unsigned*)(lds + (bufoff) + ldsw + _i * 8192), 16, 0, 0); } while (0)
#define PG8_LDA(dst, b, h) do { _Pragma("unroll") for (int m = 0; m < 4; ++m) _Pragma("unroll") for (int k = 0; k < 2; ++k) dst[m][k] = *(const PG8_LAS bf16x8*)(lds + PG8_SA(b, h) + aoff + m * 2048 + k * 1024); } while (0)
#define PG8_LDB(dst, b, h) do { _Pragma("unroll") for (int n = 0; n < 2; ++n) _Pragma("unroll") for (int k = 0; k < 2; ++k) dst[n][k] = *(const PG8_LAS bf16x8*)(lds + PG8_SB(b, h) + boff + n * 2048 + k * 1024); } while (0)
#define PG8_MMA(ai, bj, At, Bt) do { __builtin_amdgcn_s_setprio(1); _Pragma("unroll") for (int m = 0; m < 4; ++m) _Pragma("unroll") for (int n = 0; n < 2; ++n) _Pragma("unroll") for (int k = 0; k < 2; ++k) \
        acc[ai][bj][m][n] = __builtin_amdgcn_mfma_f32_16x16x32_bf16(Bt[n][k], At[m][k], acc[ai][bj][m][n], 0, 0, 0); __builtin_amdgcn_s_setprio(0); } while (0)
#define PG8_WAIT_V(n) asm volatile("s_waitcnt vmcnt(" #n ")" ::: "memory")
#define PG8_WAIT_L(n) asm volatile("s_waitcnt lgkmcnt(" #n ")" ::: "memory")
#define PG8_BAR __builtin_amdgcn_s_barrier()
#define PG8_SCHED __builtin_amdgcn_sched_barrier(0)
    Unit cur, nxt; int ui = 0;
    if (!S.next(0, cur)) return;
    f32x4 acc[2][2][4][2];
#pragma unroll
    for (int a = 0; a < 2; ++a)
#pragma unroll
        for (int b = 0; b < 2; ++b)
#pragma unroll
            for (int m = 0; m < 4; ++m)
#pragma unroll
                for (int n = 0; n < 2; ++n) acc[a][b][m][n] = (f32x4){0.f, 0.f, 0.f, 0.f};
    bf16x8 At[4][2], B0[2][2], B1[2][2];
    const char* cA = (const char*)g.A + (size_t)cur.pm * tstep + (size_t)cur.ko * 2; const char* cB = (const char*)g.Bt + (size_t)cur.pn * tstep + (size_t)cur.ko * 2;
    S.a_ready(cur);
    if constexpr (SP2) {
        PG8_STAGE(PG8_SB(0, 0), cB, voffB); PG8_STAGE(PG8_SB(0, 1), cB + hstep, voffB); PG8_STAGE(PG8_SA(0, 0), cA, voffA); PG8_STAGE(PG8_SA(0, 1), cA + hstep, voffA);
        if (wr == 1) PG8_BAR;
        PG8_WAIT_V(2); PG8_BAR;
        PG8_STAGE(PG8_SB(1, 0), cB + kstep, voffB); PG8_STAGE(PG8_SA(1, 0), cA + kstep, voffA); PG8_STAGE(PG8_SB(1, 1), cB + hstep + kstep, voffB);
        PG8_WAIT_V(6); PG8_BAR;
    } else {
        PG8_STAGE(PG8_SB(0, 0), cB, voffB); PG8_STAGE(PG8_SA(0, 0), cA, voffA); PG8_STAGE(PG8_SB(0, 1), cB + hstep, voffB); PG8_STAGE(PG8_SA(0, 1), cA + hstep, voffA);
        if (wr == 1) PG8_BAR;
        PG8_WAIT_V(4); PG8_BAR;
        PG8_STAGE(PG8_SB(1, 0), cB + kstep, voffB); PG8_STAGE(PG8_SA(1, 0), cA + kstep, voffA); PG8_STAGE(PG8_SB(1, 1), cB + hstep + kstep, voffB);
        PG8_WAIT_V(6); PG8_BAR;
    }
    for (;;) {
        const bool has_next = S.next(ui + 1, nxt);
        const char* nA = has_next ? (const char*)g.A + (size_t)nxt.pm * tstep + (size_t)nxt.ko * 2 : cA; const char* nB = has_next ? (const char*)g.Bt + (size_t)nxt.pn * tstep + (size_t)nxt.ko * 2 : cB;
        for (int t = 0; t < nt; t += 2) {
            const bool last = (t == nt - 2);
            const char* a1 = cA + (size_t)(t + 1) * kstep;
            const char* a2 = last ? nA : cA + (size_t)(t + 2) * kstep; const char* b2 = last ? nB : cB + (size_t)(t + 2) * kstep;
            const char* a3 = a2 + kstep; const char* b3 = b2 + kstep;
            if (last && has_next) S.a_ready(nxt);
            if constexpr (SP2) {
            PG8_LDB(B0, 0, 0); PG8_LDB(B1, 0, 1); PG8_SCHED; PG8_LDA(At, 0, 0); PG8_STAGE(PG8_SA(1, 1), a1 + hstep, voffA);
            PG8_WAIT_V(8); PG8_WAIT_L(0); PG8_BAR; PG8_MMA(0, 0, At, B0); PG8_MMA(0, 1, At, B1); PG8_BAR; PG8_SCHED;
            PG8_LDA(At, 0, 1); PG8_STAGE(PG8_SB(0, 0), b2, voffB); PG8_STAGE(PG8_SB(0, 1), b2 + hstep, voffB); PG8_STAGE(PG8_SA(0, 0), a2, voffA);
            PG8_WAIT_V(8); PG8_WAIT_L(0); PG8_BAR; PG8_MMA(1, 0, At, B0); PG8_MMA(1, 1, At, B1); PG8_BAR; PG8_SCHED;
            PG8_LDB(B0, 1, 0); PG8_LDB(B1, 1, 1); PG8_SCHED; PG8_LDA(At, 1, 0); PG8_STAGE(PG8_SA(0, 1), a2 + hstep, voffA);
            PG8_WAIT_V(8); PG8_WAIT_L(0); PG8_BAR; PG8_MMA(0, 0, At, B0); PG8_MMA(0, 1, At, B1); PG8_BAR; PG8_SCHED;
            PG8_LDA(At, 1, 1); PG8_STAGE(PG8_SB(1, 0), b3, voffB); PG8_STAGE(PG8_SB(1, 1), b3 + hstep, voffB); PG8_STAGE(PG8_SA(1, 0), a3, voffA);
            PG8_WAIT_V(8); PG8_WAIT_L(0); PG8_BAR; PG8_MMA(1, 0, At, B0); PG8_MMA(1, 1, At, B1); PG8_BAR; PG8_SCHED;
            } else {
            PG8_LDB(B0, 0, 0); PG8_SCHED; PG8_LDA(At, 0, 0); PG8_STAGE(PG8_SA(1, 1), a1 + hstep, voffA);
            PG8_WAIT_L(8); PG8_BAR; PG8_WAIT_L(0); PG8_MMA(0, 0, At, B0); PG8_BAR; PG8_SCHED;
            PG8_LDB(B1, 0, 1); PG8_STAGE(PG8_SB(0, 0), b2, voffB);
            PG8_BAR; PG8_WAIT_L(0); PG8_MMA(0, 1, At, B1); PG8_BAR;
            PG8_LDA(At, 0, 1); PG8_STAGE(PG8_SA(0, 0), a2, voffA);
            PG8_BAR; PG8_WAIT_L(0); PG8_MMA(1, 0, At, B0); PG8_BAR; PG8_SCHED;
            PG8_STAGE(PG8_SB(0, 1), b2 + hstep, voffB);
            PG8_WAIT_V(6); PG8_BAR; PG8_MMA(1, 1, At, B1); PG8_BAR;
            PG8_LDB(B0, 1, 0); PG8_SCHED; PG8_LDA(At, 1, 0); PG8_STAGE(PG8_SA(0, 1), a2 + hstep, voffA);
            PG8_WAIT_L(8); PG8_BAR; PG8_WAIT_L(0); PG8_MMA(0, 0, At, B0); PG8_BAR; PG8_SCHED;
            PG8_LDB(B1, 1, 1); PG8_STAGE(PG8_SB(1, 0), b3, voffB);
            PG8_BAR; PG8_WAIT_L(0); PG8_MMA(0, 1, At, B1); PG8_BAR;
            PG8_LDA(At, 1, 1); PG8_STAGE(PG8_SA(1, 0), a3, voffA);
            PG8_BAR; PG8_WAIT_L(0); PG8_MMA(1, 0, At, B0); PG8_BAR; PG8_SCHED;
            PG8_STAGE(PG8_SB(1, 1), b3 + hstep, voffB);
            PG8_WAIT_V(6); PG8_BAR; PG8_MMA(1, 1, At, B1); PG8_BAR;
            }
        }
        STAMP(30);
        if constexpr (ALIGN_EPI) { if (wr == 0) PG8_BAR; }
        STAMP(31);
        if constexpr (!Epi::AFTER_DRAIN) { E(acc, cur, wr, wc, fr, fq); S.done(cur); }
        STAMP(Epi::TAG);
        if (!has_next) break;
#pragma unroll
        for (int a = 0; a < 2; ++a)
#pragma unroll
            for (int b = 0; b < 2; ++b)
#pragma unroll
                for (int m = 0; m < 4; ++m)
#pragma unroll
                    for (int n = 0; n < 2; ++n) acc[a][b][m][n] = (f32x4){0.f, 0.f, 0.f, 0.f};
        cur = nxt; cA = nA; cB = nB; ++ui;
        if constexpr (ALIGN_EPI) { if (wr == 1) PG8_BAR; }
    }
    PG8_WAIT_V(0);
    if constexpr (!ALIGN_EPI) { if (wr == 0) PG8_BAR; }
    PG8_BAR;
    if constexpr (Epi::AFTER_DRAIN) { E.fused(acc, cur, wr, wc, fr, fq, lds, wid, lane); S.done(cur); }
#undef PG8_SA
#undef PG8_SB
#undef PG8_STAGE
#undef PG8_LDA
#undef PG8_LDB
#undef PG8_MMA
#undef PG8_WAIT_V
#undef PG8_WAIT_L
#undef PG8_BAR
#undef PG8_SCHED
}
}
namespace pg8 {
__device__ __forceinline__ float row_rinv(const float* rowss, size_t R, int fq) {
    const f32x4 v = *(const f32x4*)(rowss + R * 16 + 4 * fq); float s = (v[0] + v[1]) + (v[2] + v[3]);
    s = xl_sumx32(xl_sumx16(s));
    return 1.0f / sqrtf(s * (1.0f / 1024.0f) + 1e-6f);
}
struct EpiResGate {
    static constexpr bool PERM = true, AFTER_DRAIN = false; static constexpr int TAG = 35;
    bf16_t* XB; const float* gate; const float* scn; bf16_t* XM; float* rowss;
    __device__ __forceinline__ void operator()(const f32x4 (&acc)[2][2][4][2], const Unit& u, int wr, int wc, int fr, int fq) const {
        asm volatile("" : "+v"(fr), "+v"(fq));
        const int b = u.pm / 33, p = u.pm % 33, bb = (p == 0) ? 4 : b;
        const int col0 = u.pn * BM + wc * 32 + 8 * fq;
        u32x4 xin[4][2];
#pragma unroll
        for (int m = 0; m < 4; ++m) { const size_t R = (size_t)u.pm * BM + wr * 64 + m * 16 + fr;
#pragma unroll
            for (int bj = 0; bj < 2; ++bj) xin[m][bj] = *(const u32x4*)(XB + R * 1024 + col0 + bj * HALF); }
        f32x4 (&accw)[2][2][4][2] = const_cast<f32x4 (&)[2][2][4][2]>(acc);
        unsigned sp[2][4];
#pragma unroll
        for (int bj = 0; bj < 2; ++bj)
#pragma unroll
            for (int n = 0; n < 2; ++n) { const f32x4 gq = *(const f32x4*)(gate + bb * 6144 + col0 + bj * HALF + 4 * n);
#pragma unroll
                for (int ai = 0; ai < 2; ++ai)
#pragma unroll
                    for (int m = 0; m < 4; ++m) accw[ai][bj][m][n] *= gq;
                if (scn) { const f32x4 sq = *(const f32x4*)(scn + bb * 6144 + col0 + bj * HALF + 4 * n) + 1.0f; sp[bj][2 * n] = cvt_pk_bf16(sq[0], sq[1]); sp[bj][2 * n + 1] = cvt_pk_bf16(sq[2], sq[3]); }
                else { sp[bj][2 * n] = 0x3f803f80u; sp[bj][2 * n + 1] = 0x3f803f80u; } }
#define PG8_LO(w) __builtin_bit_cast(float, (w) << 16)
#define PG8_HI(w) __builtin_bit_cast(float, (w) & 0xffff0000u)
#pragma unroll
        for (int ai = 0; ai < 2; ++ai) {
            if (ai == 1) {
#pragma unroll
                for (int m = 0; m < 4; ++m) { const size_t R = (size_t)u.pm * BM + HALF + wr * 64 + m * 16 + fr;
#pragma unroll
                    for (int bj = 0; bj < 2; ++bj) xin[m][bj] = *(const u32x4*)(XB + R * 1024 + col0 + bj * HALF); } }
            asm volatile("" ::: "memory");
#pragma unroll
            for (int m = 0; m < 4; ++m) { const size_t R = (size_t)u.pm * BM + ai * HALF + wr * 64 + m * 16 + fr;
                float ss = 0.f;
#pragma unroll
                for (int bj = 0; bj < 2; ++bj) { const u32x4 xw = xin[m][bj];
                    const f32x4 o0 = (f32x4){PG8_LO(xw.x), PG8_HI(xw.x), PG8_LO(xw.y), PG8_HI(xw.y)} + acc[ai][bj][m][0], o1 = (f32x4){PG8_LO(xw.z), PG8_HI(xw.z), PG8_LO(xw.w), PG8_HI(xw.w)} + acc[ai][bj][m][1];
                    u32x4 w; w.x = cvt_pk_bf16(o0[0], o0[1]); w.y = cvt_pk_bf16(o0[2], o0[3]); w.z = cvt_pk_bf16(o1[0], o1[1]); w.w = cvt_pk_bf16(o1[2], o1[3]);
                    *(u32x4*)(XB + R * 1024 + col0 + bj * HALF) = w;
                    ss += ((o0[0] * o0[0] + o0[1] * o0[1]) + (o0[2] * o0[2] + o0[3] * o0[3])) + ((o1[0] * o1[0] + o1[1] * o1[1]) + (o1[2] * o1[2] + o1[3] * o1[3]));
                    if (scn) { const f32x4 s0 = (f32x4){PG8_LO(sp[bj][0]), PG8_HI(sp[bj][0]), PG8_LO(sp[bj][1]), PG8_HI(sp[bj][1])}, s1 = (f32x4){PG8_LO(sp[bj][2]), PG8_HI(sp[bj][2]), PG8_LO(sp[bj][3]), PG8_HI(sp[bj][3])};
                        const f32x4 y0 = o0 * s0, y1 = o1 * s1; w.x = cvt_pk_bf16(y0[0], y0[1]); w.y = cvt_pk_bf16(y0[2], y0[3]); w.z = cvt_pk_bf16(y1[0], y1[1]); w.w = cvt_pk_bf16(y1[2], y1[3]);
                        *(u32x4*)(XM + R * 1024 + col0 + bj * HALF) = w; } }
                ss = xl_sumx32(xl_sumx16(ss));
                if (fq == 0) rowss[R * 16 + u.pn * 4 + wc] = ss; }
            asm volatile("" ::: "memory");
        }
#undef PG8_LO
#undef PG8_HI
    }
};
struct EpiPartial {
    static constexpr bool PERM = false, AFTER_DRAIN = false; static constexpr int TAG = 36;
    float* P; int kslice;
    __device__ __forceinline__ void operator()(const f32x4 (&acc)[2][2][4][2], const Unit& u, int wr, int wc, int fr, int fq) const {
        asm volatile("" : "+v"(fr), "+v"(fq));
        const int b = u.pm / 33, ks = u.ko / kslice; const int col0 = u.pn * BM + wc * 32 + 4 * fq;
        float* rp = P + ((size_t)ks * 1024 + (size_t)b * 256 + wr * 64 + fr) * 1024 + col0;
#pragma unroll
        for (int ai = 0; ai < 2; ++ai)
#pragma unroll
            for (int m = 0; m < 4; ++m) {
#pragma unroll
                for (int bj = 0; bj < 2; ++bj)
#pragma unroll
                    for (int n = 0; n < 2; ++n) *(f32x4*)(rp + bj * HALF + n * 16) = acc[ai][bj][m][n];
                rp += (m == 3 ? 80 : 16) * 1024; asm volatile("" : "+v"(rp)); }
    }
};
struct EpiBf16N {
    static constexpr bool PERM = true, AFTER_DRAIN = false; static constexpr int TAG = 33;
    bf16_t* O; int ldc; const float* bias; int nb; const PG8_LAS float* rtab; const float* rowss; const float* qn; const float* kn; const float* rope; float qscale;
    __device__ __forceinline__ void operator()(const f32x4 (&acc)[2][2][4][2], const Unit& u, int wr, int wc, int fr, int fq) const {
        asm volatile("" : "+v"(fr), "+v"(fq));
        const int b = u.pm / 33, p = u.pm % 33, bb = (p == 0) ? 4 : b;
        const int row0 = u.pm * BM + wr * 64 + fr, col0 = u.pn * BM + wc * 32 + 8 * fq;
        f32x4 bv[2][2];
#pragma unroll
        for (int bj = 0; bj < 2; ++bj)
#pragma unroll
            for (int n = 0; n < 2; ++n) bv[bj][n] = (u.ord < 12) ? *(const PG8_LAS f32x4*)(rtab + 12 * 256 + u.ord * 256 + wc * 32 + 8 * fq + bj * HALF + 4 * n) : *(const f32x4*)(bias + (size_t)bb * nb + col0 + bj * HALF + 4 * n);
        if (u.pn >= 1 && u.pn <= 3) {
            const int hh = 4 * (u.pn - 1) + wc;
            const int dlo = (fq < 2) ? 8 * fq : 8 * fq + 16;
            bf16_t* obase = O + 256 + hh * 64 + dlo;
            const bool normed = hh < 10, isq = hh < 8;
            f32x4 g1[2], g2[2];
#pragma unroll
            for (int n = 0; n < 2; ++n) { const float* gp = (isq ? qn : kn) + dlo + 4 * n; const float sc = isq ? qscale : 1.0f;
                g1[n] = normed ? *(const f32x4*)gp * sc : (f32x4){1.f, 1.f, 1.f, 1.f}; g2[n] = normed ? *(const f32x4*)(gp + 16) * sc : (f32x4){1.f, 1.f, 1.f, 1.f}; }
#pragma unroll
            for (int ai = 0; ai < 2; ++ai)
#pragma unroll
                for (int m = 0; m < 4; ++m) { const int rl = ai * HALF + wr * 64 + m * 16 + fr; const size_t R = (size_t)u.pm * BM + rl; const float ri = (u.ord < 12) ? rtab[u.ord * 256 + rl] : row_rinv(rowss, R, fq);
                    f32x4 v1[2], v2[2];
#pragma unroll
                    for (int n = 0; n < 2; ++n) { v1[n] = acc[ai][0][m][n] * ri + bv[0][n]; v2[n] = acc[ai][1][m][n] * ri + bv[1][n]; }
                    if (normed) {
                        float ss = 0.f;
#pragma unroll
                        for (int n = 0; n < 2; ++n) ss += ((v1[n][0] * v1[n][0] + v1[n][1] * v1[n][1]) + (v1[n][2] * v1[n][2] + v1[n][3] * v1[n][3])) + ((v2[n][0] * v2[n][0] + v2[n][1] * v2[n][1]) + (v2[n][2] * v2[n][2] + v2[n][3] * v2[n][3]));
                        ss = xl_sumx32(xl_sumx16(ss));
                        const float hr = 1.0f / sqrtf(ss * (1.0f / 64.0f) + 1e-6f);
#pragma unroll
                        for (int n = 0; n < 2; ++n) { v1[n] = v1[n] * hr * g1[n]; v2[n] = v2[n] * hr * g2[n]; }
                        if (p != 0) {
                            const float* rp = rope + ((size_t)(256 * (p - 1) + rl) * 32 + 8 * fq) * 2;
#pragma unroll
                            for (int n = 0; n < 2; ++n) { const f32x4 c0 = *(const f32x4*)(rp + 8 * n), c1 = *(const f32x4*)(rp + 8 * n + 4);
                                const f32x4 cs = (f32x4){c0[0], c0[2], c1[0], c1[2]}, sn = (f32x4){c0[1], c0[3], c1[1], c1[3]};
                                const f32x4 o1 = v1[n] * cs - v2[n] * sn, o2 = v1[n] * sn + v2[n] * cs; v1[n] = o1; v2[n] = o2; }
                        }
                    }
                    u32x4 w; w.x = cvt_pk_bf16(v1[0][0], v1[0][1]); w.y = cvt_pk_bf16(v1[0][2], v1[0][3]); w.z = cvt_pk_bf16(v1[1][0], v1[1][1]); w.w = cvt_pk_bf16(v1[1][2], v1[1][3]);
                    *(u32x4*)(obase + R * ldc) = w;
                    w.x = cvt_pk_bf16(v2[0][0], v2[0][1]); w.y = cvt_pk_bf16(v2[0][2], v2[0][3]); w.z = cvt_pk_bf16(v2[1][0], v2[1][1]); w.w = cvt_pk_bf16(v2[1][2], v2[1][3]);
                    *(u32x4*)(obase + R * ldc + 16) = w; }
            return;
        }
#pragma unroll
        for (int ai = 0; ai < 2; ++ai)
#pragma unroll
            for (int m = 0; m < 4; ++m) { const size_t R = (size_t)(row0 + ai * HALF + m * 16); const float ri = (u.ord < 12) ? rtab[u.ord * 256 + ai * HALF + wr * 64 + m * 16 + fr] : row_rinv(rowss, R, fq); bf16_t* rowp = O + R * ldc + col0;
#pragma unroll
                for (int bj = 0; bj < 2; ++bj) { const f32x4 v0 = acc[ai][bj][m][0] * ri + bv[bj][0], v1 = acc[ai][bj][m][1] * ri + bv[bj][1];
                    u32x4 w; w.x = cvt_pk_bf16(v0[0], v0[1]); w.y = cvt_pk_bf16(v0[2], v0[3]); w.z = cvt_pk_bf16(v1[0], v1[1]); w.w = cvt_pk_bf16(v1[2], v1[3]);
                    *(u32x4*)(rowp + bj * HALF) = w; } }
    }
};
struct EpiSwiGLU {
    static constexpr bool PERM = true, AFTER_DRAIN = false; static constexpr int TAG = 34;
    bf16_t* O; int ldc; const float* bias; int nb; const PG8_LAS float* rtab; const float* rowss;
    __device__ __forceinline__ void operator()(const f32x4 (&acc)[2][2][4][2], const Unit& u, int wr, int wc, int fr, int fq) const {
        asm volatile("" : "+v"(fr), "+v"(fq));
        const int b = u.pm / 33, p = u.pm % 33, bb = (p == 0) ? 4 : b;
        const int row0 = u.pm * BM + wr * 64 + fr, col0 = u.pn * HALF + wc * 32 + 8 * fq, bcol0 = u.pn * BM + wc * 32 + 8 * fq;
        f32x4 bv[2][2];
#pragma unroll
        for (int bj = 0; bj < 2; ++bj)
#pragma unroll
            for (int n = 0; n < 2; ++n) bv[bj][n] = (u.ord < 12) ? *(const PG8_LAS f32x4*)(rtab + 12 * 256 + u.ord * 256 + wc * 32 + 8 * fq + bj * HALF + 4 * n) : *(const f32x4*)(bias + (size_t)bb * nb + bcol0 + bj * HALF + 4 * n);
#pragma unroll
        for (int ai = 0; ai < 2; ++ai)
#pragma unroll
            for (int m = 0; m < 4; ++m) { const size_t R = (size_t)(row0 + ai * HALF + m * 16); const float ri = (u.ord < 12) ? rtab[u.ord * 256 + ai * HALF + wr * 64 + m * 16 + fr] : row_rinv(rowss, R, fq); bf16_t* rowp = O + R * ldc + col0;
                float hv[8];
#pragma unroll
                for (int n = 0; n < 2; ++n)
#pragma unroll
                    for (int e = 0; e < 4; ++e) { const float g = acc[ai][0][m][n][e] * ri + bv[0][n][e], up = acc[ai][1][m][n][e] * ri + bv[1][n][e];
                        hv[n * 4 + e] = g * up * __builtin_amdgcn_rcpf(1.0f + __builtin_amdgcn_exp2f(-1.44269504089f * g)); }
                u32x4 w; w.x = cvt_pk_bf16(hv[0], hv[1]); w.y = cvt_pk_bf16(hv[2], hv[3]); w.z = cvt_pk_bf16(hv[4], hv[5]); w.w = cvt_pk_bf16(hv[6], hv[7]);
                *(u32x4*)rowp = w; }
    }
};
}
#ifndef PG8_SP2
#define PG8_SP2 true
#endif
#ifndef PG8_ALIGN
#define PG8_ALIGN true
#endif
#include <hip/hip_bf16.h>
#include <cmath>
namespace attn_body {
using bf16=__hip_bfloat16;
using bf16x8=__attribute__((ext_vector_type(8)))short;
using s16x4=__attribute__((ext_vector_type(4)))short;
using f32x16=__attribute__((ext_vector_type(16)))float;
using u32x4=__attribute__((ext_vector_type(4)))unsigned;
constexpr int D=64,PQ=2304,PO=1280;
constexpr int NW=8,QBLK=32,QB=QBLK*NW,KVBLK=64;
constexpr int ATTN_UNIT_ROWS=QB;
__device__ __forceinline__ int crow(int r,int hi){return (r&3)+8*(r>>2)+4*hi;}
#define SBAR() __builtin_amdgcn_sched_barrier(0)
constexpr int NSLOT=3, SLOTB=8192;
constexpr int LDS_K=0, LDS_V=NSLOT*SLOTB, LDS_WS=2*NSLOT*SLOTB, LDS_OST=LDS_WS+NW*64*4, LDS_BYTES=LDS_OST+NW*4096;
constexpr float C2=0.125f*1.4426950408889634f;
__device__ __forceinline__ void glds16(const void*gsrc,unsigned lds_dst){unsigned keep;
  asm volatile("s_mov_b32 %0, m0\n\ts_mov_b32 m0, %2\n\ts_nop 0\n\tglobal_load_lds_dwordx4 %1, off\n\ts_mov_b32 m0, %0":"=&s"(keep):"v"(gsrc),"s"(lds_dst):"memory");}
__device__ __forceinline__ float max3f(float a,float b,float c){float r;asm("v_max3_f32 %0, %1, %2, %3":"=v"(r):"v"(a),"v"(b),"v"(c));return r;}
__device__ __forceinline__ float max2f(float a,float b){float r;asm("v_max_f32_e32 %0, %1, %2":"=v"(r):"v"(a),"v"(b));return r;}
__device__ __forceinline__ float fadd_s(float a,float b){float r;asm("v_add_f32_e32 %0, %1, %2":"=v"(r):"v"(a),"v"(b));return r;}
__device__ __forceinline__ float fsub_s(float a,float b){float r;asm("v_sub_f32_e32 %0, %1, %2":"=v"(r):"v"(a),"v"(b));return r;}
typedef float f32x2_t __attribute__((ext_vector_type(2))); typedef __bf16 bf16x2_t __attribute__((ext_vector_type(2)));
__device__ __forceinline__ unsigned cvtpk_s(float lo,float hi){f32x2_t v={lo,hi};bf16x2_t b=__builtin_convertvector(v,bf16x2_t);return __builtin_bit_cast(unsigned,b);}
#define WAIT_BAR(N) asm volatile("s_waitcnt vmcnt(" #N ") lgkmcnt(0)\n\ts_barrier":::"memory")

__device__ __forceinline__ void qkt(f32x16&p0,f32x16&p1,const char*Kslot,const bf16x8*qr,const f32x16&negm,int r32,int hi){
  const char*kb=Kslot+hi*1024+r32*16;
  #pragma unroll
  for(int d0=0;d0<4;++d0){
    const bf16x8 b0=*reinterpret_cast<const bf16x8*>(kb+d0*2048);
    const bf16x8 b1=*reinterpret_cast<const bf16x8*>(kb+d0*2048+512);
    if(d0==0){p0=__builtin_amdgcn_mfma_f32_32x32x16_bf16(b0,qr[0],negm,0,0,0);p1=__builtin_amdgcn_mfma_f32_32x32x16_bf16(b1,qr[0],negm,0,0,0);}
    else{p0=__builtin_amdgcn_mfma_f32_32x32x16_bf16(b0,qr[d0],p0,0,0,0);p1=__builtin_amdgcn_mfma_f32_32x32x16_bf16(b1,qr[d0],p1,0,0,0);}}
}
typedef __attribute__((address_space(3))) const char* lds_cptr;
typedef short v4i16_t __attribute__((ext_vector_type(4)));
__device__ __forceinline__ void kload8(bf16x8*kf,lds_cptr kp){
  kf[0]=*(const __attribute__((address_space(3))) bf16x8*)(kp);      kf[1]=*(const __attribute__((address_space(3))) bf16x8*)(kp+512);
  kf[2]=*(const __attribute__((address_space(3))) bf16x8*)(kp+2048); kf[3]=*(const __attribute__((address_space(3))) bf16x8*)(kp+2560);
  kf[4]=*(const __attribute__((address_space(3))) bf16x8*)(kp+4096); kf[5]=*(const __attribute__((address_space(3))) bf16x8*)(kp+4608);
  kf[6]=*(const __attribute__((address_space(3))) bf16x8*)(kp+6144); kf[7]=*(const __attribute__((address_space(3))) bf16x8*)(kp+6656);
}
__device__ __forceinline__ void kload2(bf16x8*kf,lds_cptr kp,int j){ kf[2*j]=*(const __attribute__((address_space(3))) bf16x8*)(kp+j*2048); kf[2*j+1]=*(const __attribute__((address_space(3))) bf16x8*)(kp+j*2048+512); }
__device__ __forceinline__ s16x4 vtr(lds_cptr p){ return __builtin_bit_cast(s16x4,__builtin_amdgcn_ds_read_tr16_b64_v4i16((__attribute__((address_space(3))) v4i16_t*)p)); }
__device__ __forceinline__ float rowmax(const f32x16&p0,const f32x16&p1){
  float a=max3f(p0[0],p0[1],p1[0]),b=max3f(p0[2],p0[3],p1[1]);a=max3f(a,p1[2],p1[3]);
  #pragma unroll
  for(int r=4;r<16;r+=4){a=max3f(a,p0[r],p0[r+1]);b=max3f(b,p0[r+2],p0[r+3]);a=max3f(a,p1[r],p1[r+1]);b=max3f(b,p1[r+2],p1[r+3]);}
  const float m=max2f(a,b);
  auto rr=__builtin_amdgcn_permlane32_swap(__float_as_uint(m),__float_as_uint(m),false,false);
  return max2f(__uint_as_float(rr[0]),__uint_as_float(rr[1]));
}
__device__ __forceinline__ void pv(f32x16*o,int vb,bf16x8 pa0,bf16x8 pa1,bf16x8 pa2,bf16x8 pa3){
  #pragma unroll
  for(int d0=0;d0<2;++d0){s16x4 lo[4],hi[4];
    #pragma unroll
    for(int ks=0;ks<4;++ks){
      asm volatile("ds_read_b64_tr_b16 %0,%1 offset:%c2":"=&v"(lo[ks]):"v"(vb),"i"(d0*4096+ks*1024):"memory");
      asm volatile("ds_read_b64_tr_b16 %0,%1 offset:%c2":"=&v"(hi[ks]):"v"(vb),"i"(d0*4096+ks*1024+512):"memory");}
    asm volatile("s_waitcnt lgkmcnt(0)":::"memory");SBAR();
    #define PK(k) (bf16x8){lo[k][0],lo[k][1],lo[k][2],lo[k][3],hi[k][0],hi[k][1],hi[k][2],hi[k][3]}
    o[d0]=__builtin_amdgcn_mfma_f32_32x32x16_bf16(pa0,PK(0),o[d0],0,0,0);
    o[d0]=__builtin_amdgcn_mfma_f32_32x32x16_bf16(pa1,PK(1),o[d0],0,0,0);
    o[d0]=__builtin_amdgcn_mfma_f32_32x32x16_bf16(pa2,PK(2),o[d0],0,0,0);
    o[d0]=__builtin_amdgcn_mfma_f32_32x32x16_bf16(pa3,PK(3),o[d0],0,0,0);
    #undef PK
  }
}

#ifndef ATTN_STORE16
#define ATTN_STORE16(p,v) (*(u32x4*)(p)=(v))
#endif
template<int THRL> __device__ __forceinline__ void attn_unit(const bf16*Qu,const bf16*__restrict__ Kh,const bf16*__restrict__ Vh,bf16*Ou,const int NT,char*shm,int tid){
  const int lane=tid&63,r32=lane&31,hi=lane>>5; const int wid=__builtin_amdgcn_readfirstlane(tid>>6);
  const bf16*Qw=Qu+(long)(wid*QBLK)*PQ;
  const unsigned lds0=(unsigned)(uintptr_t)shm;
  float*wsf=(float*)(shm+LDS_WS)+wid*64;
  const bf16*ksrc=Kh+(long)lane*PQ+wid*8;
  const bf16*vsrc=Vh+(long)(16*(wid&3)+(lane>>2))*PQ+(wid>>2)*32+(lane&3)*8;
  const unsigned kdst=lds0+LDS_K+wid*1024, vdst=lds0+LDS_V+wid*1024;
  #define DMA_K(t,slot) glds16(ksrc+(long)(t)*KVBLK*PQ,(unsigned)__builtin_amdgcn_readfirstlane(kdst+(slot)))
  #define DMA_V(t,slot) glds16(vsrc+(long)(t)*KVBLK*PQ,(unsigned)__builtin_amdgcn_readfirstlane(vdst+(slot)))
  const int vb0=(int)(lds0+LDS_V)+((lane>>4)&1)*32+(lane&3)*8+(4*hi+((lane&15)>>2))*64;
  const char*Kbase=shm+LDS_K; bf16x8 kf[8];
  const lds_cptr shm3=(lds_cptr)shm; const lds_cptr kp0=shm3+LDS_K+hi*1024+r32*16; const lds_cptr vp0=shm3+LDS_V+((lane>>4)&1)*32+(lane&3)*8+(4*hi+((lane&15)>>2))*64;
  DMA_K(0,0);DMA_V(0,0);DMA_K(1,SLOTB);
  bf16x8 qr[4];
  #pragma unroll
  for(int d0=0;d0<4;++d0)qr[d0]=*reinterpret_cast<const bf16x8*>(&Qw[(long)r32*PQ+d0*16+hi*8]);
  float mhat=0.f,l_reg=0.f;f32x16 o[2];o[0]=f32x16{};o[1]=f32x16{};f32x16 negm=f32x16{};asm volatile("":"+v"(negm));
  #define CMASK(P0,P1,t) do{}while(0)
  bool resc=false;
  #define START(P0,P1) do{ const float rm=rowmax(P0,P1); resc=false; \
    { const float dl=rm; mhat=fadd_s(mhat,dl); \
      _Pragma("unroll") for(int r=0;r<16;++r){P0[r]=fsub_s(P0[r],dl);P1[r]=fsub_s(P1[r],dl);} \
      _Pragma("unroll") for(int r=0;r<16;++r)negm[r]=-mhat; asm volatile("":"+v"(negm)); } \
    _Pragma("unroll") for(int r=0;r<16;++r)P0[r]=__builtin_amdgcn_exp2f(P0[r]); }while(0)
  #define RESC() do{ if(resc){ asm volatile("s_waitcnt lgkmcnt(0)":::"memory"); \
      _Pragma("unroll") for(int d_=0;d_<2;++d_) _Pragma("unroll") for(int r=0;r<16;++r)o[d_][r]*=wsf[crow(r,hi)]; } }while(0)
  f32x16 pA0,pA1,pB0,pB1;
  int sl_prev=0,sl_cur=0,sl_next=SLOTB;
  #define ROT() do{sl_prev=sl_cur;sl_cur=sl_next;sl_next=(sl_next==(NSLOT-1)*SLOTB)?0:sl_next+SLOTB;}while(0)
  DMA_K(2,2*SLOTB);
  WAIT_BAR(3);
  qkt(pA0,pA1,Kbase,qr,negm,r32,hi);asm volatile("s_nop 15\n\ts_nop 7":"+v"(pA0),"+v"(pA1));CMASK(pA0,pA1,0);
  START(pA0,pA1);
  _Pragma("unroll") for(int r=0;r<16;++r)pA1[r]=__builtin_amdgcn_exp2f(pA1[r]);
  WAIT_BAR(0);
  DMA_K(3,0);DMA_V(1,SLOTB);
  ROT();
  kload8(kf,kp0+sl_cur);
  WAIT_BAR(2);
  s16x4 vlo[8],vhi[8]; u32x4 pw0,pw1,pw2,pw3;
  #define PKW(P,B) cvtpk_s(P[B],P[B+1])
  #define PAF(k) __builtin_bit_cast(bf16x8,pw##k)
  #define VFR(i) (bf16x8){vlo[i][0],vlo[i][1],vlo[i][2],vlo[i][3],vhi[i][0],vhi[i][1],vhi[i][2],vhi[i][3]}
  #define PIN(x) asm volatile("":"+v"(x))
  #define MX3(a,b,c) __builtin_fmaxf(__builtin_fmaxf((a),(b)),(c))
  #define GAPA(MF,A0,A1,A2,A3,W0,W1,PW) do{ MF; sacc+=A0; sacc+=A1; sacc+=A2; sacc+=A3; PIN(sacc); W0; W1; PIN(PW); SBAR(); }while(0)
  #define EX(v) __builtin_amdgcn_exp2f(v)
  #define GAPB(MF,X,B) do{ MF; X[B]=EX(X[B]); X[B+1]=EX(X[B+1]); X[B+2]=EX(X[B+2]); X[B+3]=EX(X[B+3]); PIN(X); SBAR(); }while(0)
  #define VRD(i) do{ vlo[i]=vtr(vp_+(((i)>>2)*4096+((i)&3)*1024)); vhi[i]=vtr(vp_+(((i)>>2)*4096+((i)&3)*1024+512)); }while(0)
  #define KRD(G,j) do{ if(G){ kload2(kf,kp0+sl_next,j); SBAR(); } }while(0)
  #define STEP(C0,C1,P0,P1,t,GK,GV,GL) do{ SBAR(); \
    const lds_cptr vp_=vp0+sl_prev; \
    VRD(0); SBAR(); float sacc=(P0[0]+P0[1]); \
    GAPA(C0=__builtin_amdgcn_mfma_f32_32x32x16_bf16(kf[0],qr[0],negm,0,0,0), P0[2],P0[3],P0[4],P0[5],     pw0[0]=PKW(P0,0), pw0[1]=PKW(P0,2), pw0); \
    VRD(4); SBAR(); GAPA(C1=__builtin_amdgcn_mfma_f32_32x32x16_bf16(kf[1],qr[0],negm,0,0,0), P0[6],P0[7],P0[8],P0[9],     pw0[2]=PKW(P0,4), pw0[3]=PKW(P0,6), pw0); \
    VRD(1); SBAR(); GAPA(C0=__builtin_amdgcn_mfma_f32_32x32x16_bf16(kf[2],qr[1],C0,0,0,0),   P0[10],P0[11],P0[12],P0[13], pw1[0]=PKW(P0,8), pw1[1]=PKW(P0,10), pw1); \
    VRD(5); SBAR(); GAPA(C1=__builtin_amdgcn_mfma_f32_32x32x16_bf16(kf[3],qr[1],C1,0,0,0),   P0[14],P0[15],P1[0],P1[1],   pw1[2]=PKW(P0,12),pw1[3]=PKW(P0,14), pw1); \
    VRD(2); SBAR(); GAPA(C0=__builtin_amdgcn_mfma_f32_32x32x16_bf16(kf[4],qr[2],C0,0,0,0),   P1[2],P1[3],P1[4],P1[5],     pw2[0]=PKW(P1,0), pw2[1]=PKW(P1,2), pw2); \
    VRD(6); SBAR(); GAPA(C1=__builtin_amdgcn_mfma_f32_32x32x16_bf16(kf[5],qr[2],C1,0,0,0),   P1[6],P1[7],P1[8],P1[9],     pw2[2]=PKW(P1,4), pw2[3]=PKW(P1,6), pw2); \
    VRD(3); SBAR(); GAPA(C0=__builtin_amdgcn_mfma_f32_32x32x16_bf16(kf[6],qr[3],C0,0,0,0),   P1[10],P1[11],P1[12],P1[13], pw3[0]=PKW(P1,8), pw3[1]=PKW(P1,10), pw3); \
    VRD(7); SBAR(); GAPA(C1=__builtin_amdgcn_mfma_f32_32x32x16_bf16(kf[7],qr[3],C1,0,0,0),   P1[14],P1[15],0.f,0.f,       pw3[2]=PKW(P1,12),pw3[3]=PKW(P1,14), pw3); \
    l_reg+=sacc; \
    if(GK){DMA_K((t)+3,sl_cur);} if(GV){DMA_V((t)+1,sl_next);} \
    CMASK(C0,C1,t); \
    { float a=MX3(C0[0],C0[1],C1[0]),b=MX3(C0[2],C0[3],C1[1]); a=MX3(a,C1[2],C1[3]); \
      _Pragma("unroll") for(int r=4;r<16;r+=4){a=MX3(a,C0[r],C0[r+1]);b=MX3(b,C0[r+2],C0[r+3]);a=MX3(a,C1[r],C1[r+1]);b=MX3(b,C1[r+2],C1[r+3]);} \
      float rm=__builtin_fmaxf(a,b); { auto rr=__builtin_amdgcn_permlane32_swap(__float_as_uint(rm),__float_as_uint(rm),false,false); rm=__builtin_fmaxf(__uint_as_float(rr[0]),__uint_as_float(rr[1])); } \
      resc=false; \
      if(__builtin_expect(__any(rm>(float)THRL),0)){ const float dl=__builtin_fmaxf(rm,0.f); mhat+=dl; \
        _Pragma("unroll") for(int r=0;r<16;++r){C0[r]-=dl;C1[r]-=dl;} \
        _Pragma("unroll") for(int r=0;r<16;++r)negm[r]=-mhat; asm volatile("":"+v"(negm)); \
        const float f=__builtin_amdgcn_exp2f(-dl); l_reg*=f; if(hi==0)wsf[r32]=f; resc=true; } } \
    SBAR(); \
    GAPB(o[0]=__builtin_amdgcn_mfma_f32_32x32x16_bf16(PAF(0),VFR(0),o[0],0,0,0), C0,0); \
    GAPB(o[1]=__builtin_amdgcn_mfma_f32_32x32x16_bf16(PAF(0),VFR(4),o[1],0,0,0), C0,4); \
    KRD(GL,0); GAPB(o[0]=__builtin_amdgcn_mfma_f32_32x32x16_bf16(PAF(1),VFR(1),o[0],0,0,0), C0,8); \
    KRD(GL,1); GAPB(o[1]=__builtin_amdgcn_mfma_f32_32x32x16_bf16(PAF(1),VFR(5),o[1],0,0,0), C0,12); \
    KRD(GL,2); GAPB(o[0]=__builtin_amdgcn_mfma_f32_32x32x16_bf16(PAF(2),VFR(2),o[0],0,0,0), C1,0); \
    KRD(GL,3); GAPB(o[1]=__builtin_amdgcn_mfma_f32_32x32x16_bf16(PAF(2),VFR(6),o[1],0,0,0), C1,4); \
    GAPB(o[0]=__builtin_amdgcn_mfma_f32_32x32x16_bf16(PAF(3),VFR(3),o[0],0,0,0), C1,8); \
    GAPB(o[1]=__builtin_amdgcn_mfma_f32_32x32x16_bf16(PAF(3),VFR(7),o[1],0,0,0), C1,12); \
    }while(0)
  int t=1;
  #undef CMASK
  #define CMASK(P0,P1,t) do{}while(0)
  for(;t+5<NT;t+=2){
    STEP(pB0,pB1,pA0,pA1,t,true,true,true);     WAIT_BAR(2); RESC(); ROT();
    STEP(pA0,pA1,pB0,pB1,t+1,true,true,true);   WAIT_BAR(2); RESC(); ROT();
  }
  #undef CMASK
  #define CMASK(P0,P1,t) do{}while(0)
  #define ENDW(tt) do{ if((tt)+3<NT){WAIT_BAR(2);} else if((tt)+2<NT){WAIT_BAR(1);} else {WAIT_BAR(0);} }while(0)
  for(;t+1<NT;t+=2){
    STEP(pB0,pB1,pA0,pA1,t,(t+3<NT),(t+1<NT),(t+1<NT));       ENDW(t);   RESC(); ROT();
    STEP(pA0,pA1,pB0,pB1,t+1,(t+4<NT),(t+2<NT),(t+2<NT));     ENDW(t+1); RESC(); ROT();
  }
  STEP(pB0,pB1,pA0,pA1,NT-1,false,false,false); RESC();
  { float sacc=pB0[0]+pB0[1]; _Pragma("unroll") for(int r=2;r<16;++r)sacc+=pB0[r]; _Pragma("unroll") for(int r=0;r<16;++r)sacc+=pB1[r]; l_reg+=sacc;
    pw0=(u32x4){PKW(pB0,0),PKW(pB0,2),PKW(pB0,4),PKW(pB0,6)};pw1=(u32x4){PKW(pB0,8),PKW(pB0,10),PKW(pB0,12),PKW(pB0,14)};pw2=(u32x4){PKW(pB1,0),PKW(pB1,2),PKW(pB1,4),PKW(pB1,6)};pw3=(u32x4){PKW(pB1,8),PKW(pB1,10),PKW(pB1,12),PKW(pB1,14)};
    SBAR(); pv(o,vb0+sl_cur,PAF(0),PAF(1),PAF(2),PAF(3)); }
  #undef PKW
  #undef PAF
  #undef VFR
  #undef PIN
  #undef MX3
  #undef GAPA
  #undef GAPB
  #undef EX
  #undef VRD
  #undef KRD
  #undef STEP
  #undef ENDW
  {auto rr=__builtin_amdgcn_permlane32_swap(__float_as_uint(l_reg),__float_as_uint(l_reg),false,false);l_reg=__uint_as_float(rr[0])+__uint_as_float(rr[1]);}
  if(hi==0)wsf[32+r32]=l_reg;asm volatile("s_waitcnt lgkmcnt(0)":::"memory");
  float rli[16];
  #pragma unroll
  for(int r=0;r<16;++r)rli[r]=__builtin_amdgcn_rcpf(wsf[32+crow(r,hi)]);
  bf16*Ow=Ou+(long)(wid*QBLK)*PO;
  { bf16*stg=(bf16*)(shm+LDS_OST)+wid*2048;
    #pragma unroll
    for(int r=0;r<16;++r){const int orow=crow(r,hi);
      #pragma unroll
      for(int d0=0;d0<2;++d0)stg[orow*64+d0*32+r32]=__float2bfloat16(o[d0][r]*rli[r]);}
    asm volatile("s_waitcnt lgkmcnt(0)":::"memory");
    #pragma unroll
    for(int i=0;i<4;++i){const int row=i*8+(lane>>3),ch=lane&7; const u32x4 v=*(const u32x4*)(stg+row*64+ch*8); ATTN_STORE16(Ow+(long)row*PO+ch*8,v);} }
  asm volatile("s_waitcnt lgkmcnt(0)\n\ts_barrier":::"memory");
  #undef DMA_K
  #undef DMA_V
  #undef CMASK
  #undef START
  #undef RESC
  #undef ROT
}
constexpr int ATTN_LDS_BYTES=LDS_BYTES;
#undef SBAR
#undef WAIT_BAR
}

constexpr int NWAVES = 8, NTHREADS = NWAVES * 64;
constexpr int DM = 1024, NB = 4, SEQ = 8192, CTXL = 256, DEPTH = 4;
constexpr int TPB = SEQ + CTXL;
constexpr int MROWS = NB * TPB;
constexpr int PROJ = 2304, DFF = 2816, KMIX = 1280;
constexpr int OFF_Q = 256, OFF_K = 768, OFF_V = 896, OFF_FF = 1024, OFF_FB = 1280, OFF_I = 1536, OFF_HQ = 1792, OFF_G = 2048;
constexpr int MIX_P = 0, MIX_Q = 256, MIX_A = 512, MIX_R = 1024;
constexpr float EPS = 1e-6f;
constexpr float QSCALE = 0.125f * 1.4426950408889634f;
constexpr int MOD_SH_A = 0, MOD_SC_A = 1024, MOD_G_A = 2048, MOD_SH_F = 3072, MOD_SC_F = 4096, MOD_G_F = 5120;

constexpr size_t MiB = 1u << 20;
constexpr size_t WS_CTL = 0, CTL_ZERO_BYTES = 1 * MiB;
constexpr size_t WS_MODS = 1 * MiB;
constexpr size_t WS_LB = WS_MODS + 512 * 1024;
constexpr size_t WS_TW = WS_LB + 65536;
constexpr size_t WS_FT128 = WS_TW + 65536;
constexpr size_t WS_W64F = WS_FT128 + 65536;
constexpr size_t WS_CT256 = WS_W64F + 16384;
static_assert(WS_CT256 + 262144 <= 2 * MiB, "tables");
constexpr size_t WS_ROPE = 2 * MiB;
constexpr size_t WS_TF = 4 * MiB;
constexpr size_t WS_XC = 6 * MiB;
constexpr size_t WS_WIN = 10 * MiB;
constexpr size_t WS_WOUT = 28 * MiB;
constexpr size_t WS_WGU = 38 * MiB;
constexpr size_t WS_WDN = 82 * MiB;
constexpr size_t WS_XB = 104 * MiB;
constexpr size_t WS_HGS = 170 * MiB;
constexpr size_t WS_UX = 236 * MiB;
constexpr size_t WS_MIX = 385 * MiB;
constexpr size_t WS_H = WS_UX;
constexpr size_t WS_HGG = 468 * MiB;
constexpr size_t WS_ROWSS = 470 * MiB;
constexpr size_t WS_BIASA = 473 * MiB;
constexpr size_t WS_BIASF = 474 * MiB;
constexpr size_t WS_END = 475 * MiB;
static_assert(WS_UX + (size_t)MROWS * PROJ * 2 <= WS_MIX && WS_MIX + (size_t)MROWS * KMIX * 2 <= WS_END && WS_H + (size_t)MROWS * DFF * 2 <= WS_END, "d_ws map");
static_assert(WS_XB + (size_t)MROWS * DM * 2 <= WS_HGS && WS_HGS + (size_t)2 * MROWS * 256 * 4 <= WS_UX, "d_ws map 2");
constexpr int CW_TMO = 0, CW_CODE = 1, CW_BAR = 4096;

constexpr int RING_OFF = 0, RING_BYTES = 131072;
constexpr int LDSCTL_OFF = RING_BYTES, MISC_OFF = LDSCTL_OFF + 320;
constexpr int RINV_OFF = LDSCTL_OFF + 512, RINV_SLOTS = 12;
constexpr int BTAB_OFF = RINV_OFF + RINV_SLOTS * 1024;
constexpr int LDS_BYTES = 157696;
static_assert(BTAB_OFF + RINV_SLOTS * 1024 <= LDS_BYTES && LDS_BYTES <= 163840, "LDS map");

#define GAS __attribute__((address_space(1)))
#define LAS __attribute__((address_space(3)))
typedef unsigned short bf16;
typedef unsigned v4u __attribute__((ext_vector_type(4)));
typedef float f32x4 __attribute__((ext_vector_type(4)));
typedef short bf16x8 __attribute__((ext_vector_type(8)));
typedef GAS unsigned gu32;
typedef GAS unsigned long long gu64;
#define RLX_AGENT __ATOMIC_RELAXED, __HIP_MEMORY_SCOPE_AGENT
#define LDS_WAIT() asm volatile("s_waitcnt lgkmcnt(0)" ::: "memory")
#define VM_WAIT() asm volatile("s_waitcnt vmcnt(0)" ::: "memory")
__device__ __forceinline__ unsigned long long rt() { return __builtin_amdgcn_s_memrealtime(); }
__device__ __forceinline__ unsigned f2bf(float f) { unsigned u = __builtin_bit_cast(unsigned, f); return (u + 0x7fffu + ((u >> 16) & 1u)) >> 16; }
__device__ __forceinline__ unsigned pk2(float lo, float hi) { return f2bf(lo) | (f2bf(hi) << 16); }

#define XB_TMO      128
#define XB_XCNT(j)  (256  + 64 * (j))
#define XB_XSUB(j)  (1280 + 64 * (j))
#define XB_XGEN(j)  (2304 + 64 * (j))
#define XB_TOP      3328
#define XB_TOPGEN   3392
#define XCD_BAR_WORDS 3456
#define XB_SPIN_CAP (1u << 18)

__device__ __forceinline__ unsigned xb_ld(unsigned* p)              { return __hip_atomic_load(p, __ATOMIC_RELAXED, __HIP_MEMORY_SCOPE_AGENT); }
__device__ __forceinline__ unsigned xb_add(unsigned* p, unsigned v) { return __hip_atomic_fetch_add(p, v, __ATOMIC_RELAXED, __HIP_MEMORY_SCOPE_AGENT); }
__device__ __forceinline__ unsigned xb_xcc_id() { return (unsigned)__builtin_amdgcn_s_getreg((3 << 11) | 20) & 0xFu; }
#define XB_SPIN(cond, bar) do { unsigned _sp = 0; while (cond) { __builtin_amdgcn_s_sleep(1); \
    if ((++_sp & 255u) == 0u) { if (xb_ld(&(bar)[XB_TMO])) break; if (_sp > XB_SPIN_CAP) { atomicAdd(&(bar)[XB_TMO], 1u); break; } } } } while (0)

struct XcdBarrier {
    unsigned* bar; unsigned x;
    volatile LAS unsigned* st;
};

__device__ __forceinline__ XcdBarrier xcd_barrier_post(unsigned* bar, volatile LAS unsigned* st) {
    XcdBarrier b; b.bar = bar; b.x = xb_xcc_id(); b.st = st;
    if (threadIdx.x == 0) (void)xb_add(&bar[XB_XCNT(b.x)], 1u);
    return b;
}
__device__ __forceinline__ void xcd_barrier_complete(unsigned* bar, unsigned x, unsigned& nloc, unsigned& nx) {
    const unsigned G = gridDim.x * gridDim.y * gridDim.z;
    unsigned sum, cnt, mine, sp = 0u;
    for (;;) {
        sum = 0u; cnt = 0u; mine = 0u;
#pragma unroll
        for (unsigned j = 0; j < 16; ++j) { const unsigned c = xb_ld(&bar[XB_XCNT(j)]); sum += c; cnt += (c > 0u) ? 1u : 0u; mine = (j == x) ? c : mine; }
        if (sum == G) break;
        __builtin_amdgcn_s_sleep(1);
        if ((++sp & 255u) == 0u) { if (xb_ld(&bar[XB_TMO])) break; if (sp > XB_SPIN_CAP) { atomicAdd(&bar[XB_TMO], 1u); break; } }
    }
    nloc = mine > 0u ? mine : 1u; nx = cnt > 0u ? cnt : 1u;
}

__device__ __forceinline__ void xcd_barrier(const XcdBarrier& b) {
    asm volatile("s_waitcnt vmcnt(0)" ::: "memory");
    __syncthreads();
    if (threadIdx.x == 0) {
        unsigned* bar = b.bar;
        __builtin_amdgcn_s_waitcnt(0);
        unsigned nloc = b.st[0], nx = b.st[1];
        if (nloc == 0u) { xcd_barrier_complete(bar, b.x, nloc, nx); b.st[0] = nloc; b.st[1] = nx; }
        const unsigned old = xb_add(&bar[XB_XSUB(b.x)], 1u);
        const unsigned gen = old / nloc;
        if (old + 1u == (gen + 1u) * nloc) {
            __builtin_amdgcn_fence(__ATOMIC_RELEASE, "agent");
            asm volatile("s_waitcnt vmcnt(0)" ::: "memory");
            const unsigned og = xb_add(&bar[XB_TOP], 1u);
            const unsigned tg = og / nx;
            if (og + 1u == (tg + 1u) * nx) xb_add(&bar[XB_TOPGEN], 1u);
            else XB_SPIN(xb_ld(&bar[XB_TOPGEN]) == tg, bar);
            __builtin_amdgcn_fence(__ATOMIC_ACQUIRE, "agent");
            xb_add(&bar[XB_XGEN(b.x)], 1u);
            asm volatile("s_waitcnt vmcnt(0)" ::: "memory");
        } else {
            XB_SPIN(xb_ld(&bar[XB_XGEN(b.x)]) == gen, bar);
            __builtin_amdgcn_fence(__ATOMIC_ACQUIRE, "agent");
            asm volatile("s_waitcnt vmcnt(0)" ::: "memory");
        }
    }
    __syncthreads();
}

typedef float f32x2 __attribute__((ext_vector_type(2)));
typedef unsigned u32x2 __attribute__((ext_vector_type(2)));
typedef const GAS float* const __attribute__((address_space(4)))* kargs_t;
struct Frame {
    LAS unsigned char* lds;
    volatile LAS unsigned* MISC;
    int tid, lane, wave, vcu, G;
    unsigned long long dt, da;
    GAS unsigned char* ws; GAS float* outg;
    __device__ __forceinline__ float* out_() const { return (float*)outg; }
    __device__ __forceinline__ bf16* HN() const { return (bf16*)outg; }
    __device__ __forceinline__ const float* in(int i) const { return (const float*)(((kargs_t)__builtin_amdgcn_kernarg_segment_ptr())[i]); }
#define FIN(name, idx) __device__ __forceinline__ const float* name() const { return in(idx); }
    FIN(x, 0) FIN(c, 1) FIN(ctx, 2) FIN(c_ctx, 3) FIN(w_ada, 4) FIN(b_ada, 5) FIN(w_in, 6) FIN(w_four, 7) FIN(q_norm, 8) FIN(k_norm, 9) FIN(hg_lb, 10) FIN(hg_norm, 11) FIN(w_out, 12) FIN(w_gate, 13) FIN(w_up, 14) FIN(w_down, 15) FIN(final_norm, 16)
#undef FIN
#define FWS(type, name, off) __device__ __forceinline__ type* name() const { return (type*)(ws + (off)); }
    FWS(unsigned, ctlw, WS_CTL) FWS(float, MODS, WS_MODS) FWS(float, LB, WS_LB) FWS(f32x2, ROPE, WS_ROPE) FWS(float, TF, WS_TF) FWS(float, XC, WS_XC) FWS(float, HGS, WS_HGS) FWS(float, HGG, WS_HGG) FWS(float, ROWSS, WS_ROWSS) FWS(float, BIASA, WS_BIASA) FWS(float, BIASF, WS_BIASF)
    FWS(f32x2, TW, WS_TW) FWS(bf16, FT128, WS_FT128) FWS(bf16, W64F, WS_W64F) FWS(bf16, CT256, WS_CT256)
    FWS(bf16, WIN, WS_WIN) FWS(bf16, WOUT, WS_WOUT) FWS(bf16, WGU, WS_WGU) FWS(bf16, WDN, WS_WDN) FWS(bf16, XB, WS_XB) FWS(bf16, UX, WS_UX) FWS(bf16, MIX, WS_MIX) FWS(bf16, HB, WS_H)
#undef FWS
};
__device__ __forceinline__ float bf2f(unsigned short h) { return __builtin_bit_cast(float, (unsigned)h << 16); }
__device__ __forceinline__ float bflo(unsigned w) { return __builtin_bit_cast(float, w << 16); }
__device__ __forceinline__ float bfhi(unsigned w) { return __builtin_bit_cast(float, w & 0xffff0000u); }
__device__ __forceinline__ float wave_sum(float v) { return xl_sum64(v); }
__device__ __forceinline__ float sigmoidf_(float z) { return __builtin_amdgcn_rcpf(1.0f + __builtin_amdgcn_exp2f(-1.44269504089f * z)); }
__device__ __forceinline__ float siluf_(float z) { return z * sigmoidf_(z); }
__device__ __forceinline__ const float* xrow_ptr(const float* lat, const float* ctx, int R) {
    const int b = R / TPB, t = R - b * TPB;
    return (t < CTXL) ? ctx + ((size_t)b * CTXL + t) * DM : lat + ((size_t)b * SEQ + (t - CTXL)) * DM;
}

__host__ __device__ __forceinline__ int win_row(int c) {
    if (c < 256 || c >= 1024) return c;
    const int hh = (c - 256) >> 6, d = (c - 256) & 63, bj = (d >> 4) & 1, p = (d & 15) + ((d >> 5) << 4);
    return 256 * (1 + (hh >> 2)) + 128 * bj + 32 * (hh & 3) + p;
}
__device__ __forceinline__ void tr_item(const float* src, int ldsrc, bf16* dst, int ldt, LAS float* scr, int lane, int row16 = 16) {
#pragma unroll 1
    for (int h = 0; h < 4; ++h) { float tv[8];
#pragma unroll
        for (int i = 0; i < 8; ++i) tv[i] = src[(size_t)(2 * (8 * h + i) + (lane >> 5)) * ldsrc + (lane & 31)];
#pragma unroll
        for (int i = 0; i < 8; ++i) scr[(2 * (8 * h + i) + (lane >> 5)) * 33 + (lane & 31)] = tv[i]; }
    LDS_WAIT(); asm volatile("" ::: "memory");
    const int c = lane & 7;
#pragma unroll
    for (int j = 0; j < 4; ++j) { const int n = (lane >> 3) + 8 * j; const LAS float* s = scr + (8 * c) * 33 + n;
        v4u o; o.x = pk2(s[0 * 33], s[1 * 33]); o.y = pk2(s[2 * 33], s[3 * 33]); o.z = pk2(s[4 * 33], s[5 * 33]); o.w = pk2(s[6 * 33], s[7 * 33]);
        *(GAS v4u*)(dst + (size_t)(j < 2 ? n : n - 16 + row16) * ldt + 8 * c) = o; }
    LDS_WAIT(); asm volatile("" ::: "memory");
}
__device__ __forceinline__ void p0a_prologue(Frame& F) {
    const int gw = F.vcu * NWAVES + F.wave, NGW = F.G * NWAVES;
    const int gt = F.vcu * NTHREADS + F.tid, NGT = F.G * NTHREADS;
    LAS float* scr = (LAS float*)(F.lds + RING_OFF + F.wave * 12288);
    LAS float* sil = (LAS float*)(F.lds + RING_OFF + 98304);
    LAS f32x2* cs64 = (LAS f32x2*)(F.lds + RING_OFF + 98304 + 20480 + 10240);
    if (F.tid < 64) { const float a = (float)F.tid * (1.0f / 32.0f); cs64[F.tid] = (f32x2){cospif(a), sinpif(a)}; }
    for (int i = F.tid; i < 5 * DM; i += NTHREADS) { const int bb = i >> 10, k = i & 1023; const float v = (bb < 4) ? F.c()[bb * DM + k] : F.c_ctx()[k]; sil[i] = v / (1.0f + expf(-v)); }
    __syncthreads();
    {
        LAS float* part = (LAS float*)(F.lds + RING_OFF + 98304 + 20480);
        for (int it = F.vcu; it < DEPTH * 96; it += F.G) {
            const int l = it / 96, j = (it % 96) * 64 + F.lane;
            const float* wp = F.w_ada() + (size_t)l * DM * 6144 + (size_t)(128 * F.wave) * 6144 + j;
            float a0 = 0.f, a1 = 0.f, a2 = 0.f, a3 = 0.f, a4 = 0.f;
            float wn[16];
#pragma unroll
            for (int i = 0; i < 16; ++i) wn[i] = wp[(size_t)i * 6144];
            for (int k0 = 0; k0 < 128; k0 += 16) {
                float w[16];
#pragma unroll
                for (int i = 0; i < 16; ++i) w[i] = wn[i];
                if (k0 + 16 < 128) {
#pragma unroll
                    for (int i = 0; i < 16; ++i) wn[i] = wp[(size_t)(k0 + 16 + i) * 6144]; }
#pragma unroll
                for (int i = 0; i < 16; ++i) { const int k = 128 * F.wave + k0 + i; a0 += sil[k] * w[i]; a1 += sil[1024 + k] * w[i]; a2 += sil[2048 + k] * w[i]; a3 += sil[3072 + k] * w[i]; a4 += sil[4096 + k] * w[i]; }
            }
            LAS float* pw = part + F.wave * 320 + F.lane;
            pw[0] = a0; pw[64] = a1; pw[128] = a2; pw[192] = a3; pw[256] = a4;
            __syncthreads();
            if (F.tid < 320) { float s = 0.f;
#pragma unroll
                for (int ww = 0; ww < 8; ++ww) s += part[ww * 320 + F.tid];
                const int bb = F.tid >> 6, jj = (it % 96) * 64 + (F.tid & 63);
                F.MODS()[(size_t)l * 5 * 6144 + bb * 6144 + jj] = s + F.b_ada()[l * 6144 + jj]; }
            __syncthreads();
        }
    }
    constexpr int I_IN = 16 * 72, I_OUT = 12 * 32, I_G = 16 * 88, I_D = 44 * 32, I_L = I_IN + I_OUT + 2 * I_G + I_D;
    for (int it = gw; it < DEPTH * I_L; it += NGW) {
        const int l = it / I_L; int r = it % I_L;
        if (r < I_IN) { const int kb = r / 72, nb = r % 72;
            const int r0 = win_row(32 * nb), r16 = win_row(32 * nb + 16);
            tr_item(F.w_in() + (size_t)l * DM * PROJ + (size_t)(64 * kb) * PROJ + 32 * nb, PROJ, F.WIN() + (size_t)l * PROJ * DM + (size_t)r0 * DM + 64 * kb, DM, scr, F.lane, r16 - r0); continue; }
        r -= I_IN;
        if (r < I_OUT) { const int kb = r / 32, nb = r % 32;
            tr_item(F.w_out() + (size_t)l * DM * DM + (size_t)(256 + 64 * kb) * DM + 32 * nb, DM, F.WOUT() + (size_t)l * DM * KMIX + (size_t)(32 * nb) * KMIX + 512 + 64 * kb, KMIX, scr, F.lane); continue; }
        r -= I_OUT;
        if (r < 2 * I_G) { const int up = r / I_G, rr = r % I_G, kb = rr / 88, nb = rr % 88, n0 = 32 * nb;
            const float* W = (up ? F.w_up() : F.w_gate()) + (size_t)l * DM * DFF;
            const int drow = (n0 >> 7) * 256 + up * 128 + (n0 & 127);
            tr_item(W + (size_t)(64 * kb) * DFF + n0, DFF, F.WGU() + (size_t)l * 5632 * DM + (size_t)drow * DM + 64 * kb, DM, scr, F.lane); continue; }
        r -= 2 * I_G;
        { const int kb = r / 32, nb = r % 32;
            tr_item(F.w_down() + (size_t)l * DFF * DM + (size_t)(64 * kb) * DM + 32 * nb, DM, F.WDN() + (size_t)l * DM * DFF + (size_t)(32 * nb) * DFF + 64 * kb, DFF, scr, F.lane); }
    }
    for (int it = gt; it < DEPTH * 2 * 256 * 256; it += NGT) {
        const int jp = it & 255, gc = (it >> 8) & 255, s = (it >> 16) & 1, l = it >> 17, g = gc >> 6, cc = gc & 63;
        const float* wf = F.w_four() + (size_t)l * 65536 + (size_t)(g * 64) * 256 + jp;
        float a = 0.f;
        for (int m = 0; m < 64; ++m) { const f32x2 cs = cs64[(cc * m) & 63]; a += (s ? -cs.y : cs.x) * wf[m * 256]; }
        F.TF()[it] = a * 0.125f;
    }
    for (int it = gt; it < 2 * 256; it += NGT) {
        const int d = it >> 8, cc = it & 255; float v[DEPTH], mx = -INFINITY, sm = 0.f;
#pragma unroll
        for (int l = 0; l < DEPTH; ++l) { v[l] = F.hg_lb()[(d * DEPTH + l) * 256 + cc]; mx = fmaxf(mx, v[l]); }
#pragma unroll
        for (int l = 0; l < DEPTH; ++l) { v[l] = expf(v[l] - mx); sm += v[l]; }
        float cum = 0.f;
#pragma unroll
        for (int l = 0; l < DEPTH; ++l) { if (l > 0) cum += v[l] / sm; F.LB()[(d * DEPTH + l) * 256 + cc] = cum; }
    }
    for (int it = gt; it < SEQ * 32; it += NGT) {
        const int p = it >> 5, i = it & 31; const float pos = (float)((i < 16) ? (p >> 6) : (p & 63));
        const float fr = powf(10000.0f, -(float)(2 * (i & 15)) / 32.0f); const float ang = pos * fr;
        F.ROPE()[it] = (f32x2){cosf(ang), sinf(ang)};
    }
    for (int it = gt; it < SEQ; it += NGT) { const float a = (float)it * (1.0f / 4096.0f); F.TW()[it] = (f32x2){cospif(a), sinpif(a)}; }
    for (int it = gt; it < 2 * 128 * 128; it += NGT) { const int s = it >> 14, k = (it >> 7) & 127, n = it & 127; const float a = (float)((k * n) & 127) * (1.0f / 64.0f); F.FT128()[it] = (bf16)f2bf(s ? sinpif(a) : cospif(a)); }
    for (int it = gt; it < 2 * 2 * 4 * 64 * 8; it += NGT) { const int jj = it & 7, ln = (it >> 3) & 63, T = (it >> 9) & 3, a2 = (it >> 11) & 1, s = it >> 12;
        const int k2 = 16 * T + (ln & 15), g = ln >> 4, n2 = 32 * a2 + (jj < 4 ? 4 * g + jj : 16 + 4 * g + (jj - 4)); const float a = (float)((k2 * n2) & 63) * (1.0f / 32.0f);
        F.W64F()[it] = (bf16)f2bf(s ? sinpif(a) : cospif(a)); }
    for (int it = gt; it < 2 * 256 * 256; it += NGT) { const int jj = it & 7, ln = (it >> 3) & 63, ks = (it >> 9) & 7, T = (it >> 12) & 15, s = it >> 16;
        const int k = 16 * T + (ln & 15), g = ln >> 4, n = 32 * ks + (jj < 4 ? 4 * g + jj : 16 + 4 * g + (jj - 4)); const float a = (float)((k * n) & 255) * (1.0f / 128.0f); F.CT256()[it] = (bf16)f2bf(s ? sinpif(a) : cospif(a)); }
}
__device__ __forceinline__ void p0b_fold(Frame& F) {
    {
        LAS float* tfl = (LAS float*)(F.lds + RING_OFF + 16384);
        for (int it = F.vcu; it < DEPTH * 64 * 2; it += F.G) {
            const int jh = it & 1, kg = (it >> 1) & 63, l = it >> 7, j = jh * 512 + F.tid;
            const float* tf = F.TF() + (size_t)l * 131072 + (size_t)(kg * 8) * 256;
            for (int i = F.tid; i < 2048; i += NTHREADS) tfl[(i & 255) * 8 + (i >> 8)] = tf[i];
            __syncthreads();
            const float* wo = F.w_out() + (size_t)l * DM * DM + j;
            float a[8] = {0.f, 0.f, 0.f, 0.f, 0.f, 0.f, 0.f, 0.f};
            for (int jp0 = 0; jp0 < 256; jp0 += 8) {
                float w[8];
#pragma unroll
                for (int i = 0; i < 8; ++i) w[i] = wo[(size_t)(jp0 + i) * DM];
#pragma unroll
                for (int i = 0; i < 8; ++i) { const f32x4 t0 = *(const LAS f32x4*)(tfl + (jp0 + i) * 8), t1 = *(const LAS f32x4*)(tfl + (jp0 + i) * 8 + 4);
                    a[0] += t0[0] * w[i]; a[1] += t0[1] * w[i]; a[2] += t0[2] * w[i]; a[3] += t0[3] * w[i]; a[4] += t1[0] * w[i]; a[5] += t1[1] * w[i]; a[6] += t1[2] * w[i]; a[7] += t1[3] * w[i]; }
            }
            v4u o; o.x = pk2(a[0], a[1]); o.y = pk2(a[2], a[3]); o.z = pk2(a[4], a[5]); o.w = pk2(a[6], a[7]);
            *(GAS v4u*)(F.WOUT() + (size_t)l * DM * KMIX + (size_t)j * KMIX + kg * 8) = o;
            __syncthreads();
        }
    }
    {
        LAS float* part = (LAS float*)(F.lds + RING_OFF);
        for (int it = F.vcu; it < DEPTH * 124; it += F.G) {
            const int l = it / 124, v0 = (it % 124) * 64;
            const float* W; int ldw, col, shoff; float* dst; int dstride;
            if (v0 < 2304) { W = F.w_in() + (size_t)l * DM * PROJ; ldw = PROJ; col = v0 + F.lane; shoff = MOD_SH_A; dst = F.BIASA() + (size_t)l * 5 * 2304 + win_row(col); dstride = 2304; }
            else { const int up = v0 >= 2304 + DFF, hid = v0 - 2304 - up * DFF + F.lane; W = (up ? F.w_up() : F.w_gate()) + (size_t)l * DM * DFF; ldw = DFF; col = hid; shoff = MOD_SH_F;
                dst = F.BIASF() + (size_t)l * 5 * 5632 + (hid >> 7) * 256 + up * 128 + (hid & 127); dstride = 5632; }
            const float* wp = W + (size_t)(128 * F.wave) * ldw + col; const float* shp = F.MODS() + (size_t)l * 5 * 6144 + shoff + 128 * F.wave;
            LAS float* shl = (LAS float*)(F.lds + RING_OFF + 32768) + F.wave * 640;
            for (int i = F.lane; i < 640; i += 64) shl[i] = shp[(size_t)(i >> 7) * 6144 + (i & 127)];
            asm volatile("s_waitcnt vmcnt(0) lgkmcnt(0)" ::: "memory");
            float a0 = 0.f, a1 = 0.f, a2 = 0.f, a3 = 0.f, a4 = 0.f;
            float wn[16];
#pragma unroll
            for (int i = 0; i < 16; ++i) wn[i] = wp[(size_t)i * ldw];
            for (int k0 = 0; k0 < 128; k0 += 16) {
                float w[16];
#pragma unroll
                for (int i = 0; i < 16; ++i) w[i] = wn[i];
                if (k0 + 16 < 128) {
#pragma unroll
                    for (int i = 0; i < 16; ++i) wn[i] = wp[(size_t)(k0 + 16 + i) * ldw]; }
#pragma unroll
                for (int i = 0; i < 16; ++i) { const int k = k0 + i; a0 += shl[k] * w[i]; a1 += shl[128 + k] * w[i]; a2 += shl[256 + k] * w[i]; a3 += shl[384 + k] * w[i]; a4 += shl[512 + k] * w[i]; }
            }
            LAS float* pw = part + F.wave * 320 + F.lane;
            pw[0] = a0; pw[64] = a1; pw[128] = a2; pw[192] = a3; pw[256] = a4;
            __syncthreads();
            float s = 0.f;
            if (F.tid < 320) {
#pragma unroll
                for (int ww = 0; ww < 8; ++ww) s += part[ww * 320 + F.tid]; }
            if (F.tid < 320) dst[(size_t)(F.tid >> 6) * dstride] = s;
            __syncthreads();
        }
    }
    {
        const int gw = F.vcu * NWAVES + F.wave, NGW = F.G * NWAVES;
        for (int R = gw; R < MROWS; R += NGW) {
            const int b = R / TPB, t = R - b * TPB, bb = (t < CTXL) ? 4 : b;
            const GAS f32x4* xr = (const GAS f32x4*)xrow_ptr(F.x(), F.ctx(), R) + F.lane;
            const GAS f32x4* scp = (const GAS f32x4*)(F.MODS() + bb * 6144 + MOD_SC_A) + F.lane;
            f32x4 v[4]; float s = 0.f;
#pragma unroll
            for (int j = 0; j < 4; ++j) { v[j] = xr[64 * j]; s += (v[j].x * v[j].x + v[j].y * v[j].y) + (v[j].z * v[j].z + v[j].w * v[j].w); }
            s = wave_sum(s);
            GAS u32x2* o8 = (GAS u32x2*)(F.HN() + (size_t)R * DM) + F.lane; GAS u32x2* x8 = (GAS u32x2*)(F.XB() + (size_t)R * DM) + F.lane;
#pragma unroll
            for (int j = 0; j < 4; ++j) { const f32x4 y = v[j] * (scp[64 * j] + 1.0f); u32x2 w; w.x = pk2(y.x, y.y); w.y = pk2(y.z, y.w); o8[64 * j] = w;
                u32x2 xw; xw.x = pk2(v[j].x, v[j].y); xw.y = pk2(v[j].z, v[j].w); x8[64 * j] = xw; }
            if (F.lane < 16) F.ROWSS()[(size_t)R * 16 + F.lane] = (F.lane == 0) ? s : 0.f;
        }
    }
}

template <class Sched>
__device__ __forceinline__ void rinv_fill(Frame& F, const Sched& S, const float* bias, int nb) {
    LAS float* tab = (LAS float*)(F.lds + RINV_OFF); LAS float* btab = (LAS float*)(F.lds + BTAB_OFF);
    LAS int* pml = (LAS int*)(F.lds + BTAB_OFF + RINV_SLOTS * 1024 - 128);
    __syncthreads();
    int n = 0;
    if (F.tid < RINV_SLOTS) { pg8::Unit u; const bool ok = S.next(F.tid, u); pml[2 * F.tid] = ok ? u.pm : -1; pml[2 * F.tid + 1] = ok ? u.pn : 0; }
    __syncthreads();
#pragma unroll 1
    for (int i = 0; i < RINV_SLOTS; ++i) if (pml[2 * i] >= 0) n = i + 1;
    float rv[RINV_SLOTS / 2], bvv[RINV_SLOTS / 2];
#pragma unroll
    for (int k = 0; k < RINV_SLOTS / 2; ++k) { const int it = F.tid + k * NTHREADS, i = it >> 8, rl = it & 255; rv[k] = 0.f; bvv[k] = 0.f;
        if (i < n) { const int pm = pml[2 * i], pn = pml[2 * i + 1], bb = (pm % 33 == 0) ? 4 : pm / 33;
            const GAS f32x4* p = (const GAS f32x4*)(F.ROWSS() + ((size_t)pm * 256 + rl) * 16); const f32x4 a = p[0], b = p[1], c = p[2], d = p[3];
            bvv[k] = *(const GAS float*)(bias + (size_t)bb * nb + pn * 256 + rl);
            const float s = ((a[0] + a[1]) + (a[2] + a[3])) + ((b[0] + b[1]) + (b[2] + b[3])) + ((c[0] + c[1]) + (c[2] + c[3])) + ((d[0] + d[1]) + (d[2] + d[3]));
            rv[k] = 1.0f / sqrtf(s * (1.0f / DM) + EPS); } }
    __syncthreads();
#pragma unroll
    for (int k = 0; k < RINV_SLOTS / 2; ++k) { const int it = F.tid + k * NTHREADS; if ((it >> 8) < n) { tab[it] = rv[k]; btab[it] = bvv[k]; } }
    __syncthreads();
}
template <int NSPLIT>
__device__ __forceinline__ void ctx_reduce_pass(Frame& F, const float* P, const float* gate, const float* scn) {
    const int gw = F.vcu * NWAVES + F.wave, NGW = F.G * NWAVES;
    for (int cr = gw; cr < NB * CTXL; cr += NGW) {
        const int b = cr >> 8, t = cr & 255; const size_t R = (size_t)b * TPB + t;
        float ss = 0.f;
#pragma unroll 1
        for (int j = 0; j < 4; ++j) { const int col = 4 * F.lane + 256 * j;
            f32x4 pv[NSPLIT];
#pragma unroll
            for (int s = 0; s < NSPLIT; ++s) pv[s] = *(const GAS f32x4*)(P + ((size_t)s * 1024 + cr) * 1024 + col);
            f32x4 a = pv[0];
#pragma unroll
            for (int s = 1; s < NSPLIT; ++s) a += pv[s];
            const u32x2 xo = *(const GAS u32x2*)(F.XB() + R * DM + col);
            const f32x4 xn = (f32x4){bflo(xo.x), bfhi(xo.x), bflo(xo.y), bfhi(xo.y)} + *(const GAS f32x4*)(gate + 4 * 6144 + col) * a;
            u32x2 xw; xw.x = pk2(xn.x, xn.y); xw.y = pk2(xn.z, xn.w); *(GAS u32x2*)(F.XB() + R * DM + col) = xw;
            ss += (xn.x * xn.x + xn.y * xn.y) + (xn.z * xn.z + xn.w * xn.w);
            if (scn) { const f32x4 y = xn * (*(const GAS f32x4*)(scn + 4 * 6144 + col) + 1.0f); u32x2 w; w.x = pk2(y.x, y.y); w.y = pk2(y.z, y.w); *(GAS u32x2*)(F.HN() + R * DM + col) = w; } }
        ss = wave_sum(ss);
        if (F.lane < 16) F.ROWSS()[R * 16 + F.lane] = (F.lane == 0) ? ss : 0.f;
    }
}
__device__ __forceinline__ void final_norm_phase(Frame& F) {
    const int gw = F.vcu * NWAVES + F.wave, NGW = F.G * NWAVES;
    for (int r = gw; r < NB * SEQ; r += NGW) {
        const int b = r >> 13, n = r & (SEQ - 1); const size_t R = (size_t)b * TPB + CTXL + n;
        float s = (F.lane < 16) ? F.ROWSS()[R * 16 + F.lane] : 0.f;
        s = wave_sum(s);
        const float rinv = 1.0f / sqrtf(s * (1.0f / DM) + EPS);
        const GAS u32x2* xr = (const GAS u32x2*)(F.XB() + R * DM) + F.lane; const GAS f32x4* gp = (const GAS f32x4*)F.final_norm() + F.lane;
        GAS f32x4* orow = (GAS f32x4*)(F.out_() + (size_t)r * DM) + F.lane;
#pragma unroll
        for (int j = 0; j < 4; ++j) { const u32x2 w = xr[64 * j]; orow[64 * j] = (f32x4){bflo(w.x), bfhi(w.x), bflo(w.y), bfhi(w.y)} * rinv * gp[64 * j]; }
    }
}

__device__ __forceinline__ void attn_fast_phase(Frame& F, int l) {
    char* shm = (char*)(F.lds + RING_OFF);
    const attn_body::bf16* UXp = (const attn_body::bf16*)F.UX(); attn_body::bf16* MIXp = (attn_body::bf16*)F.MIX();
    for (int base = F.vcu * 4; base < NB * 8 * 32 + F.G * 4; base += F.G * 4) {
        for (int i = 0; i < 5; ++i) {
            int bh, q0, NT;
            if (base < NB * 8 * 32) { if (i == 4) break; const int U = base + i; bh = U >> 5; q0 = CTXL + (U & 31) * 256; NT = TPB / 64; }
            else { const int c = base - NB * 8 * 32 + i * 0; if (i > 0 || l == DEPTH - 1) break; const int cu = c / 4; if ((cu & 7) != 0 || cu >= 256) break; bh = cu >> 3; q0 = 0; NT = CTXL / 64; }
            const int b = bh >> 3, h = bh & 7, kvh = h >> 2; const size_t rb = (size_t)b * TPB;
            attn_body::attn_unit<8>(UXp + (rb + q0) * PROJ + OFF_Q + h * 64, UXp + rb * PROJ + OFF_K + kvh * 64, UXp + rb * PROJ + OFF_V + kvh * 64, MIXp + (rb + q0) * KMIX + MIX_A + h * 64, NT, shm, F.tid);
        }
    }
}

namespace fft {
typedef short v4i16_t __attribute__((ext_vector_type(4)));
constexpr int ZP = 544;
__device__ __forceinline__ v4i16_t trrd(const LAS char* p) { return __builtin_amdgcn_ds_read_tr16_b64_v4i16((LAS v4i16_t*)p); }
__device__ __forceinline__ bf16x8 cat8(v4i16_t lo, v4i16_t hi) { return (bf16x8){lo[0], lo[1], lo[2], lo[3], hi[0], hi[1], hi[2], hi[3]}; }
__device__ __forceinline__ bf16x8 ld_frag2(const bf16* p0, const bf16* p1) { const u32x2 a = *(const GAS u32x2*)p0, b = *(const GAS u32x2*)p1; v4u w; w.x = a.x; w.y = a.y; w.z = b.x; w.w = b.y; return __builtin_bit_cast(bf16x8, w); }
#define MFMA16(a, b, c) __builtin_amdgcn_mfma_f32_16x16x32_bf16((a), (b), (c), 0, 0, 0)
}
__device__ __forceinline__ void fourier_fast_phase(Frame& F) {
    using namespace fft;
    LAS char* Z = (LAS char*)(F.lds + RING_OFF);
    LAS char* Zc = Z + 128 * ZP;
    const int tid = F.tid, lane = F.lane, w = F.wave, l16 = lane & 15, g = lane >> 4, q = l16 >> 2, p = l16 & 3;
    const bf16* UXp = F.UX(); bf16* MIXp = F.MIX();
    for (int unit = F.vcu; unit < NB * 64; unit += F.G) {
        const int b = unit >> 6, cg = unit & 63;
        { const bf16* zsrc = UXp + ((size_t)b * TPB + CTXL) * PROJ + cg * 4;
#pragma unroll 4
          for (int i = 0; i < 16; ++i) { const int n = tid + 512 * i; const u32x2 v = *(const GAS u32x2*)(zsrc + (size_t)n * PROJ);
              LAS char* d = Z + (n >> 6) * ZP + (n & 63) * 2;
              *(LAS unsigned short*)(d) = (unsigned short)(v.x & 0xffffu); *(LAS unsigned short*)(d + 128) = (unsigned short)(v.x >> 16);
              *(LAS unsigned short*)(d + 256) = (unsigned short)(v.y & 0xffffu); *(LAS unsigned short*)(d + 384) = (unsigned short)(v.y >> 16); }
          if (tid < CTXL) *(LAS u32x2*)(Zc + tid * 8) = *(const GAS u32x2*)(UXp + ((size_t)b * TPB + tid) * PROJ + cg * 4); }
        __syncthreads(); STAMP(40);
        const int k1 = 16 * w + l16;
        bf16x8 Bre[4][2], Bim[4][2];
        {
            bf16x8 Fc[4], Fs[4];
            const bf16* ftc = F.FT128() + k1 * 128; const bf16* fts = ftc + 128 * 128;
#pragma unroll
            for (int ks = 0; ks < 4; ++ks) { Fc[ks] = ld_frag2(ftc + 32 * ks + 4 * g, ftc + 32 * ks + 16 + 4 * g); Fs[ks] = ld_frag2(fts + 32 * ks + 4 * g, fts + 32 * ks + 16 + 4 * g); }
            f32x2 tw[4][4];
#pragma unroll
            for (int be = 0; be < 4; ++be)
#pragma unroll
                for (int r = 0; r < 4; ++r) tw[be][r] = F.TW()[k1 * (16 * be + 4 * g + r)];
            const LAS char* zrd = Z + (4 * g + q) * ZP + 8 * p;
#pragma unroll
            for (int c = 0; c < 4; ++c) {
                f32x4 ar[4], ai[4];
#pragma unroll
                for (int be = 0; be < 4; ++be) { ar[be] = (f32x4){0.f, 0.f, 0.f, 0.f}; ai[be] = (f32x4){0.f, 0.f, 0.f, 0.f}; }
#pragma unroll
                for (int ks = 0; ks < 4; ++ks)
#pragma unroll
                    for (int be = 0; be < 4; ++be) { const LAS char* a0 = zrd + (32 * ks) * ZP + (c * 64 + 16 * be) * 2;
                        const bf16x8 A = cat8(trrd(a0), trrd(a0 + 16 * ZP));
                        ar[be] = MFMA16(A, Fc[ks], ar[be]); ai[be] = MFMA16(A, Fs[ks], ai[be]); }
                float br[4][4], bi[4][4];
#pragma unroll
                for (int be = 0; be < 4; ++be)
#pragma unroll
                    for (int r = 0; r < 4; ++r) { const float ct = tw[be][r].x, st = tw[be][r].y; br[be][r] = ar[be][r] * ct - ai[be][r] * st; bi[be][r] = ar[be][r] * st + ai[be][r] * ct; }
#pragma unroll
                for (int a = 0; a < 2; ++a) { v4u wr_, wi_;
                    wr_.x = pk2(br[2 * a][0], br[2 * a][1]); wr_.y = pk2(br[2 * a][2], br[2 * a][3]); wr_.z = pk2(br[2 * a + 1][0], br[2 * a + 1][1]); wr_.w = pk2(br[2 * a + 1][2], br[2 * a + 1][3]);
                    wi_.x = pk2(bi[2 * a][0], bi[2 * a][1]); wi_.y = pk2(bi[2 * a][2], bi[2 * a][3]); wi_.z = pk2(bi[2 * a + 1][0], bi[2 * a + 1][1]); wi_.w = pk2(bi[2 * a + 1][2], bi[2 * a + 1][3]);
                    Bre[c][a] = __builtin_bit_cast(bf16x8, wr_); Bim[c][a] = __builtin_bit_cast(bf16x8, wi_); }
                __builtin_amdgcn_sched_barrier(0);
            }
        }
        STAMP(41);
        {
            const float sc = 0.011048543456039806f;
#pragma unroll 1
            for (int T = 0; T < 4; ++T) {
                bf16x8 Wc[2], Ws[2];
#pragma unroll
                for (int a = 0; a < 2; ++a) { Wc[a] = *(const GAS bf16x8*)(F.W64F() + (((0 * 2 + a) * 4 + T) * 64 + lane) * 8); Ws[a] = *(const GAS bf16x8*)(F.W64F() + (((1 * 2 + a) * 4 + T) * 64 + lane) * 8); }
                f32x4 P[4], Q[4];
#pragma unroll
                for (int c = 0; c < 4; ++c) {
                    bf16x8 nim[2];
#pragma unroll
                    for (int a = 0; a < 2; ++a) { v4u t = __builtin_bit_cast(v4u, Bim[c][a]); t.x ^= 0x80008000u; t.y ^= 0x80008000u; t.z ^= 0x80008000u; t.w ^= 0x80008000u; nim[a] = __builtin_bit_cast(bf16x8, t); }
                    f32x4 pp = (f32x4){0.f, 0.f, 0.f, 0.f}, qq = (f32x4){0.f, 0.f, 0.f, 0.f};
#pragma unroll
                    for (int a = 0; a < 2; ++a) { pp = MFMA16(Bre[c][a], Wc[a], pp); pp = MFMA16(nim[a], Ws[a], pp); qq = MFMA16(Bre[c][a], Ws[a], qq); qq = MFMA16(Bim[c][a], Wc[a], qq); }
                    P[c] = pp; Q[c] = qq;
                }
#pragma unroll
                for (int r = 0; r < 4; ++r) { const int k = (16 * w + 4 * g + r) + 128 * (16 * T + l16);
                    bf16* mp = MIXp + ((size_t)b * TPB + CTXL + k) * KMIX + cg * 4;
                    u32x2 o; o.x = pk2(P[0][r] * sc, P[1][r] * sc); o.y = pk2(P[2][r] * sc, P[3][r] * sc); *(GAS u32x2*)(mp + MIX_P) = o;
                    o.x = pk2(Q[0][r] * sc, Q[1][r] * sc); o.y = pk2(Q[2][r] * sc, Q[3][r] * sc); *(GAS u32x2*)(mp + MIX_Q) = o; }
            }
        }
        STAMP(42);
        {
            f32x4 aP[2], aQ[2];
#pragma unroll
            for (int tt = 0; tt < 2; ++tt) { aP[tt] = (f32x4){0.f, 0.f, 0.f, 0.f}; aQ[tt] = (f32x4){0.f, 0.f, 0.f, 0.f}; }
            const bf16* ctc = F.CT256() + (size_t)(2 * w) * 8 * 512 + lane * 8; const bf16* cts = ctc + 256 * 256;
#pragma unroll 1
            for (int hk = 0; hk < 4; ++hk) {
                bf16x8 Bc[2][2], Bs[2][2];
#pragma unroll
                for (int tt = 0; tt < 2; ++tt)
#pragma unroll
                    for (int kk = 0; kk < 2; ++kk) { const int ks = 2 * hk + kk; Bc[tt][kk] = *(const GAS bf16x8*)(ctc + (tt * 8 + ks) * 512); Bs[tt][kk] = *(const GAS bf16x8*)(cts + (tt * 8 + ks) * 512); }
#pragma unroll
                for (int kk = 0; kk < 2; ++kk) { const int ks = 2 * hk + kk;
                    const LAS char* a0 = Zc + (32 * ks + 4 * g + q) * 8;
                    const bf16x8 A = cat8(trrd(a0), trrd(a0 + 16 * 8));
#pragma unroll
                    for (int tt = 0; tt < 2; ++tt) { aP[tt] = MFMA16(A, Bc[tt][kk], aP[tt]); aQ[tt] = MFMA16(A, Bs[tt][kk], aQ[tt]); } }
            }
            if (g == 0) {
#pragma unroll
                for (int tt = 0; tt < 2; ++tt) { const int k = 16 * (2 * w + tt) + l16; bf16* mp = MIXp + ((size_t)b * TPB + k) * KMIX + cg * 4;
                    u32x2 o; o.x = pk2(aP[tt][0] * 0.0625f, aP[tt][1] * 0.0625f); o.y = pk2(aP[tt][2] * 0.0625f, aP[tt][3] * 0.0625f); *(GAS u32x2*)(mp + MIX_P) = o;
                    o.x = pk2(aQ[tt][0] * 0.0625f, aQ[tt][1] * 0.0625f); o.y = pk2(aQ[tt][2] * 0.0625f, aQ[tt][3] * 0.0625f); *(GAS u32x2*)(mp + MIX_Q) = o; }
            }
        }
        STAMP(43);
        __syncthreads(); STAMP(44);
    }
}

__device__ __forceinline__ float hg_exp(float x) { return __builtin_amdgcn_exp2f(x); }
#define LDS_BAR() asm volatile("s_waitcnt lgkmcnt(0)\n\ts_barrier" ::: "memory")
namespace hg {
using fft::trrd; using fft::cat8;
constexpr int IP = 160;
constexpr int IMG = 64 * IP;
__device__ __forceinline__ int scan_pos(int c, int dir) { return dir == 0 ? c : (c < 4 ? 3 - c : 135 - c); }
__device__ __forceinline__ float dpp_shr(float v, int n) {
    const int x = __builtin_bit_cast(int, v); int r;
    switch (n) { case 1: r = __builtin_amdgcn_update_dpp(0, x, 0x111, 0xF, 0xF, true); break; case 2: r = __builtin_amdgcn_update_dpp(0, x, 0x112, 0xF, 0xF, true); break;
                 case 4: r = __builtin_amdgcn_update_dpp(0, x, 0x114, 0xF, 0xF, true); break; default: r = __builtin_amdgcn_update_dpp(0, x, 0x118, 0xF, 0xF, true); break; }
    return __builtin_bit_cast(float, r);
}
__device__ __forceinline__ float scan_incl(float v, int lane) {
    v += dpp_shr(v, 1); v += dpp_shr(v, 2); v += dpp_shr(v, 4); v += dpp_shr(v, 8);
    v += __builtin_bit_cast(float, __builtin_amdgcn_update_dpp(0, __builtin_bit_cast(int, v), 0x142, 0xA, 0xF, false));
    v += __builtin_bit_cast(float, __builtin_amdgcn_update_dpp(0, __builtin_bit_cast(int, v), 0x143, 0xC, 0xF, false));
    (void)lane; return v;
}
__device__ __forceinline__ float lane_bcast(float v, int src) { return __builtin_bit_cast(float, __builtin_amdgcn_readlane(__builtin_bit_cast(int, v), src)); }
__device__ __forceinline__ void gates16(const v4u z0, const v4u z1, const float lbl  , int lane, float (&kk)[16], float (&cum)[16]) {
    const unsigned zw[8] = {z0.x, z0.y, z0.z, z0.w, z1.x, z1.y, z1.z, z1.w};
#pragma unroll
    for (int i = 0; i < 16; ++i) { const float z = (i & 1) ? bfhi(zw[i >> 1]) : bflo(zw[i >> 1]); const float lb = lane_bcast(lbl, i);
        const float sg = sigmoidf_(z), f = fmaxf(lb + (1.0f - lb) * sg, 1e-30f); kk[i] = (1.0f - lb) * (1.0f - sg);     cum[i] = scan_incl(__builtin_amdgcn_logf(f), lane); }
}
__device__ __forceinline__ void st16(LAS char* p, const float (&v)[16]) {
    v4u a, b; a.x = pk2(v[0], v[1]); a.y = pk2(v[2], v[3]); a.z = pk2(v[4], v[5]); a.w = pk2(v[6], v[7]); b.x = pk2(v[8], v[9]); b.y = pk2(v[10], v[11]); b.z = pk2(v[12], v[13]); b.w = pk2(v[14], v[15]);
    *(LAS v4u*)p = a; *(LAS v4u*)(p + 16) = b;
}
}
struct HgInA { v4u z0, z1, v0, v1; float lb; };
__device__ __forceinline__ HgInA hg_load_a(const bf16* UXp, const float* LBl  , int unit, int dir, int wd, int lane) {
    const int c = unit % (TPB / 64), bh = unit / (TPB / 64), b = bh >> 2, h = bh & 3;
    const size_t row = (size_t)b * TPB + 64 * c + (dir ? 63 - lane : lane);
    const bf16* rp = UXp + row * PROJ + h * 64 + 16 * wd; HgInA r;
    r.z0 = *(const GAS v4u*)(rp + (dir ? OFF_FB : OFF_FF)); r.z1 = *(const GAS v4u*)(rp + (dir ? OFF_FB : OFF_FF) + 8);
    r.v0 = *(const GAS v4u*)(rp + OFF_I); r.v1 = *(const GAS v4u*)(rp + OFF_I + 8); r.lb = *(const GAS float*)(LBl + h * 64 + 16 * wd + (lane & 15)); return r;
}
__device__ __forceinline__ void hgrn_a_phase(Frame& F, int l) {
    using namespace hg;
    const int lane = F.lane, w = F.wave, dir = w >> 2, wd = w & 3, l16 = lane & 15, g = lane >> 4, q = l16 >> 2, p = l16 & 3;
    LAS char* KI = (LAS char*)(F.lds + RING_OFF) + dir * 2 * IMG; LAS char* VI = KI + IMG;
    const bf16* UXp = F.UX();
    constexpr int NU = NB * 4 * (TPB / 64);
    const float* LBl = F.LB() + (dir * DEPTH + l) * 256;
    HgInA nx = hg_load_a(UXp, LBl, F.vcu < NU ? F.vcu : 0, dir, wd, lane);
    for (int unit = F.vcu; unit < NU; unit += F.G) {
        const int c = unit % (TPB / 64), bh = unit / (TPB / 64), b = bh >> 2, h = bh & 3;
        const HgInA in = nx;
        if (unit + F.G < NU) nx = hg_load_a(UXp, LBl, unit + F.G, dir, wd, lane);
        float kk[16], cum[16];
        gates16(in.z0, in.z1, in.lb, lane, kk, cum);
        float ko[16], gl[16];
#pragma unroll
        for (int i = 0; i < 16; ++i) { const float last = lane_bcast(cum[i], 63); gl[i] = last; ko[i] = kk[i] * hg_exp(last - cum[i]); }
        st16(KI + lane * IP + 32 * wd, ko);
        *(LAS v4u*)(VI + lane * IP + 32 * wd) = in.v0; *(LAS v4u*)(VI + lane * IP + 32 * wd + 16) = in.v1;
        const int ch = (b * 4 + h) * 2 + dir, pp = scan_pos(c, dir);
        if (lane < 16) { float gv = 0.f;
#pragma unroll
            for (int i = 0; i < 16; ++i) gv = (lane == i) ? gl[i] : gv;
            F.HGG()[((size_t)ch * 132 + pp) * 64 + 16 * wd + lane] = hg_exp(gv); }
        LDS_BAR();
        bf16x8 Af[2];
#pragma unroll
        for (int ks = 0; ks < 2; ++ks) { const LAS char* a0 = KI + (32 * ks + 4 * g + q) * IP + (16 * wd + 4 * p) * 2; Af[ks] = cat8(trrd(a0), trrd(a0 + 16 * IP)); }
        bf16* sp = (bf16*)F.HGS() + ((size_t)ch * 132 + pp) * 4096;
#pragma unroll
        for (int et = 0; et < 4; ++et) { f32x4 acc = (f32x4){0.f, 0.f, 0.f, 0.f};
#pragma unroll
            for (int ks = 0; ks < 2; ++ks) { const LAS char* b0 = VI + (32 * ks + 4 * g + q) * IP + (16 * et + 4 * p) * 2; acc = MFMA16(Af[ks], cat8(trrd(b0), trrd(b0 + 16 * IP)), acc); }
            u32x2 o2; o2.x = pk2(acc[0], acc[1]); o2.y = pk2(acc[2], acc[3]); *(GAS u32x2*)(sp + (16 * et + l16) * 64 + 16 * wd + 4 * g) = o2; }
        LDS_BAR();
    }
}
__device__ __forceinline__ void hgrn_b_phase(Frame& F) {
    const int gt = F.vcu * NTHREADS + F.tid, NGT = F.G * NTHREADS;
    for (int it = gt; it < 32 * 2048; it += NGT) {
        const int ch = it >> 11, idx = (it & 2047) * 2, d = idx & 63;
        unsigned* sp = (unsigned*)((bf16*)F.HGS() + (size_t)ch * 132 * 4096 + idx); const f32x2* gp = (const f32x2*)(F.HGG() + (size_t)ch * 132 * 64 + d);
        float s0 = 0.f, s1 = 0.f;
        for (int p0 = 0; p0 < 132; p0 += 6) {
            unsigned kv[6]; f32x2 gg[6];
#pragma unroll
            for (int i = 0; i < 6; ++i) { kv[i] = sp[(size_t)(p0 + i) * 2048]; gg[i] = gp[(p0 + i) * 32]; }
#pragma unroll
            for (int i = 0; i < 6; ++i) { sp[(size_t)(p0 + i) * 2048] = pk2(s0, s1); s0 = gg[i].x * s0 + bflo(kv[i]); s1 = gg[i].y * s1 + bfhi(kv[i]); }
        }
    }
}
struct HgInC { v4u z0, z1, q0, q1, v0, v1; v4u s[2]; u32x2 gr[2]; float lb; };
__device__ __forceinline__ HgInC hg_load_c(const bf16* UXp, const bf16* HGSp, const float* LBl, int unit, int nch, int c0, int dir, int wd, int lane, int w) {
    const int c = c0 + unit % nch, bh = unit / nch, b = bh >> 2, h = bh & 3, l16 = lane & 15, g = lane >> 4;
    const size_t R0 = (size_t)b * TPB + 64 * c, row = R0 + (dir ? 63 - lane : lane);
    const bf16* rp = UXp + row * PROJ + h * 64 + 16 * wd; HgInC r;
    r.z0 = *(const GAS v4u*)(rp + (dir ? OFF_FB : OFF_FF)); r.z1 = *(const GAS v4u*)(rp + (dir ? OFF_FB : OFF_FF) + 8);
    r.q0 = *(const GAS v4u*)(rp + OFF_HQ); r.q1 = *(const GAS v4u*)(rp + OFF_HQ + 8);
    r.v0 = *(const GAS v4u*)(rp + OFF_I); r.v1 = *(const GAS v4u*)(rp + OFF_I + 8);
    const int ch = (b * 4 + h) * 2 + dir, pp = hg::scan_pos(c, dir);
    const bf16* sp = HGSp + ((size_t)ch * 132 + pp) * 4096 + (size_t)(16 * wd + l16) * 64;
#pragma unroll
    for (int ks = 0; ks < 2; ++ks) r.s[ks] = *(const GAS v4u*)(sp + 32 * ks + 8 * g);
#pragma unroll
    for (int ps = 0; ps < 2; ++ps) r.gr[ps] = *(const GAS u32x2*)(UXp + (R0 + 8 * w + 4 * ps + g) * PROJ + OFF_G + h * 64 + 4 * l16);
    r.lb = *(const GAS float*)(LBl + h * 64 + 16 * wd + l16);
    return r;
}
__device__ __forceinline__ void hgrn_c_phase(Frame& F, int l) {
    using namespace hg;
    const int lane = F.lane, w = F.wave, dir = w >> 2, wd = w & 3, l16 = lane & 15, g = lane >> 4, q = l16 >> 2, p = l16 & 3;
    LAS char* base = (LAS char*)(F.lds + RING_OFF);
    LAS char* QI = base + dir * 3 * IMG; LAS char* KI = QI + IMG; LAS char* VI = KI + IMG;
    LAS float* ES = (LAS float*)(base + 6 * IMG) + dir * 64;
    LAS float* OF = (LAS float*)(base + 6 * IMG + 512);
    const bf16* UXp = F.UX(); bf16* MIXp = F.MIX(); const bf16* HGSp = (const bf16*)F.HGS();
    const f32x4 gn = *(const GAS f32x4*)(F.hg_norm() + l * 64 + 4 * l16);
    const int c0 = (l == DEPTH - 1) ? 4 : 0, nch = TPB / 64 - c0, NU = NB * 4 * nch;
    const float* LBl = F.LB() + (dir * DEPTH + l) * 256;
    const int nfull = NU / F.G, rem = NU - nfull * F.G; const bool spread = rem <= F.G / 4;
    const int my_n = spread ? nfull + (((F.vcu & 3) == 2 && (F.vcu >> 2) < rem) ? 1 : 0) : nfull + (F.vcu < rem ? 1 : 0);
#define HGC_UNIT(i) (((i) < nfull) ? F.vcu + (i) * F.G : (spread ? nfull * F.G + (F.vcu >> 2) : F.vcu + (i) * F.G))
    HgInC nx = hg_load_c(UXp, HGSp, LBl, my_n > 0 ? HGC_UNIT(0) : 0, nch, c0, dir, wd, lane, w);
    for (int ui = 0; ui < my_n; ++ui) {
        const int unit = HGC_UNIT(ui);
        const int c = c0 + unit % nch, bh = unit / nch, b = bh >> 2, h = bh & 3;
        const size_t R0 = (size_t)b * TPB + 64 * c;
        STAMP(23);
        const HgInC in = nx;
        if (ui + 1 < my_n) nx = hg_load_c(UXp, HGSp, LBl, HGC_UNIT(ui + 1), nch, c0, dir, wd, lane, w);
        {
            float kk[16], cum[16];
            gates16(in.z0, in.z1, in.lb, lane, kk, cum);
            const unsigned qw[8] = {in.q0.x, in.q0.y, in.q0.z, in.q0.w, in.q1.x, in.q1.y, in.q1.z, in.q1.w};
            float qo[16], ko[16], ev = 0.f;
#pragma unroll
            for (int i = 0; i < 16; ++i) { const float ref = lane_bcast(cum[i], 31); const float qv = (i & 1) ? bfhi(qw[i >> 1]) : bflo(qw[i >> 1]);
                qo[i] = qv * hg_exp(fminf(cum[i] - ref, 115.f)); ko[i] = kk[i] * hg_exp(fminf(ref - cum[i], 115.f)); ev = (lane == i) ? ref : ev; }
            st16(QI + lane * IP + 32 * wd, qo); st16(KI + lane * IP + 32 * wd, ko);
            *(LAS v4u*)(VI + lane * IP + 32 * wd) = in.v0; *(LAS v4u*)(VI + lane * IP + 32 * wd + 16) = in.v1;
            if (lane < 16) ES[16 * wd + lane] = hg_exp(ev);
        }
        LDS_BAR(); STAMP(20);
        {
            const int et = wd;
            bf16x8 Sf[2], Vf[2];
#pragma unroll
            for (int ks = 0; ks < 2; ++ks) { const v4u sw = in.s[ks];
                const f32x4 e0 = *(const LAS f32x4*)(ES + 32 * ks + 8 * g), e1 = *(const LAS f32x4*)(ES + 32 * ks + 8 * g + 4);
                v4u t; t.x = pk2(bflo(sw.x) * e0.x, bfhi(sw.x) * e0.y); t.y = pk2(bflo(sw.y) * e0.z, bfhi(sw.y) * e0.w); t.z = pk2(bflo(sw.z) * e1.x, bfhi(sw.z) * e1.y); t.w = pk2(bflo(sw.w) * e1.z, bfhi(sw.w) * e1.w); Sf[ks] = __builtin_bit_cast(bf16x8, t);
                const LAS char* b0 = VI + (32 * ks + 4 * g + q) * IP + (16 * et + 4 * p) * 2; Vf[ks] = cat8(trrd(b0), trrd(b0 + 16 * IP)); }
#pragma unroll
            for (int jb = 0; jb < 4; ++jb) {
                bf16x8 Qf[2];
#pragma unroll
                for (int ks = 0; ks < 2; ++ks) Qf[ks] = *(const LAS bf16x8*)(QI + (16 * jb + l16) * IP + (32 * ks + 8 * g) * 2);
                f32x4 o = (f32x4){0.f, 0.f, 0.f, 0.f};
#pragma unroll
                for (int ks = 0; ks < 2; ++ks) o = MFMA16(Qf[ks], Sf[ks], o);
#pragma unroll
                for (int a = 0; a <= (jb >> 1); ++a) {
                    f32x4 X[2];
#pragma unroll
                    for (int hh = 0; hh < 2; ++hh) { const int sb = 2 * a + hh; X[hh] = (f32x4){0.f, 0.f, 0.f, 0.f};
                        if (sb <= jb) {
#pragma unroll
                            for (int ks = 0; ks < 2; ++ks) X[hh] = MFMA16(*(const LAS bf16x8*)(KI + (16 * sb + l16) * IP + (32 * ks + 8 * g) * 2), Qf[ks], X[hh]);
                            if (sb == jb) {
#pragma unroll
                                for (int r = 0; r < 4; ++r) X[hh][r] = (4 * g + r <= l16) ? X[hh][r] : 0.f; } } }
                    v4u t; t.x = pk2(X[0][0], X[0][1]); t.y = pk2(X[0][2], X[0][3]); t.z = pk2(X[1][0], X[1][1]); t.w = pk2(X[1][2], X[1][3]);
                    o = MFMA16(__builtin_bit_cast(bf16x8, t), Vf[a], o);
                }
#pragma unroll
                for (int r = 0; r < 4; ++r) { const int j = 16 * jb + 4 * g + r, tok = dir ? 63 - j : j; OF[(dir * 64 + tok) * 64 + 16 * et + l16] = o[r]; }
            }
        }
        LDS_BAR(); STAMP(21);
        {
#pragma unroll
            for (int ps = 0; ps < 2; ++ps) { const int tok = 8 * w + 4 * ps + g;
                const f32x4 a = *(const LAS f32x4*)(OF + tok * 64 + 4 * l16), bq = *(const LAS f32x4*)(OF + (64 + tok) * 64 + 4 * l16); const f32x4 o = a + bq;
                float ss = (o.x * o.x + o.y * o.y) + (o.z * o.z + o.w * o.w);
                ss = xl_sum16(ss);
                const float rinv = 1.0f / sqrtf(ss * (1.0f / 64.0f) + EPS);
                const u32x2 graw = in.gr[ps];
                u32x2 wv; wv.x = pk2(o.x * rinv * gn.x * siluf_(bflo(graw.x)), o.y * rinv * gn.y * siluf_(bfhi(graw.x))); wv.y = pk2(o.z * rinv * gn.z * siluf_(bflo(graw.y)), o.w * rinv * gn.w * siluf_(bfhi(graw.y)));
                *(GAS u32x2*)(MIXp + (R0 + tok) * KMIX + MIX_R + h * 64 + 4 * l16) = wv; }
        }
        LDS_BAR(); STAMP(22);
    }
}

#ifndef R_P0A
#define R_P0A 1
#endif
#ifndef R_FFT
#define R_FFT 1
#endif
#ifndef R_HGA
#define R_HGA 1
#endif
#ifndef R_HGC
#define R_HGC 1
#endif
#ifndef R_ATT
#define R_ATT 1
#endif
#ifndef STAGGER_US
#define STAGGER_US 0
#endif
#define STAGGER() do { if (STAGGER_US > 0 && (F.vcu & 1)) { const unsigned long long t0_ = rt(); while (rt() - t0_ < (unsigned long long)(STAGGER_US * 100)) __builtin_amdgcn_s_sleep(16); } } while (0)
#ifndef MK_MULTI
#define MK_MULTI 0
#endif
constexpr int PH_L0 = 2, NPL = 7, PH_FINAL = PH_L0 + NPL, NPH = PH_FINAL + 1;
struct Args { const float* in[17]; float* out; unsigned char* ws; int l_lo, l_hi; };
template <int PH_LO, int PH_HI>
__global__ void __launch_bounds__(NTHREADS, 2) fwd_kernel(Args args) {
    extern __shared__ __attribute__((aligned(16))) unsigned char lds[];
    Frame F;
    F.lds = (LAS unsigned char*)lds;
    F.MISC = (volatile LAS unsigned*)(F.lds + MISC_OFF);
    F.tid = threadIdx.x; F.lane = F.tid & 63; F.wave = __builtin_amdgcn_readfirstlane(F.tid >> 6);
    const int wave0 = F.wave;
    F.G = gridDim.x; { const int bx = blockIdx.x; F.vcu = (F.G % 8 == 0) ? (bx % 8) * (F.G / 8) + bx / 8 : bx; }
    F.ws = (GAS unsigned char*)args.ws; F.outg = (GAS float*)args.out;
    for (int u = F.tid; u < (LDS_BYTES - LDSCTL_OFF) / 4; u += NTHREADS) ((LAS unsigned*)(F.lds + LDSCTL_OFF))[u] = 0u;
    __syncthreads();
    if (!MK_MULTI) (void)xcd_barrier_post((F.ctlw() + CW_BAR), F.MISC + 8);
#define IN(k) (PH_LO <= (k) && (k) < PH_HI)
#define RELANE() do { int ln_; asm volatile("v_mbcnt_lo_u32_b32 %0, -1, 0\n\tv_mbcnt_hi_u32_b32 %0, -1, %0" : "=v"(ln_)); F.lane = ln_; F.tid = wave0 * 64 + ln_; F.wave = wave0; unsigned long long w_ = (unsigned long long)F.ws, o_ = (unsigned long long)F.outg; asm volatile("" : "+s"(w_), "+s"(o_), "+s"(F.vcu), "+s"(F.G)); F.ws = (GAS unsigned char*)w_; F.outg = (GAS float*)o_; } while (0)
#define bx_() ({ int b_ = (int)blockIdx.x; asm volatile("" : "+s"(b_)); b_; })
#define SEAM(tag) do { if (!MK_MULTI) { unsigned long long w_ = (unsigned long long)F.ws; asm volatile("" : "+s"(w_)); XcdBarrier bar_; bar_.bar = (unsigned*)((GAS unsigned char*)w_ + WS_CTL) + CW_BAR; bar_.x = xb_xcc_id(); bar_.st = (volatile LAS unsigned*)(F.lds + MISC_OFF) + 8; xcd_barrier(bar_); }     \
    STAMP(tag); } while (0)
    F.dt = (DIAG_J >= 0) ? rt() : 0ull; F.da = 0ull;

    if (IN(0)) { for (int rep = 0; rep < R_P0A; ++rep) { RELANE(); p0a_prologue(F); SEAM(7); } }
    if (IN(1)) { RELANE(); p0b_fold(F); SEAM(8); }

    for (int l_it = args.l_lo; l_it < args.l_hi; ++l_it) {
        int l = l_it; asm volatile("" : "+s"(l));
        constexpr int s0 = PH_L0;
#define MODS_L (F.MODS() + (size_t)l * 5 * 6144)
        if (IN(s0 + 0)) { RELANE();
            pg8::Gemm g{F.HN(), F.WIN() + (size_t)l * PROJ * DM, MROWS, PROJ, DM, DM}; pg8::StaticOrder S; S.init(MROWS, PROJ, F.G, bx_());
            rinv_fill(F, S, F.BIASA() + (size_t)l * 5 * 2304, 2304);
            pg8::EpiBf16N E{F.UX(), PROJ, F.BIASA() + (size_t)l * 5 * 2304, 2304, (const LAS float*)(F.lds + RINV_OFF), F.ROWSS(), F.q_norm() + l * 64, F.k_norm() + l * 64, (const float*)F.ROPE(), QSCALE};
            pg8::gemm_phase<pg8::EpiBf16N, pg8::StaticOrder, PG8_ALIGN, PG8_SP2, DM, DM, Frame>(F.lds + RING_OFF, g, S, E, F.tid, F);
            SEAM(0);
        }
        if (IN(s0 + 1)) { STAMP(10); for (int rep = 0; rep < R_FFT; ++rep) { RELANE(); fourier_fast_phase(F); } STAMP(11); for (int rep = 0; rep < R_HGA; ++rep) { RELANE(); hgrn_a_phase(F, l); } SEAM(1); }
        if (IN(s0 + 2)) { RELANE(); hgrn_b_phase(F); SEAM(2); }
        if (IN(s0 + 3)) { for (int rep = 0; rep < R_ATT; ++rep) { RELANE(); attn_fast_phase(F, l); } STAMP(12); for (int rep = 0; rep < R_HGC; ++rep) { RELANE(); hgrn_c_phase(F, l); } SEAM(3); }
        if (IN(s0 + 4)) { RELANE();
            const int lastl = (l == DEPTH - 1);
            {
                pg8::Gemm g{F.MIX(), F.WOUT() + (size_t)l * DM * KMIX, MROWS, DM, KMIX, KMIX}; pg8::StaticOrder S; S.init(NB * SEQ, DM, F.G, bx_(), 1);
                pg8::EpiResGate E{F.XB(), MODS_L + MOD_G_A, MODS_L + MOD_SC_F, F.HN(), F.ROWSS()};
                pg8::gemm_phase<pg8::EpiResGate, pg8::StaticOrder, PG8_ALIGN, PG8_SP2, KMIX, KMIX, Frame>(F.lds + RING_OFF, g, S, E, F.tid, F);
            }
            if (!lastl) {
                RELANE();
                pg8::Gemm g{F.MIX(), F.WOUT() + (size_t)l * DM * KMIX, MROWS, DM, 256, KMIX}; pg8::CtxSplitOrder S; S.init(DM, KMIX, 256, F.G, bx_());
                pg8::EpiPartial E{F.HGS(), 256};
                pg8::gemm_phase<pg8::EpiPartial, pg8::CtxSplitOrder, PG8_ALIGN, PG8_SP2, 256, KMIX, Frame>(F.lds + RING_OFF, g, S, E, F.tid, F);
                SEAM(4); RELANE();
                { const float* m2 = F.MODS() + (size_t)l * 5 * 6144; ctx_reduce_pass<KMIX / 256>(F, F.HGS(), m2 + MOD_G_A, m2 + MOD_SC_F); }
            }
            SEAM(4);
        }
        if (IN(s0 + 5)) { RELANE();
            const int lastl = (l == DEPTH - 1);
            STAGGER();
            pg8::Gemm g{F.HN(), F.WGU() + (size_t)l * 5632 * DM, MROWS, 5632, DM, DM}; pg8::StaticOrder S; S.init(lastl ? NB * SEQ : MROWS, 5632, F.G, bx_(), lastl);
            rinv_fill(F, S, F.BIASF() + (size_t)l * 5 * 5632, 5632);
            pg8::EpiSwiGLU E{F.HB(), DFF, F.BIASF() + (size_t)l * 5 * 5632, 5632, (const LAS float*)(F.lds + RINV_OFF), F.ROWSS()};
            pg8::gemm_phase<pg8::EpiSwiGLU, pg8::StaticOrder, PG8_ALIGN, PG8_SP2, DM, DM, Frame>(F.lds + RING_OFF, g, S, E, F.tid, F);
            SEAM(5);
        }
        if (IN(s0 + 6)) { RELANE();
            const int lastl = (l == DEPTH - 1);
            {
                pg8::Gemm g{F.HB(), F.WDN() + (size_t)l * DM * DFF, MROWS, DM, DFF, DFF}; pg8::StaticOrder S; S.init(NB * SEQ, DM, F.G, bx_(), 1);
                pg8::EpiResGate E{F.XB(), MODS_L + MOD_G_F, (l + 1 < DEPTH) ? MODS_L + 5 * 6144 + MOD_SC_A : nullptr, F.HN(), F.ROWSS()};
                pg8::gemm_phase<pg8::EpiResGate, pg8::StaticOrder, PG8_ALIGN, PG8_SP2, DFF, DFF, Frame>(F.lds + RING_OFF, g, S, E, F.tid, F);
            }
            if (!lastl) {
                RELANE();
                pg8::Gemm g{F.HB(), F.WDN() + (size_t)l * DM * DFF, MROWS, DM, 256, DFF}; pg8::CtxSplitOrder S; S.init(DM, DFF, 256, F.G, bx_());
                pg8::EpiPartial E{F.HGS(), 256};
                pg8::gemm_phase<pg8::EpiPartial, pg8::CtxSplitOrder, PG8_ALIGN, PG8_SP2, 256, DFF, Frame>(F.lds + RING_OFF, g, S, E, F.tid, F);
                SEAM(6); RELANE();
                { const float* m2 = F.MODS() + (size_t)l * 5 * 6144; ctx_reduce_pass<DFF / 256>(F, F.HGS(), m2 + MOD_G_F, (l + 1 < DEPTH) ? m2 + 5 * 6144 + MOD_SC_A : nullptr); }
            }
            SEAM(6);
        }
    }
    if (IN(PH_FINAL)) { RELANE(); final_norm_phase(F); if (DIAG_J >= 0) { asm volatile("s_waitcnt vmcnt(0)" ::: "memory"); const unsigned long long t_ = rt(); if (DIAG_J == 9) F.da += t_ - F.dt;
        if (blockIdx.x == 0) { const unsigned long long tend = t_ + (unsigned long long)DIAG_A * F.da; while (rt() < tend) __builtin_amdgcn_s_sleep(32); } } }
#undef IN
#undef SEAM
}

#if MK_MULTI
#define MAIN_KERNEL (fwd_kernel<3, 4>)
#define LAUNCH(p) hipLaunchKernelGGL((fwd_kernel<p, p + 1>), dim3(grid), dim3(NTHREADS), LDS_BYTES, stream, a)
template <int P> static bool set_lds_one() { return hipFuncSetAttribute((const void*)fwd_kernel<P, P + 1>, hipFuncAttributeMaxDynamicSharedMemorySize, LDS_BYTES) == hipSuccess; }
static bool set_lds_all() { return set_lds_one<0>() && set_lds_one<1>() && set_lds_one<2>() && set_lds_one<3>() && set_lds_one<4>() && set_lds_one<5>() && set_lds_one<6>() && set_lds_one<7>() && set_lds_one<8>() && set_lds_one<9>() ; }
#else
#define MAIN_KERNEL (fwd_kernel<0, NPH>)
static bool set_lds_all() { return hipFuncSetAttribute((const void*)fwd_kernel<0, NPH>, hipFuncAttributeMaxDynamicSharedMemorySize, LDS_BYTES) == hipSuccess; }
#endif
extern "C" void kernel_launch(void* const* d_in, const int* in_sizes, int n_in, void* d_out, int out_size, void* d_ws, size_t ws_size, hipStream_t stream) {
    static int grid = 0;
    if (grid == 0) {
        if (n_in != 17 || in_sizes[0] != NB * SEQ * DM || out_size != NB * SEQ * DM || ws_size < WS_END) { fprintf(stderr, "kernel_launch: unexpected shapes (n_in %d, in0 %d, out %d, ws %zu < %zu); nothing launched\n", n_in, n_in > 0 ? in_sizes[0] : -1, out_size, ws_size, (size_t)WS_END); grid = -1; return; }
        int dev = 0, cus = 0, per_cu = 0;
        if (hipGetDevice(&dev) != hipSuccess || hipDeviceGetAttribute(&cus, hipDeviceAttributeMultiprocessorCount, dev) != hipSuccess) { grid = -1; return; }
        if (!set_lds_all()) { fprintf(stderr, "kernel_launch: hipFuncSetAttribute failed\n"); grid = -1; return; }
        if (hipOccupancyMaxActiveBlocksPerMultiprocessor(&per_cu, (const void*)MAIN_KERNEL, NTHREADS, LDS_BYTES) != hipSuccess || per_cu < 1) { fprintf(stderr, "kernel_launch: occupancy query says %d blocks per CU; nothing launched\n", per_cu); (void)hipGetLastError(); grid = -1; return; }
        grid = cus;
    }
    if (grid < 0) return;
    if (hipMemsetAsync((char*)d_ws + WS_CTL, 0, CTL_ZERO_BYTES, stream) != hipSuccess) return;
    Args a{};
    for (int i = 0; i < 17; ++i) a.in[i] = (const float*)d_in[i];
    a.out = (float*)d_out; a.ws = (unsigned char*)d_ws;
#if MK_MULTI
    a.l_lo = 0; a.l_hi = 0;
    LAUNCH(0); LAUNCH(1);
    for (int l = 0; l < DEPTH; ++l) { a.l_lo = l; a.l_hi = l + 1; LAUNCH(2); LAUNCH(3); LAUNCH(4); LAUNCH(5); LAUNCH(6); LAUNCH(7); LAUNCH(8); }
    a.l_lo = 0; a.l_hi = 0; LAUNCH(9);
#else
    a.l_lo = 0; a.l_hi = DEPTH;
    hipLaunchKernelGGL((fwd_kernel<0, NPH>), dim3(grid), dim3(NTHREADS), LDS_BYTES, stream, a);
#endif
}
```

```cpp
#include <hip/hip_runtime.h>
#include <hip/hip_bf16.h>
#include <cstdio>
#include <cstdint>
#include <cmath>
#ifndef DIAG_J
#define DIAG_J -1
#endif
#ifndef DIAG_A
#define DIAG_A 4
#endif
#define STAMP(tag) do { if (DIAG_J >= 0) { const unsigned long long t_ = __builtin_amdgcn_s_memrealtime(); if ((tag) == DIAG_J) F.da += t_ - F.dt; F.dt = t_; } } while (0)
#ifndef XL_DPP
#define XL_DPP 1
#endif
#ifndef XL_P32
#define XL_P32 0
#endif
__device__ __forceinline__ float xl_bperm_xor(float v, int mask) {
    int ln_; asm volatile("v_mbcnt_lo_u32_b32 %0, -1, 0\n\tv_mbcnt_hi_u32_b32 %0, -1, %0" : "=v"(ln_));
    return __builtin_bit_cast(float, __builtin_amdgcn_ds_bpermute((ln_ ^ mask) << 2, __builtin_bit_cast(int, v)));
}
#if !XL_DPP
__device__ __forceinline__ float xl_dpp_qp2301(float v) { return xl_bperm_xor(v, 2); }
__device__ __forceinline__ float xl_sum4(float v) { v += xl_bperm_xor(v, 1); v += xl_bperm_xor(v, 2); return v; }
__device__ __forceinline__ float xl_sum8(float v) { v = xl_sum4(v); v += xl_bperm_xor(v, 4); return v; }
__device__ __forceinline__ float xl_sum16(float v) { v = xl_sum8(v); v += xl_bperm_xor(v, 8); return v; }
#else
__device__ __forceinline__ float xl_dpp_qp1032(float v) { return __builtin_bit_cast(float, __builtin_amdgcn_update_dpp(0, __builtin_bit_cast(int, v), 0xB1, 0xF, 0xF, false)); }
__device__ __forceinline__ float xl_dpp_qp2301(float v) { return __builtin_bit_cast(float, __builtin_amdgcn_update_dpp(0, __builtin_bit_cast(int, v), 0x4E, 0xF, 0xF, false)); }
__device__ __forceinline__ float xl_dpp_hmirror(float v) { return __builtin_bit_cast(float, __builtin_amdgcn_update_dpp(0, __builtin_bit_cast(int, v), 0x141, 0xF, 0xF, false)); }
__device__ __forceinline__ float xl_dpp_mirror(float v) { return __builtin_bit_cast(float, __builtin_amdgcn_update_dpp(0, __builtin_bit_cast(int, v), 0x140, 0xF, 0xF, false)); }
__device__ __forceinline__ float xl_sum4(float v) { v += xl_dpp_qp1032(v); v += xl_dpp_qp2301(v); return v; }
__device__ __forceinline__ float xl_sum8(float v) { v = xl_sum4(v); v += xl_dpp_hmirror(v); return v; }
__device__ __forceinline__ float xl_sum16(float v) { v = xl_sum8(v); v += xl_dpp_mirror(v); return v; }
#endif
__device__ __forceinline__ float xl_sumx16(float v) { return v + xl_bperm_xor(v, 16); }
#if XL_P32
__device__ __forceinline__ float xl_sumx32(float v) { const auto r = __builtin_amdgcn_permlane32_swap(__builtin_bit_cast(unsigned, v), __builtin_bit_cast(unsigned, v), false, false); return __builtin_bit_cast(float, r[0]) + __builtin_bit_cast(float, r[1]); }
#else
__device__ __forceinline__ float xl_sumx32(float v) { return v + xl_bperm_xor(v, 32); }
#endif
__device__ __forceinline__ float xl_sum64(float v) { return xl_sumx32(xl_sumx16(xl_sum16(v))); }
namespace pg8 {
#define PG8_LAS __attribute__((address_space(3)))
typedef unsigned short bf16_t;
typedef short bf16x8 __attribute__((ext_vector_type(8)));
typedef float f32x4 __attribute__((ext_vector_type(4)));
typedef unsigned u32x4 __attribute__((ext_vector_type(4)));
constexpr int BM = 256, BK = 64, HALF = 128, HTB = HALF * BK * 2  , STAGE_BYTES = 8 * HTB, NXCD = 8, WGM = 8;

__host__ __device__ __forceinline__ int lds_byte(int r, int c) { const int st = (r >> 4) * 2 + (c >> 5), rr = r & 15, cc = c & 31, ob = rr * 64 + cc * 2; return st * 1024 + (ob ^ (((ob >> 9) & 1) << 5)); }
__host__ __device__ __forceinline__ void stage_rc(int b, int& R, int& C) { const int st = b / 1024, sb = b % 1024, swz = sb ^ (((sb >> 9) & 1) << 5); R = (st >> 1) * 16 + swz / 64; C = (st & 1) * 32 + (swz % 64) / 2; }
__host__ __device__ __forceinline__ int perm32(int rho) { const int n = rho >> 4, i = rho & 15; return 8 * (i >> 2) + 4 * n + (i & 3); }

struct Unit { int pm, pn, ko, ord; };
struct Gemm { const bf16_t* A; const bf16_t* Bt; int M, N, K, ld; };

struct StaticOrder {
    int nM, nN, nwg, G, c, skipc;
    __host__ __device__ void init(int M, int N, int G_, int c_, int skipc_ = 0) { nM = M / BM; nN = N / BM; nwg = nM * nN; G = G_; c = c_; skipc = skipc_; }
    __host__ __device__ bool next(int i, Unit& u) const {
        const long L = (long)i * G + c; if (L >= nwg) return false;
        int wgid = (int)L; { const int q = nwg / NXCD, r = nwg % NXCD, xcd = wgid % NXCD, off = wgid / NXCD; wgid = (xcd < r ? xcd * (q + 1) : r * (q + 1) + (xcd - r) * q) + off; }
        const int nig = WGM * nN, gid = wgid / nig, fm = gid * WGM, gsz = (nM - fm) < WGM ? (nM - fm) : WGM;
        u.pm = fm + ((wgid % nig) % gsz); u.pn = (wgid % nig) / gsz; if (skipc) u.pm += u.pm / 32 + 1; u.ko = 0; u.ord = i; return true;
    }
    __device__ __forceinline__ void a_ready(const Unit&) const {}
    __device__ __forceinline__ void done(const Unit&) const {}
};

struct CtxSplitOrder {
    int nsplit, kslice, G, c;
    __host__ __device__ void init(int N, int K, int kslice_, int G_, int c_) { kslice = kslice_; nsplit = K / kslice_; G = G_; c = c_; (void)N; }
    __host__ __device__ bool next(int i, Unit& u) const {
        const int L = i * G + c; if (L >= 16 * nsplit) return false;
        const int ks = L >> 4, r = L & 15; u.pm = 33 * (r >> 2); u.pn = r & 3; u.ko = ks * kslice; u.ord = i; return true;
    }
    __device__ __forceinline__ void a_ready(const Unit&) const {}
    __device__ __forceinline__ void done(const Unit&) const {}
};
__device__ __forceinline__ unsigned cvt_pk_bf16(float lo, float hi) { unsigned r; asm volatile("v_cvt_pk_bf16_f32 %0, %1, %2" : "=v"(r) : "v"(lo), "v"(hi)); return r; }
typedef float f32x2 __attribute__((ext_vector_type(2)));
__device__ __forceinline__ f32x2 gelu_pk(f32x2 v) {
    const f32x2 av = __builtin_elementwise_abs(v), d = av * 0.2316418882f + 1.0f;
    f32x2 t; t.x = __builtin_amdgcn_rcpf(d.x); t.y = __builtin_amdgcn_rcpf(d.y);
    f32x2 q = t * 0.5307027145f + (-0.7265760135f); q = q * t + 0.7107068705f; q = q * t + (-0.142248368f); q = q * t + 0.127414796f; q = q * t;
    const f32x2 s = (v * v) * (-0.72134752044f);
    f32x2 e; e.x = __builtin_amdgcn_exp2f(s.x); e.y = __builtin_amdgcn_exp2f(s.y);
    const f32x2 m = v * (q * e), r = v - m;
    f32x2 o; o.x = v.x < 0.f ? m.x : r.x; o.y = v.y < 0.f ? m.y : r.y; return o;
}

template <int ACT  > struct EpiBf16 {
    static constexpr bool PERM = true, AFTER_DRAIN = false; static_assert(ACT == 0 || ACT == 1, "EpiBf16: ACT is 0 (none) or 1 (gelu_pk)");
    bf16_t* O; int ldc; const float* bias; int split_cols; size_t split_stride; float scale0;
    __device__ __forceinline__ void operator()(const f32x4 (&acc)[2][2][4][2], const Unit& u, int wr, int wc, int fr, int fq) const {
        const int row0 = u.pm * BM + wr * 64 + fr; int colt = u.pn * BM; bf16_t* base = O;
        float sc = 1.f; if (split_cols) { const int t = colt / split_cols; base += (size_t)t * split_stride; colt -= t * split_cols; if (t == 0) sc = scale0; }
        const int col0 = colt + wc * 32 + 8 * fq, bcol0 = u.pn * BM + wc * 32 + 8 * fq;
        f32x4 bv[2][2];
#pragma unroll
        for (int bj = 0; bj < 2; ++bj)
#pragma unroll
            for (int n = 0; n < 2; ++n) bv[bj][n] = bias ? *(const f32x4*)(bias + bcol0 + bj * HALF + 4 * n) : (f32x4){0.f, 0.f, 0.f, 0.f};
#pragma unroll
        for (int ai = 0; ai < 2; ++ai)
#pragma unroll
            for (int m = 0; m < 4; ++m) { bf16_t* rowp = base + (size_t)(row0 + ai * HALF + m * 16) * ldc + col0;
#pragma unroll
                for (int bj = 0; bj < 2; ++bj) { f32x4 v0 = acc[ai][bj][m][0] + bv[bj][0], v1 = acc[ai][bj][m][1] + bv[bj][1];
                    if (ACT == 1) { f32x2 a = gelu_pk((f32x2){v0[0], v0[1]}), b = gelu_pk((f32x2){v0[2], v0[3]}), c = gelu_pk((f32x2){v1[0], v1[1]}), d = gelu_pk((f32x2){v1[2], v1[3]});
                        v0 = (f32x4){a.x, a.y, b.x, b.y}; v1 = (f32x4){c.x, c.y, d.x, d.y}; }
                    v0 = v0 * sc; v1 = v1 * sc; u32x4 w; w.x = cvt_pk_bf16(v0[0], v0[1]); w.y = cvt_pk_bf16(v0[2], v0[3]); w.z = cvt_pk_bf16(v1[0], v1[1]); w.w = cvt_pk_bf16(v1[2], v1[3]);
                    *(u32x4*)(rowp + bj * HALF) = w; } }
    }
};
template <class Epi, class Sched, bool ALIGN_EPI = false, bool SP2 = false, int KC = 0, int LDC = 0, class Dg = int>
__device__ __forceinline__ void gemm_phase(PG8_LAS unsigned char* lds, const Gemm g, const Sched& S, const Epi& E, int tid_in, Dg& F) {
    STAMP(47);
    int tid_ = tid_in; asm volatile("" : "+v"(tid_));
    const int tid = tid_, wid = __builtin_amdgcn_readfirstlane(tid >> 6), lane = tid & 63, wr = wid >> 2, wc = wid & 3, fr = lane & 15, fq = lane >> 4;
    const int K = KC ? KC : g.K, nt = K / BK, LD = LDC ? LDC : g.ld;
    unsigned voffA[2], voffB[2];
#pragma unroll
    for (int i = 0; i < 2; ++i) { int R, C; stage_rc(tid * 16 + i * 8192, R, C); const int Rb = Epi::PERM ? ((R & ~31) + perm32(R & 31)) : R;
        voffA[i] = (unsigned)(R * LD + C) * 2u; voffB[i] = (unsigned)(Rb * LD + C) * 2u; }
    const size_t kstep = (size_t)(BK * 2);
    const size_t hstep = (size_t)HALF * LD * 2;
    const size_t tstep = 2 * hstep;
    const int aoff = lds_byte(wr * 64 + fr, fq * 8), boff = lds_byte(wc * 32 + fr, fq * 8);
    const unsigned ldsw = (unsigned)wid * 1024u;
#define PG8_SA(b, h) (((b) * 2 + (h)) * HTB)
#define PG8_SB(b, h) ((4 + (b) * 2 + (h)) * HTB)
#define PG8_STAGE(bufoff, gbase, voff) do { _Pragma("unroll") for (int _i = 0; _i < 2; ++_i) \
        __builtin_amdgcn_global_load_lds((const unsigned*)((const char*)(gbase) + (voff)[_i]), (PG8_LAS unsigned*)(lds + (bufoff) + ldsw + _i * 8192), 16, 0, 0); } while (0)
#define PG8_LDA(dst, b, h) do { _Pragma("unroll") for (int m = 0; m < 4; ++m) _Pragma("unroll") for (int k = 0; k < 2; ++k) dst[m][k] = *(const PG8_LAS bf16x8*)(lds + PG8_SA(b, h) + aoff + m * 2048 + k * 1024); } while (0)
#define PG8_LDB(dst, b, h) do { _Pragma("unroll") for (int n = 0; n < 2; ++n) _Pragma("unroll") for (int k = 0; k < 2; ++k) dst[n][k] = *(const PG8_LAS bf16x8*)(lds + PG8_SB(b, h) + boff + n * 2048 + k * 1024); } while (0)
#define PG8_MMA(ai, bj, At, Bt) do { __builtin_amdgcn_s_setprio(1); _Pragma("unroll") for (int m = 0; m < 4; ++m) _Pragma("unroll") for (int n = 0; n < 2; ++n) _Pragma("unroll") for (int k = 0; k < 2; ++k) \
        acc[ai][bj][m][n] = __builtin_amdgcn_mfma_f32_16x16x32_bf16(Bt[n][k], At[m][k], acc[ai][bj][m][n], 0, 0, 0); __builtin_amdgcn_s_setprio(0); } while (0)
#define PG8_WAIT_V(n) asm volatile("s_waitcnt vmcnt(" #n ")" ::: "memory")
#define PG8_WAIT_L(n) asm volatile("s_waitcnt lgkmcnt(" #n ")" ::: "memory")
#define PG8_BAR __builtin_amdgcn_s_barrier()
#define PG8_SCHED __builtin_amdgcn_sched_barrier(0)
    Unit cur, nxt; int ui = 0;
    if (!S.next(0, cur)) return;
    f32x4 acc[2][2][4][2];
#pragma unroll
    for (int a = 0; a < 2; ++a)
#pragma unroll
        for (int b = 0; b < 2; ++b)
#pragma unroll
            for (int m = 0; m < 4; ++m)
#pragma unroll
                for (int n = 0; n < 2; ++n) acc[a][b][m][n] = (f32x4){0.f, 0.f, 0.f, 0.f};
    bf16x8 At[4][2], B0[2][2], B1[2][2];
    const char* cA = (const char*)g.A + (size_t)cur.pm * tstep + (size_t)cur.ko * 2; const char* cB = (const char*)g.Bt + (size_t)cur.pn * tstep + (size_t)cur.ko * 2;
    S.a_ready(cur);
    if constexpr (SP2) {
        PG8_STAGE(PG8_SB(0, 0), cB, voffB); PG8_STAGE(PG8_SB(0, 1), cB + hstep, voffB); PG8_STAGE(PG8_SA(0, 0), cA, voffA); PG8_STAGE(PG8_SA(0, 1), cA + hstep, voffA);
        if (wr == 1) PG8_BAR;
        PG8_WAIT_V(2); PG8_BAR;
        PG8_STAGE(PG8_SB(1, 0), cB + kstep, voffB); PG8_STAGE(PG8_SA(1, 0), cA + kstep, voffA); PG8_STAGE(PG8_SB(1, 1), cB + hstep + kstep, voffB);
        PG8_WAIT_V(6); PG8_BAR;
    } else {
        PG8_STAGE(PG8_SB(0, 0), cB, voffB); PG8_STAGE(PG8_SA(0, 0), cA, voffA); PG8_STAGE(PG8_SB(0, 1), cB + hstep, voffB); PG8_STAGE(PG8_SA(0, 1), cA + hstep, voffA);
        if (wr == 1) PG8_BAR;
        PG8_WAIT_V(4); PG8_BAR;
        PG8_STAGE(PG8_SB(1, 0), cB + kstep, voffB); PG8_STAGE(PG8_SA(1, 0), cA + kstep, voffA); PG8_STAGE(PG8_SB(1, 1), cB + hstep + kstep, voffB);
        PG8_WAIT_V(6); PG8_BAR;
    }
    STAMP(48);
    for (;;) {
        const bool has_next = S.next(ui + 1, nxt);
        const char* nA = has_next ? (const char*)g.A + (size_t)nxt.pm * tstep + (size_t)nxt.ko * 2 : cA; const char* nB = has_next ? (const char*)g.Bt + (size_t)nxt.pn * tstep + (size_t)nxt.ko * 2 : cB;
        for (int t = 0; t < nt; t += 2) {
            const bool last = (t == nt - 2);
            const char* a1 = cA + (size_t)(t + 1) * kstep;
            const char* a2 = last ? nA : cA + (size_t)(t + 2) * kstep; const char* b2 = last ? nB : cB + (size_t)(t + 2) * kstep;
            const char* a3 = a2 + kstep; const char* b3 = b2 + kstep;
            if (last && has_next) S.a_ready(nxt);
            if constexpr (SP2) {
            PG8_LDB(B0, 0, 0); PG8_LDB(B1, 0, 1); PG8_SCHED; PG8_LDA(At, 0, 0); PG8_STAGE(PG8_SA(1, 1), a1 + hstep, voffA);
            PG8_WAIT_V(8); PG8_WAIT_L(0); PG8_BAR; PG8_MMA(0, 0, At, B0); PG8_MMA(0, 1, At, B1); PG8_BAR; PG8_SCHED;
            PG8_LDA(At, 0, 1); PG8_STAGE(PG8_SB(0, 0), b2, voffB); PG8_STAGE(PG8_SB(0, 1), b2 + hstep, voffB); PG8_STAGE(PG8_SA(0, 0), a2, voffA);
            PG8_WAIT_V(8); PG8_WAIT_L(0); PG8_BAR; PG8_MMA(1, 0, At, B0); PG8_MMA(1, 1, At, B1); PG8_BAR; PG8_SCHED;
            PG8_LDB(B0, 1, 0); PG8_LDB(B1, 1, 1); PG8_SCHED; PG8_LDA(At, 1, 0); PG8_STAGE(PG8_SA(0, 1), a2 + hstep, voffA);
            PG8_WAIT_V(8); PG8_WAIT_L(0); PG8_BAR; PG8_MMA(0, 0, At, B0); PG8_MMA(0, 1, At, B1); PG8_BAR; PG8_SCHED;
            PG8_LDA(At, 1, 1); PG8_STAGE(PG8_SB(1, 0), b3, voffB); PG8_STAGE(PG8_SB(1, 1), b3 + hstep, voffB); PG8_STAGE(PG8_SA(1, 0), a3, voffA);
            PG8_WAIT_V(8); PG8_WAIT_L(0); PG8_BAR; PG8_MMA(1, 0, At, B0); PG8_MMA(1, 1, At, B1); PG8_BAR; PG8_SCHED;
            } else {
            PG8_LDB(B0, 0, 0); PG8_SCHED; PG8_LDA(At, 0, 0); PG8_STAGE(PG8_SA(1, 1), a1 + hstep, voffA);
            PG8_WAIT_L(8); PG8_BAR; PG8_WAIT_L(0); PG8_MMA(0, 0, At, B0); PG8_BAR; PG8_SCHED;
            PG8_LDB(B1, 0, 1); PG8_STAGE(PG8_SB(0, 0), b2, voffB);
            PG8_BAR; PG8_WAIT_L(0); PG8_MMA(0, 1, At, B1); PG8_BAR;
            PG8_LDA(At, 0, 1); PG8_STAGE(PG8_SA(0, 0), a2, voffA);
            PG8_BAR; PG8_WAIT_L(0); PG8_MMA(1, 0, At, B0); PG8_BAR; PG8_SCHED;
            PG8_STAGE(PG8_SB(0, 1), b2 + hstep, voffB);
            PG8_WAIT_V(6); PG8_BAR; PG8_MMA(1, 1, At, B1); PG8_BAR;
            PG8_LDB(B0, 1, 0); PG8_SCHED; PG8_LDA(At, 1, 0); PG8_STAGE(PG8_SA(0, 1), a2 + hstep, voffA);
            PG8_WAIT_L(8); PG8_BAR; PG8_WAIT_L(0); PG8_MMA(0, 0, At, B0); PG8_BAR; PG8_SCHED;
            PG8_LDB(B1, 1, 1); PG8_STAGE(PG8_SB(1, 0), b3, voffB);
            PG8_BAR; PG8_WAIT_L(0); PG8_MMA(0, 1, At, B1); PG8_BAR;
            PG8_LDA(At, 1, 1); PG8_STAGE(PG8_SA(1, 0), a3, voffA);
            PG8_BAR; PG8_WAIT_L(0); PG8_MMA(1, 0, At, B0); PG8_BAR; PG8_SCHED;
            PG8_STAGE(PG8_SB(1, 1), b3 + hstep, voffB);
            PG8_WAIT_V(6); PG8_BAR; PG8_MMA(1, 1, At, B1); PG8_BAR;
            }
        }
        STAMP(Epi::TAG + 10);
        if constexpr (ALIGN_EPI) { if (wr == 0) PG8_BAR; }
        STAMP(31);
        if constexpr (!Epi::AFTER_DRAIN) { E(acc, cur, wr, wc, fr, fq); S.done(cur); }
        STAMP(Epi::TAG);
        if (!has_next) break;
#pragma unroll
        for (int a = 0; a < 2; ++a)
#pragma unroll
            for (int b = 0; b < 2; ++b)
#pragma unroll
                for (int m = 0; m < 4; ++m)
#pragma unroll
                    for (int n = 0; n < 2; ++n) acc[a][b][m][n] = (f32x4){0.f, 0.f, 0.f, 0.f};
        cur = nxt; cA = nA; cB = nB; ++ui;
        if constexpr (ALIGN_EPI) { if (wr == 1) PG8_BAR; }
    }
    PG8_WAIT_V(0);
    if constexpr (!ALIGN_EPI) { if (wr == 0) PG8_BAR; }
    PG8_BAR;
    if constexpr (Epi::AFTER_DRAIN) { E.fused(acc, cur, wr, wc, fr, fq, lds, wid, lane); S.done(cur); }
#undef PG8_SA
#undef PG8_SB
#undef PG8_STAGE
#undef PG8_LDA
#undef PG8_LDB
#undef PG8_MMA
#undef PG8_WAIT_V
#undef PG8_WAIT_L
#undef PG8_BAR
#undef PG8_SCHED
}
}
namespace pg8 {
__device__ __forceinline__ float row_rinv(const float* rowss, size_t R, int fq) {
    const f32x4 v = *(const f32x4*)(rowss + R * 16 + 4 * fq); float s = (v[0] + v[1]) + (v[2] + v[3]);
    s = xl_sumx32(xl_sumx16(s));
    return 1.0f / sqrtf(s * (1.0f / 1024.0f) + 1e-6f);
}
struct EpiResGate {
    static constexpr bool PERM = true, AFTER_DRAIN = false; static constexpr int TAG = 35;
    bf16_t* XB; const float* gate; const float* scn; bf16_t* XM; float* rowss;
    __device__ __forceinline__ void operator()(const f32x4 (&acc)[2][2][4][2], const Unit& u, int wr, int wc, int fr, int fq) const {
        asm volatile("" : "+v"(fr), "+v"(fq));
        const int b = u.pm / 33, p = u.pm % 33, bb = (p == 0) ? 4 : b;
        const int col0 = u.pn * BM + wc * 32 + 8 * fq;
        u32x4 xin[2][2][2];
#pragma unroll
        for (int mm = 0; mm < 2; ++mm) { const size_t R = (size_t)u.pm * BM + wr * 64 + mm * 16 + fr;
#pragma unroll
            for (int bj = 0; bj < 2; ++bj) xin[0][mm][bj] = *(const u32x4*)(XB + R * 1024 + col0 + bj * HALF); }
        f32x4 (&accw)[2][2][4][2] = const_cast<f32x4 (&)[2][2][4][2]>(acc);
        unsigned sp[2][4];
#pragma unroll
        for (int bj = 0; bj < 2; ++bj)
#pragma unroll
            for (int n = 0; n < 2; ++n) { const f32x4 gq = *(const f32x4*)(gate + bb * 6144 + col0 + bj * HALF + 4 * n);
#pragma unroll
                for (int ai = 0; ai < 2; ++ai)
#pragma unroll
                    for (int m = 0; m < 4; ++m) accw[ai][bj][m][n] *= gq;
                if (scn) { const f32x4 sq = *(const f32x4*)(scn + bb * 6144 + col0 + bj * HALF + 4 * n) + 1.0f; sp[bj][2 * n] = cvt_pk_bf16(sq[0], sq[1]); sp[bj][2 * n + 1] = cvt_pk_bf16(sq[2], sq[3]); }
                else { sp[bj][2 * n] = 0x3f803f80u; sp[bj][2 * n + 1] = 0x3f803f80u; } }
#define PG8_LO(w) __builtin_bit_cast(float, (w) << 16)
#define PG8_HI(w) __builtin_bit_cast(float, (w) & 0xffff0000u)
#pragma unroll
        for (int qb = 0; qb < 4; ++qb) { const int ai = qb >> 1, m0 = (qb & 1) * 2;
            if (qb < 3) { const int qn_ = qb + 1, ain = qn_ >> 1, m0n = (qn_ & 1) * 2;
#pragma unroll
                for (int mm = 0; mm < 2; ++mm) { const size_t R = (size_t)u.pm * BM + ain * HALF + wr * 64 + (m0n + mm) * 16 + fr;
#pragma unroll
                    for (int bj = 0; bj < 2; ++bj) xin[qn_ & 1][mm][bj] = *(const u32x4*)(XB + R * 1024 + col0 + bj * HALF); } }
#pragma unroll
            for (int mm = 0; mm < 2; ++mm) { const int m = m0 + mm; const size_t R = (size_t)u.pm * BM + ai * HALF + wr * 64 + m * 16 + fr;
                float ss = 0.f;
#pragma unroll
                for (int bj = 0; bj < 2; ++bj) { const u32x4 xw = xin[qb & 1][mm][bj];
                    const f32x4 o0 = (f32x4){PG8_LO(xw.x), PG8_HI(xw.x), PG8_LO(xw.y), PG8_HI(xw.y)} + acc[ai][bj][m][0], o1 = (f32x4){PG8_LO(xw.z), PG8_HI(xw.z), PG8_LO(xw.w), PG8_HI(xw.w)} + acc[ai][bj][m][1];
                    u32x4 w; w.x = cvt_pk_bf16(o0[0], o0[1]); w.y = cvt_pk_bf16(o0[2], o0[3]); w.z = cvt_pk_bf16(o1[0], o1[1]); w.w = cvt_pk_bf16(o1[2], o1[3]);
                    *(u32x4*)(XB + R * 1024 + col0 + bj * HALF) = w;
                    ss += ((o0[0] * o0[0] + o0[1] * o0[1]) + (o0[2] * o0[2] + o0[3] * o0[3])) + ((o1[0] * o1[0] + o1[1] * o1[1]) + (o1[2] * o1[2] + o1[3] * o1[3]));
                    if (scn) { const f32x4 s0 = (f32x4){PG8_LO(sp[bj][0]), PG8_HI(sp[bj][0]), PG8_LO(sp[bj][1]), PG8_HI(sp[bj][1])}, s1 = (f32x4){PG8_LO(sp[bj][2]), PG8_HI(sp[bj][2]), PG8_LO(sp[bj][3]), PG8_HI(sp[bj][3])};
                        const f32x4 y0 = o0 * s0, y1 = o1 * s1; w.x = cvt_pk_bf16(y0[0], y0[1]); w.y = cvt_pk_bf16(y0[2], y0[3]); w.z = cvt_pk_bf16(y1[0], y1[1]); w.w = cvt_pk_bf16(y1[2], y1[3]);
                        *(u32x4*)(XM + R * 1024 + col0 + bj * HALF) = w; } }
                ss = xl_sumx32(xl_sumx16(ss));
                if (fq == 0) rowss[R * 16 + u.pn * 4 + wc] = ss; }
        }
#undef PG8_LO
#undef PG8_HI
    }
};
struct EpiPartial {
    static constexpr bool PERM = false, AFTER_DRAIN = false; static constexpr int TAG = 36;
    float* P; int kslice;
    __device__ __forceinline__ void operator()(const f32x4 (&acc)[2][2][4][2], const Unit& u, int wr, int wc, int fr, int fq) const {
        asm volatile("" : "+v"(fr), "+v"(fq));
        const int b = u.pm / 33, ks = u.ko / kslice; const int col0 = u.pn * BM + wc * 32 + 4 * fq;
        float* rp = P + ((size_t)ks * 1024 + (size_t)b * 256 + wr * 64 + fr) * 1024 + col0;
#pragma unroll
        for (int ai = 0; ai < 2; ++ai)
#pragma unroll
            for (int m = 0; m < 4; ++m) {
#pragma unroll
                for (int bj = 0; bj < 2; ++bj)
#pragma unroll
                    for (int n = 0; n < 2; ++n) *(f32x4*)(rp + bj * HALF + n * 16) = acc[ai][bj][m][n];
                rp += (m == 3 ? 80 : 16) * 1024; asm volatile("" : "+v"(rp)); }
    }
};
struct EpiBf16N {
    static constexpr bool PERM = true, AFTER_DRAIN = false; static constexpr int TAG = 33;
    bf16_t* O; int ldc; const float* bias; int nb; const PG8_LAS float* rtab; const float* rowss; const float* qn; const float* kn; const float* rope; float qscale;
    __device__ __forceinline__ void operator()(const f32x4 (&acc)[2][2][4][2], const Unit& u, int wr, int wc, int fr, int fq) const {
        asm volatile("" : "+v"(fr), "+v"(fq));
        const int b = u.pm / 33, p = u.pm % 33, bb = (p == 0) ? 4 : b;
        const int row0 = u.pm * BM + wr * 64 + fr, col0 = u.pn * BM + wc * 32 + 8 * fq;
        f32x4 bv[2][2];
#pragma unroll
        for (int bj = 0; bj < 2; ++bj)
#pragma unroll
            for (int n = 0; n < 2; ++n) bv[bj][n] = (u.ord < 12) ? *(const PG8_LAS f32x4*)(rtab + 12 * 256 + u.ord * 256 + wc * 32 + 8 * fq + bj * HALF + 4 * n) : *(const f32x4*)(bias + (size_t)bb * nb + col0 + bj * HALF + 4 * n);
        if (u.pn >= 1 && u.pn <= 3) {
            const int hh = 4 * (u.pn - 1) + wc;
            const int dlo = (fq < 2) ? 8 * fq : 8 * fq + 16;
            bf16_t* obase = O + 256 + hh * 64 + dlo;
            const bool normed = hh < 10, isq = hh < 8;
            f32x4 g1[2], g2[2];
#pragma unroll
            for (int n = 0; n < 2; ++n) { const float* gp = (isq ? qn : kn) + dlo + 4 * n; const float sc = isq ? qscale : 1.0f;
                g1[n] = normed ? *(const f32x4*)gp * sc : (f32x4){1.f, 1.f, 1.f, 1.f}; g2[n] = normed ? *(const f32x4*)(gp + 16) * sc : (f32x4){1.f, 1.f, 1.f, 1.f}; }
            const bool roped = normed && p != 0;
            const float* rp0 = rope + ((size_t)(256 * (roped ? p - 1 : 0) + wr * 64 + fr) * 32 + 8 * fq) * 2;
            f32x4 rc[2][4];
            if (roped) {
#pragma unroll
                for (int j = 0; j < 4; ++j) rc[0][j] = *(const f32x4*)(rp0 + 4 * j); }
#pragma unroll
            for (int am = 0; am < 8; ++am) { const int ai = am >> 2, m = am & 3;
                const int rl = ai * HALF + wr * 64 + m * 16 + fr; const size_t R = (size_t)u.pm * BM + rl; const float ri = (u.ord < 12) ? rtab[u.ord * 256 + rl] : row_rinv(rowss, R, fq);
                if (roped && am < 7) { const int an = am + 1; const float* rpn = rp0 + (size_t)((an >> 2) * HALF + (an & 3) * 16) * 64;
#pragma unroll
                    for (int j = 0; j < 4; ++j) rc[an & 1][j] = *(const f32x4*)(rpn + 4 * j); }
                f32x4 v1[2], v2[2];
#pragma unroll
                for (int n = 0; n < 2; ++n) { v1[n] = acc[ai][0][m][n] * ri + bv[0][n]; v2[n] = acc[ai][1][m][n] * ri + bv[1][n]; }
                if (normed) {
                    float ss = 0.f;
#pragma unroll
                    for (int n = 0; n < 2; ++n) ss += ((v1[n][0] * v1[n][0] + v1[n][1] * v1[n][1]) + (v1[n][2] * v1[n][2] + v1[n][3] * v1[n][3])) + ((v2[n][0] * v2[n][0] + v2[n][1] * v2[n][1]) + (v2[n][2] * v2[n][2] + v2[n][3] * v2[n][3]));
                    ss = xl_sumx32(xl_sumx16(ss));
                    const float hr = 1.0f / sqrtf(ss * (1.0f / 64.0f) + 1e-6f);
#pragma unroll
                    for (int n = 0; n < 2; ++n) { v1[n] = v1[n] * hr * g1[n]; v2[n] = v2[n] * hr * g2[n]; }
                    if (roped) {
#pragma unroll
                        for (int n = 0; n < 2; ++n) { const f32x4 c0 = rc[am & 1][2 * n], c1 = rc[am & 1][2 * n + 1];
                            const f32x4 cs = (f32x4){c0[0], c0[2], c1[0], c1[2]}, sn = (f32x4){c0[1], c0[3], c1[1], c1[3]};
                            const f32x4 o1 = v1[n] * cs - v2[n] * sn, o2 = v1[n] * sn + v2[n] * cs; v1[n] = o1; v2[n] = o2; }
                    }
                }
                u32x4 w; w.x = cvt_pk_bf16(v1[0][0], v1[0][1]); w.y = cvt_pk_bf16(v1[0][2], v1[0][3]); w.z = cvt_pk_bf16(v1[1][0], v1[1][1]); w.w = cvt_pk_bf16(v1[1][2], v1[1][3]);
                *(u32x4*)(obase + R * ldc) = w;
                w.x = cvt_pk_bf16(v2[0][0], v2[0][1]); w.y = cvt_pk_bf16(v2[0][2], v2[0][3]); w.z = cvt_pk_bf16(v2[1][0], v2[1][1]); w.w = cvt_pk_bf16(v2[1][2], v2[1][3]);
                *(u32x4*)(obase + R * ldc + 16) = w; }
            return;
        }
#pragma unroll
        for (int ai = 0; ai < 2; ++ai)
#pragma unroll
            for (int m = 0; m < 4; ++m) { const size_t R = (size_t)(row0 + ai * HALF + m * 16); const float ri = (u.ord < 12) ? rtab[u.ord * 256 + ai * HALF + wr * 64 + m * 16 + fr] : row_rinv(rowss, R, fq); bf16_t* rowp = O + R * ldc + col0;
#pragma unroll
                for (int bj = 0; bj < 2; ++bj) { const f32x4 v0 = acc[ai][bj][m][0] * ri + bv[bj][0], v1 = acc[ai][bj][m][1] * ri + bv[bj][1];
                    u32x4 w; w.x = cvt_pk_bf16(v0[0], v0[1]); w.y = cvt_pk_bf16(v0[2], v0[3]); w.z = cvt_pk_bf16(v1[0], v1[1]); w.w = cvt_pk_bf16(v1[2], v1[3]);
                    *(u32x4*)(rowp + bj * HALF) = w; } }
    }
};
struct EpiSwiGLU {
    static constexpr bool PERM = true, AFTER_DRAIN = false; static constexpr int TAG = 34;
    bf16_t* O; int ldc; const float* bias; int nb; const PG8_LAS float* rtab; const float* rowss;
    __device__ __forceinline__ void operator()(const f32x4 (&acc)[2][2][4][2], const Unit& u, int wr, int wc, int fr, int fq) const {
        asm volatile("" : "+v"(fr), "+v"(fq));
        const int b = u.pm / 33, p = u.pm % 33, bb = (p == 0) ? 4 : b;
        const int row0 = u.pm * BM + wr * 64 + fr, col0 = u.pn * HALF + wc * 32 + 8 * fq, bcol0 = u.pn * BM + wc * 32 + 8 * fq;
        f32x4 bv[2][2];
#pragma unroll
        for (int bj = 0; bj < 2; ++bj)
#pragma unroll
            for (int n = 0; n < 2; ++n) bv[bj][n] = (u.ord < 12) ? *(const PG8_LAS f32x4*)(rtab + 12 * 256 + u.ord * 256 + wc * 32 + 8 * fq + bj * HALF + 4 * n) : *(const f32x4*)(bias + (size_t)bb * nb + bcol0 + bj * HALF + 4 * n);
#pragma unroll
        for (int ai = 0; ai < 2; ++ai)
#pragma unroll
            for (int m = 0; m < 4; ++m) { const size_t R = (size_t)(row0 + ai * HALF + m * 16); const float ri = (u.ord < 12) ? rtab[u.ord * 256 + ai * HALF + wr * 64 + m * 16 + fr] : row_rinv(rowss, R, fq); bf16_t* rowp = O + R * ldc + col0;
                float hv[8];
#pragma unroll
                for (int n = 0; n < 2; ++n)
#pragma unroll
                    for (int e = 0; e < 4; ++e) { const float g = acc[ai][0][m][n][e] * ri + bv[0][n][e], up = acc[ai][1][m][n][e] * ri + bv[1][n][e];
                        hv[n * 4 + e] = g * up * __builtin_amdgcn_rcpf(1.0f + __builtin_amdgcn_exp2f(-1.44269504089f * g)); }
                u32x4 w; w.x = cvt_pk_bf16(hv[0], hv[1]); w.y = cvt_pk_bf16(hv[2], hv[3]); w.z = cvt_pk_bf16(hv[4], hv[5]); w.w = cvt_pk_bf16(hv[6], hv[7]);
                *(u32x4*)rowp = w; }
    }
};
}
#ifndef PG8_SP2
#define PG8_SP2 true
#endif
#ifndef PG8_ALIGN
#define PG8_ALIGN true
#endif
#include <hip/hip_bf16.h>
#include <cmath>
namespace attn_body {
using bf16=__hip_bfloat16;
using bf16x8=__attribute__((ext_vector_type(8)))short;
using s16x4=__attribute__((ext_vector_type(4)))short;
using f32x16=__attribute__((ext_vector_type(16)))float;
using u32x4=__attribute__((ext_vector_type(4)))unsigned;
constexpr int D=64,PQ=2304,PO=1280;
constexpr int NW=8,QBLK=32,QB=QBLK*NW,KVBLK=64;
constexpr int ATTN_UNIT_ROWS=QB;
__device__ __forceinline__ int crow(int r,int hi){return (r&3)+8*(r>>2)+4*hi;}
#define SBAR() __builtin_amdgcn_sched_barrier(0)
constexpr int NSLOT=3, SLOTB=8192;
constexpr int LDS_K=0, LDS_V=NSLOT*SLOTB, LDS_WS=2*NSLOT*SLOTB, LDS_OST=LDS_WS+NW*64*4, LDS_BYTES=LDS_OST+NW*4096;
constexpr float C2=0.125f*1.4426950408889634f;
__device__ __forceinline__ void glds16(const void*gsrc,unsigned lds_dst){unsigned keep;
  asm volatile("s_mov_b32 %0, m0\n\ts_mov_b32 m0, %2\n\ts_nop 0\n\tglobal_load_lds_dwordx4 %1, off\n\ts_mov_b32 m0, %0":"=&s"(keep):"v"(gsrc),"s"(lds_dst):"memory");}
__device__ __forceinline__ float max3f(float a,float b,float c){float r;asm("v_max3_f32 %0, %1, %2, %3":"=v"(r):"v"(a),"v"(b),"v"(c));return r;}
__device__ __forceinline__ float max2f(float a,float b){float r;asm("v_max_f32_e32 %0, %1, %2":"=v"(r):"v"(a),"v"(b));return r;}
__device__ __forceinline__ float fadd_s(float a,float b){float r;asm("v_add_f32_e32 %0, %1, %2":"=v"(r):"v"(a),"v"(b));return r;}
__device__ __forceinline__ float fsub_s(float a,float b){float r;asm("v_sub_f32_e32 %0, %1, %2":"=v"(r):"v"(a),"v"(b));return r;}
typedef float f32x2_t __attribute__((ext_vector_type(2))); typedef __bf16 bf16x2_t __attribute__((ext_vector_type(2)));
__device__ __forceinline__ unsigned cvtpk_s(float lo,float hi){f32x2_t v={lo,hi};bf16x2_t b=__builtin_convertvector(v,bf16x2_t);return __builtin_bit_cast(unsigned,b);}
#define WAIT_BAR(N) asm volatile("s_waitcnt vmcnt(" #N ") lgkmcnt(0)\n\ts_barrier":::"memory")

__device__ __forceinline__ void qkt(f32x16&p0,f32x16&p1,const char*Kslot,const bf16x8*qr,const f32x16&negm,int r32,int hi){
  const char*kb=Kslot+hi*1024+r32*16;
  #pragma unroll
  for(int d0=0;d0<4;++d0){
    const bf16x8 b0=*reinterpret_cast<const bf16x8*>(kb+d0*2048);
    const bf16x8 b1=*reinterpret_cast<const bf16x8*>(kb+d0*2048+512);
    if(d0==0){p0=__builtin_amdgcn_mfma_f32_32x32x16_bf16(b0,qr[0],negm,0,0,0);p1=__builtin_amdgcn_mfma_f32_32x32x16_bf16(b1,qr[0],negm,0,0,0);}
    else{p0=__builtin_amdgcn_mfma_f32_32x32x16_bf16(b0,qr[d0],p0,0,0,0);p1=__builtin_amdgcn_mfma_f32_32x32x16_bf16(b1,qr[d0],p1,0,0,0);}}
}
typedef __attribute__((address_space(3))) const char* lds_cptr;
typedef short v4i16_t __attribute__((ext_vector_type(4)));
__device__ __forceinline__ void kload8(bf16x8*kf,lds_cptr kp){
  kf[0]=*(const __attribute__((address_space(3))) bf16x8*)(kp);      kf[1]=*(const __attribute__((address_space(3))) bf16x8*)(kp+512);
  kf[2]=*(const __attribute__((address_space(3))) bf16x8*)(kp+2048); kf[3]=*(const __attribute__((address_space(3))) bf16x8*)(kp+2560);
  kf[4]=*(const __attribute__((address_space(3))) bf16x8*)(kp+4096); kf[5]=*(const __attribute__((address_space(3))) bf16x8*)(kp+4608);
  kf[6]=*(const __attribute__((address_space(3))) bf16x8*)(kp+6144); kf[7]=*(const __attribute__((address_space(3))) bf16x8*)(kp+6656);
}
__device__ __forceinline__ void kload2(bf16x8*kf,lds_cptr kp,int j){ kf[2*j]=*(const __attribute__((address_space(3))) bf16x8*)(kp+j*2048); kf[2*j+1]=*(const __attribute__((address_space(3))) bf16x8*)(kp+j*2048+512); }
__device__ __forceinline__ s16x4 vtr(lds_cptr p){ return __builtin_bit_cast(s16x4,__builtin_amdgcn_ds_read_tr16_b64_v4i16((__attribute__((address_space(3))) v4i16_t*)p)); }
__device__ __forceinline__ float rowmax(const f32x16&p0,const f32x16&p1){
  float a=max3f(p0[0],p0[1],p1[0]),b=max3f(p0[2],p0[3],p1[1]);a=max3f(a,p1[2],p1[3]);
  #pragma unroll
  for(int r=4;r<16;r+=4){a=max3f(a,p0[r],p0[r+1]);b=max3f(b,p0[r+2],p0[r+3]);a=max3f(a,p1[r],p1[r+1]);b=max3f(b,p1[r+2],p1[r+3]);}
  const float m=max2f(a,b);
  auto rr=__builtin_amdgcn_permlane32_swap(__float_as_uint(m),__float_as_uint(m),false,false);
  return max2f(__uint_as_float(rr[0]),__uint_as_float(rr[1]));
}
__device__ __forceinline__ void pv(f32x16*o,int vb,bf16x8 pa0,bf16x8 pa1,bf16x8 pa2,bf16x8 pa3){
  #pragma unroll
  for(int d0=0;d0<2;++d0){s16x4 lo[4],hi[4];
    #pragma unroll
    for(int ks=0;ks<4;++ks){
      asm volatile("ds_read_b64_tr_b16 %0,%1 offset:%c2":"=&v"(lo[ks]):"v"(vb),"i"(d0*4096+ks*1024):"memory");
      asm volatile("ds_read_b64_tr_b16 %0,%1 offset:%c2":"=&v"(hi[ks]):"v"(vb),"i"(d0*4096+ks*1024+512):"memory");}
    asm volatile("s_waitcnt lgkmcnt(0)":::"memory");SBAR();
    #define PK(k) (bf16x8){lo[k][0],lo[k][1],lo[k][2],lo[k][3],hi[k][0],hi[k][1],hi[k][2],hi[k][3]}
    o[d0]=__builtin_amdgcn_mfma_f32_32x32x16_bf16(pa0,PK(0),o[d0],0,0,0);
    o[d0]=__builtin_amdgcn_mfma_f32_32x32x16_bf16(pa1,PK(1),o[d0],0,0,0);
    o[d0]=__builtin_amdgcn_mfma_f32_32x32x16_bf16(pa2,PK(2),o[d0],0,0,0);
    o[d0]=__builtin_amdgcn_mfma_f32_32x32x16_bf16(pa3,PK(3),o[d0],0,0,0);
    #undef PK
  }
}

#ifndef ATTN_STORE16
#define ATTN_STORE16(p,v) (*(u32x4*)(p)=(v))
#endif
template<int THRL> __device__ __forceinline__ void attn_unit(const bf16*Qu,const bf16*__restrict__ Kh,const bf16*__restrict__ Vh,bf16*Ou,const int NT,char*shm,int tid){
  const int lane=tid&63,r32=lane&31,hi=lane>>5; const int wid=__builtin_amdgcn_readfirstlane(tid>>6);
  const bf16*Qw=Qu+(long)(wid*QBLK)*PQ;
  const unsigned lds0=(unsigned)(uintptr_t)shm;
  float*wsf=(float*)(shm+LDS_WS)+wid*64;
  const bf16*ksrc=Kh+(long)lane*PQ+wid*8;
  const bf16*vsrc=Vh+(long)(16*(wid&3)+(lane>>2))*PQ+(wid>>2)*32+(lane&3)*8;
  const unsigned kdst=lds0+LDS_K+wid*1024, vdst=lds0+LDS_V+wid*1024;
  #define DMA_K(t,slot) glds16(ksrc+(long)(t)*KVBLK*PQ,(unsigned)__builtin_amdgcn_readfirstlane(kdst+(slot)))
  #define DMA_V(t,slot) glds16(vsrc+(long)(t)*KVBLK*PQ,(unsigned)__builtin_amdgcn_readfirstlane(vdst+(slot)))
  const int vb0=(int)(lds0+LDS_V)+((lane>>4)&1)*32+(lane&3)*8+(4*hi+((lane&15)>>2))*64;
  const char*Kbase=shm+LDS_K; bf16x8 kf[8];
  const lds_cptr shm3=(lds_cptr)shm; const lds_cptr kp0=shm3+LDS_K+hi*1024+r32*16; const lds_cptr vp0=shm3+LDS_V+((lane>>4)&1)*32+(lane&3)*8+(4*hi+((lane&15)>>2))*64;
  DMA_K(0,0);DMA_V(0,0);DMA_K(1,SLOTB);
  bf16x8 qr[4];
  #pragma unroll
  for(int d0=0;d0<4;++d0)qr[d0]=*reinterpret_cast<const bf16x8*>(&Qw[(long)r32*PQ+d0*16+hi*8]);
  float mhat=0.f,l_reg=0.f;f32x16 o[2];o[0]=f32x16{};o[1]=f32x16{};f32x16 negm=f32x16{};asm volatile("":"+v"(negm));
  #define CMASK(P0,P1,t) do{}while(0)
  bool resc=false;
  #define START(P0,P1) do{ const float rm=rowmax(P0,P1); resc=false; \
    { const float dl=rm; mhat=fadd_s(mhat,dl); \
      _Pragma("unroll") for(int r=0;r<16;++r){P0[r]=fsub_s(P0[r],dl);P1[r]=fsub_s(P1[r],dl);} \
      _Pragma("unroll") for(int r=0;r<16;++r)negm[r]=-mhat; asm volatile("":"+v"(negm)); } \
    _Pragma("unroll") for(int r=0;r<16;++r)P0[r]=__builtin_amdgcn_exp2f(P0[r]); }while(0)
  #define RESC() do{ if(resc){ asm volatile("s_waitcnt lgkmcnt(0)":::"memory"); \
      _Pragma("unroll") for(int d_=0;d_<2;++d_) _Pragma("unroll") for(int r=0;r<16;++r)o[d_][r]*=wsf[crow(r,hi)]; } }while(0)
  f32x16 pA0,pA1,pB0,pB1;
  int sl_prev=0,sl_cur=0,sl_next=SLOTB;
  #define ROT() do{sl_prev=sl_cur;sl_cur=sl_next;sl_next=(sl_next==(NSLOT-1)*SLOTB)?0:sl_next+SLOTB;}while(0)
  DMA_K(2,2*SLOTB);
  WAIT_BAR(3);
  qkt(pA0,pA1,Kbase,qr,negm,r32,hi);asm volatile("s_nop 15\n\ts_nop 7":"+v"(pA0),"+v"(pA1));CMASK(pA0,pA1,0);
  START(pA0,pA1);
  _Pragma("unroll") for(int r=0;r<16;++r)pA1[r]=__builtin_amdgcn_exp2f(pA1[r]);
  WAIT_BAR(0);
  DMA_K(3,0);DMA_V(1,SLOTB);
  ROT();
  kload8(kf,kp0+sl_cur);
  WAIT_BAR(2);
  s16x4 vlo[8],vhi[8]; u32x4 pw0,pw1,pw2,pw3;
  #define PKW(P,B) cvtpk_s(P[B],P[B+1])
  #define PAF(k) __builtin_bit_cast(bf16x8,pw##k)
  #define VFR(i) (bf16x8){vlo[i][0],vlo[i][1],vlo[i][2],vlo[i][3],vhi[i][0],vhi[i][1],vhi[i][2],vhi[i][3]}
  #define PIN(x) asm volatile("":"+v"(x))
  #define MX3(a,b,c) __builtin_fmaxf(__builtin_fmaxf((a),(b)),(c))
  #define GAPA(MF,A0,A1,A2,A3,W0,W1,PW) do{ MF; sacc+=A0; sacc+=A1; sacc+=A2; sacc+=A3; PIN(sacc); W0; W1; PIN(PW); SBAR(); }while(0)
  #define EX(v) __builtin_amdgcn_exp2f(v)
  #define GAPB(MF,X,B) do{ MF; X[B]=EX(X[B]); X[B+1]=EX(X[B+1]); X[B+2]=EX(X[B+2]); X[B+3]=EX(X[B+3]); PIN(X); SBAR(); }while(0)
  #define VRD(i) do{ vlo[i]=vtr(vp_+(((i)>>2)*4096+((i)&3)*1024)); vhi[i]=vtr(vp_+(((i)>>2)*4096+((i)&3)*1024+512)); }while(0)
  #define KRD(G,j) do{ if(G){ kload2(kf,kp0+sl_next,j); SBAR(); } }while(0)
  #define STEP(C0,C1,P0,P1,t,GK,GV,GL) do{ SBAR(); \
    const lds_cptr vp_=vp0+sl_prev; \
    VRD(0); SBAR(); float sacc=(P0[0]+P0[1]); \
    GAPA(C0=__builtin_amdgcn_mfma_f32_32x32x16_bf16(kf[0],qr[0],negm,0,0,0), P0[2],P0[3],P0[4],P0[5],     pw0[0]=PKW(P0,0), pw0[1]=PKW(P0,2), pw0); \
    VRD(4); SBAR(); GAPA(C1=__builtin_amdgcn_mfma_f32_32x32x16_bf16(kf[1],qr[0],negm,0,0,0), P0[6],P0[7],P0[8],P0[9],     pw0[2]=PKW(P0,4), pw0[3]=PKW(P0,6), pw0); \
    VRD(1); SBAR(); GAPA(C0=__builtin_amdgcn_mfma_f32_32x32x16_bf16(kf[2],qr[1],C0,0,0,0),   P0[10],P0[11],P0[12],P0[13], pw1[0]=PKW(P0,8), pw1[1]=PKW(P0,10), pw1); \
    VRD(5); SBAR(); GAPA(C1=__builtin_amdgcn_mfma_f32_32x32x16_bf16(kf[3],qr[1],C1,0,0,0),   P0[14],P0[15],P1[0],P1[1],   pw1[2]=PKW(P0,12),pw1[3]=PKW(P0,14), pw1); \
    VRD(2); SBAR(); GAPA(C0=__builtin_amdgcn_mfma_f32_32x32x16_bf16(kf[4],qr[2],C0,0,0,0),   P1[2],P1[3],P1[4],P1[5],     pw2[0]=PKW(P1,0), pw2[1]=PKW(P1,2), pw2); \
    VRD(6); SBAR(); GAPA(C1=__builtin_amdgcn_mfma_f32_32x32x16_bf16(kf[5],qr[2],C1,0,0,0),   P1[6],P1[7],P1[8],P1[9],     pw2[2]=PKW(P1,4), pw2[3]=PKW(P1,6), pw2); \
    VRD(3); SBAR(); GAPA(C0=__builtin_amdgcn_mfma_f32_32x32x16_bf16(kf[6],qr[3],C0,0,0,0),   P1[10],P1[11],P1[12],P1[13], pw3[0]=PKW(P1,8), pw3[1]=PKW(P1,10), pw3); \
    VRD(7); SBAR(); GAPA(C1=__builtin_amdgcn_mfma_f32_32x32x16_bf16(kf[7],qr[3],C1,0,0,0),   P1[14],P1[15],0.f,0.f,       pw3[2]=PKW(P1,12),pw3[3]=PKW(P1,14), pw3); \
    l_reg+=sacc; \
    if(GK){DMA_K((t)+3,sl_cur);} if(GV){DMA_V((t)+1,sl_next);} \
    CMASK(C0,C1,t); \
    { float a=MX3(C0[0],C0[1],C1[0]),b=MX3(C0[2],C0[3],C1[1]); a=MX3(a,C1[2],C1[3]); \
      _Pragma("unroll") for(int r=4;r<16;r+=4){a=MX3(a,C0[r],C0[r+1]);b=MX3(b,C0[r+2],C0[r+3]);a=MX3(a,C1[r],C1[r+1]);b=MX3(b,C1[r+2],C1[r+3]);} \
      float rm=__builtin_fmaxf(a,b); { auto rr=__builtin_amdgcn_permlane32_swap(__float_as_uint(rm),__float_as_uint(rm),false,false); rm=__builtin_fmaxf(__uint_as_float(rr[0]),__uint_as_float(rr[1])); } \
      resc=false; \
      if(__builtin_expect(__any(rm>(float)THRL),0)){ const float dl=__builtin_fmaxf(rm,0.f); mhat+=dl; \
        _Pragma("unroll") for(int r=0;r<16;++r){C0[r]-=dl;C1[r]-=dl;} \
        _Pragma("unroll") for(int r=0;r<16;++r)negm[r]=-mhat; asm volatile("":"+v"(negm)); \
        const float f=__builtin_amdgcn_exp2f(-dl); l_reg*=f; if(hi==0)wsf[r32]=f; resc=true; } } \
    SBAR(); \
    GAPB(o[0]=__builtin_amdgcn_mfma_f32_32x32x16_bf16(PAF(0),VFR(0),o[0],0,0,0), C0,0); \
    GAPB(o[1]=__builtin_amdgcn_mfma_f32_32x32x16_bf16(PAF(0),VFR(4),o[1],0,0,0), C0,4); \
    KRD(GL,0); GAPB(o[0]=__builtin_amdgcn_mfma_f32_32x32x16_bf16(PAF(1),VFR(1),o[0],0,0,0), C0,8); \
    KRD(GL,1); GAPB(o[1]=__builtin_amdgcn_mfma_f32_32x32x16_bf16(PAF(1),VFR(5),o[1],0,0,0), C0,12); \
    KRD(GL,2); GAPB(o[0]=__builtin_amdgcn_mfma_f32_32x32x16_bf16(PAF(2),VFR(2),o[0],0,0,0), C1,0); \
    KRD(GL,3); GAPB(o[1]=__builtin_amdgcn_mfma_f32_32x32x16_bf16(PAF(2),VFR(6),o[1],0,0,0), C1,4); \
    GAPB(o[0]=__builtin_amdgcn_mfma_f32_32x32x16_bf16(PAF(3),VFR(3),o[0],0,0,0), C1,8); \
    GAPB(o[1]=__builtin_amdgcn_mfma_f32_32x32x16_bf16(PAF(3),VFR(7),o[1],0,0,0), C1,12); \
    }while(0)
  int t=1;
  #undef CMASK
  #define CMASK(P0,P1,t) do{}while(0)
  for(;t+5<NT;t+=2){
    STEP(pB0,pB1,pA0,pA1,t,true,true,true);     WAIT_BAR(2); RESC(); ROT();
    STEP(pA0,pA1,pB0,pB1,t+1,true,true,true);   WAIT_BAR(2); RESC(); ROT();
  }
  #undef CMASK
  #define CMASK(P0,P1,t) do{}while(0)
  #define ENDW(tt) do{ if((tt)+3<NT){WAIT_BAR(2);} else if((tt)+2<NT){WAIT_BAR(1);} else {WAIT_BAR(0);} }while(0)
  for(;t+1<NT;t+=2){
    STEP(pB0,pB1,pA0,pA1,t,(t+3<NT),(t+1<NT),(t+1<NT));       ENDW(t);   RESC(); ROT();
    STEP(pA0,pA1,pB0,pB1,t+1,(t+4<NT),(t+2<NT),(t+2<NT));     ENDW(t+1); RESC(); ROT();
  }
  STEP(pB0,pB1,pA0,pA1,NT-1,false,false,false); RESC();
  { float sacc=pB0[0]+pB0[1]; _Pragma("unroll") for(int r=2;r<16;++r)sacc+=pB0[r]; _Pragma("unroll") for(int r=0;r<16;++r)sacc+=pB1[r]; l_reg+=sacc;
    pw0=(u32x4){PKW(pB0,0),PKW(pB0,2),PKW(pB0,4),PKW(pB0,6)};pw1=(u32x4){PKW(pB0,8),PKW(pB0,10),PKW(pB0,12),PKW(pB0,14)};pw2=(u32x4){PKW(pB1,0),PKW(pB1,2),PKW(pB1,4),PKW(pB1,6)};pw3=(u32x4){PKW(pB1,8),PKW(pB1,10),PKW(pB1,12),PKW(pB1,14)};
    SBAR(); pv(o,vb0+sl_cur,PAF(0),PAF(1),PAF(2),PAF(3)); }
  #undef PKW
  #undef PAF
  #undef VFR
  #undef PIN
  #undef MX3
  #undef GAPA
  #undef GAPB
  #undef EX
  #undef VRD
  #undef KRD
  #undef STEP
  #undef ENDW
  {auto rr=__builtin_amdgcn_permlane32_swap(__float_as_uint(l_reg),__float_as_uint(l_reg),false,false);l_reg=__uint_as_float(rr[0])+__uint_as_float(rr[1]);}
  if(hi==0)wsf[32+r32]=l_reg;asm volatile("s_waitcnt lgkmcnt(0)":::"memory");
  float rli[16];
  #pragma unroll
  for(int r=0;r<16;++r)rli[r]=__builtin_amdgcn_rcpf(wsf[32+crow(r,hi)]);
  bf16*Ow=Ou+(long)(wid*QBLK)*PO;
  { bf16*stg=(bf16*)(shm+LDS_OST)+wid*2048;
    #pragma unroll
    for(int r=0;r<16;++r){const int orow=crow(r,hi);
      #pragma unroll
      for(int d0=0;d0<2;++d0)stg[orow*64+d0*32+r32]=__float2bfloat16(o[d0][r]*rli[r]);}
    asm volatile("s_waitcnt lgkmcnt(0)":::"memory");
    #pragma unroll
    for(int i=0;i<4;++i){const int row=i*8+(lane>>3),ch=lane&7; const u32x4 v=*(const u32x4*)(stg+row*64+ch*8); ATTN_STORE16(Ow+(long)row*PO+ch*8,v);} }
  asm volatile("s_waitcnt lgkmcnt(0)\n\ts_barrier":::"memory");
  #undef DMA_K
  #undef DMA_V
  #undef CMASK
  #undef START
  #undef RESC
  #undef ROT
}
constexpr int ATTN_LDS_BYTES=LDS_BYTES;
#undef SBAR
#undef WAIT_BAR
}

constexpr int NWAVES = 8, NTHREADS = NWAVES * 64;
constexpr int DM = 1024, NB = 4, SEQ = 8192, CTXL = 256, DEPTH = 4;
constexpr int TPB = SEQ + CTXL;
constexpr int MROWS = NB * TPB;
constexpr int PROJ = 2304, DFF = 2816, KMIX = 1280;
constexpr int OFF_Q = 256, OFF_K = 768, OFF_V = 896, OFF_FF = 1024, OFF_FB = 1280, OFF_I = 1536, OFF_HQ = 1792, OFF_G = 2048;
constexpr int MIX_P = 0, MIX_Q = 256, MIX_A = 512, MIX_R = 1024;
constexpr float EPS = 1e-6f;
constexpr float QSCALE = 0.125f * 1.4426950408889634f;
constexpr int MOD_SH_A = 0, MOD_SC_A = 1024, MOD_G_A = 2048, MOD_SH_F = 3072, MOD_SC_F = 4096, MOD_G_F = 5120;

constexpr size_t MiB = 1u << 20;
constexpr size_t WS_CTL = 0, CTL_ZERO_BYTES = 1 * MiB;
constexpr size_t WS_MODS = 1 * MiB;
constexpr size_t WS_LB = WS_MODS + 512 * 1024;
constexpr size_t WS_TW = WS_LB + 65536;
constexpr size_t WS_FT128 = WS_TW + 65536;
constexpr size_t WS_W64F = WS_FT128 + 65536;
constexpr size_t WS_CT256 = WS_W64F + 16384;
static_assert(WS_CT256 + 262144 <= 2 * MiB, "tables");
constexpr size_t WS_ROPE = 2 * MiB;
constexpr size_t WS_TF = 4 * MiB;
constexpr size_t WS_XC = 6 * MiB;
constexpr size_t WS_WIN = 10 * MiB;
constexpr size_t WS_WOUT = 28 * MiB;
constexpr size_t WS_WGU = 38 * MiB;
constexpr size_t WS_WDN = 82 * MiB;
constexpr size_t WS_XB = 104 * MiB;
constexpr size_t WS_HGS = 170 * MiB;
constexpr size_t WS_UX = 236 * MiB;
constexpr size_t WS_MIX = 385 * MiB;
constexpr size_t WS_H = WS_UX;
constexpr size_t WS_HGG = 468 * MiB;
constexpr size_t WS_ROWSS = 470 * MiB;
constexpr size_t WS_BIASA = 473 * MiB;
constexpr size_t WS_BIASF = 474 * MiB;
constexpr size_t WS_END = 475 * MiB;
static_assert(WS_UX + (size_t)MROWS * PROJ * 2 <= WS_MIX && WS_MIX + (size_t)MROWS * KMIX * 2 <= WS_END && WS_H + (size_t)MROWS * DFF * 2 <= WS_END, "d_ws map");
static_assert(WS_XB + (size_t)MROWS * DM * 2 <= WS_HGS && WS_HGS + (size_t)2 * MROWS * 256 * 4 <= WS_UX, "d_ws map 2");
constexpr int CW_TMO = 0, CW_CODE = 1, CW_BAR = 4096;

constexpr int RING_OFF = 0, RING_BYTES = 131072;
constexpr int LDSCTL_OFF = RING_BYTES, MISC_OFF = LDSCTL_OFF + 320;
constexpr int RINV_OFF = LDSCTL_OFF + 512, RINV_SLOTS = 12;
constexpr int BTAB_OFF = RINV_OFF + RINV_SLOTS * 1024;
constexpr int LDS_BYTES = 157696;
static_assert(BTAB_OFF + RINV_SLOTS * 1024 <= LDS_BYTES && LDS_BYTES <= 163840, "LDS map");

#define GAS __attribute__((address_space(1)))
#define LAS __attribute__((address_space(3)))
typedef unsigned short bf16;
typedef unsigned v4u __attribute__((ext_vector_type(4)));
typedef float f32x4 __attribute__((ext_vector_type(4)));
typedef short bf16x8 __attribute__((ext_vector_type(8)));
typedef GAS unsigned gu32;
typedef GAS unsigned long long gu64;
#define RLX_AGENT __ATOMIC_RELAXED, __HIP_MEMORY_SCOPE_AGENT
#define LDS_WAIT() asm volatile("s_waitcnt lgkmcnt(0)" ::: "memory")
#define VM_WAIT() asm volatile("s_waitcnt vmcnt(0)" ::: "memory")
__device__ __forceinline__ unsigned long long rt() { return __builtin_amdgcn_s_memrealtime(); }
__device__ __forceinline__ unsigned f2bf(float f) { unsigned u = __builtin_bit_cast(unsigned, f); return (u + 0x7fffu + ((u >> 16) & 1u)) >> 16; }
__device__ __forceinline__ unsigned pk2(float lo, float hi) { return f2bf(lo) | (f2bf(hi) << 16); }

#define XB_TMO      128
#define XB_XCNT(j)  (256  + 64 * (j))
#define XB_XSUB(j)  (1280 + 64 * (j))
#define XB_XGEN(j)  (2304 + 64 * (j))
#define XB_TOP      3328
#define XB_TOPGEN   3392
#define XCD_BAR_WORDS 3456
#define XB_SPIN_CAP (1u << 18)

__device__ __forceinline__ unsigned xb_ld(unsigned* p)              { return __hip_atomic_load(p, __ATOMIC_RELAXED, __HIP_MEMORY_SCOPE_AGENT); }
__device__ __forceinline__ unsigned xb_add(unsigned* p, unsigned v) { return __hip_atomic_fetch_add(p, v, __ATOMIC_RELAXED, __HIP_MEMORY_SCOPE_AGENT); }
__device__ __forceinline__ unsigned xb_xcc_id() { return (unsigned)__builtin_amdgcn_s_getreg((3 << 11) | 20) & 0xFu; }
#define XB_SPIN(cond, bar) do { unsigned _sp = 0; while (cond) { __builtin_amdgcn_s_sleep(1); \
    if ((++_sp & 255u) == 0u) { if (xb_ld(&(bar)[XB_TMO])) break; if (_sp > XB_SPIN_CAP) { atomicAdd(&(bar)[XB_TMO], 1u); break; } } } } while (0)

struct XcdBarrier {
    unsigned* bar; unsigned x;
    volatile LAS unsigned* st;
};

__device__ __forceinline__ XcdBarrier xcd_barrier_post(unsigned* bar, volatile LAS unsigned* st) {
    XcdBarrier b; b.bar = bar; b.x = xb_xcc_id(); b.st = st;
    if (threadIdx.x == 0) (void)xb_add(&bar[XB_XCNT(b.x)], 1u);
    return b;
}
__device__ __forceinline__ void xcd_barrier_complete(unsigned* bar, unsigned x, unsigned& nloc, unsigned& nx) {
    const unsigned G = gridDim.x * gridDim.y * gridDim.z;
    unsigned sum, cnt, mine, sp = 0u;
    for (;;) {
        sum = 0u; cnt = 0u; mine = 0u;
#pragma unroll
        for (unsigned j = 0; j < 16; ++j) { const unsigned c = xb_ld(&bar[XB_XCNT(j)]); sum += c; cnt += (c > 0u) ? 1u : 0u; mine = (j == x) ? c : mine; }
        if (sum == G) break;
        __builtin_amdgcn_s_sleep(1);
        if ((++sp & 255u) == 0u) { if (xb_ld(&bar[XB_TMO])) break; if (sp > XB_SPIN_CAP) { atomicAdd(&bar[XB_TMO], 1u); break; } }
    }
    nloc = mine > 0u ? mine : 1u; nx = cnt > 0u ? cnt : 1u;
}

__device__ __forceinline__ void xcd_barrier(const XcdBarrier& b) {
    asm volatile("s_waitcnt vmcnt(0)" ::: "memory");
    __syncthreads();
    if (threadIdx.x == 0) {
        unsigned* bar = b.bar;
        __builtin_amdgcn_s_waitcnt(0);
        unsigned nloc = b.st[0], nx = b.st[1];
        if (nloc == 0u) { xcd_barrier_complete(bar, b.x, nloc, nx); b.st[0] = nloc; b.st[1] = nx; }
        const unsigned old = xb_add(&bar[XB_XSUB(b.x)], 1u);
        const unsigned gen = old / nloc;
        if (old + 1u == (gen + 1u) * nloc) {
            __builtin_amdgcn_fence(__ATOMIC_RELEASE, "agent");
            asm volatile("s_waitcnt vmcnt(0)" ::: "memory");
            const unsigned og = xb_add(&bar[XB_TOP], 1u);
            const unsigned tg = og / nx;
            if (og + 1u == (tg + 1u) * nx) xb_add(&bar[XB_TOPGEN], 1u);
            else XB_SPIN(xb_ld(&bar[XB_TOPGEN]) == tg, bar);
            __builtin_amdgcn_fence(__ATOMIC_ACQUIRE, "agent");
            xb_add(&bar[XB_XGEN(b.x)], 1u);
            asm volatile("s_waitcnt vmcnt(0)" ::: "memory");
        } else {
            XB_SPIN(xb_ld(&bar[XB_XGEN(b.x)]) == gen, bar);
            __builtin_amdgcn_fence(__ATOMIC_ACQUIRE, "agent");
            asm volatile("s_waitcnt vmcnt(0)" ::: "memory");
        }
    }
    __syncthreads();
}

typedef float f32x2 __attribute__((ext_vector_type(2)));
typedef unsigned u32x2 __attribute__((ext_vector_type(2)));
typedef const GAS float* const __attribute__((address_space(4)))* kargs_t;
struct Frame {
    LAS unsigned char* lds;
    volatile LAS unsigned* MISC;
    int tid, lane, wave, vcu, G;
    unsigned long long dt, da;
    GAS unsigned char* ws; GAS float* outg;
    __device__ __forceinline__ float* out_() const { return (float*)outg; }
    __device__ __forceinline__ bf16* HN() const { return (bf16*)outg; }
    __device__ __forceinline__ const float* in(int i) const { return (const float*)(((kargs_t)__builtin_amdgcn_kernarg_segment_ptr())[i]); }
#define FIN(name, idx) __device__ __forceinline__ const float* name() const { return in(idx); }
    FIN(x, 0) FIN(c, 1) FIN(ctx, 2) FIN(c_ctx, 3) FIN(w_ada, 4) FIN(b_ada, 5) FIN(w_in, 6) FIN(w_four, 7) FIN(q_norm, 8) FIN(k_norm, 9) FIN(hg_lb, 10) FIN(hg_norm, 11) FIN(w_out, 12) FIN(w_gate, 13) FIN(w_up, 14) FIN(w_down, 15) FIN(final_norm, 16)
#undef FIN
#define FWS(type, name, off) __device__ __forceinline__ type* name() const { return (type*)(ws + (off)); }
    FWS(unsigned, ctlw, WS_CTL) FWS(float, MODS, WS_MODS) FWS(float, LB, WS_LB) FWS(f32x2, ROPE, WS_ROPE) FWS(float, TF, WS_TF) FWS(float, XC, WS_XC) FWS(float, HGS, WS_HGS) FWS(float, HGG, WS_HGG) FWS(float, ROWSS, WS_ROWSS) FWS(float, BIASA, WS_BIASA) FWS(float, BIASF, WS_BIASF)
    FWS(f32x2, TW, WS_TW) FWS(bf16, FT128, WS_FT128) FWS(bf16, W64F, WS_W64F) FWS(bf16, CT256, WS_CT256)
    FWS(bf16, WIN, WS_WIN) FWS(bf16, WOUT, WS_WOUT) FWS(bf16, WGU, WS_WGU) FWS(bf16, WDN, WS_WDN) FWS(bf16, XB, WS_XB) FWS(bf16, UX, WS_UX) FWS(bf16, MIX, WS_MIX) FWS(bf16, HB, WS_H)
#undef FWS
};
__device__ __forceinline__ float bf2f(unsigned short h) { return __builtin_bit_cast(float, (unsigned)h << 16); }
__device__ __forceinline__ float bflo(unsigned w) { return __builtin_bit_cast(float, w << 16); }
__device__ __forceinline__ float bfhi(unsigned w) { return __builtin_bit_cast(float, w & 0xffff0000u); }
__device__ __forceinline__ float wave_sum(float v) { return xl_sum64(v); }
__device__ __forceinline__ float sigmoidf_(float z) { return __builtin_amdgcn_rcpf(1.0f + __builtin_amdgcn_exp2f(-1.44269504089f * z)); }
__device__ __forceinline__ float siluf_(float z) { return z * sigmoidf_(z); }
__device__ __forceinline__ const float* xrow_ptr(const float* lat, const float* ctx, int R) {
    const int b = R / TPB, t = R - b * TPB;
    return (t < CTXL) ? ctx + ((size_t)b * CTXL + t) * DM : lat + ((size_t)b * SEQ + (t - CTXL)) * DM;
}

__host__ __device__ __forceinline__ int win_row(int c) {
    if (c < 256 || c >= 1024) return c;
    const int hh = (c - 256) >> 6, d = (c - 256) & 63, bj = (d >> 4) & 1, p = (d & 15) + ((d >> 5) << 4);
    return 256 * (1 + (hh >> 2)) + 128 * bj + 32 * (hh & 3) + p;
}
__device__ __forceinline__ void tr_item(const float* src, int ldsrc, bf16* dst, int ldt, LAS float* scr, int lane, int row16 = 16) {
#pragma unroll 1
    for (int h = 0; h < 4; ++h) { float tv[8];
#pragma unroll
        for (int i = 0; i < 8; ++i) tv[i] = src[(size_t)(2 * (8 * h + i) + (lane >> 5)) * ldsrc + (lane & 31)];
#pragma unroll
        for (int i = 0; i < 8; ++i) scr[(2 * (8 * h + i) + (lane >> 5)) * 33 + (lane & 31)] = tv[i]; }
    LDS_WAIT(); asm volatile("" ::: "memory");
    const int c = lane & 7;
#pragma unroll
    for (int j = 0; j < 4; ++j) { const int n = (lane >> 3) + 8 * j; const LAS float* s = scr + (8 * c) * 33 + n;
        v4u o; o.x = pk2(s[0 * 33], s[1 * 33]); o.y = pk2(s[2 * 33], s[3 * 33]); o.z = pk2(s[4 * 33], s[5 * 33]); o.w = pk2(s[6 * 33], s[7 * 33]);
        *(GAS v4u*)(dst + (size_t)(j < 2 ? n : n - 16 + row16) * ldt + 8 * c) = o; }
    LDS_WAIT(); asm volatile("" ::: "memory");
}
__device__ __forceinline__ void p0a_prologue(Frame& F) {
    const int gw = F.vcu * NWAVES + F.wave, NGW = F.G * NWAVES;
    const int gt = F.vcu * NTHREADS + F.tid, NGT = F.G * NTHREADS;
    LAS float* scr = (LAS float*)(F.lds + RING_OFF + F.wave * 12288);
    LAS float* sil = (LAS float*)(F.lds + RING_OFF + 98304);
    LAS f32x2* cs64 = (LAS f32x2*)(F.lds + RING_OFF + 98304 + 20480 + 10240);
    if (F.tid < 64) { const float a = (float)F.tid * (1.0f / 32.0f); cs64[F.tid] = (f32x2){cospif(a), sinpif(a)}; }
    for (int i = F.tid; i < 5 * DM; i += NTHREADS) { const int bb = i >> 10, k = i & 1023; const float v = (bb < 4) ? F.c()[bb * DM + k] : F.c_ctx()[k]; sil[i] = v / (1.0f + expf(-v)); }
    __syncthreads();
    {
        LAS float* part = (LAS float*)(F.lds + RING_OFF + 98304 + 20480);
        for (int it = F.vcu; it < DEPTH * 96; it += F.G) {
            const int l = it / 96, j = (it % 96) * 64 + F.lane;
            const float* wp = F.w_ada() + (size_t)l * DM * 6144 + (size_t)(128 * F.wave) * 6144 + j;
            float a0 = 0.f, a1 = 0.f, a2 = 0.f, a3 = 0.f, a4 = 0.f;
            float wn[16];
#pragma unroll
            for (int i = 0; i < 16; ++i) wn[i] = wp[(size_t)i * 6144];
            for (int k0 = 0; k0 < 128; k0 += 16) {
                float w[16];
#pragma unroll
                for (int i = 0; i < 16; ++i) w[i] = wn[i];
                if (k0 + 16 < 128) {
#pragma unroll
                    for (int i = 0; i < 16; ++i) wn[i] = wp[(size_t)(k0 + 16 + i) * 6144]; }
#pragma unroll
                for (int i = 0; i < 16; ++i) { const int k = 128 * F.wave + k0 + i; a0 += sil[k] * w[i]; a1 += sil[1024 + k] * w[i]; a2 += sil[2048 + k] * w[i]; a3 += sil[3072 + k] * w[i]; a4 += sil[4096 + k] * w[i]; }
            }
            LAS float* pw = part + F.wave * 320 + F.lane;
            pw[0] = a0; pw[64] = a1; pw[128] = a2; pw[192] = a3; pw[256] = a4;
            __syncthreads();
            if (F.tid < 320) { float s = 0.f;
#pragma unroll
                for (int ww = 0; ww < 8; ++ww) s += part[ww * 320 + F.tid];
                const int bb = F.tid >> 6, jj = (it % 96) * 64 + (F.tid & 63);
                F.MODS()[(size_t)l * 5 * 6144 + bb * 6144 + jj] = s + F.b_ada()[l * 6144 + jj]; }
            __syncthreads();
        }
    }
    constexpr int I_IN = 16 * 72, I_OUT = 12 * 32, I_G = 16 * 88, I_D = 44 * 32, I_L = I_IN + I_OUT + 2 * I_G + I_D;
    for (int it = gw; it < DEPTH * I_L; it += NGW) {
        const int l = it / I_L; int r = it % I_L;
        if (r < I_IN) { const int kb = r / 72, nb = r % 72;
            const int r0 = win_row(32 * nb), r16 = win_row(32 * nb + 16);
            tr_item(F.w_in() + (size_t)l * DM * PROJ + (size_t)(64 * kb) * PROJ + 32 * nb, PROJ, F.WIN() + (size_t)l * PROJ * DM + (size_t)r0 * DM + 64 * kb, DM, scr, F.lane, r16 - r0); continue; }
        r -= I_IN;
        if (r < I_OUT) { const int kb = r / 32, nb = r % 32;
            tr_item(F.w_out() + (size_t)l * DM * DM + (size_t)(256 + 64 * kb) * DM + 32 * nb, DM, F.WOUT() + (size_t)l * DM * KMIX + (size_t)(32 * nb) * KMIX + 512 + 64 * kb, KMIX, scr, F.lane); continue; }
        r -= I_OUT;
        if (r < 2 * I_G) { const int up = r / I_G, rr = r % I_G, kb = rr / 88, nb = rr % 88, n0 = 32 * nb;
            const float* W = (up ? F.w_up() : F.w_gate()) + (size_t)l * DM * DFF;
            const int drow = (n0 >> 7) * 256 + up * 128 + (n0 & 127);
            tr_item(W + (size_t)(64 * kb) * DFF + n0, DFF, F.WGU() + (size_t)l * 5632 * DM + (size_t)drow * DM + 64 * kb, DM, scr, F.lane); continue; }
        r -= 2 * I_G;
        { const int kb = r / 32, nb = r % 32;
            tr_item(F.w_down() + (size_t)l * DFF * DM + (size_t)(64 * kb) * DM + 32 * nb, DM, F.WDN() + (size_t)l * DM * DFF + (size_t)(32 * nb) * DFF + 64 * kb, DFF, scr, F.lane); }
    }
    for (int it = gt; it < DEPTH * 2 * 256 * 256; it += NGT) {
        const int jp = it & 255, gc = (it >> 8) & 255, s = (it >> 16) & 1, l = it >> 17, g = gc >> 6, cc = gc & 63;
        const float* wf = F.w_four() + (size_t)l * 65536 + (size_t)(g * 64) * 256 + jp;
        float a = 0.f;
        for (int m = 0; m < 64; ++m) { const f32x2 cs = cs64[(cc * m) & 63]; a += (s ? -cs.y : cs.x) * wf[m * 256]; }
        F.TF()[it] = a * 0.125f;
    }
    for (int it = gt; it < 2 * 256; it += NGT) {
        const int d = it >> 8, cc = it & 255; float v[DEPTH], mx = -INFINITY, sm = 0.f;
#pragma unroll
        for (int l = 0; l < DEPTH; ++l) { v[l] = F.hg_lb()[(d * DEPTH + l) * 256 + cc]; mx = fmaxf(mx, v[l]); }
#pragma unroll
        for (int l = 0; l < DEPTH; ++l) { v[l] = expf(v[l] - mx); sm += v[l]; }
        float cum = 0.f;
#pragma unroll
        for (int l = 0; l < DEPTH; ++l) { if (l > 0) cum += v[l] / sm; F.LB()[(d * DEPTH + l) * 256 + cc] = cum; }
    }
    for (int it = gt; it < SEQ * 32; it += NGT) {
        const int p = it >> 5, i = it & 31; const float pos = (float)((i < 16) ? (p >> 6) : (p & 63));
        const float fr = powf(10000.0f, -(float)(2 * (i & 15)) / 32.0f); const float ang = pos * fr;
        F.ROPE()[it] = (f32x2){cosf(ang), sinf(ang)};
    }
    for (int it = gt; it < SEQ; it += NGT) { const float a = (float)it * (1.0f / 4096.0f); F.TW()[it] = (f32x2){cospif(a), sinpif(a)}; }
    for (int it = gt; it < 2 * 128 * 128; it += NGT) { const int s = it >> 14, k = (it >> 7) & 127, n = it & 127; const float a = (float)((k * n) & 127) * (1.0f / 64.0f); F.FT128()[it] = (bf16)f2bf(s ? sinpif(a) : cospif(a)); }
    for (int it = gt; it < 2 * 2 * 4 * 64 * 8; it += NGT) { const int jj = it & 7, ln = (it >> 3) & 63, T = (it >> 9) & 3, a2 = (it >> 11) & 1, s = it >> 12;
        const int k2 = 16 * T + (ln & 15), g = ln >> 4, n2 = 32 * a2 + (jj < 4 ? 4 * g + jj : 16 + 4 * g + (jj - 4)); const float a = (float)((k2 * n2) & 63) * (1.0f / 32.0f);
        F.W64F()[it] = (bf16)f2bf(s ? sinpif(a) : cospif(a)); }
    for (int it = gt; it < 2 * 256 * 256; it += NGT) { const int jj = it & 7, ln = (it >> 3) & 63, ks = (it >> 9) & 7, T = (it >> 12) & 15, s = it >> 16;
        const int k = 16 * T + (ln & 15), g = ln >> 4, n = 32 * ks + (jj < 4 ? 4 * g + jj : 16 + 4 * g + (jj - 4)); const float a = (float)((k * n) & 255) * (1.0f / 128.0f); F.CT256()[it] = (bf16)f2bf(s ? sinpif(a) : cospif(a)); }
}
__device__ __forceinline__ void p0b_fold(Frame& F) {
    {
        LAS float* tfl = (LAS float*)(F.lds + RING_OFF + 16384);
        for (int it = F.vcu; it < DEPTH * 64 * 2; it += F.G) {
            const int jh = it & 1, kg = (it >> 1) & 63, l = it >> 7, j = jh * 512 + F.tid;
            const float* tf = F.TF() + (size_t)l * 131072 + (size_t)(kg * 8) * 256;
            for (int i = F.tid; i < 2048; i += NTHREADS) tfl[(i & 255) * 8 + (i >> 8)] = tf[i];
            __syncthreads();
            const float* wo = F.w_out() + (size_t)l * DM * DM + j;
            float a[8] = {0.f, 0.f, 0.f, 0.f, 0.f, 0.f, 0.f, 0.f};
            for (int jp0 = 0; jp0 < 256; jp0 += 8) {
                float w[8];
#pragma unroll
                for (int i = 0; i < 8; ++i) w[i] = wo[(size_t)(jp0 + i) * DM];
#pragma unroll
                for (int i = 0; i < 8; ++i) { const f32x4 t0 = *(const LAS f32x4*)(tfl + (jp0 + i) * 8), t1 = *(const LAS f32x4*)(tfl + (jp0 + i) * 8 + 4);
                    a[0] += t0[0] * w[i]; a[1] += t0[1] * w[i]; a[2] += t0[2] * w[i]; a[3] += t0[3] * w[i]; a[4] += t1[0] * w[i]; a[5] += t1[1] * w[i]; a[6] += t1[2] * w[i]; a[7] += t1[3] * w[i]; }
            }
            v4u o; o.x = pk2(a[0], a[1]); o.y = pk2(a[2], a[3]); o.z = pk2(a[4], a[5]); o.w = pk2(a[6], a[7]);
            *(GAS v4u*)(F.WOUT() + (size_t)l * DM * KMIX + (size_t)j * KMIX + kg * 8) = o;
            __syncthreads();
        }
    }
    {
        LAS float* part = (LAS float*)(F.lds + RING_OFF);
        for (int it = F.vcu; it < DEPTH * 124; it += F.G) {
            const int l = it / 124, v0 = (it % 124) * 64;
            const float* W; int ldw, col, shoff; float* dst; int dstride;
            if (v0 < 2304) { W = F.w_in() + (size_t)l * DM * PROJ; ldw = PROJ; col = v0 + F.lane; shoff = MOD_SH_A; dst = F.BIASA() + (size_t)l * 5 * 2304 + win_row(col); dstride = 2304; }
            else { const int up = v0 >= 2304 + DFF, hid = v0 - 2304 - up * DFF + F.lane; W = (up ? F.w_up() : F.w_gate()) + (size_t)l * DM * DFF; ldw = DFF; col = hid; shoff = MOD_SH_F;
                dst = F.BIASF() + (size_t)l * 5 * 5632 + (hid >> 7) * 256 + up * 128 + (hid & 127); dstride = 5632; }
            const float* wp = W + (size_t)(128 * F.wave) * ldw + col; const float* shp = F.MODS() + (size_t)l * 5 * 6144 + shoff + 128 * F.wave;
            LAS float* shl = (LAS float*)(F.lds + RING_OFF + 32768) + F.wave * 640;
            for (int i = F.lane; i < 640; i += 64) shl[i] = shp[(size_t)(i >> 7) * 6144 + (i & 127)];
            asm volatile("s_waitcnt vmcnt(0) lgkmcnt(0)" ::: "memory");
            float a0 = 0.f, a1 = 0.f, a2 = 0.f, a3 = 0.f, a4 = 0.f;
            float wn[16];
#pragma unroll
            for (int i = 0; i < 16; ++i) wn[i] = wp[(size_t)i * ldw];
            for (int k0 = 0; k0 < 128; k0 += 16) {
                float w[16];
#pragma unroll
                for (int i = 0; i < 16; ++i) w[i] = wn[i];
                if (k0 + 16 < 128) {
#pragma unroll
                    for (int i = 0; i < 16; ++i) wn[i] = wp[(size_t)(k0 + 16 + i) * ldw]; }
#pragma unroll
                for (int i = 0; i < 16; ++i) { const int k = k0 + i; a0 += shl[k] * w[i]; a1 += shl[128 + k] * w[i]; a2 += shl[256 + k] * w[i]; a3 += shl[384 + k] * w[i]; a4 += shl[512 + k] * w[i]; }
            }
            LAS float* pw = part + F.wave * 320 + F.lane;
            pw[0] = a0; pw[64] = a1; pw[128] = a2; pw[192] = a3; pw[256] = a4;
            __syncthreads();
            float s = 0.f;
            if (F.tid < 320) {
#pragma unroll
                for (int ww = 0; ww < 8; ++ww) s += part[ww * 320 + F.tid]; }
            if (F.tid < 320) dst[(size_t)(F.tid >> 6) * dstride] = s;
            __syncthreads();
        }
    }
    {
        const int gw = F.vcu * NWAVES + F.wave, NGW = F.G * NWAVES;
        for (int R = gw; R < MROWS; R += NGW) {
            const int b = R / TPB, t = R - b * TPB, bb = (t < CTXL) ? 4 : b;
            const GAS f32x4* xr = (const GAS f32x4*)xrow_ptr(F.x(), F.ctx(), R) + F.lane;
            const GAS f32x4* scp = (const GAS f32x4*)(F.MODS() + bb * 6144 + MOD_SC_A) + F.lane;
            f32x4 v[4]; float s = 0.f;
#pragma unroll
            for (int j = 0; j < 4; ++j) { v[j] = xr[64 * j]; s += (v[j].x * v[j].x + v[j].y * v[j].y) + (v[j].z * v[j].z + v[j].w * v[j].w); }
            s = wave_sum(s);
            GAS u32x2* o8 = (GAS u32x2*)(F.HN() + (size_t)R * DM) + F.lane; GAS u32x2* x8 = (GAS u32x2*)(F.XB() + (size_t)R * DM) + F.lane;
#pragma unroll
            for (int j = 0; j < 4; ++j) { const f32x4 y = v[j] * (scp[64 * j] + 1.0f); u32x2 w; w.x = pk2(y.x, y.y); w.y = pk2(y.z, y.w); o8[64 * j] = w;
                u32x2 xw; xw.x = pk2(v[j].x, v[j].y); xw.y = pk2(v[j].z, v[j].w); x8[64 * j] = xw; }
            if (F.lane < 16) F.ROWSS()[(size_t)R * 16 + F.lane] = (F.lane == 0) ? s : 0.f;
        }
    }
}

template <class Sched>
__device__ __forceinline__ void rinv_fill(Frame& F, const Sched& S, const float* bias, int nb) {
    LAS float* tab = (LAS float*)(F.lds + RINV_OFF); LAS float* btab = (LAS float*)(F.lds + BTAB_OFF);
    LAS int* pml = (LAS int*)(F.lds + BTAB_OFF + RINV_SLOTS * 1024 - 128);
    __syncthreads();
    int n = 0;
    if (F.tid < RINV_SLOTS) { pg8::Unit u; const bool ok = S.next(F.tid, u); pml[2 * F.tid] = ok ? u.pm : -1; pml[2 * F.tid + 1] = ok ? u.pn : 0; }
    __syncthreads();
#pragma unroll 1
    for (int i = 0; i < RINV_SLOTS; ++i) if (pml[2 * i] >= 0) n = i + 1;
    float rv[RINV_SLOTS / 2], bvv[RINV_SLOTS / 2];
#pragma unroll
    for (int k = 0; k < RINV_SLOTS / 2; ++k) { const int it = F.tid + k * NTHREADS, i = it >> 8, rl = it & 255; rv[k] = 0.f; bvv[k] = 0.f;
        if (i < n) { const int pm = pml[2 * i], pn = pml[2 * i + 1], bb = (pm % 33 == 0) ? 4 : pm / 33;
            const GAS f32x4* p = (const GAS f32x4*)(F.ROWSS() + ((size_t)pm * 256 + rl) * 16); const f32x4 a = p[0], b = p[1], c = p[2], d = p[3];
            bvv[k] = *(const GAS float*)(bias + (size_t)bb * nb + pn * 256 + rl);
            const float s = ((a[0] + a[1]) + (a[2] + a[3])) + ((b[0] + b[1]) + (b[2] + b[3])) + ((c[0] + c[1]) + (c[2] + c[3])) + ((d[0] + d[1]) + (d[2] + d[3]));
            rv[k] = 1.0f / sqrtf(s * (1.0f / DM) + EPS); } }
    __syncthreads();
#pragma unroll
    for (int k = 0; k < RINV_SLOTS / 2; ++k) { const int it = F.tid + k * NTHREADS; if ((it >> 8) < n) { tab[it] = rv[k]; btab[it] = bvv[k]; } }
    __syncthreads();
}
template <int NSPLIT>
__device__ __forceinline__ void ctx_reduce_pass(Frame& F, const float* P, const float* gate, const float* scn) {
    const int gw = F.vcu * NWAVES + F.wave, NGW = F.G * NWAVES;
    for (int cr = gw; cr < NB * CTXL; cr += NGW) {
        const int b = cr >> 8, t = cr & 255; const size_t R = (size_t)b * TPB + t;
        float ss = 0.f;
#pragma unroll 1
        for (int j = 0; j < 4; ++j) { const int col = 4 * F.lane + 256 * j;
            f32x4 pv[NSPLIT];
#pragma unroll
            for (int s = 0; s < NSPLIT; ++s) pv[s] = *(const GAS f32x4*)(P + ((size_t)s * 1024 + cr) * 1024 + col);
            f32x4 a = pv[0];
#pragma unroll
            for (int s = 1; s < NSPLIT; ++s) a += pv[s];
            const u32x2 xo = *(const GAS u32x2*)(F.XB() + R * DM + col);
            const f32x4 xn = (f32x4){bflo(xo.x), bfhi(xo.x), bflo(xo.y), bfhi(xo.y)} + *(const GAS f32x4*)(gate + 4 * 6144 + col) * a;
            u32x2 xw; xw.x = pk2(xn.x, xn.y); xw.y = pk2(xn.z, xn.w); *(GAS u32x2*)(F.XB() + R * DM + col) = xw;
            ss += (xn.x * xn.x + xn.y * xn.y) + (xn.z * xn.z + xn.w * xn.w);
            if (scn) { const f32x4 y = xn * (*(const GAS f32x4*)(scn + 4 * 6144 + col) + 1.0f); u32x2 w; w.x = pk2(y.x, y.y); w.y = pk2(y.z, y.w); *(GAS u32x2*)(F.HN() + R * DM + col) = w; } }
        ss = wave_sum(ss);
        if (F.lane < 16) F.ROWSS()[R * 16 + F.lane] = (F.lane == 0) ? ss : 0.f;
    }
}
__device__ __forceinline__ void final_norm_phase(Frame& F) {
    const int gw = F.vcu * NWAVES + F.wave, NGW = F.G * NWAVES;
    for (int r = gw; r < NB * SEQ; r += NGW) {
        const int b = r >> 13, n = r & (SEQ - 1); const size_t R = (size_t)b * TPB + CTXL + n;
        float s = (F.lane < 16) ? F.ROWSS()[R * 16 + F.lane] : 0.f;
        s = wave_sum(s);
        const float rinv = 1.0f / sqrtf(s * (1.0f / DM) + EPS);
        const GAS u32x2* xr = (const GAS u32x2*)(F.XB() + R * DM) + F.lane; const GAS f32x4* gp = (const GAS f32x4*)F.final_norm() + F.lane;
        GAS f32x4* orow = (GAS f32x4*)(F.out_() + (size_t)r * DM) + F.lane;
#pragma unroll
        for (int j = 0; j < 4; ++j) { const u32x2 w = xr[64 * j]; orow[64 * j] = (f32x4){bflo(w.x), bfhi(w.x), bflo(w.y), bfhi(w.y)} * rinv * gp[64 * j]; }
    }
}

__device__ __forceinline__ void attn_fast_phase(Frame& F, int l) {
    char* shm = (char*)(F.lds + RING_OFF);
    const attn_body::bf16* UXp = (const attn_body::bf16*)F.UX(); attn_body::bf16* MIXp = (attn_body::bf16*)F.MIX();
    for (int base = F.vcu * 4; base < NB * 8 * 32 + F.G * 4; base += F.G * 4) {
        for (int i = 0; i < 5; ++i) {
            int bh, q0, NT;
            if (base < NB * 8 * 32) { if (i == 4) break; const int U = base + i; bh = U >> 5; q0 = CTXL + (U & 31) * 256; NT = TPB / 64; }
            else { const int c = base - NB * 8 * 32 + i * 0; if (i > 0 || l == DEPTH - 1) break; const int cu = c / 4; if ((cu & 7) != 0 || cu >= 256) break; bh = cu >> 3; q0 = 0; NT = CTXL / 64; }
            const int b = bh >> 3, h = bh & 7, kvh = h >> 2; const size_t rb = (size_t)b * TPB;
            attn_body::attn_unit<8>(UXp + (rb + q0) * PROJ + OFF_Q + h * 64, UXp + rb * PROJ + OFF_K + kvh * 64, UXp + rb * PROJ + OFF_V + kvh * 64, MIXp + (rb + q0) * KMIX + MIX_A + h * 64, NT, shm, F.tid);
        }
    }
}

namespace fft {
typedef short v4i16_t __attribute__((ext_vector_type(4)));
constexpr int ZP = 544;
__device__ __forceinline__ v4i16_t trrd(const LAS char* p) { return __builtin_amdgcn_ds_read_tr16_b64_v4i16((LAS v4i16_t*)p); }
__device__ __forceinline__ bf16x8 cat8(v4i16_t lo, v4i16_t hi) { return (bf16x8){lo[0], lo[1], lo[2], lo[3], hi[0], hi[1], hi[2], hi[3]}; }
__device__ __forceinline__ bf16x8 ld_frag2(const bf16* p0, const bf16* p1) { const u32x2 a = *(const GAS u32x2*)p0, b = *(const GAS u32x2*)p1; v4u w; w.x = a.x; w.y = a.y; w.z = b.x; w.w = b.y; return __builtin_bit_cast(bf16x8, w); }
#define MFMA16(a, b, c) __builtin_amdgcn_mfma_f32_16x16x32_bf16((a), (b), (c), 0, 0, 0)
}
__device__ __forceinline__ void fourier_fast_phase(Frame& F) {
    using namespace fft;
    LAS char* Z = (LAS char*)(F.lds + RING_OFF);
    LAS char* Zc = Z + 128 * ZP;
    const int tid = F.tid, lane = F.lane, w = F.wave, l16 = lane & 15, g = lane >> 4, q = l16 >> 2, p = l16 & 3;
    const bf16* UXp = F.UX(); bf16* MIXp = F.MIX();
    for (int unit = F.vcu; unit < NB * 64; unit += F.G) {
        const int b = unit >> 6, cg = unit & 63;
        { const bf16* zsrc = UXp + ((size_t)b * TPB + CTXL) * PROJ + cg * 4;
#pragma unroll 4
          for (int i = 0; i < 16; ++i) { const int n = tid + 512 * i; const u32x2 v = *(const GAS u32x2*)(zsrc + (size_t)n * PROJ);
              LAS char* d = Z + (n >> 6) * ZP + (n & 63) * 2;
              *(LAS unsigned short*)(d) = (unsigned short)(v.x & 0xffffu); *(LAS unsigned short*)(d + 128) = (unsigned short)(v.x >> 16);
              *(LAS unsigned short*)(d + 256) = (unsigned short)(v.y & 0xffffu); *(LAS unsigned short*)(d + 384) = (unsigned short)(v.y >> 16); }
          if (tid < CTXL) *(LAS u32x2*)(Zc + tid * 8) = *(const GAS u32x2*)(UXp + ((size_t)b * TPB + tid) * PROJ + cg * 4); }
        __syncthreads(); STAMP(40);
        const int k1 = 16 * w + l16;
        bf16x8 Bre[4][2], Bim[4][2];
        {
            bf16x8 Fc[4], Fs[4];
            const bf16* ftc = F.FT128() + k1 * 128; const bf16* fts = ftc + 128 * 128;
#pragma unroll
            for (int ks = 0; ks < 4; ++ks) { Fc[ks] = ld_frag2(ftc + 32 * ks + 4 * g, ftc + 32 * ks + 16 + 4 * g); Fs[ks] = ld_frag2(fts + 32 * ks + 4 * g, fts + 32 * ks + 16 + 4 * g); }
            f32x2 tw[4][4];
#pragma unroll
            for (int be = 0; be < 4; ++be)
#pragma unroll
                for (int r = 0; r < 4; ++r) tw[be][r] = F.TW()[k1 * (16 * be + 4 * g + r)];
            const LAS char* zrd = Z + (4 * g + q) * ZP + 8 * p;
#pragma unroll
            for (int c = 0; c < 4; ++c) {
                f32x4 ar[4], ai[4];
#pragma unroll
                for (int be = 0; be < 4; ++be) { ar[be] = (f32x4){0.f, 0.f, 0.f, 0.f}; ai[be] = (f32x4){0.f, 0.f, 0.f, 0.f}; }
#pragma unroll
                for (int ks = 0; ks < 4; ++ks)
#pragma unroll
                    for (int be = 0; be < 4; ++be) { const LAS char* a0 = zrd + (32 * ks) * ZP + (c * 64 + 16 * be) * 2;
                        const bf16x8 A = cat8(trrd(a0), trrd(a0 + 16 * ZP));
                        ar[be] = MFMA16(A, Fc[ks], ar[be]); ai[be] = MFMA16(A, Fs[ks], ai[be]); }
                float br[4][4], bi[4][4];
#pragma unroll
                for (int be = 0; be < 4; ++be)
#pragma unroll
                    for (int r = 0; r < 4; ++r) { const float ct = tw[be][r].x, st = tw[be][r].y; br[be][r] = ar[be][r] * ct - ai[be][r] * st; bi[be][r] = ar[be][r] * st + ai[be][r] * ct; }
#pragma unroll
                for (int a = 0; a < 2; ++a) { v4u wr_, wi_;
                    wr_.x = pk2(br[2 * a][0], br[2 * a][1]); wr_.y = pk2(br[2 * a][2], br[2 * a][3]); wr_.z = pk2(br[2 * a + 1][0], br[2 * a + 1][1]); wr_.w = pk2(br[2 * a + 1][2], br[2 * a + 1][3]);
                    wi_.x = pk2(bi[2 * a][0], bi[2 * a][1]); wi_.y = pk2(bi[2 * a][2], bi[2 * a][3]); wi_.z = pk2(bi[2 * a + 1][0], bi[2 * a + 1][1]); wi_.w = pk2(bi[2 * a + 1][2], bi[2 * a + 1][3]);
                    Bre[c][a] = __builtin_bit_cast(bf16x8, wr_); Bim[c][a] = __builtin_bit_cast(bf16x8, wi_); }
                __builtin_amdgcn_sched_barrier(0);
            }
        }
        STAMP(41);
        {
            const float sc = 0.011048543456039806f;
#pragma unroll 1
            for (int T = 0; T < 4; ++T) {
                bf16x8 Wc[2], Ws[2];
#pragma unroll
                for (int a = 0; a < 2; ++a) { Wc[a] = *(const GAS bf16x8*)(F.W64F() + (((0 * 2 + a) * 4 + T) * 64 + lane) * 8); Ws[a] = *(const GAS bf16x8*)(F.W64F() + (((1 * 2 + a) * 4 + T) * 64 + lane) * 8); }
                f32x4 P[4], Q[4];
#pragma unroll
                for (int c = 0; c < 4; ++c) {
                    bf16x8 nim[2];
#pragma unroll
                    for (int a = 0; a < 2; ++a) { v4u t = __builtin_bit_cast(v4u, Bim[c][a]); t.x ^= 0x80008000u; t.y ^= 0x80008000u; t.z ^= 0x80008000u; t.w ^= 0x80008000u; nim[a] = __builtin_bit_cast(bf16x8, t); }
                    f32x4 pp = (f32x4){0.f, 0.f, 0.f, 0.f}, qq = (f32x4){0.f, 0.f, 0.f, 0.f};
#pragma unroll
                    for (int a = 0; a < 2; ++a) { pp = MFMA16(Bre[c][a], Wc[a], pp); pp = MFMA16(nim[a], Ws[a], pp); qq = MFMA16(Bre[c][a], Ws[a], qq); qq = MFMA16(Bim[c][a], Wc[a], qq); }
                    P[c] = pp; Q[c] = qq;
                }
#pragma unroll
                for (int r = 0; r < 4; ++r) { const int k = (16 * w + 4 * g + r) + 128 * (16 * T + l16);
                    bf16* mp = MIXp + ((size_t)b * TPB + CTXL + k) * KMIX + cg * 4;
                    u32x2 o; o.x = pk2(P[0][r] * sc, P[1][r] * sc); o.y = pk2(P[2][r] * sc, P[3][r] * sc); *(GAS u32x2*)(mp + MIX_P) = o;
                    o.x = pk2(Q[0][r] * sc, Q[1][r] * sc); o.y = pk2(Q[2][r] * sc, Q[3][r] * sc); *(GAS u32x2*)(mp + MIX_Q) = o; }
            }
        }
        STAMP(42);
        {
            f32x4 aP[2], aQ[2];
#pragma unroll
            for (int tt = 0; tt < 2; ++tt) { aP[tt] = (f32x4){0.f, 0.f, 0.f, 0.f}; aQ[tt] = (f32x4){0.f, 0.f, 0.f, 0.f}; }
            const bf16* ctc = F.CT256() + (size_t)(2 * w) * 8 * 512 + lane * 8; const bf16* cts = ctc + 256 * 256;
#pragma unroll 1
            for (int hk = 0; hk < 4; ++hk) {
                bf16x8 Bc[2][2], Bs[2][2];
#pragma unroll
                for (int tt = 0; tt < 2; ++tt)
#pragma unroll
                    for (int kk = 0; kk < 2; ++kk) { const int ks = 2 * hk + kk; Bc[tt][kk] = *(const GAS bf16x8*)(ctc + (tt * 8 + ks) * 512); Bs[tt][kk] = *(const GAS bf16x8*)(cts + (tt * 8 + ks) * 512); }
#pragma unroll
                for (int kk = 0; kk < 2; ++kk) { const int ks = 2 * hk + kk;
                    const LAS char* a0 = Zc + (32 * ks + 4 * g + q) * 8;
                    const bf16x8 A = cat8(trrd(a0), trrd(a0 + 16 * 8));
#pragma unroll
                    for (int tt = 0; tt < 2; ++tt) { aP[tt] = MFMA16(A, Bc[tt][kk], aP[tt]); aQ[tt] = MFMA16(A, Bs[tt][kk], aQ[tt]); } }
            }
            if (g == 0) {
#pragma unroll
                for (int tt = 0; tt < 2; ++tt) { const int k = 16 * (2 * w + tt) + l16; bf16* mp = MIXp + ((size_t)b * TPB + k) * KMIX + cg * 4;
                    u32x2 o; o.x = pk2(aP[tt][0] * 0.0625f, aP[tt][1] * 0.0625f); o.y = pk2(aP[tt][2] * 0.0625f, aP[tt][3] * 0.0625f); *(GAS u32x2*)(mp + MIX_P) = o;
                    o.x = pk2(aQ[tt][0] * 0.0625f, aQ[tt][1] * 0.0625f); o.y = pk2(aQ[tt][2] * 0.0625f, aQ[tt][3] * 0.0625f); *(GAS u32x2*)(mp + MIX_Q) = o; }
            }
        }
        STAMP(43);
        __syncthreads(); STAMP(44);
    }
}

__device__ __forceinline__ float hg_exp(float x) { return __builtin_amdgcn_exp2f(x); }
#define LDS_BAR() asm volatile("s_waitcnt lgkmcnt(0)\n\ts_barrier" ::: "memory")
namespace hg {
using fft::trrd; using fft::cat8;
constexpr int IP = 160;
constexpr int IMG = 64 * IP;
__device__ __forceinline__ int scan_pos(int c, int dir) { return dir == 0 ? c : (c < 4 ? 3 - c : 135 - c); }
__device__ __forceinline__ float dpp_shr(float v, int n) {
    const int x = __builtin_bit_cast(int, v); int r;
    switch (n) { case 1: r = __builtin_amdgcn_update_dpp(0, x, 0x111, 0xF, 0xF, true); break; case 2: r = __builtin_amdgcn_update_dpp(0, x, 0x112, 0xF, 0xF, true); break;
                 case 4: r = __builtin_amdgcn_update_dpp(0, x, 0x114, 0xF, 0xF, true); break; default: r = __builtin_amdgcn_update_dpp(0, x, 0x118, 0xF, 0xF, true); break; }
    return __builtin_bit_cast(float, r);
}
__device__ __forceinline__ float scan_incl(float v, int lane) {
    v += dpp_shr(v, 1); v += dpp_shr(v, 2); v += dpp_shr(v, 4); v += dpp_shr(v, 8);
    v += __builtin_bit_cast(float, __builtin_amdgcn_update_dpp(0, __builtin_bit_cast(int, v), 0x142, 0xA, 0xF, false));
    v += __builtin_bit_cast(float, __builtin_amdgcn_update_dpp(0, __builtin_bit_cast(int, v), 0x143, 0xC, 0xF, false));
    (void)lane; return v;
}
__device__ __forceinline__ float lane_bcast(float v, int src) { return __builtin_bit_cast(float, __builtin_amdgcn_readlane(__builtin_bit_cast(int, v), src)); }
#define HG_SB() __builtin_amdgcn_sched_barrier(0)
__device__ __forceinline__ void gates16(const v4u z0, const v4u z1, const float lbl  , int lane, float (&kk)[16], float (&cum)[16]) {
    const unsigned zw[8] = {z0.x, z0.y, z0.z, z0.w, z1.x, z1.y, z1.z, z1.w};
    float e[16], lb[16];
#pragma unroll
    for (int i = 0; i < 16; ++i) { const float z = (i & 1) ? bfhi(zw[i >> 1]) : bflo(zw[i >> 1]); e[i] = __builtin_amdgcn_exp2f(-1.44269504089f * z); lb[i] = lane_bcast(lbl, i); }
    HG_SB();
#pragma unroll
    for (int i = 0; i < 16; ++i) e[i] = __builtin_amdgcn_rcpf(1.0f + e[i]);
    HG_SB();
#pragma unroll
    for (int i = 0; i < 16; ++i) { const float om = 1.0f - lb[i]; kk[i] = om - om * e[i]; e[i] = fmaxf(lb[i] + om * e[i], 1e-30f); }
    HG_SB();
#pragma unroll
    for (int i = 0; i < 16; ++i) cum[i] = __builtin_amdgcn_logf(e[i]);
    HG_SB();
#pragma unroll
    for (int i = 0; i < 16; ++i) cum[i] += dpp_shr(cum[i], 1);
    HG_SB();
#pragma unroll
    for (int i = 0; i < 16; ++i) cum[i] += dpp_shr(cum[i], 2);
    HG_SB();
#pragma unroll
    for (int i = 0; i < 16; ++i) cum[i] += dpp_shr(cum[i], 4);
    HG_SB();
#pragma unroll
    for (int i = 0; i < 16; ++i) cum[i] += dpp_shr(cum[i], 8);
    HG_SB();
#pragma unroll
    for (int i = 0; i < 16; ++i) cum[i] += __builtin_bit_cast(float, __builtin_amdgcn_update_dpp(0, __builtin_bit_cast(int, cum[i]), 0x142, 0xA, 0xF, false));
    HG_SB();
#pragma unroll
    for (int i = 0; i < 16; ++i) cum[i] += __builtin_bit_cast(float, __builtin_amdgcn_update_dpp(0, __builtin_bit_cast(int, cum[i]), 0x143, 0xC, 0xF, false));
    HG_SB();
    (void)lane;
}
__device__ __forceinline__ void st16(LAS char* p, const float (&v)[16]) {
    v4u a, b; a.x = pk2(v[0], v[1]); a.y = pk2(v[2], v[3]); a.z = pk2(v[4], v[5]); a.w = pk2(v[6], v[7]); b.x = pk2(v[8], v[9]); b.y = pk2(v[10], v[11]); b.z = pk2(v[12], v[13]); b.w = pk2(v[14], v[15]);
    *(LAS v4u*)p = a; *(LAS v4u*)(p + 16) = b;
}
}
struct HgInA { v4u z0, z1, v0, v1; float lb; };
__device__ __forceinline__ HgInA hg_load_a(const bf16* UXp, const float* LBl  , int unit, int dir, int wd, int lane) {
    const int c = unit % (TPB / 64), bh = unit / (TPB / 64), b = bh >> 2, h = bh & 3;
    const size_t row = (size_t)b * TPB + 64 * c + (dir ? 63 - lane : lane);
    const bf16* rp = UXp + row * PROJ + h * 64 + 16 * wd; HgInA r;
    r.z0 = *(const GAS v4u*)(rp + (dir ? OFF_FB : OFF_FF)); r.z1 = *(const GAS v4u*)(rp + (dir ? OFF_FB : OFF_FF) + 8);
    r.v0 = *(const GAS v4u*)(rp + OFF_I); r.v1 = *(const GAS v4u*)(rp + OFF_I + 8); r.lb = *(const GAS float*)(LBl + h * 64 + 16 * wd + (lane & 15)); return r;
}
__device__ __forceinline__ void hgrn_a_phase(Frame& F, int l) {
    using namespace hg;
    const int lane = F.lane, w = F.wave, dir = w >> 2, wd = w & 3, l16 = lane & 15, g = lane >> 4, q = l16 >> 2, p = l16 & 3;
    LAS char* KI = (LAS char*)(F.lds + RING_OFF) + dir * 2 * IMG; LAS char* VI = KI + IMG;
    const bf16* UXp = F.UX();
    constexpr int NU = NB * 4 * (TPB / 64);
    const float* LBl = F.LB() + (dir * DEPTH + l) * 256;
    HgInA nx = hg_load_a(UXp, LBl, F.vcu < NU ? F.vcu : 0, dir, wd, lane);
    for (int unit = F.vcu; unit < NU; unit += F.G) {
        const int c = unit % (TPB / 64), bh = unit / (TPB / 64), b = bh >> 2, h = bh & 3;
        const HgInA in = nx;
        if (unit + F.G < NU) nx = hg_load_a(UXp, LBl, unit + F.G, dir, wd, lane);
        float kk[16], cum[16];
        gates16(in.z0, in.z1, in.lb, lane, kk, cum);
        float ko[16], gl[16];
#pragma unroll
        for (int i = 0; i < 16; ++i) { gl[i] = lane_bcast(cum[i], 63); ko[i] = gl[i] - cum[i]; }
        HG_SB();
#pragma unroll
        for (int i = 0; i < 16; ++i) ko[i] = hg_exp(ko[i]);
        HG_SB();
#pragma unroll
        for (int i = 0; i < 16; ++i) ko[i] *= kk[i];
        st16(KI + lane * IP + 32 * wd, ko);
        *(LAS v4u*)(VI + lane * IP + 32 * wd) = in.v0; *(LAS v4u*)(VI + lane * IP + 32 * wd + 16) = in.v1;
        const int ch = (b * 4 + h) * 2 + dir, pp = scan_pos(c, dir);
        if (lane < 16) { float gv = 0.f;
#pragma unroll
            for (int i = 0; i < 16; ++i) gv = (lane == i) ? gl[i] : gv;
            F.HGG()[((size_t)ch * 132 + pp) * 64 + 16 * wd + lane] = hg_exp(gv); }
        LDS_BAR();
        bf16x8 Af[2];
#pragma unroll
        for (int ks = 0; ks < 2; ++ks) { const LAS char* a0 = KI + (32 * ks + 4 * g + q) * IP + (16 * wd + 4 * p) * 2; Af[ks] = cat8(trrd(a0), trrd(a0 + 16 * IP)); }
        bf16* sp = (bf16*)F.HGS() + ((size_t)ch * 132 + pp) * 4096;
#pragma unroll
        for (int et = 0; et < 4; ++et) { f32x4 acc = (f32x4){0.f, 0.f, 0.f, 0.f};
#pragma unroll
            for (int ks = 0; ks < 2; ++ks) { const LAS char* b0 = VI + (32 * ks + 4 * g + q) * IP + (16 * et + 4 * p) * 2; acc = MFMA16(Af[ks], cat8(trrd(b0), trrd(b0 + 16 * IP)), acc); }
            u32x2 o2; o2.x = pk2(acc[0], acc[1]); o2.y = pk2(acc[2], acc[3]); *(GAS u32x2*)(sp + (16 * et + l16) * 64 + 16 * wd + 4 * g) = o2; }
        LDS_BAR();
    }
}
__device__ __forceinline__ void hgrn_b_phase(Frame& F) {
    const int gt = F.vcu * NTHREADS + F.tid, NGT = F.G * NTHREADS;
    for (int it = gt; it < 32 * 2048; it += NGT) {
        const int ch = it >> 11, idx = (it & 2047) * 2, d = idx & 63;
        unsigned* sp = (unsigned*)((bf16*)F.HGS() + (size_t)ch * 132 * 4096 + idx); const f32x2* gp = (const f32x2*)(F.HGG() + (size_t)ch * 132 * 64 + d);
        float s0 = 0.f, s1 = 0.f;
        for (int p0 = 0; p0 < 132; p0 += 6) {
            unsigned kv[6]; f32x2 gg[6];
#pragma unroll
            for (int i = 0; i < 6; ++i) { kv[i] = sp[(size_t)(p0 + i) * 2048]; gg[i] = gp[(p0 + i) * 32]; }
#pragma unroll
            for (int i = 0; i < 6; ++i) { sp[(size_t)(p0 + i) * 2048] = pk2(s0, s1); s0 = gg[i].x * s0 + bflo(kv[i]); s1 = gg[i].y * s1 + bfhi(kv[i]); }
        }
    }
}
struct HgInC { v4u z0, z1, q0, q1, v0, v1; v4u s[2]; u32x2 gr[2]; float lb; };
__device__ __forceinline__ HgInC hg_load_c(const bf16* UXp, const bf16* HGSp, const float* LBl, int unit, int nch, int c0, int dir, int wd, int lane, int w) {
    const int c = c0 + unit % nch, bh = unit / nch, b = bh >> 2, h = bh & 3, l16 = lane & 15, g = lane >> 4;
    const size_t R0 = (size_t)b * TPB + 64 * c, row = R0 + (dir ? 63 - lane : lane);
    const bf16* rp = UXp + row * PROJ + h * 64 + 16 * wd; HgInC r;
    r.z0 = *(const GAS v4u*)(rp + (dir ? OFF_FB : OFF_FF)); r.z1 = *(const GAS v4u*)(rp + (dir ? OFF_FB : OFF_FF) + 8);
    r.q0 = *(const GAS v4u*)(rp + OFF_HQ); r.q1 = *(const GAS v4u*)(rp + OFF_HQ + 8);
    r.v0 = *(const GAS v4u*)(rp + OFF_I); r.v1 = *(const GAS v4u*)(rp + OFF_I + 8);
    const int ch = (b * 4 + h) * 2 + dir, pp = hg::scan_pos(c, dir);
    const bf16* sp = HGSp + ((size_t)ch * 132 + pp) * 4096 + (size_t)(16 * wd + l16) * 64;
#pragma unroll
    for (int ks = 0; ks < 2; ++ks) r.s[ks] = *(const GAS v4u*)(sp + 32 * ks + 8 * g);
#pragma unroll
    for (int ps = 0; ps < 2; ++ps) r.gr[ps] = *(const GAS u32x2*)(UXp + (R0 + 8 * w + 4 * ps + g) * PROJ + OFF_G + h * 64 + 4 * l16);
    r.lb = *(const GAS float*)(LBl + h * 64 + 16 * wd + l16);
    return r;
}
__device__ __forceinline__ void hgrn_c_phase(Frame& F, int l) {
    using namespace hg;
    const int lane = F.lane, w = F.wave, dir = w >> 2, wd = w & 3, l16 = lane & 15, g = lane >> 4, q = l16 >> 2, p = l16 & 3;
    LAS char* base = (LAS char*)(F.lds + RING_OFF);
    LAS char* QI = base + dir * 3 * IMG; LAS char* KI = QI + IMG; LAS char* VI = KI + IMG;
    LAS float* ES = (LAS float*)(base + 6 * IMG) + dir * 64;
    LAS float* OF = (LAS float*)(base + 6 * IMG + 512);
    const bf16* UXp = F.UX(); bf16* MIXp = F.MIX(); const bf16* HGSp = (const bf16*)F.HGS();
    const f32x4 gn = *(const GAS f32x4*)(F.hg_norm() + l * 64 + 4 * l16);
    const int c0 = (l == DEPTH - 1) ? 4 : 0, nch = TPB / 64 - c0, NU = NB * 4 * nch;
    const float* LBl = F.LB() + (dir * DEPTH + l) * 256;
    const int nfull = NU / F.G, rem = NU - nfull * F.G; const bool spread = rem <= F.G / 4;
    const int my_n = spread ? nfull + (((F.vcu & 3) == 2 && (F.vcu >> 2) < rem) ? 1 : 0) : nfull + (F.vcu < rem ? 1 : 0);
#define HGC_UNIT(i) (((i) < nfull) ? F.vcu + (i) * F.G : (spread ? nfull * F.G + (F.vcu >> 2) : F.vcu + (i) * F.G))
    HgInC nx = hg_load_c(UXp, HGSp, LBl, my_n > 0 ? HGC_UNIT(0) : 0, nch, c0, dir, wd, lane, w);
    for (int ui = 0; ui < my_n; ++ui) {
        const int unit = HGC_UNIT(ui);
        const int c = c0 + unit % nch, bh = unit / nch, b = bh >> 2, h = bh & 3;
        const size_t R0 = (size_t)b * TPB + 64 * c;
        STAMP(23);
        const HgInC in = nx;
        if (ui + 1 < my_n) nx = hg_load_c(UXp, HGSp, LBl, HGC_UNIT(ui + 1), nch, c0, dir, wd, lane, w);
        {
            float kk[16], cum[16];
            gates16(in.z0, in.z1, in.lb, lane, kk, cum);
            const unsigned qw[8] = {in.q0.x, in.q0.y, in.q0.z, in.q0.w, in.q1.x, in.q1.y, in.q1.z, in.q1.w};
            float qo[16], ko[16], ev = 0.f;
#pragma unroll
            for (int i = 0; i < 16; ++i) { const float ref = lane_bcast(cum[i], 31); const float dlt = cum[i] - ref; qo[i] = fminf(dlt, 115.f); ko[i] = fminf(-dlt, 115.f); ev = (lane == i) ? ref : ev; }
            HG_SB();
#pragma unroll
            for (int i = 0; i < 16; ++i) { qo[i] = hg_exp(qo[i]); ko[i] = hg_exp(ko[i]); }
            HG_SB();
#pragma unroll
            for (int i = 0; i < 16; ++i) { const float qv = (i & 1) ? bfhi(qw[i >> 1]) : bflo(qw[i >> 1]); qo[i] *= qv; ko[i] *= kk[i]; }
            st16(QI + lane * IP + 32 * wd, qo); st16(KI + lane * IP + 32 * wd, ko);
            *(LAS v4u*)(VI + lane * IP + 32 * wd) = in.v0; *(LAS v4u*)(VI + lane * IP + 32 * wd + 16) = in.v1;
            if (lane < 16) ES[16 * wd + lane] = hg_exp(ev);
        }
        LDS_BAR(); STAMP(20);
        {
            const int et = wd;
            bf16x8 Sf[2], Vf[2];
#pragma unroll
            for (int ks = 0; ks < 2; ++ks) { const v4u sw = in.s[ks];
                const f32x4 e0 = *(const LAS f32x4*)(ES + 32 * ks + 8 * g), e1 = *(const LAS f32x4*)(ES + 32 * ks + 8 * g + 4);
                v4u t; t.x = pk2(bflo(sw.x) * e0.x, bfhi(sw.x) * e0.y); t.y = pk2(bflo(sw.y) * e0.z, bfhi(sw.y) * e0.w); t.z = pk2(bflo(sw.z) * e1.x, bfhi(sw.z) * e1.y); t.w = pk2(bflo(sw.w) * e1.z, bfhi(sw.w) * e1.w); Sf[ks] = __builtin_bit_cast(bf16x8, t);
                const LAS char* b0 = VI + (32 * ks + 4 * g + q) * IP + (16 * et + 4 * p) * 2; Vf[ks] = cat8(trrd(b0), trrd(b0 + 16 * IP)); }
#pragma unroll
            for (int jb = 0; jb < 4; ++jb) {
                bf16x8 Qf[2];
#pragma unroll
                for (int ks = 0; ks < 2; ++ks) Qf[ks] = *(const LAS bf16x8*)(QI + (16 * jb + l16) * IP + (32 * ks + 8 * g) * 2);
                f32x4 o = (f32x4){0.f, 0.f, 0.f, 0.f};
#pragma unroll
                for (int ks = 0; ks < 2; ++ks) o = MFMA16(Qf[ks], Sf[ks], o);
#pragma unroll
                for (int a = 0; a <= (jb >> 1); ++a) {
                    f32x4 X[2];
#pragma unroll
                    for (int hh = 0; hh < 2; ++hh) { const int sb = 2 * a + hh; X[hh] = (f32x4){0.f, 0.f, 0.f, 0.f};
                        if (sb <= jb) {
#pragma unroll
                            for (int ks = 0; ks < 2; ++ks) X[hh] = MFMA16(*(const LAS bf16x8*)(KI + (16 * sb + l16) * IP + (32 * ks + 8 * g) * 2), Qf[ks], X[hh]);
                            if (sb == jb) {
#pragma unroll
                                for (int r = 0; r < 4; ++r) X[hh][r] = (4 * g + r <= l16) ? X[hh][r] : 0.f; } } }
                    v4u t; t.x = pk2(X[0][0], X[0][1]); t.y = pk2(X[0][2], X[0][3]); t.z = pk2(X[1][0], X[1][1]); t.w = pk2(X[1][2], X[1][3]);
                    o = MFMA16(__builtin_bit_cast(bf16x8, t), Vf[a], o);
                }
#pragma unroll
                for (int r = 0; r < 4; ++r) { const int j = 16 * jb + 4 * g + r, tok = dir ? 63 - j : j; OF[(dir * 64 + tok) * 64 + 16 * et + l16] = o[r]; }
            }
        }
        LDS_BAR(); STAMP(21);
        {
#pragma unroll
            for (int ps = 0; ps < 2; ++ps) { const int tok = 8 * w + 4 * ps + g;
                const f32x4 a = *(const LAS f32x4*)(OF + tok * 64 + 4 * l16), bq = *(const LAS f32x4*)(OF + (64 + tok) * 64 + 4 * l16); const f32x4 o = a + bq;
                float ss = (o.x * o.x + o.y * o.y) + (o.z * o.z + o.w * o.w);
                ss = xl_sum16(ss);
                const float rinv = 1.0f / sqrtf(ss * (1.0f / 64.0f) + EPS);
                const u32x2 graw = in.gr[ps];
                u32x2 wv; wv.x = pk2(o.x * rinv * gn.x * siluf_(bflo(graw.x)), o.y * rinv * gn.y * siluf_(bfhi(graw.x))); wv.y = pk2(o.z * rinv * gn.z * siluf_(bflo(graw.y)), o.w * rinv * gn.w * siluf_(bfhi(graw.y)));
                *(GAS u32x2*)(MIXp + (R0 + tok) * KMIX + MIX_R + h * 64 + 4 * l16) = wv; }
        }
        LDS_BAR(); STAMP(22);
    }
}

#ifndef R_P0A
#define R_P0A 1
#endif
#ifndef R_FFT
#define R_FFT 1
#endif
#ifndef R_HGA
#define R_HGA 1
#endif
#ifndef R_HGC
#define R_HGC 1
#endif
#ifndef R_ATT
#define R_ATT 1
#endif
#ifndef STAGGER_US
#define STAGGER_US 0
#endif
#define STAGGER() do { if (STAGGER_US > 0 && (F.vcu & 1)) { const unsigned long long t0_ = rt(); while (rt() - t0_ < (unsigned long long)(STAGGER_US * 100)) __builtin_amdgcn_s_sleep(16); } } while (0)
#ifndef MK_MULTI
#define MK_MULTI 0
#endif
constexpr int PH_L0 = 2, NPL = 7, PH_FINAL = PH_L0 + NPL, NPH = PH_FINAL + 1;
struct Args { const float* in[17]; float* out; unsigned char* ws; int l_lo, l_hi; };
template <int PH_LO, int PH_HI>
__global__ void __launch_bounds__(NTHREADS, 2) fwd_kernel(Args args) {
    extern __shared__ __attribute__((aligned(16))) unsigned char lds[];
    Frame F;
    F.lds = (LAS unsigned char*)lds;
    F.MISC = (volatile LAS unsigned*)(F.lds + MISC_OFF);
    F.tid = threadIdx.x; F.lane = F.tid & 63; F.wave = __builtin_amdgcn_readfirstlane(F.tid >> 6);
    const int wave0 = F.wave;
    F.G = gridDim.x; { const int bx = blockIdx.x; F.vcu = (F.G % 8 == 0) ? (bx % 8) * (F.G / 8) + bx / 8 : bx; }
    F.ws = (GAS unsigned char*)args.ws; F.outg = (GAS float*)args.out;
    for (int u = F.tid; u < (LDS_BYTES - LDSCTL_OFF) / 4; u += NTHREADS) ((LAS unsigned*)(F.lds + LDSCTL_OFF))[u] = 0u;
    __syncthreads();
    if (!MK_MULTI) (void)xcd_barrier_post((F.ctlw() + CW_BAR), F.MISC + 8);
#define IN(k) (PH_LO <= (k) && (k) < PH_HI)
#define RELANE() do { int ln_; asm volatile("v_mbcnt_lo_u32_b32 %0, -1, 0\n\tv_mbcnt_hi_u32_b32 %0, -1, %0" : "=v"(ln_)); F.lane = ln_; F.tid = wave0 * 64 + ln_; F.wave = wave0; unsigned long long w_ = (unsigned long long)F.ws, o_ = (unsigned long long)F.outg; asm volatile("" : "+s"(w_), "+s"(o_), "+s"(F.vcu), "+s"(F.G)); F.ws = (GAS unsigned char*)w_; F.outg = (GAS float*)o_; } while (0)
#define bx_() ({ int b_ = (int)blockIdx.x; asm volatile("" : "+s"(b_)); b_; })
#define SEAM(tag) do { if (!MK_MULTI) { unsigned long long w_ = (unsigned long long)F.ws; asm volatile("" : "+s"(w_)); XcdBarrier bar_; bar_.bar = (unsigned*)((GAS unsigned char*)w_ + WS_CTL) + CW_BAR; bar_.x = xb_xcc_id(); bar_.st = (volatile LAS unsigned*)(F.lds + MISC_OFF) + 8; xcd_barrier(bar_); }     \
    STAMP(tag); } while (0)
    F.dt = (DIAG_J >= 0) ? rt() : 0ull; F.da = 0ull;

    if (IN(0)) { for (int rep = 0; rep < R_P0A; ++rep) { RELANE(); p0a_prologue(F); SEAM(7); } }
    if (IN(1)) { RELANE(); p0b_fold(F); SEAM(8); }

    for (int l_it = args.l_lo; l_it < args.l_hi; ++l_it) {
        int l = l_it; asm volatile("" : "+s"(l));
        constexpr int s0 = PH_L0;
#define MODS_L (F.MODS() + (size_t)l * 5 * 6144)
        if (IN(s0 + 0)) { RELANE();
            pg8::Gemm g{F.HN(), F.WIN() + (size_t)l * PROJ * DM, MROWS, PROJ, DM, DM}; pg8::StaticOrder S; S.init(MROWS, PROJ, F.G, bx_());
            rinv_fill(F, S, F.BIASA() + (size_t)l * 5 * 2304, 2304);
            pg8::EpiBf16N E{F.UX(), PROJ, F.BIASA() + (size_t)l * 5 * 2304, 2304, (const LAS float*)(F.lds + RINV_OFF), F.ROWSS(), F.q_norm() + l * 64, F.k_norm() + l * 64, (const float*)F.ROPE(), QSCALE};
            pg8::gemm_phase<pg8::EpiBf16N, pg8::StaticOrder, PG8_ALIGN, PG8_SP2, DM, DM, Frame>(F.lds + RING_OFF, g, S, E, F.tid, F);
            SEAM(0);
        }
        if (IN(s0 + 1)) { STAMP(10); for (int rep = 0; rep < R_FFT; ++rep) { RELANE(); fourier_fast_phase(F); } STAMP(11); for (int rep = 0; rep < R_HGA; ++rep) { RELANE(); hgrn_a_phase(F, l); } SEAM(1); }
        if (IN(s0 + 2)) { RELANE(); hgrn_b_phase(F); SEAM(2); }
        if (IN(s0 + 3)) { for (int rep = 0; rep < R_ATT; ++rep) { RELANE(); attn_fast_phase(F, l); } STAMP(12); for (int rep = 0; rep < R_HGC; ++rep) { RELANE(); hgrn_c_phase(F, l); } SEAM(3); }
        if (IN(s0 + 4)) { RELANE();
            const int lastl = (l == DEPTH - 1);
            {
                pg8::Gemm g{F.MIX(), F.WOUT() + (size_t)l * DM * KMIX, MROWS, DM, KMIX, KMIX}; pg8::StaticOrder S; S.init(NB * SEQ, DM, F.G, bx_(), 1);
                pg8::EpiResGate E{F.XB(), MODS_L + MOD_G_A, MODS_L + MOD_SC_F, F.HN(), F.ROWSS()};
                pg8::gemm_phase<pg8::EpiResGate, pg8::StaticOrder, PG8_ALIGN, PG8_SP2, KMIX, KMIX, Frame>(F.lds + RING_OFF, g, S, E, F.tid, F);
            }
            if (!lastl) {
                RELANE();
                pg8::Gemm g{F.MIX(), F.WOUT() + (size_t)l * DM * KMIX, MROWS, DM, 256, KMIX}; pg8::CtxSplitOrder S; S.init(DM, KMIX, 256, F.G, bx_());
                pg8::EpiPartial E{F.HGS(), 256};
                pg8::gemm_phase<pg8::EpiPartial, pg8::CtxSplitOrder, PG8_ALIGN, PG8_SP2, 256, KMIX, Frame>(F.lds + RING_OFF, g, S, E, F.tid, F);
                SEAM(4); RELANE();
                { const float* m2 = F.MODS() + (size_t)l * 5 * 6144; ctx_reduce_pass<KMIX / 256>(F, F.HGS(), m2 + MOD_G_A, m2 + MOD_SC_F); }
            }
            SEAM(4);
        }
        if (IN(s0 + 5)) { RELANE();
            const int lastl = (l == DEPTH - 1);
            STAGGER();
            pg8::Gemm g{F.HN(), F.WGU() + (size_t)l * 5632 * DM, MROWS, 5632, DM, DM}; pg8::StaticOrder S; S.init(lastl ? NB * SEQ : MROWS, 5632, F.G, bx_(), lastl);
            rinv_fill(F, S, F.BIASF() + (size_t)l * 5 * 5632, 5632);
            pg8::EpiSwiGLU E{F.HB(), DFF, F.BIASF() + (size_t)l * 5 * 5632, 5632, (const LAS float*)(F.lds + RINV_OFF), F.ROWSS()};
            pg8::gemm_phase<pg8::EpiSwiGLU, pg8::StaticOrder, PG8_ALIGN, PG8_SP2, DM, DM, Frame>(F.lds + RING_OFF, g, S, E, F.tid, F);
            SEAM(5);
        }
        if (IN(s0 + 6)) { RELANE();
            const int lastl = (l == DEPTH - 1);
            {
                pg8::Gemm g{F.HB(), F.WDN() + (size_t)l * DM * DFF, MROWS, DM, DFF, DFF}; pg8::StaticOrder S; S.init(NB * SEQ, DM, F.G, bx_(), 1);
                pg8::EpiResGate E{F.XB(), MODS_L + MOD_G_F, (l + 1 < DEPTH) ? MODS_L + 5 * 6144 + MOD_SC_A : nullptr, F.HN(), F.ROWSS()};
                pg8::gemm_phase<pg8::EpiResGate, pg8::StaticOrder, PG8_ALIGN, PG8_SP2, DFF, DFF, Frame>(F.lds + RING_OFF, g, S, E, F.tid, F);
            }
            if (!lastl) {
                RELANE();
                pg8::Gemm g{F.HB(), F.WDN() + (size_t)l * DM * DFF, MROWS, DM, 256, DFF}; pg8::CtxSplitOrder S; S.init(DM, DFF, 256, F.G, bx_());
                pg8::EpiPartial E{F.HGS(), 256};
                pg8::gemm_phase<pg8::EpiPartial, pg8::CtxSplitOrder, PG8_ALIGN, PG8_SP2, 256, DFF, Frame>(F.lds + RING_OFF, g, S, E, F.tid, F);
                SEAM(6); RELANE();
                { const float* m2 = F.MODS() + (size_t)l * 5 * 6144; ctx_reduce_pass<DFF / 256>(F, F.HGS(), m2 + MOD_G_F, (l + 1 < DEPTH) ? m2 + 5 * 6144 + MOD_SC_A : nullptr); }
            }
            SEAM(6);
        }
    }
    if (IN(PH_FINAL)) { RELANE(); final_norm_phase(F); if (DIAG_J >= 0) { asm volatile("s_waitcnt vmcnt(0)" ::: "memory"); const unsigned long long t_ = rt(); if (DIAG_J == 9) F.da += t_ - F.dt;
        if (blockIdx.x == 0) { const unsigned long long tend = t_ + (unsigned long long)DIAG_A * F.da; while (rt() < tend) __builtin_amdgcn_s_sleep(32); } } }
#undef IN
#undef SEAM
}

#if MK_MULTI
#define MAIN_KERNEL (fwd_kernel<3, 4>)
#define LAUNCH(p) hipLaunchKernelGGL((fwd_kernel<p, p + 1>), dim3(grid), dim3(NTHREADS), LDS_BYTES, stream, a)
template <int P> static bool set_lds_one() { return hipFuncSetAttribute((const void*)fwd_kernel<P, P + 1>, hipFuncAttributeMaxDynamicSharedMemorySize, LDS_BYTES) == hipSuccess; }
static bool set_lds_all() { return set_lds_one<0>() && set_lds_one<1>() && set_lds_one<2>() && set_lds_one<3>() && set_lds_one<4>() && set_lds_one<5>() && set_lds_one<6>() && set_lds_one<7>() && set_lds_one<8>() && set_lds_one<9>() ; }
#else
#define MAIN_KERNEL (fwd_kernel<0, NPH>)
static bool set_lds_all() { return hipFuncSetAttribute((const void*)fwd_kernel<0, NPH>, hipFuncAttributeMaxDynamicSharedMemorySize, LDS_BYTES) == hipSuccess; }
#endif
extern "C" void kernel_launch(void* const* d_in, const int* in_sizes, int n_in, void* d_out, int out_size, void* d_ws, size_t ws_size, hipStream_t stream) {
    static int grid = 0;
    if (grid == 0) {
        if (n_in != 17 || in_sizes[0] != NB * SEQ * DM || out_size != NB * SEQ * DM || ws_size < WS_END) { fprintf(stderr, "kernel_launch: unexpected shapes (n_in %d, in0 %d, out %d, ws %zu < %zu); nothing launched\n", n_in, n_in > 0 ? in_sizes[0] : -1, out_size, ws_size, (size_t)WS_END); grid = -1; return; }
        int dev = 0, cus = 0, per_cu = 0;
        if (hipGetDevice(&dev) != hipSuccess || hipDeviceGetAttribute(&cus, hipDeviceAttributeMultiprocessorCount, dev) != hipSuccess) { grid = -1; return; }
        if (!set_lds_all()) { fprintf(stderr, "kernel_launch: hipFuncSetAttribute failed\n"); grid = -1; return; }
        if (hipOccupancyMaxActiveBlocksPerMultiprocessor(&per_cu, (const void*)MAIN_KERNEL, NTHREADS, LDS_BYTES) != hipSuccess || per_cu < 1) { fprintf(stderr, "kernel_launch: occupancy query says %d blocks per CU; nothing launched\n", per_cu); (void)hipGetLastError(); grid = -1; return; }
        grid = cus;
    }
    if (grid < 0) return;
    if (hipMemsetAsync((char*)d_ws + WS_CTL, 0, CTL_ZERO_BYTES, stream) != hipSuccess) return;
    Args a{};
    for (int i = 0; i < 17; ++i) a.in[i] = (const float*)d_in[i];
    a.out = (float*)d_out; a.ws = (unsigned char*)d_ws;
#if MK_MULTI
    a.l_lo = 0; a.l_hi = 0;
    LAUNCH(0); LAUNCH(1);
    for (int l = 0; l < DEPTH; ++l) { a.l_lo = l; a.l_hi = l + 1; LAUNCH(2); LAUNCH(3); LAUNCH(4); LAUNCH(5); LAUNCH(6); LAUNCH(7); LAUNCH(8); }
    a.l_lo = 0; a.l_hi = 0; LAUNCH(9);
#else
    a.l_lo = 0; a.l_hi = DEPTH;
    hipLaunchKernelGGL((fwd_kernel<0, NPH>), dim3(grid), dim3(NTHREADS), LDS_BYTES, stream, a);
#endif
}
```
